# Optimizing an MI355X kernel written in HIP

```python
import jax, jax.numpy as jnp
from jax import lax
import numpy as np

D_MODEL = 1024
BATCH = 2
SEQ = 8192
DEPTH = 2
DEC_BATCH = 32
DEC_SEQ = 4
PAST_LEN = 8192
PAGE_SIZE = 128

HEAD_DIM = 64
N_HEADS = D_MODEL // HEAD_DIM
N_KV = 4
HPG = N_HEADS // N_KV
Q_W = N_HEADS * HEAD_DIM
KV_W = N_KV * HEAD_DIM
NSA_SPLITS = tuple(Q_W + i * KV_W for i in range(7))
D_FF = ((8 * D_MODEL // 3 + 127) // 128) * 128
PLE_DIM = 256
CONV_W = 3
CMP_BLK = 64
SEL_BLK = 64
TOP_N = 16
WINDOW = 512
CMP_HID = 2 * HEAD_DIM
QBLK = 128
ROPE_THETA = 10000.0
RMS_EPS = 1e-6
FORCE_BONUS = 1e4
N_CONV = (DEPTH + 1) // 2
N_NSA = DEPTH // 2

kernel_name = 'hybrid_conv_nsa_macaron_step'


def rms_norm(x, g):
    x32 = x.astype(jnp.float32)
    y = x32 * lax.rsqrt(jnp.mean(x32 * x32, axis=-1, keepdims=True) + RMS_EPS)
    return (y * g.astype(jnp.float32)).astype(x.dtype)


def swiglu(h, w_gu, w_down):
    g, u = jnp.split(h @ w_gu, 2, axis=-1)
    return (jax.nn.silu(g) * u) @ w_down


def rope(x, pos):
    half = HEAD_DIM // 2
    inv = ROPE_THETA ** (-jnp.arange(half, dtype=jnp.float32) / half)
    ang = pos.astype(jnp.float32)[:, None] * inv
    ang = ang.reshape((pos.shape[0],) + (1,) * (x.ndim - 3) + (half,))
    cos, sin = jnp.cos(ang), jnp.sin(ang)
    x1 = x[..., :half].astype(jnp.float32)
    x2 = x[..., half:].astype(jnp.float32)
    return jnp.concatenate([x1 * cos - x2 * sin, x2 * cos + x1 * sin], axis=-1).astype(x.dtype)


def masked_softmax(s, mask):
    s = jnp.where(mask, s.astype(jnp.float32), -jnp.inf)
    m = jnp.max(s, axis=-1, keepdims=True)
    m = jnp.where(jnp.isfinite(m), m, 0.0)
    e = jnp.exp(s - m)
    return e / jnp.maximum(jnp.sum(e, axis=-1, keepdims=True), 1e-30)


def conv_mixer(h, prev, w_in, w_conv, w_out):
    t = h.shape[1]
    b_gate, c_gate, v = jnp.split(h @ w_in, 3, axis=-1)
    u = jnp.concatenate([prev.astype(h.dtype), c_gate * v], axis=1)
    y = sum(w_conv[j] * u[:, j:j + t] for j in range(CONV_W))
    return (b_gate * y) @ w_out, u[:, -(CONV_W - 1):]


def nsa_project(h, pos, w_in, qk_g):
    b, t, _ = h.shape
    q, kc, vc, ks, vs, kw, vw, gt = jnp.split(h @ w_in, NSA_SPLITS, axis=-1)
    heads = lambda a: a.reshape(b, t, N_KV, HEAD_DIM)
    q = rms_norm(q.reshape(b, t, N_KV, HPG, HEAD_DIM), qk_g[0])
    k_sel = rope(rms_norm(heads(ks), qk_g[2]), pos)
    k_win = rope(rms_norm(heads(kw), qk_g[3]), pos)
    gates = jax.nn.sigmoid(gt.reshape(b, t, N_KV, HPG, 3))
    return q, rope(q, pos), heads(kc), heads(vc), k_sel, heads(vs), k_win, heads(vw), gates


def compress(rows, pos_emb, w1, w2):
    b, l = rows.shape[:2]
    nb = l // CMP_BLK
    blk = rows[:, :nb * CMP_BLK].reshape(b, nb, CMP_BLK, N_KV, HEAD_DIM) + pos_emb[:, None, :]
    blk = blk.transpose(0, 1, 3, 2, 4).reshape(b, nb, N_KV, CMP_BLK * HEAD_DIM)
    return jax.nn.gelu(blk @ w1) @ w2


def to_blocks(rows):
    b, l = rows.shape[:2]
    nsb = -(-l // SEL_BLK)
    rows = jnp.pad(rows, ((0, 0), (0, nsb * SEL_BLK - l), (0, 0), (0, 0)))
    return rows.reshape(b, nsb, SEL_BLK, N_KV, HEAD_DIM).transpose(0, 3, 1, 2, 4)


def nsa_branches(q_nope, q_rope, gates, q_pos, kc, vc, ks_blk, vs_blk, kw, vw, kw_pos):
    scale = HEAD_DIM ** -0.5
    nb = kc.shape[1]
    nsb = ks_blk.shape[2]
    n_sel = min(TOP_N, nsb)
    s = jnp.einsum('bqghd,bngd->bghqn', q_nope, kc) * scale
    cmp_end = jnp.arange(nb) * CMP_BLK + (CMP_BLK - 1)
    p_cmp = masked_softmax(s, cmp_end[None, :] <= q_pos[:, None])
    o_cmp = jnp.einsum('bghqn,bngd->bqghd', p_cmp.astype(vc.dtype), vc)
    imp = jnp.pad(p_cmp.sum(axis=2), ((0, 0), (0, 0), (0, 0), (0, nsb - nb)))
    blk = jnp.arange(nsb)[None, :]
    cur = (q_pos // SEL_BLK)[:, None]
    forced = (blk == 0) | (blk == cur) | (blk == cur - 1)
    score = jnp.where(blk > cur, -jnp.inf, imp + jnp.where(forced, FORCE_BONUS, 0.0))
    top_s, idx = lax.top_k(score, n_sel)
    gather = jax.vmap(jax.vmap(lambda blocks, ix: blocks[ix]))
    lead = idx.shape[:3]
    k_g = gather(ks_blk, idx).reshape(lead + (n_sel * SEL_BLK, HEAD_DIM))
    v_g = gather(vs_blk, idx).reshape(lead + (n_sel * SEL_BLK, HEAD_DIM))
    k_pos = (idx[..., None] * SEL_BLK + jnp.arange(SEL_BLK)).reshape(lead + (n_sel * SEL_BLK,))
    sel_mask = (k_pos <= q_pos[:, None]) & jnp.repeat(jnp.isfinite(top_s), SEL_BLK, axis=-1)
    s = jnp.einsum('bqghd,bgqkd->bghqk', q_rope, k_g) * scale
    p_sel = masked_softmax(s, sel_mask[:, :, None])
    o_sel = jnp.einsum('bghqk,bgqkd->bqghd', p_sel.astype(v_g.dtype), v_g)
    diff = q_pos[:, None] - kw_pos[None, :]
    win_mask = (diff >= 0) & (diff < WINDOW) & (kw_pos >= 0)[None, :]
    s = jnp.einsum('bqghd,bkgd->bghqk', q_rope, kw) * scale
    p_win = masked_softmax(s, win_mask)
    o_win = jnp.einsum('bghqk,bkgd->bqghd', p_win.astype(vw.dtype), vw)
    return gates[..., 0:1] * o_cmp + gates[..., 1:2] * o_sel + gates[..., 2:3] * o_win


def nsa_prompt(h, w_in, qk_g, cmp_pos, cmp_w1, cmp_w2, w_out):
    b, t, _ = h.shape
    pos = jnp.arange(t)
    q_nope, q_rope, kc_r, vc_r, ks, vs, kw, vw, gates = nsa_project(h, pos, w_in, qk_g)
    kc = rms_norm(compress(kc_r, cmp_pos[0], cmp_w1[0], cmp_w2[0]), qk_g[1])
    vc = compress(vc_r, cmp_pos[1], cmp_w1[1], cmp_w2[1])
    ks_blk, vs_blk = to_blocks(ks), to_blocks(vs)
    pad = ((0, 0), (WINDOW, 0), (0, 0), (0, 0))
    kw_pad, vw_pad = jnp.pad(kw, pad), jnp.pad(vw, pad)

    def query_block(i):
        start = i * QBLK
        sl = lambda a, n: lax.dynamic_slice_in_dim(a, start, n, axis=1)
        q_pos = start + jnp.arange(QBLK)
        kw_pos = start - WINDOW + jnp.arange(QBLK + WINDOW)
        return nsa_branches(sl(q_nope, QBLK), sl(q_rope, QBLK), sl(gates, QBLK), q_pos, kc, vc,
                            ks_blk, vs_blk, sl(kw_pad, QBLK + WINDOW), sl(vw_pad, QBLK + WINDOW), kw_pos)

    o = lax.map(query_block, jnp.arange(t // QBLK))
    o = o.transpose(1, 0, 2, 3, 4, 5).reshape(b, t, Q_W)
    keep = min(WINDOW, t)
    return o @ w_out, (kc_r, vc_r, ks, vs, kw[:, -keep:], vw[:, -keep:])


def nsa_sample(h, k_cmp_pool, v_cmp_pool, k_sel_pool, v_sel_pool, k_win_buf, v_win_buf, page_table,
               w_in, qk_g, cmp_pos, cmp_w1, cmp_w2, w_out):
    b, t, _ = h.shape
    pos = PAST_LEN + jnp.arange(t)
    q_nope, q_rope, kc_r, vc_r, ks, vs, kw, vw, gates = nsa_project(h, pos, w_in, qk_g)
    gather_past = lambda pool: pool[page_table].reshape(b, -1, N_KV, HEAD_DIM)
    cat = lambda pool, new: jnp.concatenate([gather_past(pool).astype(new.dtype), new], axis=1)
    kc = rms_norm(compress(cat(k_cmp_pool, kc_r), cmp_pos[0], cmp_w1[0], cmp_w2[0]), qk_g[1])
    vc = compress(cat(v_cmp_pool, vc_r), cmp_pos[1], cmp_w1[1], cmp_w2[1])
    ks_blk, vs_blk = to_blocks(cat(k_sel_pool, ks)), to_blocks(cat(v_sel_pool, vs))
    w_buf = k_win_buf.shape[1]
    kw_all = jnp.concatenate([k_win_buf.astype(kw.dtype), kw], axis=1)
    vw_all = jnp.concatenate([v_win_buf.astype(vw.dtype), vw], axis=1)
    kw_pos = PAST_LEN - w_buf + jnp.arange(w_buf + t)
    o = nsa_branches(q_nope, q_rope, gates, pos, kc, vc, ks_blk, vs_blk, kw_all, vw_all, kw_pos)
    return o.reshape(b, t, Q_W) @ w_out, (kc_r, vc_r, ks, vs, kw_all[:, -w_buf:], vw_all[:, -w_buf:])


def macaron_layer(x, p, norm_g, w_gu, w_down, w_ple_proj, w_ple_gate, mixer):
    x = x + 0.5 * swiglu(rms_norm(x, norm_g[0]), w_gu[0], w_down[0])
    m, state = mixer(rms_norm(x, norm_g[1]))
    x = x + m
    x = x + 0.5 * swiglu(rms_norm(x, norm_g[2]), w_gu[1], w_down[1])
    x = x + jax.nn.sigmoid(rms_norm(x, norm_g[3]) @ w_ple_gate) * (p @ w_ple_proj)
    return x, state


def setup_inputs(seed: int = 0) -> dict:
    key = jax.random.key(seed)
    k = jax.random.split(key, 26)
    f32 = jnp.float32

    def nrm(kk, shape, scale=1.0):
        return scale * jax.random.normal(kk, shape, f32)

    n_pages = PAST_LEN // PAGE_SIZE
    n_used = DEC_BATCH * n_pages
    n_pool = n_used + max(1, n_used // 4)
    w_buf = min(WINDOW, PAST_LEN)
    pool = (N_NSA, n_pool, PAGE_SIZE, N_KV, HEAD_DIM)
    buf = (N_NSA, DEC_BATCH, w_buf, N_KV, HEAD_DIM)
    page_table = jax.random.permutation(k[9], n_pool)[:n_used].reshape(DEC_BATCH, n_pages).astype(jnp.int32)
    return {
        'x_prompt': nrm(k[0], (BATCH, SEQ, D_MODEL)),
        'x_sample': nrm(k[1], (DEC_BATCH, DEC_SEQ, D_MODEL)),
        'state_conv': nrm(k[2], (N_CONV, DEC_BATCH, CONV_W - 1, D_MODEL)),
        'cache_k_cmp': nrm(k[3], pool),
        'cache_v_cmp': nrm(k[4], pool),
        'cache_k_sel': nrm(k[5], pool),
        'cache_v_sel': nrm(k[6], pool),
        'cache_k_win': nrm(k[7], buf),
        'cache_v_win': nrm(k[8], buf),
        'page_table': page_table,
        'p_prompt': nrm(k[10], (DEPTH, BATCH, SEQ, PLE_DIM)),
        'p_sample': nrm(k[11], (DEPTH, DEC_BATCH, DEC_SEQ, PLE_DIM)),
        'norm_g': 1.0 + nrm(k[12], (DEPTH, 4, D_MODEL), 0.05),
        'ffn_w_gu': nrm(k[13], (DEPTH, 2, D_MODEL, 2 * D_FF), D_MODEL ** -0.5),
        'ffn_w_down': nrm(k[14], (DEPTH, 2, D_FF, D_MODEL), D_FF ** -0.5),
        'ple_w_proj': nrm(k[15], (DEPTH, PLE_DIM, D_MODEL), PLE_DIM ** -0.5),
        'ple_w_gate': nrm(k[16], (DEPTH, D_MODEL, D_MODEL), D_MODEL ** -0.5),
        'conv_w_in': nrm(k[17], (N_CONV, D_MODEL, 3 * D_MODEL), D_MODEL ** -0.5),
        'conv_w': nrm(k[18], (N_CONV, CONV_W, D_MODEL), CONV_W ** -0.5),
        'conv_w_out': nrm(k[19], (N_CONV, D_MODEL, D_MODEL), D_MODEL ** -0.5),
        'nsa_w_in': nrm(k[20], (N_NSA, D_MODEL, Q_W + 6 * KV_W + 3 * N_HEADS), D_MODEL ** -0.5),
        'nsa_qk_g': 1.0 + nrm(k[21], (N_NSA, 4, HEAD_DIM), 0.05),
        'nsa_cmp_pos': nrm(k[22], (N_NSA, 2, CMP_BLK, HEAD_DIM), 0.1),
        'nsa_cmp_w1': nrm(k[23], (N_NSA, 2, CMP_BLK * HEAD_DIM, CMP_HID), (CMP_BLK * HEAD_DIM) ** -0.5),
        'nsa_cmp_w2': nrm(k[24], (N_NSA, 2, CMP_HID, HEAD_DIM), CMP_HID ** -0.5),
        'nsa_w_out': nrm(k[25], (N_NSA, Q_W, D_MODEL), Q_W ** -0.5),
    }


def reference(x_prompt, x_sample, state_conv, cache_k_cmp, cache_v_cmp, cache_k_sel, cache_v_sel,
              cache_k_win, cache_v_win, page_table, p_prompt, p_sample, norm_g, ffn_w_gu, ffn_w_down,
              ple_w_proj, ple_w_gate, conv_w_in, conv_w, conv_w_out, nsa_w_in, nsa_qk_g, nsa_cmp_pos,
              nsa_cmp_w1, nsa_cmp_w2, nsa_w_out):
    conv_p_list, conv_s_list, nsa_p_list, nsa_s_list = [], [], [], []
    for i in range(DEPTH):
        j = i // 2
        lw = (norm_g[i], ffn_w_gu[i], ffn_w_down[i], ple_w_proj[i], ple_w_gate[i])
        if i % 2 == 0:
            cw = (conv_w_in[j], conv_w[j], conv_w_out[j])
            zero_prev = jnp.zeros((x_prompt.shape[0], CONV_W - 1, D_MODEL), x_prompt.dtype)
            x_prompt, st_p = macaron_layer(x_prompt, p_prompt[i], *lw,
                                           lambda h: conv_mixer(h, zero_prev, *cw))
            x_sample, st_s = macaron_layer(x_sample, p_sample[i], *lw,
                                           lambda h: conv_mixer(h, state_conv[j], *cw))
            conv_p_list.append(st_p)
            conv_s_list.append(st_s)
        else:
            nw = (nsa_w_in[j], nsa_qk_g[j], nsa_cmp_pos[j], nsa_cmp_w1[j], nsa_cmp_w2[j], nsa_w_out[j])
            x_prompt, st_p = macaron_layer(x_prompt, p_prompt[i], *lw, lambda h: nsa_prompt(h, *nw))
            x_sample, st_s = macaron_layer(
                x_sample, p_sample[i], *lw,
                lambda h: nsa_sample(h, cache_k_cmp[j], cache_v_cmp[j], cache_k_sel[j], cache_v_sel[j],
                                     cache_k_win[j], cache_v_win[j], page_table, *nw))
            nsa_p_list.append(st_p)
            nsa_s_list.append(st_s)
    conv_p = jnp.stack(conv_p_list)
    conv_s = jnp.stack(conv_s_list)
    k_cmp_p, v_cmp_p, k_sel_p, v_sel_p, k_win_p, v_win_p = [jnp.stack(a) for a in zip(*nsa_p_list)]
    k_cmp_s, v_cmp_s, k_sel_s, v_sel_s, k_win_s, v_win_s = [jnp.stack(a) for a in zip(*nsa_s_list)]
    return (x_prompt, x_sample, conv_p, conv_s, k_cmp_p, v_cmp_p, k_sel_p, v_sel_p, k_win_p, v_win_p,
            k_cmp_s, v_cmp_s, k_sel_s, v_sel_s, k_win_s, v_win_s)
```

```cpp
#include <hip/hip_runtime.h>
#include <cstdio>
#include <cstdint>

#define GAS __attribute__((address_space(1)))
#define LAS __attribute__((address_space(3)))
typedef unsigned short bf16;
typedef unsigned v4u __attribute__((ext_vector_type(4)));
typedef unsigned v2u __attribute__((ext_vector_type(2)));
typedef float f32x4 __attribute__((ext_vector_type(4)));
typedef float f32x2 __attribute__((ext_vector_type(2)));
typedef short bf16x8 __attribute__((ext_vector_type(8)));
typedef short s16x4 __attribute__((ext_vector_type(4)));
typedef GAS unsigned gu32;

constexpr int D = 1024, MP = 16384, MS = 128, MT = MP + MS, FF = 2816, NGU = 2 * FF, NCV = 3072, NNS = 2608, NNSP = 2816, PLE = 256;
constexpr int SEQ = 8192, SB = 32, ST = 4, PAST = 8192, NPAGE = 64, HD = 64, KVW = 256, WIN = 512, NBT = 34  ;
constexpr float RMS_EPS = 1e-6f;
constexpr float QSCALE = 0.125f * 1.4426950408889634f;

constexpr size_t O_Y = 0, O_YS = O_Y + (size_t)MP * D, O_CONVP = O_YS + (size_t)MS * D, O_CONVS = O_CONVP + 2 * 2 * D, O_KCP = O_CONVS + 32 * 2 * D;
constexpr size_t SZ_P = (size_t)MP * KVW, SZ_WP = 2 * 512 * KVW, SZ_S = (size_t)MS * KVW, SZ_WS = 32 * 512 * KVW;
constexpr size_t O_VCP = O_KCP + SZ_P, O_KSP = O_VCP + SZ_P, O_VSP = O_KSP + SZ_P, O_KWP = O_VSP + SZ_P, O_VWP = O_KWP + SZ_WP;
constexpr size_t O_KCS = O_VWP + SZ_WP, O_VCS = O_KCS + SZ_S, O_KSS = O_VCS + SZ_S, O_VSS = O_KSS + SZ_S, O_KWS = O_VSS + SZ_S, O_VWS = O_KWS + SZ_WS, O_END = O_VWS + SZ_WS;
static_assert(O_END == 42799104, "d_out size");

constexpr size_t MiB = 1u << 20;
constexpr size_t WS_CTL = 0, CTL_ZERO_BYTES = 1 * MiB;
constexpr size_t WS_WGU = 2 * MiB;
constexpr size_t SZ_WGU = (size_t)NGU * D * 2;
constexpr size_t WS_WDN = WS_WGU + 4 * SZ_WGU;
constexpr size_t SZ_WDN = (size_t)D * FF * 2;
constexpr size_t WS_WGATE = WS_WDN + 4 * SZ_WDN;
constexpr size_t SZ_WSQ = (size_t)D * D * 2;
constexpr size_t WS_WPROJ = WS_WGATE + 2 * SZ_WSQ;
constexpr size_t SZ_WPROJ = (size_t)D * PLE * 2;
constexpr size_t WS_WCIN = WS_WPROJ + 2 * SZ_WPROJ;
constexpr size_t WS_WCOUT = WS_WCIN + (size_t)NCV * D * 2;
constexpr size_t WS_WNIN = WS_WCOUT + SZ_WSQ;
constexpr size_t WS_WNOUT = WS_WNIN + (size_t)NNSP * D * 2;
constexpr size_t WS_W1T = WS_WNOUT + SZ_WSQ;
constexpr size_t WS_W2T = WS_W1T + 2 * (size_t)128 * 4096 * 2;
constexpr size_t WS_ROPE = WS_W2T + 2 * 64 * 128 * 2;
constexpr size_t WS_SS = (WS_ROPE + (size_t)8196 * 64 * 4 + MiB - 1) / MiB * MiB;
constexpr size_t SZ_SS = (size_t)MT * 16 * 4;
constexpr size_t WS_XB = (WS_SS + 2 * SZ_SS + MiB - 1) / MiB * MiB;
constexpr size_t SZ_XB = (size_t)MT * D * 2;
constexpr size_t WS_H = (WS_XB + 2 * SZ_XB + MiB - 1) / MiB * MiB;
constexpr size_t WS_AC = (WS_H + (size_t)MT * NCV * 2 + MiB - 1) / MiB * MiB;
constexpr size_t WS_PB = (WS_AC + SZ_XB + MiB - 1) / MiB * MiB;
constexpr size_t WS_P = (WS_PB + 2 * (size_t)MT * PLE * 2 + MiB - 1) / MiB * MiB;
constexpr size_t WS_QN = (WS_P + 2 * SZ_XB + MiB - 1) / MiB * MiB;
constexpr size_t WS_QR = (WS_QN + SZ_XB + MiB - 1) / MiB * MiB;
constexpr size_t SZ_KV = (size_t)MT * KVW * 2;
constexpr size_t WS_KS = (WS_QR + SZ_XB + MiB - 1) / MiB * MiB;
constexpr size_t WS_VS = WS_KS + SZ_KV, WS_KW = WS_VS + SZ_KV, WS_VW = WS_KW + SZ_KV;
constexpr size_t WS_GATES = (WS_VW + SZ_KV + MiB - 1) / MiB * MiB;
constexpr size_t WS_KC = (WS_GATES + (size_t)MT * 48 * 4 + MiB - 1) / MiB * MiB;
constexpr size_t SZ_KC = (size_t)NBT * 4 * 128 * 64 * 2;
constexpr size_t WS_VC = (WS_KC + SZ_KC + MiB - 1) / MiB * MiB;
constexpr size_t WS_CPART = (WS_VC + SZ_KC + MiB - 1) / MiB * MiB;
constexpr size_t WS_CBIAS = WS_CPART + 2 * 64 * 128 * 4;
constexpr size_t WS_END = WS_CPART + MiB;

constexpr int CW_TMO = 0, CW_CODE = 1, CW_BAR = 4096;

constexpr int RING_BYTES = 131072, LDSCTL_OFF = RING_BYTES, MISC_OFF = LDSCTL_OFF + 320, LDS_BYTES = 147456;
constexpr int NWAVES = 8;

#define RLX_AGENT __ATOMIC_RELAXED, __HIP_MEMORY_SCOPE_AGENT
#define LDS_WAIT() asm volatile("s_waitcnt lgkmcnt(0)" ::: "memory")
#define VM_WAIT() asm volatile("s_waitcnt vmcnt(0)" ::: "memory")

typedef float f2v __attribute__((ext_vector_type(2)));
typedef __bf16 b2v __attribute__((ext_vector_type(2)));
__device__ __forceinline__ unsigned pk2(float lo, float hi) { f2v v = {lo, hi}; b2v b = __builtin_convertvector(v, b2v); return __builtin_bit_cast(unsigned, b); }
__device__ __forceinline__ float bflo(unsigned u) { return __uint_as_float(u << 16); }
__device__ __forceinline__ float bfhi(unsigned u) { return __uint_as_float(u & 0xffff0000u); }
__device__ __forceinline__ float fast_exp2(float x) { return __builtin_amdgcn_exp2f(x); }
__device__ __forceinline__ float sigmoidf_(float x) { return __builtin_amdgcn_rcpf(1.f + fast_exp2(-1.4426950408889634f * x)); }

namespace pg8 {
#define PG8_LAS __attribute__((address_space(3)))
typedef unsigned short bf16_t;
typedef short bf16x8 __attribute__((ext_vector_type(8)));
typedef float f32x4 __attribute__((ext_vector_type(4)));
typedef unsigned u32x4 __attribute__((ext_vector_type(4)));
constexpr int BM = 256, BK = 64, HALF = 128, HTB = HALF * BK * 2  , STAGE_BYTES = 8 * HTB, NXCD = 8, WGM = 8;

__host__ __device__ __forceinline__ int lds_byte(int r, int c) { const int st = (r >> 4) * 2 + (c >> 5), rr = r & 15, cc = c & 31, ob = rr * 64 + cc * 2; return st * 1024 + (ob ^ (((ob >> 9) & 1) << 5)); }
__host__ __device__ __forceinline__ void stage_rc(int b, int& R, int& C) { const int st = b / 1024, sb = b % 1024, swz = sb ^ (((sb >> 9) & 1) << 5); R = (st >> 1) * 16 + swz / 64; C = (st & 1) * 32 + (swz % 64) / 2; }
__host__ __device__ __forceinline__ int perm32(int rho) { const int n = rho >> 4, i = rho & 15; return 8 * (i >> 2) + 4 * n + (i & 3); }

struct Unit { int pm, pn; };
struct Gemm { const bf16_t* A; const bf16_t* Bt; int M, N, K; };

struct StaticOrder {
    int nM, nN, nwg, G, c;
    __host__ __device__ void init(int M, int N, int G_, int c_) { nM = M / BM; nN = N / BM; nwg = nM * nN; G = G_; c = c_; }
    __host__ __device__ bool next(int i, Unit& u) const {
        const long L = (long)i * G + c; if (L >= nwg) return false;
        int wgid = (int)L; { const int q = nwg / NXCD, r = nwg % NXCD, xcd = wgid % NXCD, off = wgid / NXCD; wgid = (xcd < r ? xcd * (q + 1) : r * (q + 1) + (xcd - r) * q) + off; }
        const int nig = WGM * nN, gid = wgid / nig, fm = gid * WGM, gsz = (nM - fm) < WGM ? (nM - fm) : WGM;
        u.pm = fm + ((wgid % nig) % gsz); u.pn = (wgid % nig) / gsz; return true;
    }
    __device__ __forceinline__ void a_ready(const Unit&) const {}
    __device__ __forceinline__ void done(const Unit&) const {}
};
template <class Epi, class Sched, bool ALIGN_EPI = false, bool SP2 = false>
__device__ __forceinline__ void gemm_phase(PG8_LAS unsigned char* lds, const Gemm g, const Sched& S, const Epi& E) {
    int tid_ = threadIdx.x; asm volatile("" : "+v"(tid_));
    const int tid = tid_, wid = __builtin_amdgcn_readfirstlane(tid >> 6), lane = tid & 63, wr = wid >> 2, wc = wid & 3, fr = lane & 15, fq = lane >> 4;
    const int K = g.K, nt = K / BK;
    unsigned voffA[2], voffB[2];
#pragma unroll
    for (int i = 0; i < 2; ++i) { int R, C; stage_rc(tid * 16 + i * 8192, R, C); const int Rb = Epi::PERM ? ((R & ~31) + perm32(R & 31)) : R;
        voffA[i] = (unsigned)(R * K + C) * 2u; voffB[i] = (unsigned)(Rb * K + C) * 2u; }
    const size_t kstep = (size_t)(BK * 2);
    const size_t hstep = (size_t)HALF * K * 2;
    const size_t tstep = 2 * hstep;
    const unsigned ldsw = (unsigned)wid * 1024u;
    const int aoff = lds_byte(wr * 64 + fr, fq * 8), boff = lds_byte(wc * 32 + fr, fq * 8);
#define PG8_SA(b, h) (((b) * 2 + (h)) * HTB)
#define PG8_SB(b, h) ((4 + (b) * 2 + (h)) * HTB)
#define PG8_STAGE(bufoff, gbase, voff) do { _Pragma("unroll") for (int _i = 0; _i < 2; ++_i) \
        __builtin_amdgcn_global_load_lds((const unsigned*)((const char*)(gbase) + (voff)[_i]), (PG8_LAS unsigned*)(lds + (bufoff) + ldsw + _i * 8192), 16, 0, 0); } while (0)
#define PG8_LDA(dst, b, h) do { _Pragma("unroll") for (int m = 0; m < 4; ++m) _Pragma("unroll") for (int k = 0; k < 2; ++k) dst[m][k] = *(const PG8_LAS bf16x8*)(lds + PG8_SA(b, h) + aoff + m * 2048 + k * 1024); } while (0)
#define PG8_LDB(dst, b, h) do { _Pragma("unroll") for (int n = 0; n < 2; ++n) _Pragma("unroll") for (int k = 0; k < 2; ++k) dst[n][k] = *(const PG8_LAS bf16x8*)(lds + PG8_SB(b, h) + boff + n * 2048 + k * 1024); } while (0)
#define PG8_MMA(ai, bj, At, Bt) do { __builtin_amdgcn_s_setprio(1); _Pragma("unroll") for (int m = 0; m < 4; ++m) _Pragma("unroll") for (int n = 0; n < 2; ++n) _Pragma("unroll") for (int k = 0; k < 2; ++k) \
        acc[ai][bj][m][n] = __builtin_amdgcn_mfma_f32_16x16x32_bf16(Bt[n][k], At[m][k], acc[ai][bj][m][n], 0, 0, 0); __builtin_amdgcn_s_setprio(0); } while (0)
#define PG8_WAIT_V(n) asm volatile("s_waitcnt vmcnt(" #n ")" ::: "memory")
#define PG8_WAIT_L(n) asm volatile("s_waitcnt lgkmcnt(" #n ")" ::: "memory")
#define PG8_BAR __builtin_amdgcn_s_barrier()
#define PG8_SCHED __builtin_amdgcn_sched_barrier(0)
    Unit cur, nxt; int ui = 0;
    if (!S.next(0, cur)) return;
    f32x4 acc[2][2][4][2];
#pragma unroll
    for (int a = 0; a < 2; ++a)
#pragma unroll
        for (int b = 0; b < 2; ++b)
#pragma unroll
            for (int m = 0; m < 4; ++m)
#pragma unroll
                for (int n = 0; n < 2; ++n) acc[a][b][m][n] = (f32x4){0.f, 0.f, 0.f, 0.f};
    bf16x8 At[4][2], B0[2][2], B1[2][2];
    const char* cA = (const char*)g.A + (size_t)cur.pm * tstep; const char* cB = (const char*)g.Bt + (size_t)cur.pn * tstep;
    S.a_ready(cur);
    if constexpr (SP2) {
        PG8_STAGE(PG8_SB(0, 0), cB, voffB); PG8_STAGE(PG8_SB(0, 1), cB + hstep, voffB); PG8_STAGE(PG8_SA(0, 0), cA, voffA); PG8_STAGE(PG8_SA(0, 1), cA + hstep, voffA);
        if (wr == 1) PG8_BAR;
        PG8_WAIT_V(2); PG8_BAR;
        PG8_STAGE(PG8_SB(1, 0), cB + kstep, voffB); PG8_STAGE(PG8_SA(1, 0), cA + kstep, voffA); PG8_STAGE(PG8_SB(1, 1), cB + hstep + kstep, voffB);
        PG8_WAIT_V(6); PG8_BAR;
    } else {
        PG8_STAGE(PG8_SB(0, 0), cB, voffB); PG8_STAGE(PG8_SA(0, 0), cA, voffA); PG8_STAGE(PG8_SB(0, 1), cB + hstep, voffB); PG8_STAGE(PG8_SA(0, 1), cA + hstep, voffA);
        if (wr == 1) PG8_BAR;
        PG8_WAIT_V(4); PG8_BAR;
        PG8_STAGE(PG8_SB(1, 0), cB + kstep, voffB); PG8_STAGE(PG8_SA(1, 0), cA + kstep, voffA); PG8_STAGE(PG8_SB(1, 1), cB + hstep + kstep, voffB);
        PG8_WAIT_V(6); PG8_BAR;
    }
    for (;;) {
        const bool has_next = S.next(ui + 1, nxt);
        const char* nA = has_next ? (const char*)g.A + (size_t)nxt.pm * tstep : cA; const char* nB = has_next ? (const char*)g.Bt + (size_t)nxt.pn * tstep : cB;
        for (int t = 0; t < nt; t += 2) {
            const bool last = (t == nt - 2);
            const char* a1 = cA + (size_t)(t + 1) * kstep;
            const char* a2 = last ? nA : cA + (size_t)(t + 2) * kstep; const char* b2 = last ? nB : cB + (size_t)(t + 2) * kstep;
            const char* a3 = a2 + kstep; const char* b3 = b2 + kstep;
            if (last && has_next) S.a_ready(nxt);
            if constexpr (SP2) {
            PG8_LDB(B0, 0, 0); PG8_LDB(B1, 0, 1); PG8_SCHED; PG8_LDA(At, 0, 0); PG8_STAGE(PG8_SA(1, 1), a1 + hstep, voffA);
            PG8_WAIT_V(8); PG8_WAIT_L(0); PG8_BAR; PG8_MMA(0, 0, At, B0); PG8_MMA(0, 1, At, B1); PG8_BAR; PG8_SCHED;
            PG8_LDA(At, 0, 1); PG8_STAGE(PG8_SB(0, 0), b2, voffB); PG8_STAGE(PG8_SB(0, 1), b2 + hstep, voffB); PG8_STAGE(PG8_SA(0, 0), a2, voffA);
            PG8_WAIT_V(8); PG8_WAIT_L(0); PG8_BAR; PG8_MMA(1, 0, At, B0); PG8_MMA(1, 1, At, B1); PG8_BAR; PG8_SCHED;
            PG8_LDB(B0, 1, 0); PG8_LDB(B1, 1, 1); PG8_SCHED; PG8_LDA(At, 1, 0); PG8_STAGE(PG8_SA(0, 1), a2 + hstep, voffA);
            PG8_WAIT_V(8); PG8_WAIT_L(0); PG8_BAR; PG8_MMA(0, 0, At, B0); PG8_MMA(0, 1, At, B1); PG8_BAR; PG8_SCHED;
            PG8_LDA(At, 1, 1); PG8_STAGE(PG8_SB(1, 0), b3, voffB); PG8_STAGE(PG8_SB(1, 1), b3 + hstep, voffB); PG8_STAGE(PG8_SA(1, 0), a3, voffA);
            PG8_WAIT_V(8); PG8_WAIT_L(0); PG8_BAR; PG8_MMA(1, 0, At, B0); PG8_MMA(1, 1, At, B1); PG8_BAR; PG8_SCHED;
            } else {
            PG8_LDB(B0, 0, 0); PG8_SCHED; PG8_LDA(At, 0, 0); PG8_STAGE(PG8_SA(1, 1), a1 + hstep, voffA);
            PG8_WAIT_L(8); PG8_BAR; PG8_WAIT_L(0); PG8_MMA(0, 0, At, B0); PG8_BAR; PG8_SCHED;
            PG8_LDB(B1, 0, 1); PG8_STAGE(PG8_SB(0, 0), b2, voffB);
            PG8_BAR; PG8_WAIT_L(0); PG8_MMA(0, 1, At, B1); PG8_BAR;
            PG8_LDA(At, 0, 1); PG8_STAGE(PG8_SA(0, 0), a2, voffA);
            PG8_BAR; PG8_WAIT_L(0); PG8_MMA(1, 0, At, B0); PG8_BAR; PG8_SCHED;
            PG8_STAGE(PG8_SB(0, 1), b2 + hstep, voffB);
            PG8_WAIT_V(6); PG8_BAR; PG8_MMA(1, 1, At, B1); PG8_BAR;
            PG8_LDB(B0, 1, 0); PG8_SCHED; PG8_LDA(At, 1, 0); PG8_STAGE(PG8_SA(0, 1), a2 + hstep, voffA);
            PG8_WAIT_L(8); PG8_BAR; PG8_WAIT_L(0); PG8_MMA(0, 0, At, B0); PG8_BAR; PG8_SCHED;
            PG8_LDB(B1, 1, 1); PG8_STAGE(PG8_SB(1, 0), b3, voffB);
            PG8_BAR; PG8_WAIT_L(0); PG8_MMA(0, 1, At, B1); PG8_BAR;
            PG8_LDA(At, 1, 1); PG8_STAGE(PG8_SA(1, 0), a3, voffA);
            PG8_BAR; PG8_WAIT_L(0); PG8_MMA(1, 0, At, B0); PG8_BAR; PG8_SCHED;
            PG8_STAGE(PG8_SB(1, 1), b3 + hstep, voffB);
            PG8_WAIT_V(6); PG8_BAR; PG8_MMA(1, 1, At, B1); PG8_BAR;
            }
        }
        if constexpr (ALIGN_EPI) { if (wr == 0) PG8_BAR; }
        if constexpr (!Epi::AFTER_DRAIN) { E(acc, cur, wr, wc, fr, fq); S.done(cur); }
        if (!has_next) break;
#pragma unroll
        for (int a = 0; a < 2; ++a)
#pragma unroll
            for (int b = 0; b < 2; ++b)
#pragma unroll
                for (int m = 0; m < 4; ++m)
#pragma unroll
                    for (int n = 0; n < 2; ++n) acc[a][b][m][n] = (f32x4){0.f, 0.f, 0.f, 0.f};
        cur = nxt; cA = nA; cB = nB; ++ui;
        if constexpr (ALIGN_EPI) { if (wr == 1) PG8_BAR; }
    }
    PG8_WAIT_V(0);
    if constexpr (!ALIGN_EPI) { if (wr == 0) PG8_BAR; }
    PG8_BAR;
    if constexpr (Epi::AFTER_DRAIN) { E.fused(acc, cur, wr, wc, fr, fq, lds, wid, lane); S.done(cur); }
#undef PG8_SA
#undef PG8_SB
#undef PG8_STAGE
#undef PG8_LDA
#undef PG8_LDB
#undef PG8_MMA
#undef PG8_WAIT_V
#undef PG8_WAIT_L
#undef PG8_BAR
#undef PG8_SCHED
}

__device__ __forceinline__ float rstd_of(const float* ss, int row, int fq) {
    const f32x4 v = *(const f32x4*)(ss + (size_t)row * 16 + 4 * fq);
    float s = (v[0] + v[1]) + (v[2] + v[3]);
    s += __shfl_xor(s, 16); s += __shfl_xor(s, 32);
    return __builtin_amdgcn_rsqf(s * (1.f / 1024.f) + 1e-6f);
}
template <bool NORM> struct EpiRaw {
    static constexpr bool PERM = true, AFTER_DRAIN = false;
    bf16_t* O; int ldc; const float* ss;
    __device__ __forceinline__ void operator()(const f32x4 (&acc)[2][2][4][2], const Unit& u, int wr, int wc, int fr, int fq) const {
        const int row0 = u.pm * BM + wr * 64 + fr, col0 = u.pn * BM + wc * 32 + 8 * fq;
#pragma unroll
        for (int ai = 0; ai < 2; ++ai)
#pragma unroll
            for (int m = 0; m < 4; ++m) { const int row = row0 + ai * HALF + m * 16; const float r = NORM ? rstd_of(ss, row, fq) : 1.f;
                bf16_t* rowp = O + (size_t)row * ldc + col0;
#pragma unroll
                for (int bj = 0; bj < 2; ++bj) { const f32x4 v0 = acc[ai][bj][m][0] * r, v1 = acc[ai][bj][m][1] * r;
                    u32x4 w; w.x = pk2(v0[0], v0[1]); w.y = pk2(v0[2], v0[3]); w.z = pk2(v1[0], v1[1]); w.w = pk2(v1[2], v1[3]);
                    *(u32x4*)(rowp + bj * HALF) = w; } }
    }
};
struct EpiSwiglu {
    static constexpr bool PERM = true, AFTER_DRAIN = false;
    bf16_t* H; const float* ss;
    __device__ __forceinline__ void operator()(const f32x4 (&acc)[2][2][4][2], const Unit& u, int wr, int wc, int fr, int fq) const {
        const int row0 = u.pm * BM + wr * 64 + fr, col0 = u.pn * HALF + wc * 32 + 8 * fq;
#pragma unroll
        for (int ai = 0; ai < 2; ++ai)
#pragma unroll
            for (int m = 0; m < 4; ++m) { const int row = row0 + ai * HALF + m * 16; const float r = rstd_of(ss, row, fq);
                float h[8];
#pragma unroll
                for (int n = 0; n < 2; ++n)
#pragma unroll
                    for (int e = 0; e < 4; ++e) { const float g = acc[ai][0][m][n][e] * r, uu = acc[ai][1][m][n][e] * r; h[4 * n + e] = g * sigmoidf_(g) * uu; }
                u32x4 w; w.x = pk2(h[0], h[1]); w.y = pk2(h[2], h[3]); w.z = pk2(h[4], h[5]); w.w = pk2(h[6], h[7]);
                *(u32x4*)(H + (size_t)row * FF + col0) = w; }
    }
};
template <bool GATE, bool FINAL> struct EpiResid {
    static constexpr bool PERM = true, AFTER_DRAIN = false;
    float* X; bf16_t* XBo; float* SSo; float scale; const float* ss_in; const bf16_t* P;
    __device__ __forceinline__ void operator()(const f32x4 (&acc)[2][2][4][2], const Unit& u, int wr, int wc, int fr, int fq) const {
        const int row0 = u.pm * BM + wr * 64 + fr, col0 = u.pn * BM + wc * 32 + 8 * fq;
#pragma unroll
        for (int ai = 0; ai < 2; ++ai)
#pragma unroll
            for (int m = 0; m < 4; ++m) { const int row = row0 + ai * HALF + m * 16; float r = 0.f; if (GATE) r = rstd_of(ss_in, row, fq);
                float sq = 0.f;
#pragma unroll
                for (int bj = 0; bj < 2; ++bj) { float* xp = X + (size_t)row * D + col0 + bj * HALF;
                    f32x4 x0 = *(const f32x4*)xp, x1 = *(const f32x4*)(xp + 4); const f32x4 a0 = acc[ai][bj][m][0], a1 = acc[ai][bj][m][1];
                    if (GATE) { const u32x4 pw = *(const u32x4*)(P + (size_t)row * D + col0 + bj * HALF);
                        x0[0] += sigmoidf_(a0[0] * r) * bflo(pw.x); x0[1] += sigmoidf_(a0[1] * r) * bfhi(pw.x); x0[2] += sigmoidf_(a0[2] * r) * bflo(pw.y); x0[3] += sigmoidf_(a0[3] * r) * bfhi(pw.y);
                        x1[0] += sigmoidf_(a1[0] * r) * bflo(pw.z); x1[1] += sigmoidf_(a1[1] * r) * bfhi(pw.z); x1[2] += sigmoidf_(a1[2] * r) * bflo(pw.w); x1[3] += sigmoidf_(a1[3] * r) * bfhi(pw.w);
                    } else { x0 += a0 * scale; x1 += a1 * scale; }
                    *(f32x4*)xp = x0; *(f32x4*)(xp + 4) = x1;
                    if (!FINAL) { u32x4 w; w.x = pk2(x0[0], x0[1]); w.y = pk2(x0[2], x0[3]); w.z = pk2(x1[0], x1[1]); w.w = pk2(x1[2], x1[3]);
                        *(u32x4*)(XBo + (size_t)row * D + col0 + bj * HALF) = w;
                        sq += (x0[0] * x0[0] + x0[1] * x0[1]) + (x0[2] * x0[2] + x0[3] * x0[3]) + (x1[0] * x1[0] + x1[1] * x1[1]) + (x1[2] * x1[2] + x1[3] * x1[3]); } }
                if (!FINAL) { sq += __shfl_xor(sq, 16); sq += __shfl_xor(sq, 32); if (fq == 0) SSo[(size_t)row * 16 + u.pn * 4 + wc] = sq; } }
    }
};
}
typedef pg8::StaticOrder GOrder;

#define XB_TMO      128
#define XB_XCNT(j)  (256  + 64 * (j))
#define XB_XSUB(j)  (1280 + 64 * (j))
#define XB_XGEN(j)  (2304 + 64 * (j))
#define XB_TOP      3328
#define XB_TOPGEN   3392
#define XCD_BAR_WORDS 3456
#define XB_SPIN_CAP (1u << 18)

__device__ __forceinline__ unsigned xb_ld(unsigned* p)              { return __hip_atomic_load(p, __ATOMIC_RELAXED, __HIP_MEMORY_SCOPE_AGENT); }
__device__ __forceinline__ unsigned xb_add(unsigned* p, unsigned v) { return __hip_atomic_fetch_add(p, v, __ATOMIC_RELAXED, __HIP_MEMORY_SCOPE_AGENT); }
__device__ __forceinline__ unsigned xb_xcc_id() { return (unsigned)__builtin_amdgcn_s_getreg((3 << 11) | 20) & 0xFu; }
#define XB_SPIN(cond, bar) do { unsigned _sp = 0; while (cond) { __builtin_amdgcn_s_sleep(1); \
    if ((++_sp & 255u) == 0u) { if (xb_ld(&(bar)[XB_TMO])) break; if (_sp > XB_SPIN_CAP) { atomicAdd(&(bar)[XB_TMO], 1u); break; } } } } while (0)

struct XcdBarrier {
    unsigned* bar; unsigned x;
    volatile LAS unsigned* st;
};

__device__ __forceinline__ XcdBarrier xcd_barrier_post(unsigned* bar, volatile LAS unsigned* st) {
    XcdBarrier b; b.bar = bar; b.x = xb_xcc_id(); b.st = st;
    if (threadIdx.x == 0) (void)xb_add(&bar[XB_XCNT(b.x)], 1u);
    return b;
}
__device__ __forceinline__ void xcd_barrier_complete(unsigned* bar, unsigned x, unsigned& nloc, unsigned& nx) {
    const unsigned G = gridDim.x * gridDim.y * gridDim.z;
    unsigned sum, cnt, mine, sp = 0u;
    for (;;) {
        sum = 0u; cnt = 0u; mine = 0u;
#pragma unroll
        for (unsigned j = 0; j < 16; ++j) { const unsigned c = xb_ld(&bar[XB_XCNT(j)]); sum += c; cnt += (c > 0u) ? 1u : 0u; mine = (j == x) ? c : mine; }
        if (sum == G) break;
        __builtin_amdgcn_s_sleep(1);
        if ((++sp & 255u) == 0u) { if (xb_ld(&bar[XB_TMO])) break; if (sp > XB_SPIN_CAP) { atomicAdd(&bar[XB_TMO], 1u); break; } }
    }
    nloc = mine > 0u ? mine : 1u; nx = cnt > 0u ? cnt : 1u;
}

__device__ __forceinline__ void xcd_barrier(const XcdBarrier& b) {
    asm volatile("s_waitcnt vmcnt(0)" ::: "memory");
    __syncthreads();
    if (threadIdx.x == 0) {
        unsigned* bar = b.bar;
        __builtin_amdgcn_s_waitcnt(0);
        unsigned nloc = b.st[0], nx = b.st[1];
        if (nloc == 0u) { xcd_barrier_complete(bar, b.x, nloc, nx); b.st[0] = nloc; b.st[1] = nx; }
        const unsigned old = xb_add(&bar[XB_XSUB(b.x)], 1u);
        const unsigned gen = old / nloc;
        if (old + 1u == (gen + 1u) * nloc) {
            __builtin_amdgcn_fence(__ATOMIC_RELEASE, "agent");
            asm volatile("s_waitcnt vmcnt(0)" ::: "memory");
            const unsigned og = xb_add(&bar[XB_TOP], 1u);
            const unsigned tg = og / nx;
            if (og + 1u == (tg + 1u) * nx) xb_add(&bar[XB_TOPGEN], 1u);
            else XB_SPIN(xb_ld(&bar[XB_TOPGEN]) == tg, bar);
            __builtin_amdgcn_fence(__ATOMIC_ACQUIRE, "agent");
            xb_add(&bar[XB_XGEN(b.x)], 1u);
            asm volatile("s_waitcnt vmcnt(0)" ::: "memory");
        } else {
            XB_SPIN(xb_ld(&bar[XB_XGEN(b.x)]) == gen, bar);
            __builtin_amdgcn_fence(__ATOMIC_ACQUIRE, "agent");
            asm volatile("s_waitcnt vmcnt(0)" ::: "memory");
        }
    }
    __syncthreads();
}

__device__ __forceinline__ float wave_sum(float v) {
#pragma unroll
    for (int o = 1; o < 64; o <<= 1) v += __shfl_xor(v, o);
    return v;
}
__device__ __forceinline__ void st_bf16x8(bf16* p, const float* v) { v4u w; w.x = pk2(v[0], v[1]); w.y = pk2(v[2], v[3]); w.z = pk2(v[4], v[5]); w.w = pk2(v[6], v[7]); *(v4u*)p = w; }
__device__ __forceinline__ void ld_bf16x8(const bf16* p, float* v) { const v4u w = *(const v4u*)p; v[0] = bflo(w.x); v[1] = bfhi(w.x); v[2] = bflo(w.y); v[3] = bfhi(w.y); v[4] = bflo(w.z); v[5] = bfhi(w.z); v[6] = bflo(w.w); v[7] = bfhi(w.w); }

template <int MODE> __device__ __forceinline__ int sk_brow(int cu, int j) {
    if (MODE == 0) return cu * 64 + j;
    const int T = cu >> 2, q = cu & 3; return T * 256 + q * 32 + (j & 31) + ((j >> 5) ? 128 : 0);
}
template <int MODE, class Epi>
__device__ __forceinline__ void skinny_phase(LAS unsigned char* lds, const bf16* A, const bf16* Bt, int K, int ncu, const Epi& E, int vcu, int G) {
    int tid_ = threadIdx.x; asm volatile("" : "+v"(tid_));
    const int tid = tid_, wave = __builtin_amdgcn_readfirstlane(tid >> 6), lane = tid & 63, fr = lane & 15, fq = lane >> 4;
    LAS float* part = (LAS float*)lds;
    LAS float* tile = (LAS float*)(lds + 65536);
    const int kw = K >> 3, k0 = wave * kw, nst = kw >> 5;
    for (int un = G - 1 - vcu; un < 4 * ncu; un += G) {
        const int rb = un & 3, cu = un >> 2;
        f32x4 acc[2][4];
#pragma unroll
        for (int i = 0; i < 2; ++i)
#pragma unroll
            for (int c = 0; c < 4; ++c) acc[i][c] = (f32x4){0.f, 0.f, 0.f, 0.f};
        const bf16* ap = A + (size_t)(rb * 32 + fr) * K + k0 + 8 * fq;
        const bf16* bp0 = Bt + (size_t)sk_brow<MODE>(cu, fr) * K + k0 + 8 * fq;
        const bf16* bp1 = Bt + (size_t)sk_brow<MODE>(cu, 16 + fr) * K + k0 + 8 * fq;
        const bf16* bp2 = Bt + (size_t)sk_brow<MODE>(cu, 32 + fr) * K + k0 + 8 * fq;
        const bf16* bp3 = Bt + (size_t)sk_brow<MODE>(cu, 48 + fr) * K + k0 + 8 * fq;
#pragma unroll 2
        for (int s = 0; s < nst; ++s) {
            const bf16x8 a0 = *(const bf16x8*)(ap + 32 * s), a1 = *(const bf16x8*)(ap + (size_t)16 * K + 32 * s);
            const bf16x8 b0 = *(const bf16x8*)(bp0 + 32 * s), b1 = *(const bf16x8*)(bp1 + 32 * s), b2 = *(const bf16x8*)(bp2 + 32 * s), b3 = *(const bf16x8*)(bp3 + 32 * s);
            acc[0][0] = __builtin_amdgcn_mfma_f32_16x16x32_bf16(a0, b0, acc[0][0], 0, 0, 0); acc[1][0] = __builtin_amdgcn_mfma_f32_16x16x32_bf16(a1, b0, acc[1][0], 0, 0, 0);
            acc[0][1] = __builtin_amdgcn_mfma_f32_16x16x32_bf16(a0, b1, acc[0][1], 0, 0, 0); acc[1][1] = __builtin_amdgcn_mfma_f32_16x16x32_bf16(a1, b1, acc[1][1], 0, 0, 0);
            acc[0][2] = __builtin_amdgcn_mfma_f32_16x16x32_bf16(a0, b2, acc[0][2], 0, 0, 0); acc[1][2] = __builtin_amdgcn_mfma_f32_16x16x32_bf16(a1, b2, acc[1][2], 0, 0, 0);
            acc[0][3] = __builtin_amdgcn_mfma_f32_16x16x32_bf16(a0, b3, acc[0][3], 0, 0, 0); acc[1][3] = __builtin_amdgcn_mfma_f32_16x16x32_bf16(a1, b3, acc[1][3], 0, 0, 0);
        }
#pragma unroll
        for (int i = 0; i < 2; ++i)
#pragma unroll
            for (int c = 0; c < 4; ++c)
#pragma unroll
                for (int r = 0; r < 4; ++r) part[wave * 2048 + (i * 16 + 4 * fq + r) * 64 + c * 16 + fr] = acc[i][c][r];
        __syncthreads();
        { const int row = tid >> 4, cg = tid & 15; f32x4 s = (f32x4){0.f, 0.f, 0.f, 0.f};
#pragma unroll
          for (int w = 0; w < 8; ++w) s += *(const LAS f32x4*)(part + w * 2048 + row * 64 + 4 * cg);
          *(LAS f32x4*)(tile + row * 64 + 4 * cg) = s; }
        __syncthreads();
        E(tile, rb, cu, tid);
        __syncthreads();
    }
}
__device__ __forceinline__ float sk_rstd(const float* ss, int grow, int cg) {
    float s = ss[(size_t)grow * 16 + cg];
    s += __shfl_xor(s, 1); s += __shfl_xor(s, 2); s += __shfl_xor(s, 4); s += __shfl_xor(s, 8);
    return __builtin_amdgcn_rsqf(s * (1.f / 1024.f) + 1e-6f);
}
template <bool NORM> struct SkRaw { bf16* O; int ldc; const float* ss;
    __device__ __forceinline__ void operator()(const LAS float* tile, int rb, int cu, int tid) const {
        const int row = tid >> 4, cg = tid & 15, grow = MP + rb * 32 + row; const float r = NORM ? sk_rstd(ss, grow, cg) : 1.f;
        const f32x4 v = *(const LAS f32x4*)(tile + row * 64 + 4 * cg) * r; const int col = cu * 64 + 4 * cg;
        if (col < ldc) { v2u w; w.x = pk2(v[0], v[1]); w.y = pk2(v[2], v[3]); *(v2u*)(O + (size_t)grow * ldc + col) = w; }
    } };
struct SkSwiglu { bf16* H; const float* ss;
    __device__ __forceinline__ void operator()(const LAS float* tile, int rb, int cu, int tid) const {
        const int row = tid >> 4, cg = tid & 15, grow = MP + rb * 32 + row; const float r = sk_rstd(ss, grow, cg);
        if (cg < 8) { const f32x4 g = *(const LAS f32x4*)(tile + row * 64 + 4 * cg) * r, u = *(const LAS f32x4*)(tile + row * 64 + 32 + 4 * cg) * r;
            float h[4];
#pragma unroll
            for (int e = 0; e < 4; ++e) h[e] = g[e] * sigmoidf_(g[e]) * u[e];
            v2u w; w.x = pk2(h[0], h[1]); w.y = pk2(h[2], h[3]); *(v2u*)(H + (size_t)grow * FF + cu * 32 + 4 * cg) = w; }
    } };
template <bool GATE> struct SkResid { float* X; bf16* XBo; float* SSo; float scale; const float* ss_in; const bf16* P; int fin;
    __device__ __forceinline__ void operator()(const LAS float* tile, int rb, int cu, int tid) const {
        const int row = tid >> 4, cg = tid & 15, grow = MP + rb * 32 + row, col = cu * 64 + 4 * cg; float r = 0.f; if (GATE) r = sk_rstd(ss_in, grow, cg);
        const f32x4 a = *(const LAS f32x4*)(tile + row * 64 + 4 * cg); float* xp = X + (size_t)grow * D + col; f32x4 x = *(const f32x4*)xp;
        if (GATE) { const v2u pw = *(const v2u*)(P + (size_t)grow * D + col);
            x[0] += sigmoidf_(a[0] * r) * bflo(pw.x); x[1] += sigmoidf_(a[1] * r) * bfhi(pw.x); x[2] += sigmoidf_(a[2] * r) * bflo(pw.y); x[3] += sigmoidf_(a[3] * r) * bfhi(pw.y);
        } else x += a * scale;
        *(f32x4*)xp = x;
        float sq = (x[0] * x[0] + x[1] * x[1]) + (x[2] * x[2] + x[3] * x[3]);
        sq += __shfl_xor(sq, 1); sq += __shfl_xor(sq, 2); sq += __shfl_xor(sq, 4); sq += __shfl_xor(sq, 8);
        if (!fin) { v2u w; w.x = pk2(x[0], x[1]); w.y = pk2(x[2], x[3]); *(v2u*)(XBo + (size_t)grow * D + col) = w; if (cg == 0) SSo[(size_t)grow * 16 + cu] = sq; }
    } };

__device__ __forceinline__ void transpose_item(const float* W, int K, int N, int Nd, bf16* WT, const float* gain, int mode, LAS float* scr, int item, int lane) {
    const int nblk = Nd / 32, kb = item / nblk, nb = item % nblk, k0 = 64 * kb, n0 = 32 * nb;
    const int n = n0 + (lane & 31);
#pragma unroll 8
    for (int i = 0; i < 32; ++i) { const int kk = 2 * i + (lane >> 5); float v = (n < N) ? W[(size_t)(k0 + kk) * N + n] : 0.f; if (gain) v *= gain[k0 + kk]; scr[kk * 33 + (lane & 31)] = v; }
    LDS_WAIT(); asm volatile("" ::: "memory");
    const int c = lane & 7;
#pragma unroll
    for (int j = 0; j < 4; ++j) { const int nl = (lane >> 3) + 8 * j, nn = n0 + nl; const LAS float* s = scr + (8 * c) * 33 + nl;
        int drow = nn; if (mode == 1) { const int jj = nn < FF ? nn : nn - FF; drow = (jj >> 7) * 256 + (jj & 127) + (nn < FF ? 0 : 128); }
        v4u o; o.x = pk2(s[0 * 33], s[1 * 33]); o.y = pk2(s[2 * 33], s[3 * 33]); o.z = pk2(s[4 * 33], s[5 * 33]); o.w = pk2(s[6 * 33], s[7 * 33]);
        *(GAS v4u*)(WT + (size_t)drow * K + k0 + 8 * c) = o; }
    LDS_WAIT(); asm volatile("" ::: "memory");
}
struct In {
    const float *x_prompt, *x_sample, *state_conv, *ck_cmp, *cv_cmp, *ck_sel, *cv_sel, *ck_win, *cv_win; const int* page_table; const float *p_prompt, *p_sample, *norm_g, *w_gu, *w_down,
        *w_proj, *w_gate, *cw_in, *cw, *cw_out, *nw_in, *qk_g, *cmp_pos, *cmp_w1, *cmp_w2, *nw_out;
};
__device__ __forceinline__ void sincos_d(double r, float& s, float& c) {
    const double r2 = r * r;
    double sp = 1.0, cp = 1.0;
#pragma unroll
    for (int k = 12; k >= 1; --k) { sp = 1.0 - sp * r2 / (double)((2 * k) * (2 * k + 1)); cp = 1.0 - cp * r2 / (double)((2 * k - 1) * (2 * k)); }
    s = (float)(r * sp); c = (float)cp;
}
__device__ __forceinline__ void p0_prologue(const In& I, float* out, unsigned char* ws, LAS unsigned char* lds, int vcu, int G, int wave, int lane) {
    LAS float* scr = (LAS float*)(lds + wave * 16384);
    const int gw = vcu * NWAVES + wave, NGW = G * NWAVES;
    constexpr int I_GU = (D / 64) * (NGU / 32), I_DN = (FF / 64) * (D / 32), I_SQ = (D / 64) * (D / 32), I_PR = (PLE / 64) * (D / 32), I_CI = (D / 64) * (NCV / 32), I_NI = (D / 64) * (NNSP / 32),
                  I_W1 = (4096 / 64) * (128 / 32), I_W2 = (128 / 64) * (64 / 32);
    constexpr int NITEMS = 4 * I_GU + 4 * I_DN + 2 * I_SQ + 2 * I_PR + I_CI + I_SQ + I_NI + I_SQ + 2 * I_W1 + 2 * I_W2;
#define TR(W_, K_, N_, ND_, WT_, G_, MODE_, NI_) if (r < (NI_)) { transpose_item(W_, K_, N_, ND_, WT_, G_, MODE_, scr, r, lane); continue; } r -= (NI_);
    for (int it = gw; it < NITEMS; it += NGW) {
        int r = it;
        TR(I.w_gu + (size_t)0 * D * NGU, D, NGU, NGU, (bf16*)(ws + WS_WGU + 0 * SZ_WGU), I.norm_g + 0 * D, 1, I_GU)
        TR(I.w_gu + (size_t)1 * D * NGU, D, NGU, NGU, (bf16*)(ws + WS_WGU + 1 * SZ_WGU), I.norm_g + 2 * D, 1, I_GU)
        TR(I.w_gu + (size_t)2 * D * NGU, D, NGU, NGU, (bf16*)(ws + WS_WGU + 2 * SZ_WGU), I.norm_g + 4 * D, 1, I_GU)
        TR(I.w_gu + (size_t)3 * D * NGU, D, NGU, NGU, (bf16*)(ws + WS_WGU + 3 * SZ_WGU), I.norm_g + 6 * D, 1, I_GU)
        TR(I.w_down + (size_t)0 * FF * D, FF, D, D, (bf16*)(ws + WS_WDN + 0 * SZ_WDN), nullptr, 0, I_DN)
        TR(I.w_down + (size_t)1 * FF * D, FF, D, D, (bf16*)(ws + WS_WDN + 1 * SZ_WDN), nullptr, 0, I_DN)
        TR(I.w_down + (size_t)2 * FF * D, FF, D, D, (bf16*)(ws + WS_WDN + 2 * SZ_WDN), nullptr, 0, I_DN)
        TR(I.w_down + (size_t)3 * FF * D, FF, D, D, (bf16*)(ws + WS_WDN + 3 * SZ_WDN), nullptr, 0, I_DN)
        TR(I.w_gate + (size_t)0 * D * D, D, D, D, (bf16*)(ws + WS_WGATE + 0 * SZ_WSQ), I.norm_g + 3 * D, 0, I_SQ)
        TR(I.w_gate + (size_t)1 * D * D, D, D, D, (bf16*)(ws + WS_WGATE + 1 * SZ_WSQ), I.norm_g + 7 * D, 0, I_SQ)
        TR(I.w_proj + (size_t)0 * PLE * D, PLE, D, D, (bf16*)(ws + WS_WPROJ + 0 * SZ_WPROJ), nullptr, 0, I_PR)
        TR(I.w_proj + (size_t)1 * PLE * D, PLE, D, D, (bf16*)(ws + WS_WPROJ + 1 * SZ_WPROJ), nullptr, 0, I_PR)
        TR(I.cw_in, D, NCV, NCV, (bf16*)(ws + WS_WCIN), I.norm_g + 1 * D, 0, I_CI)
        TR(I.cw_out, D, D, D, (bf16*)(ws + WS_WCOUT), nullptr, 0, I_SQ)
        TR(I.nw_in, D, NNS, NNSP, (bf16*)(ws + WS_WNIN), I.norm_g + 5 * D, 0, I_NI)
        TR(I.nw_out, D, D, D, (bf16*)(ws + WS_WNOUT), nullptr, 0, I_SQ)
        TR(I.cmp_w1 + (size_t)0 * 4096 * 128, 4096, 128, 128, (bf16*)(ws + WS_W1T) + (size_t)0 * 128 * 4096, nullptr, 0, I_W1)
        TR(I.cmp_w1 + (size_t)1 * 4096 * 128, 4096, 128, 128, (bf16*)(ws + WS_W1T) + (size_t)1 * 128 * 4096, nullptr, 0, I_W1)
        TR(I.cmp_w2 + (size_t)0 * 128 * 64, 128, 64, 64, (bf16*)(ws + WS_W2T) + (size_t)0 * 64 * 128, nullptr, 0, I_W2)
        TR(I.cmp_w2 + (size_t)1 * 128 * 64, 128, 64, 64, (bf16*)(ws + WS_W2T) + (size_t)1 * 64 * 128, nullptr, 0, I_W2)
    }
#undef TR
    bf16* XB0 = (bf16*)(ws + WS_XB); float* SS0 = (float*)(ws + WS_SS);
    for (int m = gw; m < MT; m += NGW) {
        const float* src = m < MP ? I.x_prompt + (size_t)m * D : I.x_sample + (size_t)(m - MP) * D;
        const GAS f32x4* xr = (const GAS f32x4*)src + lane; GAS f32x4* xo = (GAS f32x4*)(out + (size_t)m * D) + lane;
        GAS v2u* o8 = (GAS v2u*)(XB0 + (size_t)m * D) + lane; float s = 0.f;
#pragma unroll
        for (int j = 0; j < 4; ++j) { const f32x4 v = xr[64 * j]; xo[64 * j] = v; s += (v[0] * v[0] + v[1] * v[1]) + (v[2] * v[2] + v[3] * v[3]); v2u w; w.x = pk2(v[0], v[1]); w.y = pk2(v[2], v[3]); o8[64 * j] = w; }
        s = wave_sum(s);
        if (lane < 16) SS0[(size_t)m * 16 + lane] = lane == 0 ? s : 0.f;
    }
    bf16* PB = (bf16*)(ws + WS_PB);
    for (int r = gw; r < 2 * MT; r += NGW) { const int l = r / MT, m = r % MT;
        const float* src = m < MP ? I.p_prompt + ((size_t)l * MP + m) * PLE : I.p_sample + ((size_t)l * MS + (m - MP)) * PLE;
        const f32x4 v = ((const GAS f32x4*)src)[lane]; v2u w; w.x = pk2(v[0], v[1]); w.y = pk2(v[2], v[3]); ((GAS v2u*)(PB + (size_t)r * PLE))[lane] = w; }
    float* ROPE = (float*)(ws + WS_ROPE);
    for (int i = gw * 64 + lane; i < 8196 * 32; i += NGW * 64) { const int pos = i >> 5, d = i & 31;
        const float inv = (float)exp2(-(double)d * (13.287712379549449 / 32.0));
        const float ang = (float)pos * inv; const double a = (double)ang, k = rint(a * 0.15915494309189535), rr = a - k * 6.283185307179586;
        float s, c; sincos_d(rr, s, c); ROPE[(size_t)pos * 64 + d] = c; ROPE[(size_t)pos * 64 + 32 + d] = s; }
}

__device__ __forceinline__ void conv_post(const In& I, float* out, unsigned char* ws, int vcu, int G, int wave, int lane) {
    const bf16* CV = (const bf16*)(ws + WS_H); bf16* AC = (bf16*)(ws + WS_AC);
    const int gw = vcu * NWAVES + wave, NGW = G * NWAVES;
    constexpr int NSTRIP_P = MP / 16, NITEM = (NSTRIP_P + SB) * 2;
    for (int it = gw; it < NITEM; it += NGW) {
        const int half = it & 1, st = it >> 1, ch = half * 512 + lane * 8;
        float w0[8], w1[8], w2[8], um2[8], um1[8];
#pragma unroll
        for (int e = 0; e < 8; ++e) { w0[e] = I.cw[ch + e]; w1[e] = I.cw[D + ch + e]; w2[e] = I.cw[2 * D + ch + e]; um2[e] = 0.f; um1[e] = 0.f; }
        int row0, nrow; const bool samp = st >= NSTRIP_P;
        if (!samp) { row0 = st * 16; nrow = 16;
            if ((row0 & (SEQ - 1)) != 0) { float c[8], v[8];
                ld_bf16x8(CV + (size_t)(row0 - 2) * NCV + D + ch, c); ld_bf16x8(CV + (size_t)(row0 - 2) * NCV + 2 * D + ch, v);
#pragma unroll
                for (int e = 0; e < 8; ++e) um2[e] = c[e] * v[e];
                ld_bf16x8(CV + (size_t)(row0 - 1) * NCV + D + ch, c); ld_bf16x8(CV + (size_t)(row0 - 1) * NCV + 2 * D + ch, v);
#pragma unroll
                for (int e = 0; e < 8; ++e) um1[e] = c[e] * v[e]; }
        } else { const int bs = st - NSTRIP_P; row0 = MP + bs * 4; nrow = 4;
#pragma unroll
            for (int e = 0; e < 8; ++e) { um2[e] = I.state_conv[((size_t)bs * 2 + 0) * D + ch + e]; um1[e] = I.state_conv[((size_t)bs * 2 + 1) * D + ch + e]; } }
        for (int i = 0; i < nrow; ++i) { const int row = row0 + i; float b[8], c[8], v[8], o[8], u[8];
            ld_bf16x8(CV + (size_t)row * NCV + ch, b); ld_bf16x8(CV + (size_t)row * NCV + D + ch, c); ld_bf16x8(CV + (size_t)row * NCV + 2 * D + ch, v);
#pragma unroll
            for (int e = 0; e < 8; ++e) { u[e] = c[e] * v[e]; o[e] = b[e] * (w0[e] * um2[e] + w1[e] * um1[e] + w2[e] * u[e]); um2[e] = um1[e]; um1[e] = u[e]; }
            st_bf16x8(AC + (size_t)row * D + ch, o);
            float* so = nullptr;
            if (!samp) { const int t = row & (SEQ - 1); if (t >= SEQ - 2) so = out + O_CONVP + ((size_t)(row >> 13) * 2 + (t - (SEQ - 2))) * D + ch; }
            else if (i >= 2) so = out + O_CONVS + ((size_t)(st - NSTRIP_P) * 2 + (i - 2)) * D + ch;
            if (so) { *(f32x4*)so = (f32x4){u[0], u[1], u[2], u[3]}; *(f32x4*)(so + 4) = (f32x4){u[4], u[5], u[6], u[7]}; } }
    }
}

__device__ __forceinline__ void nsa_post(const In& I, float* out, unsigned char* ws, int vcu, int G, int wave, int lane) {
    const bf16* RAW = (const bf16*)(ws + WS_H); const float* ROPE = (const float*)(ws + WS_ROPE);
    bf16* QN = (bf16*)(ws + WS_QN); bf16* QR = (bf16*)(ws + WS_QR); bf16* KS = (bf16*)(ws + WS_KS); bf16* VS = (bf16*)(ws + WS_VS); bf16* KW = (bf16*)(ws + WS_KW); bf16* VW = (bf16*)(ws + WS_VW);
    float* GATES = (float*)(ws + WS_GATES);
    const int gw = vcu * NWAVES + wave, NGW = G * NWAVES, qd = lane >> 2, p = lane & 3;
    for (int row = gw; row < MT; row += NGW) {
        const bool samp = row >= MP; const int sr = row - MP; const int pos = samp ? PAST + (sr & 3) : (row & (SEQ - 1));
        float cs[8], sn[8];
        { const f32x4 c0 = *(const f32x4*)(ROPE + (size_t)pos * 64 + 8 * p), c1 = *(const f32x4*)(ROPE + (size_t)pos * 64 + 8 * p + 4), s0 = *(const f32x4*)(ROPE + (size_t)pos * 64 + 32 + 8 * p), s1 = *(const f32x4*)(ROPE + (size_t)pos * 64 + 36 + 8 * p);
#pragma unroll
          for (int e = 0; e < 4; ++e) { cs[e] = c0[e]; cs[4 + e] = c1[e]; sn[e] = s0[e]; sn[4 + e] = s1[e]; } }
#pragma unroll
        for (int pass = 0; pass < 3; ++pass) { const int sg = qd + 16 * pass;
            if (sg < 40) {
                float x1[8], x2[8];
                ld_bf16x8(RAW + (size_t)row * NNSP + 64 * sg + 8 * p, x1); ld_bf16x8(RAW + (size_t)row * NNSP + 64 * sg + 32 + 8 * p, x2);
                const int typ = sg < 16 ? 0 : 1 + ((sg - 16) >> 2), g4 = sg & 3;
                const bool nrm = (typ == 0 || typ == 3 || typ == 5);
                if (nrm) { const int gi = typ == 0 ? 0 : (typ == 3 ? 2 : 3); float ssq = 0.f;
#pragma unroll
                    for (int e = 0; e < 8; ++e) ssq += x1[e] * x1[e] + x2[e] * x2[e];
                    ssq += __shfl_xor(ssq, 1); ssq += __shfl_xor(ssq, 2);
                    const float rs = __builtin_amdgcn_rsqf(ssq * (1.f / 64.f) + RMS_EPS);
#pragma unroll
                    for (int e = 0; e < 8; ++e) { x1[e] *= rs * I.qk_g[gi * 64 + 8 * p + e]; x2[e] *= rs * I.qk_g[gi * 64 + 32 + 8 * p + e]; } }
                float y1[8], y2[8];
#pragma unroll
                for (int e = 0; e < 8; ++e) { y1[e] = x1[e] * cs[e] - x2[e] * sn[e]; y2[e] = x2[e] * cs[e] + x1[e] * sn[e]; }
                if (typ == 0) { float a[8], b[8];
#pragma unroll
                    for (int e = 0; e < 8; ++e) { a[e] = x1[e] * QSCALE; b[e] = x2[e] * QSCALE; }
                    st_bf16x8(QN + (size_t)row * D + 64 * sg + 8 * p, a); st_bf16x8(QN + (size_t)row * D + 64 * sg + 32 + 8 * p, b);
#pragma unroll
                    for (int e = 0; e < 8; ++e) { a[e] = y1[e] * QSCALE; b[e] = y2[e] * QSCALE; }
                    st_bf16x8(QR + (size_t)row * D + 64 * sg + 8 * p, a); st_bf16x8(QR + (size_t)row * D + 64 * sg + 32 + 8 * p, b);
                } else {
                    const bool rope = (typ == 3 || typ == 5);
                    float o1[8], o2[8];
#pragma unroll
                    for (int e = 0; e < 8; ++e) { o1[e] = rope ? y1[e] : x1[e]; o2[e] = rope ? y2[e] : x2[e]; }
                    float* fo = nullptr; bf16* bo = nullptr; const size_t co = (size_t)g4 * 64 + 8 * p;
                    if (typ <= 4) { const size_t base = samp ? (typ == 1 ? O_KCS : typ == 2 ? O_VCS : typ == 3 ? O_KSS : O_VSS) + (size_t)sr * KVW : (typ == 1 ? O_KCP : typ == 2 ? O_VCP : typ == 3 ? O_KSP : O_VSP) + (size_t)row * KVW;
                        fo = out + base + co; if (typ == 3) bo = KS + (size_t)row * KVW + co; if (typ == 4) bo = VS + (size_t)row * KVW + co;
                    } else { bo = (typ == 5 ? KW : VW) + (size_t)row * KVW + co;
                        if (samp) fo = out + (typ == 5 ? O_KWS : O_VWS) + ((size_t)(sr >> 2) * 512 + 508 + (sr & 3)) * KVW + co;
                        else { const int t = row & (SEQ - 1); if (t >= SEQ - WIN) fo = out + (typ == 5 ? O_KWP : O_VWP) + ((size_t)(row >> 13) * 512 + (t - (SEQ - WIN))) * KVW + co; } }
                    if (fo) { *(f32x4*)fo = (f32x4){o1[0], o1[1], o1[2], o1[3]}; *(f32x4*)(fo + 4) = (f32x4){o1[4], o1[5], o1[6], o1[7]};
                              *(f32x4*)(fo + 32) = (f32x4){o2[0], o2[1], o2[2], o2[3]}; *(f32x4*)(fo + 36) = (f32x4){o2[4], o2[5], o2[6], o2[7]}; }
                    if (bo) { st_bf16x8(bo, o1); st_bf16x8(bo + 32, o2); }
                }
            }
        }
        if (lane < 48) { const unsigned short rv = RAW[(size_t)row * NNSP + 2560 + lane]; GATES[(size_t)row * 48 + lane] = sigmoidf_(__uint_as_float((unsigned)rv << 16)); }
    }
    { const size_t n4 = (size_t)SB * 508 * 64; const size_t gt = (size_t)(vcu * NWAVES + wave) * 64 + lane, NT = (size_t)NGW * 64;
      for (size_t i = gt; i < 2 * n4; i += NT) { const int kv = i >= n4; const size_t j = kv ? i - n4 : i; const size_t bs = j / (508 * 64), rem = j % (508 * 64);
          const f32x4 v = ((const GAS f32x4*)(kv ? I.cv_win : I.ck_win))[bs * 512 * 64 + 4 * 64 + rem];
          ((GAS f32x4*)(out + (kv ? O_VWS : O_KWS)))[bs * 512 * 64 + rem] = v; } }
}

constexpr int CMP_STAGE = 32768, CMP_NST = 3, CMP_HID_OFF = CMP_NST * CMP_STAGE, CMP_RED_OFF = CMP_HID_OFF + 16384;
__device__ __forceinline__ void cmp_bias_partials(const In& I, unsigned char* ws, int vcu, int G, int wave, int lane) {
    float* PART = (float*)(ws + WS_CPART); const int gw = vcu * NWAVES + wave, NGW = G * NWAVES;
    for (int it = gw; it < 128; it += NGW) { const int kv = it >> 6, j = it & 63; float a0 = 0.f, a1 = 0.f;
        const float* pp = I.cmp_pos + ((size_t)kv * 64 + j) * 64; const float* wp = I.cmp_w1 + ((size_t)kv * 4096 + 64 * j) * 128;
#pragma unroll 8
        for (int d = 0; d < 64; ++d) { const float p = pp[d]; a0 += p * wp[d * 128 + lane]; a1 += p * wp[d * 128 + 64 + lane]; }
        PART[(size_t)it * 128 + lane] = a0; PART[(size_t)it * 128 + 64 + lane] = a1; }
}
__device__ __forceinline__ void cmp_bias_reduce(unsigned char* ws, int vcu, int tid) {
    if (vcu != 0 || tid >= 256) return;
    const float* PART = (const float*)(ws + WS_CPART); float* BIAS = (float*)(ws + WS_CBIAS); const int kv = tid >> 7, n = tid & 127; float a = 0.f;
    for (int j = 0; j < 64; ++j) a += PART[((size_t)kv * 64 + j) * 128 + n];
    BIAS[tid] = a;
}
struct CmpSrc { const float* kbase; const float* vbase; const int* page_table; int seq0, nseq; };
__device__ __forceinline__ const float* cmp_chunk_base(const CmpSrc& S, int kv, int cid) {
    const int sq = cid >> 7, nb = cid & 127; const float* base = kv ? S.vbase : S.kbase;
    if (S.page_table) { const int pg = S.page_table[sq * NPAGE + (nb >> 1)]; return base + ((size_t)pg * 128 + (nb & 1) * 64) * KVW; }
    return base + ((size_t)sq * SEQ + nb * 64) * KVW;
}
__device__ __forceinline__ void compress_phase(const In& I, unsigned char* ws, LAS unsigned char* lds, const CmpSrc& S, int vcu, int G) {
    int tid_ = threadIdx.x; asm volatile("" : "+v"(tid_));
    const int tid = tid_, wave = __builtin_amdgcn_readfirstlane(tid >> 6), lane = tid & 63, fr = lane & 15, fq = lane >> 4, wm = wave >> 2, wn = wave & 3;
    const int upk = S.nseq * 128 / 16, nunits = 2 * upk;
    int nmine = 0; for (int u = vcu; u < nunits; u += G) ++nmine;
    if (nmine == 0) return;
    const int total = nmine * 64;
    const bf16* W1T = (const bf16*)(ws + WS_W1T); const bf16* W2T = (const bf16*)(ws + WS_W2T); const float* BIAS = (const float*)(ws + WS_CBIAS);
    unsigned aoffs[2];
#pragma unroll
    for (int i = 0; i < 2; ++i) { const int c = 2 * wave + i, r = 4 * c + (lane >> 4); aoffs[i] = (unsigned)((lane >> 4) * 256 + (((lane & 15) ^ (r & 15)) * 16)); }
    unsigned boffs[2];
#pragma unroll
    for (int i = 0; i < 2; ++i) { int R, C; pg8::stage_rc(tid * 16 + i * 8192, R, C); boffs[i] = (unsigned)(R * 4096 + C) * 2u; }
#define CMP_ISSUE(gs_) do { const int ui_ = (gs_) >> 6, j_ = (gs_) & 63, u_ = vcu + ui_ * G, kv_ = u_ >= upk ? 1 : 0, ul_ = u_ - kv_ * upk; \
        LAS unsigned char* st_ = lds + ((gs_) % CMP_NST) * CMP_STAGE; \
        _Pragma("unroll") for (int i_ = 0; i_ < 2; ++i_) { const float* cb_ = cmp_chunk_base(S, kv_, ul_ * 16 + 2 * wave + i_); \
            __builtin_amdgcn_global_load_lds((const unsigned*)((const char*)cb_ + (size_t)j_ * 1024 + aoffs[i_]), (LAS unsigned*)(st_ + (2 * wave + i_) * 1024), 16, 0, 0); } \
        const char* wb_ = (const char*)(W1T + (size_t)kv_ * 128 * 4096) + j_ * 128; \
        _Pragma("unroll") for (int i_ = 0; i_ < 2; ++i_) __builtin_amdgcn_global_load_lds((const unsigned*)(wb_ + boffs[i_]), (LAS unsigned*)(st_ + 16384 + wave * 1024 + i_ * 8192), 16, 0, 0); } while (0)
    f32x4 acc[2][2];
#pragma unroll
    for (int a = 0; a < 2; ++a)
#pragma unroll
        for (int b = 0; b < 2; ++b) acc[a][b] = (f32x4){0.f, 0.f, 0.f, 0.f};
    CMP_ISSUE(0); if (total > 1) CMP_ISSUE(1);
    for (int gs = 0; gs < total; ++gs) {
        if (gs + 1 < total) asm volatile("s_waitcnt vmcnt(4)" ::: "memory"); else asm volatile("s_waitcnt vmcnt(0)" ::: "memory");
        __builtin_amdgcn_s_barrier(); asm volatile("" ::: "memory");
        if (gs + 2 < total) CMP_ISSUE(gs + 2);
        const LAS unsigned char* st = lds + (gs % CMP_NST) * CMP_STAGE;
#pragma unroll
        for (int ks = 0; ks < 2; ++ks) {
            bf16x8 xa[2], wb[2];
#pragma unroll
            for (int rb = 0; rb < 2; ++rb) { const int row = 32 * wm + 16 * rb + fr, ch = 8 * ks + 2 * fq;
                const f32x4 lo = *(const LAS f32x4*)(st + row * 256 + ((ch ^ (row & 15)) * 16)), hi = *(const LAS f32x4*)(st + row * 256 + (((ch + 1) ^ (row & 15)) * 16));
                v4u w; w.x = pk2(lo[0], lo[1]); w.y = pk2(lo[2], lo[3]); w.z = pk2(hi[0], hi[1]); w.w = pk2(hi[2], hi[3]); xa[rb] = __builtin_bit_cast(bf16x8, w); }
#pragma unroll
            for (int cb = 0; cb < 2; ++cb) wb[cb] = *(const LAS bf16x8*)(st + 16384 + pg8::lds_byte(32 * wn + 16 * cb + fr, 32 * ks + 8 * fq));
#pragma unroll
            for (int cb = 0; cb < 2; ++cb)
#pragma unroll
                for (int rb = 0; rb < 2; ++rb) acc[cb][rb] = __builtin_amdgcn_mfma_f32_16x16x32_bf16(wb[cb], xa[rb], acc[cb][rb], 0, 0, 0);
        }
        if ((gs & 63) == 63) {
            const int ui = gs >> 6, u = vcu + ui * G, kv = u >= upk ? 1 : 0, ul = u - kv * upk;
            LAS unsigned char* hid = lds + CMP_HID_OFF; LAS float* red = (LAS float*)(lds + CMP_RED_OFF);
#pragma unroll
            for (int cb = 0; cb < 2; ++cb) { const int n0 = 32 * wn + 16 * cb + 4 * fq; const f32x4 bv = *(const f32x4*)(BIAS + kv * 128 + n0);
#pragma unroll
                for (int rb = 0; rb < 2; ++rb) { const int row = 32 * wm + 16 * rb + fr; float h[4];
#pragma unroll
                    for (int e = 0; e < 4; ++e) { const float x = acc[cb][rb][e] + bv[e]; const float t = 0.7978845608028654f * (x + 0.044715f * x * x * x); h[e] = x * sigmoidf_(2.f * t); acc[cb][rb][e] = 0.f; }
                    v2u w; w.x = pk2(h[0], h[1]); w.y = pk2(h[2], h[3]);
                    *(LAS v2u*)(hid + row * 256 + (((n0 >> 3) ^ (row & 15)) * 16) + (n0 & 7) * 2) = w; } }
            asm volatile("s_waitcnt lgkmcnt(0)" ::: "memory"); __builtin_amdgcn_s_barrier(); asm volatile("" ::: "memory");
            const int rblk = wave >> 1, oh = wave & 1;
            f32x4 o2[2] = {(f32x4){0.f, 0.f, 0.f, 0.f}, (f32x4){0.f, 0.f, 0.f, 0.f}};
#pragma unroll
            for (int ks = 0; ks < 4; ++ks) { const int row = 16 * rblk + fr, ch = 4 * ks + fq;
                const bf16x8 hb = *(const LAS bf16x8*)(hid + row * 256 + ((ch ^ (row & 15)) * 16));
#pragma unroll
                for (int ob = 0; ob < 2; ++ob) { const bf16x8 wa = *(const bf16x8*)(W2T + ((size_t)kv * 64 + 32 * oh + 16 * ob + fr) * 128 + 32 * ks + 8 * fq);
                    o2[ob] = __builtin_amdgcn_mfma_f32_16x16x32_bf16(wa, hb, o2[ob], 0, 0, 0); } }
            float ssq = 0.f;
#pragma unroll
            for (int ob = 0; ob < 2; ++ob)
#pragma unroll
                for (int e = 0; e < 4; ++e) ssq += o2[ob][e] * o2[ob][e];
            ssq += __shfl_xor(ssq, 16); ssq += __shfl_xor(ssq, 32);
            if (fq == 0) red[(16 * rblk + fr) * 2 + oh] = ssq;
            asm volatile("s_waitcnt lgkmcnt(0)" ::: "memory"); __builtin_amdgcn_s_barrier(); asm volatile("" ::: "memory");
            const int trow = 16 * rblk + fr; const float tot = red[trow * 2] + red[trow * 2 + 1];
            const float rs = kv ? 1.f : __builtin_amdgcn_rsqf(tot * (1.f / 64.f) + RMS_EPS);
            const int cid = ul * 16 + (trow >> 2), g = trow & 3, sq = S.seq0 + (cid >> 7), nb = cid & 127;
            bf16* dst = (bf16*)(ws + (kv ? WS_VC : WS_KC)) + (((size_t)sq * 4 + g) * 128 + nb) * 64;
#pragma unroll
            for (int ob = 0; ob < 2; ++ob) { const int o0 = 32 * oh + 16 * ob + 4 * fq; float y[4];
#pragma unroll
                for (int e = 0; e < 4; ++e) y[e] = o2[ob][e] * rs * (kv ? 1.f : I.qk_g[64 + o0 + e]);
                v2u w; w.x = pk2(y[0], y[1]); w.y = pk2(y[2], y[3]); *(v2u*)(dst + o0) = w; }
        }
    }
    asm volatile("s_waitcnt vmcnt(0) lgkmcnt(0)" ::: "memory"); __builtin_amdgcn_s_barrier(); asm volatile("" ::: "memory");
}

constexpr int AT_IMP = 32768, AT_OUTS = 65536, AT_SELM = LDSCTL_OFF + 1024;
constexpr int SAT_IMP = LDSCTL_OFF + 1024, SAT_SELM = SAT_IMP + 4 * 132 * 4;
static_assert(SAT_SELM + 4 * 8 * 4 <= LDS_BYTES && AT_SELM + 64 * 16 <= LDS_BYTES && AT_OUTS + 65536 <= RING_BYTES, "attention LDS");
__device__ __forceinline__ s16x4 tr16(const LAS unsigned char* p) { typedef short v4s __attribute__((ext_vector_type(4))); return __builtin_bit_cast(s16x4, __builtin_amdgcn_ds_read_tr16_b64_v4i16((LAS v4s*)p)); }
__device__ __forceinline__ unsigned dpp_max_u32(unsigned v) {
    v = max(v, (unsigned)__builtin_amdgcn_update_dpp(0, (int)v, 0xB1, 0xF, 0xF, true));
    v = max(v, (unsigned)__builtin_amdgcn_update_dpp(0, (int)v, 0x4E, 0xF, 0xF, true));
    v = max(v, (unsigned)__builtin_amdgcn_update_dpp(0, (int)v, 0x141, 0xF, 0xF, true));
    v = max(v, (unsigned)__builtin_amdgcn_update_dpp(0, (int)v, 0x140, 0xF, 0xF, true));
    const unsigned a = __builtin_amdgcn_readlane((int)v, 0), b = __builtin_amdgcn_readlane((int)v, 16), c = __builtin_amdgcn_readlane((int)v, 32), d = __builtin_amdgcn_readlane((int)v, 48);
    return max(max(a, b), max(c, d));
}
__device__ __forceinline__ void stage_block_dma(LAS unsigned char* dst, const bf16* src_row0, int pitch_bytes, int wave, int lane) {
    const int row = 8 * wave + (lane >> 3), chunk = (lane & 7) ^ (lane >> 3);
    __builtin_amdgcn_global_load_lds((const unsigned*)((const char*)src_row0 + (size_t)row * pitch_bytes + chunk * 16), (LAS unsigned*)(dst + wave * 1024), 16, 0, 0);
}
__device__ __forceinline__ void kfrags(bf16x8 (&kf)[4][2], const LAS unsigned char* kb, int fr, int fq) {
#pragma unroll
    for (int k = 0; k < 4; ++k)
#pragma unroll
        for (int ks = 0; ks < 2; ++ks) kf[k][ks] = *(const LAS bf16x8*)(kb + (16 * k + fr) * 128 + (((4 * ks + fq) ^ (fr & 7)) * 16));
}
__device__ __forceinline__ bf16x8 pack_p(const f32x4& a, const f32x4& b) { v4u w; w.x = pk2(a[0], a[1]); w.y = pk2(a[2], a[3]); w.z = pk2(b[0], b[1]); w.w = pk2(b[2], b[3]); return __builtin_bit_cast(bf16x8, w); }
__device__ __forceinline__ void pv_block(const LAS unsigned char* vb, bool do0, bool do1, const bf16x8 (&p)[2][2], f32x4 (&o)[2][4], int fr, int fq) {
    const int q4 = fr >> 2, pp = fr & 3, kk = 4 * (fq & 1) + q4;
    const LAS unsigned char* vrow = vb + (4 * fq + q4) * 128 + (pp & 1) * 8;
#pragma unroll
    for (int db = 0; db < 4; ++db) { const int xo = (((2 * db + (pp >> 1)) ^ kk) * 16);
#pragma unroll
        for (int st = 0; st < 2; ++st) {
            const s16x4 lo4 = tr16(vrow + (32 * st) * 128 + xo), hi4 = tr16(vrow + (32 * st + 16) * 128 + xo);
            const bf16x8 vf = (bf16x8){lo4[0], lo4[1], lo4[2], lo4[3], hi4[0], hi4[1], hi4[2], hi4[3]};
            if (do0) o[0][db] = __builtin_amdgcn_mfma_f32_16x16x32_bf16(vf, p[0][st], o[0][db], 0, 0, 0);
            if (do1) o[1][db] = __builtin_amdgcn_mfma_f32_16x16x32_bf16(vf, p[1][st], o[1][db], 0, 0, 0); } }
}
template <bool EDGE>
__device__ __forceinline__ void attn_block(const LAS unsigned char* kb, const LAS unsigned char* vb, bool do0, bool do1, const bf16x8 (&q)[2][2], const float (&bias)[2], const int (&lo)[2], const int (&hi)[2],
                                           f32x4 (&o)[2][4], float (&l)[2], int fr, int fq) {
    bf16x8 kf[4][2]; kfrags(kf, kb, fr, fq);
    bf16x8 p[2][2];
#pragma unroll
    for (int s = 0; s < 2; ++s) { p[s][0] = (bf16x8){0, 0, 0, 0, 0, 0, 0, 0}; p[s][1] = p[s][0];
        if (s ? do1 : do0) {
            f32x4 sc[4]; float ls = 0.f;
#pragma unroll
            for (int k = 0; k < 4; ++k) { sc[k] = (f32x4){bias[s], bias[s], bias[s], bias[s]};
#pragma unroll
                for (int ks = 0; ks < 2; ++ks) sc[k] = __builtin_amdgcn_mfma_f32_16x16x32_bf16(kf[k][ks], q[s][ks], sc[k], 0, 0, 0); }
#pragma unroll
            for (int k = 0; k < 4; ++k)
#pragma unroll
                for (int e = 0; e < 4; ++e) { float v = sc[k][e]; if (EDGE) { const int key = 16 * k + 4 * fq + e; if (key < lo[s] || key > hi[s]) v = -INFINITY; } v = fast_exp2(v); sc[k][e] = v; ls += v; }
            l[s] += ls; p[s][0] = pack_p(sc[0], sc[1]); p[s][1] = pack_p(sc[2], sc[3]); } }
    pv_block(vb, do0, do1, p, o, fr, fq);
}

__device__ __forceinline__ void attn_prompt_unit(unsigned char* ws, LAS unsigned char* lds, int b, int g, int qb, int wave, int lane) {
    const int fr = lane & 15, fq = lane >> 4, h = fr & 3, tq = fr >> 2;
    const bf16* QN = (const bf16*)(ws + WS_QN); const bf16* QR = (const bf16*)(ws + WS_QR); const float* GATES = (const float*)(ws + WS_GATES); bf16* O = (bf16*)(ws + WS_AC);
    LAS float* IMP = (LAS float*)(lds + AT_IMP); LAS unsigned* SELM = (LAS unsigned*)(lds + AT_SELM);
    const size_t seq0 = (size_t)b * SEQ; const int hc = (g * 4 + h) * 64;
    int itok[2]; size_t row[2];
#pragma unroll
    for (int s = 0; s < 2; ++s) { itok[s] = 8 * wave + 4 * s + tq; row[s] = seq0 + 64 * qb + itok[s]; }
    LAS float* outs = (LAS float*)(lds + AT_OUTS) + wave * 2048 + lane;
    {
        const int nblk = (qb + 64) >> 6;
        const bf16* KC = (const bf16*)(ws + WS_KC) + ((size_t)b * 4 + g) * 128 * 64; const bf16* VC = (const bf16*)(ws + WS_VC) + ((size_t)b * 4 + g) * 128 * 64;
        for (int i = 0; i < nblk; ++i) { stage_block_dma(lds + i * 16384, KC + (size_t)i * 64 * 64, 128, wave, lane); stage_block_dma(lds + i * 16384 + 8192, VC + (size_t)i * 64 * 64, 128, wave, lane); }
        asm volatile("s_waitcnt vmcnt(0)" ::: "memory"); __builtin_amdgcn_s_barrier(); asm volatile("" ::: "memory");
#pragma unroll 1
        for (int s = 0; s < 2; ++s) {
            bf16x8 q[2];
#pragma unroll
            for (int ks = 0; ks < 2; ++ks) q[ks] = *(const bf16x8*)(QN + row[s] * D + hc + 32 * ks + 8 * fq);
            const int nv = qb + (itok[s] == 63 ? 1 : 0);
            f32x4 sc[2][4]; float ls = 0.f;
#pragma unroll
            for (int i = 0; i < 2; ++i) {
                if (i < nblk) { bf16x8 kf[4][2]; kfrags(kf, lds + i * 16384, fr, fq);
#pragma unroll
                    for (int k = 0; k < 4; ++k) { sc[i][k] = (f32x4){0.f, 0.f, 0.f, 0.f};
#pragma unroll
                        for (int ks = 0; ks < 2; ++ks) sc[i][k] = __builtin_amdgcn_mfma_f32_16x16x32_bf16(kf[k][ks], q[ks], sc[i][k], 0, 0, 0);
#pragma unroll
                        for (int e = 0; e < 4; ++e) { const int key = 64 * i + 16 * k + 4 * fq + e; const float v = key < nv ? fast_exp2(sc[i][k][e]) : 0.f; sc[i][k][e] = v; ls += v; } }
                } else {
#pragma unroll
                    for (int k = 0; k < 4; ++k) sc[i][k] = (f32x4){0.f, 0.f, 0.f, 0.f}; } }
            ls += __shfl_xor(ls, 16); ls += __shfl_xor(ls, 32);
            const float inv = ls > 0.f ? 1.f / ls : 0.f;
            f32x4 oc[2][4];
#pragma unroll
            for (int d = 0; d < 4; ++d) { oc[0][d] = (f32x4){0.f, 0.f, 0.f, 0.f}; oc[1][d] = oc[0][d]; }
#pragma unroll
            for (int i = 0; i < 2; ++i) if (i < nblk) {
#pragma unroll
                for (int k = 0; k < 4; ++k) { f32x4 pn = sc[i][k] * inv;
#pragma unroll
                    for (int e = 0; e < 4; ++e) { float t = pn[e]; t += __shfl_xor(t, 1); t += __shfl_xor(t, 2); pn[e] = t; }
                    if (h == 0) *(LAS f32x4*)(IMP + itok[s] * 128 + 64 * i + 16 * k + 4 * fq) = pn; }
                bf16x8 p[2][2]; p[0][0] = pack_p(sc[i][0], sc[i][1]); p[0][1] = pack_p(sc[i][2], sc[i][3]); p[1][0] = p[0][0]; p[1][1] = p[0][1];
                pv_block(lds + i * 16384 + 8192, true, false, p, oc, fr, fq); }
            const float gc = GATES[row[s] * 48 + (g * 4 + h) * 3 + 0] * inv;
#pragma unroll
            for (int d = 0; d < 4; ++d)
#pragma unroll
                for (int e = 0; e < 4; ++e) outs[((s * 4 + d) * 4 + e) * 64] = oc[0][d][e] * gc;
        }
    }
    asm volatile("; MARK_TOPK");
    unsigned long long un_lo[2] = {0ull, 0ull}, un_hi[2] = {0ull, 0ull};
    asm volatile("s_waitcnt lgkmcnt(0)" ::: "memory");
#pragma unroll 1
    for (int tk = 0; tk < 8; ++tk) { const int tok = 8 * wave + tk; unsigned long long mlo, mhi = 0ull;
        if (qb <= 15) mlo = (2ull << qb) - 1ull;
        else {
            const float v0 = IMP[tok * 128 + lane], v1 = IMP[tok * 128 + 64 + lane];
            unsigned u0 = (lane >= 1 && lane <= qb - 2) ? __float_as_uint(v0) : 0u, u1 = (lane + 64 <= qb - 2) ? __float_as_uint(v1) : 0u;
            mlo = 1ull;
            if (qb - 1 < 64) mlo |= 1ull << (qb - 1); else mhi |= 1ull << (qb - 65);
            if (qb < 64) mlo |= 1ull << qb; else mhi |= 1ull << (qb - 64);
#pragma unroll 1
            for (int r = 0; r < 13; ++r) { const unsigned m = dpp_max_u32(max(u0, u1));
                const unsigned long long b0 = __ballot(u0 == m);
                if (b0) { const int idx = __builtin_ctzll(b0); mlo |= 1ull << idx; if (lane == idx) u0 = 0u; }
                else { const unsigned long long b1 = __ballot(u1 == m); const int idx = __builtin_ctzll(b1); mhi |= 1ull << idx; if (lane == idx) u1 = 0u; } }
        }
        if (lane == 0) { SELM[tok * 4 + 0] = (unsigned)mlo; SELM[tok * 4 + 1] = (unsigned)(mlo >> 32); SELM[tok * 4 + 2] = (unsigned)mhi; SELM[tok * 4 + 3] = (unsigned)(mhi >> 32); }
        if (tk < 4) { un_lo[0] |= mlo; un_hi[0] |= mhi; } else { un_lo[1] |= mlo; un_hi[1] |= mhi; }
    }
    asm volatile("s_waitcnt lgkmcnt(0)" ::: "memory");
    unsigned selw[2][4];
#pragma unroll
    for (int s = 0; s < 2; ++s)
#pragma unroll
        for (int w = 0; w < 4; ++w) selw[s][w] = SELM[itok[s] * 4 + w];
    bf16x8 qr[2][2];
#pragma unroll
    for (int s = 0; s < 2; ++s)
#pragma unroll
        for (int ks = 0; ks < 2; ++ks) qr[s][ks] = *(const bf16x8*)(QR + row[s] * D + hc + 32 * ks + 8 * fq);
    asm volatile("; MARK_SEL");
    {
        const bf16* KS = (const bf16*)(ws + WS_KS) + seq0 * KVW + g * 64; const bf16* VS = (const bf16*)(ws + WS_VS) + seq0 * KVW + g * 64;
        f32x4 os[2][4]; float lsum[2] = {0.f, 0.f};
#pragma unroll
        for (int s = 0; s < 2; ++s)
#pragma unroll
            for (int d = 0; d < 4; ++d) os[s][d] = (f32x4){0.f, 0.f, 0.f, 0.f};
        __builtin_amdgcn_s_barrier(); asm volatile("" ::: "memory");
        stage_block_dma(lds, KS, KVW * 2, wave, lane); stage_block_dma(lds + 8192, VS, KVW * 2, wave, lane);
#pragma unroll 1
        for (int n = 0; n <= qb; ++n) {
            asm volatile("s_waitcnt vmcnt(0)" ::: "memory"); __builtin_amdgcn_s_barrier(); asm volatile("" ::: "memory");
            if (n < qb) { LAS unsigned char* st = lds + ((n + 1) & 1) * 16384; stage_block_dma(st, KS + (size_t)(n + 1) * 64 * KVW, KVW * 2, wave, lane); stage_block_dma(st + 8192, VS + (size_t)(n + 1) * 64 * KVW, KVW * 2, wave, lane); }
            const bool do0 = ((n < 64 ? un_lo[0] >> n : un_hi[0] >> (n - 64)) & 1ull) != 0ull, do1 = ((n < 64 ? un_lo[1] >> n : un_hi[1] >> (n - 64)) & 1ull) != 0ull;
            if (do0 || do1) {
                const LAS unsigned char* st = lds + (n & 1) * 16384; float bias[2]; int lo[2] = {0, 0}, hi[2] = {itok[0], itok[1]};
#pragma unroll
                for (int s = 0; s < 2; ++s) { const int wi = n >> 5; const unsigned wd = wi == 0 ? selw[s][0] : (wi == 1 ? selw[s][1] : (wi == 2 ? selw[s][2] : selw[s][3])); bias[s] = ((wd >> (n & 31)) & 1u) ? 0.f : -INFINITY; }
                if (n == qb) attn_block<true>(st, st + 8192, do0, do1, qr, bias, lo, hi, os, lsum, fr, fq);
                else attn_block<false>(st, st + 8192, do0, do1, qr, bias, lo, hi, os, lsum, fr, fq);
            }
        }
#pragma unroll
        for (int s = 0; s < 2; ++s) { float ls = lsum[s]; ls += __shfl_xor(ls, 16); ls += __shfl_xor(ls, 32);
            const float gs = GATES[row[s] * 48 + (g * 4 + h) * 3 + 1] * (ls > 0.f ? 1.f / ls : 0.f);
#pragma unroll
            for (int d = 0; d < 4; ++d)
#pragma unroll
                for (int e = 0; e < 4; ++e) outs[((s * 4 + d) * 4 + e) * 64] += os[s][d][e] * gs; }
    }
    asm volatile("; MARK_WIN");
    {
        const bf16* KW = (const bf16*)(ws + WS_KW) + seq0 * KVW + g * 64; const bf16* VW = (const bf16*)(ws + WS_VW) + seq0 * KVW + g * 64;
        f32x4 ow[2][4]; float lsum[2] = {0.f, 0.f};
#pragma unroll
        for (int s = 0; s < 2; ++s)
#pragma unroll
            for (int d = 0; d < 4; ++d) ow[s][d] = (f32x4){0.f, 0.f, 0.f, 0.f};
        const int n0 = qb >= 8 ? qb - 8 : 0;
        __builtin_amdgcn_s_barrier(); asm volatile("" ::: "memory");
        stage_block_dma(lds + (n0 & 1) * 16384, KW + (size_t)n0 * 64 * KVW, KVW * 2, wave, lane); stage_block_dma(lds + (n0 & 1) * 16384 + 8192, VW + (size_t)n0 * 64 * KVW, KVW * 2, wave, lane);
#pragma unroll 1
        for (int n = n0; n <= qb; ++n) {
            asm volatile("s_waitcnt vmcnt(0)" ::: "memory"); __builtin_amdgcn_s_barrier(); asm volatile("" ::: "memory");
            if (n < qb) { LAS unsigned char* st = lds + ((n + 1) & 1) * 16384; stage_block_dma(st, KW + (size_t)(n + 1) * 64 * KVW, KVW * 2, wave, lane); stage_block_dma(st + 8192, VW + (size_t)(n + 1) * 64 * KVW, KVW * 2, wave, lane); }
            const LAS unsigned char* st = lds + (n & 1) * 16384; const float bias[2] = {0.f, 0.f};
            if (n == qb || n == qb - 8) { int lo[2], hi[2];
#pragma unroll
                for (int s = 0; s < 2; ++s) { lo[s] = (n == qb - 8) ? itok[s] + 1 : 0; hi[s] = (n == qb) ? itok[s] : 63; }
                attn_block<true>(st, st + 8192, true, true, qr, bias, lo, hi, ow, lsum, fr, fq);
            } else { const int lo[2] = {0, 0}, hi[2] = {63, 63}; attn_block<false>(st, st + 8192, true, true, qr, bias, lo, hi, ow, lsum, fr, fq); }
        }
#pragma unroll
        for (int s = 0; s < 2; ++s) { float ls = lsum[s]; ls += __shfl_xor(ls, 16); ls += __shfl_xor(ls, 32);
            const float gw = GATES[row[s] * 48 + (g * 4 + h) * 3 + 2] * (ls > 0.f ? 1.f / ls : 0.f);
#pragma unroll
            for (int d = 0; d < 4; ++d) { float y[4];
#pragma unroll
                for (int e = 0; e < 4; ++e) y[e] = outs[((s * 4 + d) * 4 + e) * 64] + ow[s][d][e] * gw;
                v2u w; w.x = pk2(y[0], y[1]); w.y = pk2(y[2], y[3]); *(v2u*)(O + row[s] * D + hc + 16 * d + 4 * fq) = w; } }
    }
    __builtin_amdgcn_s_barrier(); asm volatile("" ::: "memory");
}

__device__ __forceinline__ void stage_f32_rows(LAS unsigned char* dst, const float* src_row0  , int lane) {
#pragma unroll
    for (int half = 0; half < 2; ++half) { f32x4 v[8];
#pragma unroll
        for (int k = 0; k < 8; ++k) { const int r = 32 * half + 4 * k + (lane >> 4); v[k] = *(const f32x4*)(src_row0 + (size_t)r * KVW + 4 * (lane & 15)); }
#pragma unroll
        for (int k = 0; k < 8; ++k) { const int r = 32 * half + 4 * k + (lane >> 4), c16 = (lane & 15) >> 1; v2u w; w.x = pk2(v[k][0], v[k][1]); w.y = pk2(v[k][2], v[k][3]);
            *(LAS v2u*)(dst + r * 128 + ((c16 ^ (r & 7)) * 16) + (lane & 1) * 8) = w; } }
}
__device__ __forceinline__ void stage_bf16_rows(LAS unsigned char* dst, const bf16* src_row0, int pitch, int nvalid, int lane) {
#pragma unroll
    for (int k = 0; k < 8; ++k) { const int r = 8 * k + (lane >> 3), c = lane & 7; v4u w = (v4u){0u, 0u, 0u, 0u};
        if (r < nvalid) w = *(const v4u*)(src_row0 + (size_t)r * pitch + 8 * c);
        *(LAS v4u*)(dst + r * 128 + ((c ^ (r & 7)) * 16)) = w; }
}
__device__ __forceinline__ void attn_sample_unit(const In& I, unsigned char* ws, LAS unsigned char* lds, int bs, int g, int wave, int lane) {
    const int fr = lane & 15, fq = lane >> 4, h = fr & 3, tq = fr >> 2;
    const bf16* QN = (const bf16*)(ws + WS_QN); const bf16* QR = (const bf16*)(ws + WS_QR); const float* GATES = (const float*)(ws + WS_GATES); bf16* O = (bf16*)(ws + WS_AC);
    LAS float* IMP = (LAS float*)(lds + SAT_IMP); LAS unsigned* SELM = (LAS unsigned*)(lds + SAT_SELM);
    LAS unsigned char* my = lds + wave * 16384;
    const size_t row = (size_t)MP + 4 * bs + tq; const int hc = (g * 4 + h) * 64;
    f32x4 acc[2][4]; float lsum[2] = {0.f, 0.f};
    f32x4 oc[2][4]; float lc = 0.f;
#pragma unroll
    for (int d = 0; d < 4; ++d) { acc[0][d] = (f32x4){0.f, 0.f, 0.f, 0.f}; acc[1][d] = acc[0][d]; oc[0][d] = acc[0][d]; oc[1][d] = acc[0][d]; }
    if (wave == 0) {
        const bf16* KC = (const bf16*)(ws + WS_KC) + ((size_t)(2 + bs) * 4 + g) * 128 * 64; const bf16* VC = (const bf16*)(ws + WS_VC) + ((size_t)(2 + bs) * 4 + g) * 128 * 64;
        bf16x8 q[2];
#pragma unroll
        for (int ks = 0; ks < 2; ++ks) q[ks] = *(const bf16x8*)(QN + row * D + hc + 32 * ks + 8 * fq);
        f32x4 sc[2][4];
#pragma unroll 1
        for (int i = 0; i < 2; ++i) {
            stage_bf16_rows(my, KC + (size_t)i * 64 * 64, 64, 64, lane); stage_bf16_rows(my + 8192, VC + (size_t)i * 64 * 64, 64, 64, lane);
            asm volatile("s_waitcnt lgkmcnt(0)" ::: "memory");
            bf16x8 kf[4][2]; kfrags(kf, my, fr, fq);
            f32x4 t[4];
#pragma unroll
            for (int k = 0; k < 4; ++k) { t[k] = (f32x4){0.f, 0.f, 0.f, 0.f};
#pragma unroll
                for (int ks = 0; ks < 2; ++ks) t[k] = __builtin_amdgcn_mfma_f32_16x16x32_bf16(kf[k][ks], q[ks], t[k], 0, 0, 0);
#pragma unroll
                for (int e = 0; e < 4; ++e) { t[k][e] = fast_exp2(t[k][e]); lc += t[k][e]; } }
            bf16x8 p[2][2]; p[0][0] = pack_p(t[0], t[1]); p[0][1] = pack_p(t[2], t[3]); p[1][0] = p[0][0]; p[1][1] = p[0][1];
            pv_block(my + 8192, true, false, p, oc, fr, fq);
            asm volatile("s_waitcnt lgkmcnt(0)" ::: "memory");
#pragma unroll
            for (int k = 0; k < 4; ++k) { if (i == 0) sc[0][k] = t[k]; else sc[1][k] = t[k]; }
        }
        lc += __shfl_xor(lc, 16); lc += __shfl_xor(lc, 32);
        const float inv = 1.f / lc;
#pragma unroll
        for (int i = 0; i < 2; ++i)
#pragma unroll
            for (int k = 0; k < 4; ++k) { f32x4 pn = sc[i][k] * inv;
#pragma unroll
                for (int e = 0; e < 4; ++e) { float t = pn[e]; t += __shfl_xor(t, 1); t += __shfl_xor(t, 2); pn[e] = t; }
                if (h == 0) *(LAS f32x4*)(IMP + tq * 132 + 64 * i + 16 * k + 4 * fq) = pn; }
    }
    asm volatile("s_waitcnt lgkmcnt(0)" ::: "memory"); __builtin_amdgcn_s_barrier(); asm volatile("" ::: "memory");
    if (wave < 4) {
        const float v0 = IMP[wave * 132 + lane], v1 = IMP[wave * 132 + 64 + lane];
        unsigned u0 = (lane >= 1) ? __float_as_uint(v0) : 0u, u1 = (lane + 64 <= 126) ? __float_as_uint(v1) : 0u;
        unsigned long long mlo = 1ull, mhi = 1ull << 63;
#pragma unroll 1
        for (int r = 0; r < 13; ++r) { const unsigned m = dpp_max_u32(max(u0, u1));
            const unsigned long long b0 = __ballot(u0 == m);
            if (b0) { const int idx = __builtin_ctzll(b0); mlo |= 1ull << idx; if (lane == idx) u0 = 0u; }
            else { const unsigned long long b1 = __ballot(u1 == m); const int idx = __builtin_ctzll(b1); mhi |= 1ull << idx; if (lane == idx) u1 = 0u; } }
        if (lane == 0) { SELM[wave * 8 + 0] = (unsigned)mlo; SELM[wave * 8 + 1] = (unsigned)(mlo >> 32); SELM[wave * 8 + 2] = (unsigned)mhi; SELM[wave * 8 + 3] = (unsigned)(mhi >> 32); }
    }
    asm volatile("s_waitcnt lgkmcnt(0)" ::: "memory"); __builtin_amdgcn_s_barrier(); asm volatile("" ::: "memory");
    unsigned selw[4];
#pragma unroll
    for (int w = 0; w < 4; ++w) selw[w] = SELM[tq * 8 + w];
    unsigned long long un_lo = 0ull, un_hi = 0ull;
#pragma unroll
    for (int t = 0; t < 4; ++t) { un_lo |= (unsigned long long)SELM[t * 8 + 0] | ((unsigned long long)SELM[t * 8 + 1] << 32); un_hi |= (unsigned long long)SELM[t * 8 + 2] | ((unsigned long long)SELM[t * 8 + 3] << 32); }
    un_lo = ((unsigned long long)__builtin_amdgcn_readfirstlane((unsigned)(un_lo >> 32)) << 32) | (unsigned)__builtin_amdgcn_readfirstlane((unsigned)un_lo);
    un_hi = ((unsigned long long)__builtin_amdgcn_readfirstlane((unsigned)(un_hi >> 32)) << 32) | (unsigned)__builtin_amdgcn_readfirstlane((unsigned)un_hi);
    bf16x8 qr[2][2];
#pragma unroll
    for (int ks = 0; ks < 2; ++ks) { qr[0][ks] = *(const bf16x8*)(QR + row * D + hc + 32 * ks + 8 * fq); qr[1][ks] = qr[0][ks]; }
    int cnt = 0;
    { const int* pt = I.page_table + bs * NPAGE;
#pragma unroll 1
      for (int n = 0; n < 128; ++n) { const bool on = ((n < 64 ? un_lo >> n : un_hi >> (n - 64)) & 1ull) != 0ull; if (!on) continue;
          if ((cnt++ & 7) != wave) continue;
          const int pg = pt[n >> 1]; const size_t ro = ((size_t)pg * 128 + (n & 1) * 64) * KVW + g * 64;
          stage_f32_rows(my, I.ck_sel + ro, lane); stage_f32_rows(my + 8192, I.cv_sel + ro, lane);
          asm volatile("s_waitcnt lgkmcnt(0)" ::: "memory");
          const int wi = n >> 5; const unsigned wd = wi == 0 ? selw[0] : (wi == 1 ? selw[1] : (wi == 2 ? selw[2] : selw[3]));
          const float bias[2] = {((wd >> (n & 31)) & 1u) ? 0.f : -INFINITY, 0.f}; const int lo[2] = {0, 0}, hi[2] = {63, 63};
          attn_block<false>(my, my + 8192, true, false, qr, bias, lo, hi, acc, lsum, fr, fq);
          asm volatile("s_waitcnt lgkmcnt(0)" ::: "memory"); } }
#pragma unroll 1
    for (int wb = 0; wb < 8; ++wb) { if ((cnt++ & 7) != wave) continue;
        const size_t ro = ((size_t)bs * 512 + 64 * wb) * KVW + g * 64;
        stage_f32_rows(my, I.ck_win + ro, lane); stage_f32_rows(my + 8192, I.cv_win + ro, lane);
        asm volatile("s_waitcnt lgkmcnt(0)" ::: "memory");
        const float bias[2] = {0.f, 0.f}; const int lo[2] = {0, wb == 0 ? tq + 1 : 0}, hi[2] = {63, 63};
        attn_block<true>(my, my + 8192, false, true, qr, bias, lo, hi, acc, lsum, fr, fq);
        asm volatile("s_waitcnt lgkmcnt(0)" ::: "memory"); }
    if ((cnt++ & 7) == wave) {
        stage_bf16_rows(my, (const bf16*)(ws + WS_KS) + ((size_t)MP + 4 * bs) * KVW + g * 64, KVW, 4, lane); stage_bf16_rows(my + 8192, (const bf16*)(ws + WS_VS) + ((size_t)MP + 4 * bs) * KVW + g * 64, KVW, 4, lane);
        asm volatile("s_waitcnt lgkmcnt(0)" ::: "memory");
        const float bias[2] = {0.f, 0.f}; const int lo[2] = {0, 0}, hi[2] = {tq, tq};
        attn_block<true>(my, my + 8192, true, false, qr, bias, lo, hi, acc, lsum, fr, fq);
        asm volatile("s_waitcnt lgkmcnt(0)" ::: "memory"); }
    if ((cnt++ & 7) == wave) {
        stage_bf16_rows(my, (const bf16*)(ws + WS_KW) + ((size_t)MP + 4 * bs) * KVW + g * 64, KVW, 4, lane); stage_bf16_rows(my + 8192, (const bf16*)(ws + WS_VW) + ((size_t)MP + 4 * bs) * KVW + g * 64, KVW, 4, lane);
        asm volatile("s_waitcnt lgkmcnt(0)" ::: "memory");
        const float bias[2] = {0.f, 0.f}; const int lo[2] = {0, 0}, hi[2] = {tq, tq};
        attn_block<true>(my, my + 8192, false, true, qr, bias, lo, hi, acc, lsum, fr, fq);
        asm volatile("s_waitcnt lgkmcnt(0)" ::: "memory"); }
    __builtin_amdgcn_s_barrier(); asm volatile("" ::: "memory");
    { LAS float* red = (LAS float*)lds + wave * (2 * 17 * 64);
#pragma unroll
      for (int br = 0; br < 2; ++br) {
#pragma unroll
          for (int d = 0; d < 4; ++d)
#pragma unroll
              for (int e = 0; e < 4; ++e) red[(br * 17 + 4 * d + e) * 64 + lane] = acc[br][d][e];
          red[(br * 17 + 16) * 64 + lane] = lsum[br]; } }
    asm volatile("s_waitcnt lgkmcnt(0)" ::: "memory"); __builtin_amdgcn_s_barrier(); asm volatile("" ::: "memory");
    if (wave == 0) {
        float outv[16];
        const float gc = GATES[row * 48 + (g * 4 + h) * 3 + 0] / lc;
#pragma unroll
        for (int d = 0; d < 4; ++d)
#pragma unroll
            for (int e = 0; e < 4; ++e) outv[4 * d + e] = oc[0][d][e] * gc;
#pragma unroll
        for (int br = 0; br < 2; ++br) { float ls = 0.f; float ob[16];
#pragma unroll
            for (int k = 0; k < 16; ++k) ob[k] = 0.f;
#pragma unroll 1
            for (int w = 0; w < 8; ++w) { const LAS float* red = (const LAS float*)lds + w * (2 * 17 * 64);
#pragma unroll
                for (int k = 0; k < 16; ++k) ob[k] += red[(br * 17 + k) * 64 + lane];
                ls += red[(br * 17 + 16) * 64 + lane]; }
            ls += __shfl_xor(ls, 16); ls += __shfl_xor(ls, 32);
            const float gb = GATES[row * 48 + (g * 4 + h) * 3 + 1 + br] * (ls > 0.f ? 1.f / ls : 0.f);
#pragma unroll
            for (int k = 0; k < 16; ++k) outv[k] += ob[k] * gb; }
#pragma unroll
        for (int d = 0; d < 4; ++d) { v2u w; w.x = pk2(outv[4 * d], outv[4 * d + 1]); w.y = pk2(outv[4 * d + 2], outv[4 * d + 3]); *(v2u*)(O + row * D + hc + 16 * d + 4 * fq) = w; }
    }
    asm volatile("s_waitcnt lgkmcnt(0)" ::: "memory"); __builtin_amdgcn_s_barrier(); asm volatile("" ::: "memory");
}
__device__ __forceinline__ void attention_phase(const In& I, unsigned char* ws, LAS unsigned char* lds, int vcu, int G) {
    int tid_ = threadIdx.x; asm volatile("" : "+v"(tid_));
    const int wave = __builtin_amdgcn_readfirstlane(tid_ >> 6), lane = tid_ & 63;
#pragma unroll 1
    for (int k = vcu; k < 1024; k += G) { int bg = k & 7, qb = 127 - (k >> 3);
        if (G == 256) { const int i = k >> 8, j = vcu & 31; bg = vcu >> 5; qb = i == 0 ? 127 - j : (i == 1 ? 64 + j : (i == 2 ? 63 - j : j)); }
        asm volatile("; MARK_PROMPT_UNIT");
        attn_prompt_unit(ws, lds, bg >> 2, bg & 3, qb, wave, lane); }
#pragma unroll 1
    for (int k = (G == 256) ? ((vcu & 1) ? (vcu >> 1) : 128) : vcu; k < 128; k += G) { asm volatile("; MARK_SAMPLE_UNIT"); attn_sample_unit(I, ws, lds, k >> 2, k & 3, wave, lane); }
    asm volatile("; MARK_ATT_END");
}

#ifndef NSA_MIXER_BODY
#define NSA_MIXER_BODY { CmpSrc cs{out + O_KCP, out + O_VCP, nullptr, 0, 2}; compress_phase(I, ws, lds, cs, vcu, G); } SEAM(); \
    attention_phase(I, ws, lds, vcu, G); SEAM();
#endif

struct Args { const void* in[26]; float* out; unsigned char* ws; int ph_lo, ph_hi; };
__global__ void __launch_bounds__(NWAVES * 64, 2) fwd(Args args) {
    extern __shared__ __attribute__((aligned(16))) unsigned char lds_[];
    LAS unsigned char* lds = (LAS unsigned char*)lds_;
    const int tid = threadIdx.x, lane = tid & 63, wave = __builtin_amdgcn_readfirstlane(tid >> 6);
    const int G = gridDim.x; int vcu; { const int bx = blockIdx.x; vcu = (G % 8 == 0) ? (bx % 8) * (G / 8) + bx / 8 : bx; }
    unsigned char* ws = args.ws; float* out = args.out;
    gu32* ctl = (gu32*)(ws + WS_CTL);
    In I;
    I.x_prompt = (const float*)args.in[0]; I.x_sample = (const float*)args.in[1]; I.state_conv = (const float*)args.in[2]; I.ck_cmp = (const float*)args.in[3]; I.cv_cmp = (const float*)args.in[4];
    I.ck_sel = (const float*)args.in[5]; I.cv_sel = (const float*)args.in[6]; I.ck_win = (const float*)args.in[7]; I.cv_win = (const float*)args.in[8]; I.page_table = (const int*)args.in[9];
    I.p_prompt = (const float*)args.in[10]; I.p_sample = (const float*)args.in[11]; I.norm_g = (const float*)args.in[12]; I.w_gu = (const float*)args.in[13]; I.w_down = (const float*)args.in[14];
    I.w_proj = (const float*)args.in[15]; I.w_gate = (const float*)args.in[16]; I.cw_in = (const float*)args.in[17]; I.cw = (const float*)args.in[18]; I.cw_out = (const float*)args.in[19];
    I.nw_in = (const float*)args.in[20]; I.qk_g = (const float*)args.in[21]; I.cmp_pos = (const float*)args.in[22]; I.cmp_w1 = (const float*)args.in[23]; I.cmp_w2 = (const float*)args.in[24]; I.nw_out = (const float*)args.in[25];
    for (int u = tid; u < (LDS_BYTES - LDSCTL_OFF) / 4; u += NWAVES * 64) ((LAS unsigned*)(lds + LDSCTL_OFF))[u] = 0u;
    __syncthreads();
    (void)xcd_barrier_post((unsigned*)ctl + CW_BAR, (volatile LAS unsigned*)(lds + MISC_OFF) + 8);
    const int hi = args.ph_hi; int pid = 0;
#define SEAM() do { asm volatile("; SEAM_MARK %0" :: "i"(__LINE__)); ++pid; if (pid >= hi) return; XcdBarrier b_; b_.bar = (unsigned*)(ws + WS_CTL) + CW_BAR; b_.x = xb_xcc_id(); b_.st = (volatile LAS unsigned*)(lds + MISC_OFF) + 8; xcd_barrier(b_); } while (0)


    bf16* const XB_0 = (bf16*)(ws + WS_XB); bf16* const XB_1 = (bf16*)(ws + WS_XB + SZ_XB);
    float* const SS_0 = (float*)(ws + WS_SS); float* const SS_1 = (float*)(ws + WS_SS + SZ_SS);
    bf16* const Hb = (bf16*)(ws + WS_H); bf16* const ACb = (bf16*)(ws + WS_AC);
    bf16* const PBb = (bf16*)(ws + WS_PB); bf16* const Pb = (bf16*)(ws + WS_P);

#ifdef PH_HI_OVERRIDE
    { const size_t gt = (size_t)(vcu * NWAVES + wave) * 64 + lane, NT = (size_t)G * NWAVES * 64;
      for (size_t i = DBG_FILL_FROM / 4 + gt; i < O_END / 4; i += NT) ((GAS f32x4*)out)[i] = (f32x4){0.f, 0.f, 0.f, 0.f}; }
#endif
    p0_prologue(I, out, ws, lds, vcu, G, wave, lane);
    cmp_bias_partials(I, ws, vcu, G, wave, lane);
    SEAM();
#define PH_PROJ(l) { const bf16* Wp = (const bf16*)(ws + WS_WPROJ + (size_t)(l) * SZ_WPROJ); int kk_ = PLE; asm volatile("" : "+s"(kk_)); \
      pg8::Gemm g{PBb + (size_t)(l) * MT * PLE, Wp, MP, D, kk_}; GOrder S; S.init(MP, D, G, (int)blockIdx.x); pg8::EpiRaw<false> E{Pb + (size_t)(l) * MT * D, D, nullptr}; \
      pg8::gemm_phase<pg8::EpiRaw<false>, GOrder, true, true>(lds, g, S, E); \
      SkRaw<false> SE{Pb + (size_t)(l) * MT * D, D, nullptr}; skinny_phase<0>(lds, PBb + ((size_t)(l) * MT + MP) * PLE, Wp, PLE, D / 64, SE, vcu, G); }
    PH_PROJ(0)
    PH_PROJ(1)
    cmp_bias_reduce(ws, vcu, tid);
    SEAM();
    { CmpSrc cs{I.ck_cmp, I.cv_cmp, I.page_table, 2, 32}; compress_phase(I, ws, lds, cs, vcu, G); }
    SEAM();

#define XBP(c) ((bf16*)(ws + WS_XB + (size_t)(c) * SZ_XB))
#define SSP(c) ((float*)(ws + WS_SS + (size_t)(c) * SZ_SS))
#define PH_GU(l, s, c) { const bf16* Wgu = (const bf16*)(ws + WS_WGU + (size_t)((l) * 2 + (s)) * SZ_WGU); \
      pg8::Gemm g{XBP(c), Wgu, MP, NGU, D}; GOrder S; S.init(MP, NGU, G, (int)blockIdx.x); pg8::EpiSwiglu E{Hb, SSP(c)}; \
      pg8::gemm_phase<pg8::EpiSwiglu, GOrder, true, true>(lds, g, S, E); \
      SkSwiglu SE{Hb, SSP(c)}; skinny_phase<1>(lds, XBP(c) + (size_t)MP * D, Wgu, D, FF / 32, SE, vcu, G); } SEAM();
#define PH_RESID(Asrc, K_, Wt, scale, c) { pg8::Gemm g{(Asrc), (const bf16*)(Wt), MP, D, (K_)}; GOrder S; S.init(MP, D, G, (int)blockIdx.x); \
      pg8::EpiResid<false, false> E{out, XBP((c) ^ 1), SSP((c) ^ 1), (scale), nullptr, nullptr}; \
      pg8::gemm_phase<pg8::EpiResid<false, false>, GOrder, true, true>(lds, g, S, E); \
      SkResid<false> SE{out, XBP((c) ^ 1), SSP((c) ^ 1), (scale), nullptr, nullptr, 0}; skinny_phase<0>(lds, (Asrc) + (size_t)MP * (K_), (const bf16*)(Wt), (K_), D / 64, SE, vcu, G); } SEAM();
#define PH_RAW(Wt, N_, NCU_, c) { pg8::Gemm g{XBP(c), (const bf16*)(Wt), MP, (N_), D}; GOrder S; S.init(MP, (N_), G, (int)blockIdx.x); pg8::EpiRaw<true> E{Hb, (N_), SSP(c)}; \
      pg8::gemm_phase<pg8::EpiRaw<true>, GOrder, true, true>(lds, g, S, E); \
      SkRaw<true> SE{Hb, (N_), SSP(c)}; skinny_phase<0>(lds, XBP(c) + (size_t)MP * D, (const bf16*)(Wt), D, (NCU_), SE, vcu, G); } SEAM();
#define PH_GATE(l, c, FIN) { const bf16* Wg = (const bf16*)(ws + WS_WGATE + (size_t)(l) * SZ_WSQ); const bf16* Pl = Pb + (size_t)(l) * MT * D; \
      pg8::Gemm g{XBP(c), Wg, MP, D, D}; GOrder S; S.init(MP, D, G, (int)blockIdx.x); pg8::EpiResid<true, FIN> E{out, XBP((c) ^ 1), SSP((c) ^ 1), 1.0f, SSP(c), Pl}; \
      pg8::gemm_phase<pg8::EpiResid<true, FIN>, GOrder, true, true>(lds, g, S, E); \
      SkResid<true> SE{out, XBP((c) ^ 1), SSP((c) ^ 1), 1.0f, SSP(c), Pl, FIN}; skinny_phase<0>(lds, XBP(c) + (size_t)MP * D, Wg, D, D / 64, SE, vcu, G); } SEAM();

    PH_GU(0, 0, 0)
    PH_RESID(Hb, FF, ws + WS_WDN + 0 * SZ_WDN, 0.5f, 0)
    PH_RAW(ws + WS_WCIN, NCV, NCV / 64, 1)
    conv_post(I, out, ws, vcu, G, wave, lane); SEAM();
    PH_RESID(ACb, D, ws + WS_WCOUT, 1.0f, 1)
    PH_GU(0, 1, 0)
    PH_RESID(Hb, FF, ws + WS_WDN + 1 * SZ_WDN, 0.5f, 0)
    PH_GATE(0, 1, false)
    PH_GU(1, 0, 0)
    PH_RESID(Hb, FF, ws + WS_WDN + 2 * SZ_WDN, 0.5f, 0)
    PH_RAW(ws + WS_WNIN, NNSP, (NNS + 63) / 64, 1)
    nsa_post(I, out, ws, vcu, G, wave, lane); SEAM();
    NSA_MIXER_BODY
    PH_RESID(ACb, D, ws + WS_WNOUT, 1.0f, 1)
    PH_GU(1, 1, 0)
    PH_RESID(Hb, FF, ws + WS_WDN + 3 * SZ_WDN, 0.5f, 0)
    PH_GATE(1, 1, true)
#ifdef DBG_SCALE_FROM
    { const size_t gt = (size_t)(vcu * NWAVES + wave) * 64 + lane, NT = (size_t)G * NWAVES * 64;
      for (size_t i = (DBG_SCALE_FROM) / 4 + gt; i < (DBG_SCALE_TO) / 4; i += NT) ((GAS f32x4*)out)[i] *= 1.2f; }
#endif
#undef SEAM
}

#ifdef PH_HI_OVERRIDE
#define PH_HI PH_HI_OVERRIDE
#endif
#ifndef PH_HI
#define PH_HI 1000
#endif
extern "C" void kernel_launch(void* const* d_in, const int* in_sizes, int n_in, void* d_out, int out_size, void* d_ws, size_t ws_size, hipStream_t stream) {
    static int grid = 0;
    if (grid == 0) {
        if (n_in != 26 || out_size != (int)O_END || ws_size < WS_END) { fprintf(stderr, "kernel_launch: unexpected sizes n_in %d out %d ws %zu (need %zu)\n", n_in, out_size, ws_size, (size_t)WS_END); grid = -1; return; }
        int dev = 0, cus = 0, per_cu = 0;
        if (hipGetDevice(&dev) != hipSuccess || hipDeviceGetAttribute(&cus, hipDeviceAttributeMultiprocessorCount, dev) != hipSuccess) { grid = -1; return; }
        if (hipFuncSetAttribute((const void*)fwd, hipFuncAttributeMaxDynamicSharedMemorySize, LDS_BYTES) != hipSuccess) { fprintf(stderr, "kernel_launch: hipFuncSetAttribute failed\n"); grid = -1; return; }
        if (hipOccupancyMaxActiveBlocksPerMultiprocessor(&per_cu, (const void*)fwd, NWAVES * 64, LDS_BYTES) != hipSuccess || per_cu < 1) { fprintf(stderr, "kernel_launch: occupancy query says %d\n", per_cu); (void)hipGetLastError(); grid = -1; return; }
        grid = cus;
    }
    if (grid < 0) return;
    (void)hipMemsetAsync((char*)d_ws + WS_CTL, 0, CTL_ZERO_BYTES, stream);
    Args a{};
    for (int i = 0; i < 26; ++i) a.in[i] = d_in[i];
    a.out = (float*)d_out; a.ws = (unsigned char*)d_ws; a.ph_lo = 0; a.ph_hi = PH_HI;
    hipLaunchKernelGGL(fwd, dim3(grid), dim3(NWAVES * 64), LDS_BYTES, stream, a);
}
```

```cpp
#include <hip/hip_runtime.h>
#include <cstdio>
#include <cstdint>

#define GAS __attribute__((address_space(1)))
#define LAS __attribute__((address_space(3)))
typedef unsigned short bf16;
typedef unsigned v4u __attribute__((ext_vector_type(4)));
typedef unsigned v2u __attribute__((ext_vector_type(2)));
typedef float f32x4 __attribute__((ext_vector_type(4)));
typedef float f32x2 __attribute__((ext_vector_type(2)));
typedef short bf16x8 __attribute__((ext_vector_type(8)));
typedef short s16x4 __attribute__((ext_vector_type(4)));
typedef GAS unsigned gu32;

constexpr int D = 1024, MP = 16384, MS = 128, MT = MP + MS, FF = 2816, NGU = 2 * FF, NCV = 3072, NNS = 2608, NNSP = 2816, PLE = 256;
constexpr int SEQ = 8192, SB = 32, ST = 4, PAST = 8192, NPAGE = 64, HD = 64, KVW = 256, WIN = 512, NBT = 34  ;
constexpr float RMS_EPS = 1e-6f;
constexpr float QSCALE = 0.125f * 1.4426950408889634f;

constexpr size_t O_Y = 0, O_YS = O_Y + (size_t)MP * D, O_CONVP = O_YS + (size_t)MS * D, O_CONVS = O_CONVP + 2 * 2 * D, O_KCP = O_CONVS + 32 * 2 * D;
constexpr size_t SZ_P = (size_t)MP * KVW, SZ_WP = 2 * 512 * KVW, SZ_S = (size_t)MS * KVW, SZ_WS = 32 * 512 * KVW;
constexpr size_t O_VCP = O_KCP + SZ_P, O_KSP = O_VCP + SZ_P, O_VSP = O_KSP + SZ_P, O_KWP = O_VSP + SZ_P, O_VWP = O_KWP + SZ_WP;
constexpr size_t O_KCS = O_VWP + SZ_WP, O_VCS = O_KCS + SZ_S, O_KSS = O_VCS + SZ_S, O_VSS = O_KSS + SZ_S, O_KWS = O_VSS + SZ_S, O_VWS = O_KWS + SZ_WS, O_END = O_VWS + SZ_WS;
static_assert(O_END == 42799104, "d_out size");

constexpr size_t MiB = 1u << 20;
constexpr size_t WS_CTL = 0, CTL_ZERO_BYTES = 1 * MiB;
constexpr size_t WS_WGU = 2 * MiB;
constexpr size_t SZ_WGU = (size_t)NGU * D * 2;
constexpr size_t WS_WDN = WS_WGU + 4 * SZ_WGU;
constexpr size_t SZ_WDN = (size_t)D * FF * 2;
constexpr size_t WS_WGATE = WS_WDN + 4 * SZ_WDN;
constexpr size_t SZ_WSQ = (size_t)D * D * 2;
constexpr size_t WS_WPROJ = WS_WGATE + 2 * SZ_WSQ;
constexpr size_t SZ_WPROJ = (size_t)D * PLE * 2;
constexpr size_t WS_WCIN = WS_WPROJ + 2 * SZ_WPROJ;
constexpr size_t WS_WCOUT = WS_WCIN + (size_t)NCV * D * 2;
constexpr size_t WS_WNIN = WS_WCOUT + SZ_WSQ;
constexpr size_t WS_WNOUT = WS_WNIN + (size_t)NNSP * D * 2;
constexpr size_t WS_W1T = WS_WNOUT + SZ_WSQ;
constexpr size_t WS_W2T = WS_W1T + 2 * (size_t)128 * 4096 * 2;
constexpr size_t WS_ROPE = WS_W2T + 2 * 64 * 128 * 2;
constexpr size_t WS_SS = (WS_ROPE + (size_t)8196 * 64 * 4 + MiB - 1) / MiB * MiB;
constexpr size_t SZ_SS = (size_t)MT * 16 * 4;
constexpr size_t WS_XB = (WS_SS + 2 * SZ_SS + MiB - 1) / MiB * MiB;
constexpr size_t SZ_XB = (size_t)MT * D * 2;
constexpr size_t WS_H = (WS_XB + 2 * SZ_XB + MiB - 1) / MiB * MiB;
constexpr size_t WS_AC = (WS_H + (size_t)MT * NCV * 2 + MiB - 1) / MiB * MiB;
constexpr size_t WS_PB = (WS_AC + SZ_XB + MiB - 1) / MiB * MiB;
constexpr size_t WS_P = (WS_PB + 2 * (size_t)MT * PLE * 2 + MiB - 1) / MiB * MiB;
constexpr size_t WS_QN = (WS_P + 2 * SZ_XB + MiB - 1) / MiB * MiB;
constexpr size_t WS_QR = (WS_QN + SZ_XB + MiB - 1) / MiB * MiB;
constexpr size_t SZ_KV = (size_t)MT * KVW * 2;
constexpr size_t WS_KS = (WS_QR + SZ_XB + MiB - 1) / MiB * MiB;
constexpr size_t WS_VS = WS_KS + SZ_KV, WS_KW = WS_VS + SZ_KV, WS_VW = WS_KW + SZ_KV;
constexpr size_t WS_GATES = (WS_VW + SZ_KV + MiB - 1) / MiB * MiB;
constexpr size_t WS_KC = (WS_GATES + (size_t)MT * 48 * 4 + MiB - 1) / MiB * MiB;
constexpr size_t SZ_KC = (size_t)NBT * 4 * 128 * 64 * 2;
constexpr size_t WS_VC = (WS_KC + SZ_KC + MiB - 1) / MiB * MiB;
constexpr size_t WS_CPART = (WS_VC + SZ_KC + MiB - 1) / MiB * MiB;
constexpr size_t WS_CBIAS = WS_CPART + 2 * 64 * 128 * 4;
constexpr size_t WS_END = WS_CPART + MiB;

constexpr int CW_TMO = 0, CW_CODE = 1, CW_BAR = 4096;

constexpr int RING_BYTES = 131072, LDSCTL_OFF = RING_BYTES, MISC_OFF = LDSCTL_OFF + 320, LDS_BYTES = 147456;
constexpr int NWAVES = 8;

#define RLX_AGENT __ATOMIC_RELAXED, __HIP_MEMORY_SCOPE_AGENT
#define LDS_WAIT() asm volatile("s_waitcnt lgkmcnt(0)" ::: "memory")
#define VM_WAIT() asm volatile("s_waitcnt vmcnt(0)" ::: "memory")

typedef float f2v __attribute__((ext_vector_type(2)));
typedef __bf16 b2v __attribute__((ext_vector_type(2)));
__device__ __forceinline__ unsigned pk2(float lo, float hi) { f2v v = {lo, hi}; b2v b = __builtin_convertvector(v, b2v); return __builtin_bit_cast(unsigned, b); }
__device__ __forceinline__ float bflo(unsigned u) { return __uint_as_float(u << 16); }
__device__ __forceinline__ float bfhi(unsigned u) { return __uint_as_float(u & 0xffff0000u); }
__device__ __forceinline__ float fast_exp2(float x) { return __builtin_amdgcn_exp2f(x); }
__device__ __forceinline__ float sigmoidf_(float x) { return __builtin_amdgcn_rcpf(1.f + fast_exp2(-1.4426950408889634f * x)); }

namespace pg8 {
#define PG8_LAS __attribute__((address_space(3)))
typedef unsigned short bf16_t;
typedef short bf16x8 __attribute__((ext_vector_type(8)));
typedef float f32x4 __attribute__((ext_vector_type(4)));
typedef unsigned u32x4 __attribute__((ext_vector_type(4)));
constexpr int BM = 256, BK = 64, HALF = 128, HTB = HALF * BK * 2  , STAGE_BYTES = 8 * HTB, NXCD = 8, WGM = 8;

__host__ __device__ __forceinline__ int lds_byte(int r, int c) { const int st = (r >> 4) * 2 + (c >> 5), rr = r & 15, cc = c & 31, ob = rr * 64 + cc * 2; return st * 1024 + (ob ^ (((ob >> 9) & 1) << 5)); }
__host__ __device__ __forceinline__ void stage_rc(int b, int& R, int& C) { const int st = b / 1024, sb = b % 1024, swz = sb ^ (((sb >> 9) & 1) << 5); R = (st >> 1) * 16 + swz / 64; C = (st & 1) * 32 + (swz % 64) / 2; }
__host__ __device__ __forceinline__ int perm32(int rho) { const int n = rho >> 4, i = rho & 15; return 8 * (i >> 2) + 4 * n + (i & 3); }

struct Unit { int pm, pn; };
struct Gemm { const bf16_t* A; const bf16_t* Bt; int M, N, K; };

struct StaticOrder {
    int nM, nN, nwg, G, c;
    __host__ __device__ void init(int M, int N, int G_, int c_) { nM = M / BM; nN = N / BM; nwg = nM * nN; G = G_; c = c_; }
    __host__ __device__ bool next(int i, Unit& u) const {
        const long L = (long)i * G + c; if (L >= nwg) return false;
        int wgid = (int)L; { const int q = nwg / NXCD, r = nwg % NXCD, xcd = wgid % NXCD, off = wgid / NXCD; wgid = (xcd < r ? xcd * (q + 1) : r * (q + 1) + (xcd - r) * q) + off; }
        const int nig = WGM * nN, gid = wgid / nig, fm = gid * WGM, gsz = (nM - fm) < WGM ? (nM - fm) : WGM;
        u.pm = fm + ((wgid % nig) % gsz); u.pn = (wgid % nig) / gsz; return true;
    }
    __device__ __forceinline__ void a_ready(const Unit&) const {}
    __device__ __forceinline__ void done(const Unit&) const {}
};
template <class Epi, class Sched, bool ALIGN_EPI = false, bool SP2 = false>
__device__ __forceinline__ void gemm_phase(PG8_LAS unsigned char* lds, const Gemm g, const Sched& S, const Epi& E) {
    int tid_ = threadIdx.x; asm volatile("" : "+v"(tid_));
    const int tid = tid_, wid = __builtin_amdgcn_readfirstlane(tid >> 6), lane = tid & 63, wr = wid >> 2, wc = wid & 3, fr = lane & 15, fq = lane >> 4;
    const int K = g.K, nt = K / BK;
    unsigned voffA[2], voffB[2];
#pragma unroll
    for (int i = 0; i < 2; ++i) { int R, C; stage_rc(tid * 16 + i * 8192, R, C); const int Rb = Epi::PERM ? ((R & ~31) + perm32(R & 31)) : R;
        voffA[i] = (unsigned)(R * K + C) * 2u; voffB[i] = (unsigned)(Rb * K + C) * 2u; }
    const size_t kstep = (size_t)(BK * 2);
    const size_t hstep = (size_t)HALF * K * 2;
    const size_t tstep = 2 * hstep;
    const unsigned ldsw = (unsigned)wid * 1024u;
    const int aoff = lds_byte(wr * 64 + fr, fq * 8), boff = lds_byte(wc * 32 + fr, fq * 8);
#define PG8_SA(b, h) (((b) * 2 + (h)) * HTB)
#define PG8_SB(b, h) ((4 + (b) * 2 + (h)) * HTB)
#define PG8_STAGE(bufoff, gbase, voff) do { _Pragma("unroll") for (int _i = 0; _i < 2; ++_i) \
        __builtin_amdgcn_global_load_lds((const unsigned*)((const char*)(gbase) + (voff)[_i]), (PG8_LAS unsigned*)(lds + (bufoff) + ldsw + _i * 8192), 16, 0, 0); } while (0)
#define PG8_LDA(dst, b, h) do { _Pragma("unroll") for (int m = 0; m < 4; ++m) _Pragma("unroll") for (int k = 0; k < 2; ++k) dst[m][k] = *(const PG8_LAS bf16x8*)(lds + PG8_SA(b, h) + aoff + m * 2048 + k * 1024); } while (0)
#define PG8_LDB(dst, b, h) do { _Pragma("unroll") for (int n = 0; n < 2; ++n) _Pragma("unroll") for (int k = 0; k < 2; ++k) dst[n][k] = *(const PG8_LAS bf16x8*)(lds + PG8_SB(b, h) + boff + n * 2048 + k * 1024); } while (0)
#define PG8_MMA(ai, bj, At, Bt) do { __builtin_amdgcn_s_setprio(1); _Pragma("unroll") for (int m = 0; m < 4; ++m) _Pragma("unroll") for (int n = 0; n < 2; ++n) _Pragma("unroll") for (int k = 0; k < 2; ++k) \
        acc[ai][bj][m][n] = __builtin_amdgcn_mfma_f32_16x16x32_bf16(Bt[n][k], At[m][k], acc[ai][bj][m][n], 0, 0, 0); __builtin_amdgcn_s_setprio(0); } while (0)
#define PG8_WAIT_V(n) asm volatile("s_waitcnt vmcnt(" #n ")" ::: "memory")
#define PG8_WAIT_L(n) asm volatile("s_waitcnt lgkmcnt(" #n ")" ::: "memory")
#define PG8_BAR __builtin_amdgcn_s_barrier()
#define PG8_SCHED __builtin_amdgcn_sched_barrier(0)
    Unit cur, nxt; int ui = 0;
    if (!S.next(0, cur)) return;
    f32x4 acc[2][2][4][2];
#pragma unroll
    for (int a = 0; a < 2; ++a)
#pragma unroll
        for (int b = 0; b < 2; ++b)
#pragma unroll
            for (int m = 0; m < 4; ++m)
#pragma unroll
                for (int n = 0; n < 2; ++n) acc[a][b][m][n] = (f32x4){0.f, 0.f, 0.f, 0.f};
    bf16x8 At[4][2], B0[2][2], B1[2][2];
    const char* cA = (const char*)g.A + (size_t)cur.pm * tstep; const char* cB = (const char*)g.Bt + (size_t)cur.pn * tstep;
    S.a_ready(cur);
    if constexpr (SP2) {
        PG8_STAGE(PG8_SB(0, 0), cB, voffB); PG8_STAGE(PG8_SB(0, 1), cB + hstep, voffB); PG8_STAGE(PG8_SA(0, 0), cA, voffA); PG8_STAGE(PG8_SA(0, 1), cA + hstep, voffA);
        if (wr == 1) PG8_BAR;
        PG8_WAIT_V(2); PG8_BAR;
        PG8_STAGE(PG8_SB(1, 0), cB + kstep, voffB); PG8_STAGE(PG8_SA(1, 0), cA + kstep, voffA); PG8_STAGE(PG8_SB(1, 1), cB + hstep + kstep, voffB);
        PG8_WAIT_V(6); PG8_BAR;
    } else {
        PG8_STAGE(PG8_SB(0, 0), cB, voffB); PG8_STAGE(PG8_SA(0, 0), cA, voffA); PG8_STAGE(PG8_SB(0, 1), cB + hstep, voffB); PG8_STAGE(PG8_SA(0, 1), cA + hstep, voffA);
        if (wr == 1) PG8_BAR;
        PG8_WAIT_V(4); PG8_BAR;
        PG8_STAGE(PG8_SB(1, 0), cB + kstep, voffB); PG8_STAGE(PG8_SA(1, 0), cA + kstep, voffA); PG8_STAGE(PG8_SB(1, 1), cB + hstep + kstep, voffB);
        PG8_WAIT_V(6); PG8_BAR;
    }
    for (;;) {
        const bool has_next = S.next(ui + 1, nxt);
        const char* nA = has_next ? (const char*)g.A + (size_t)nxt.pm * tstep : cA; const char* nB = has_next ? (const char*)g.Bt + (size_t)nxt.pn * tstep : cB;
        for (int t = 0; t < nt; t += 2) {
            const bool last = (t == nt - 2);
            const char* a1 = cA + (size_t)(t + 1) * kstep;
            const char* a2 = last ? nA : cA + (size_t)(t + 2) * kstep; const char* b2 = last ? nB : cB + (size_t)(t + 2) * kstep;
            const char* a3 = a2 + kstep; const char* b3 = b2 + kstep;
            if (last && has_next) S.a_ready(nxt);
            if constexpr (SP2) {
            PG8_LDB(B0, 0, 0); PG8_LDB(B1, 0, 1); PG8_SCHED; PG8_LDA(At, 0, 0); PG8_STAGE(PG8_SA(1, 1), a1 + hstep, voffA);
            PG8_WAIT_V(8); PG8_WAIT_L(0); PG8_BAR; PG8_MMA(0, 0, At, B0); PG8_MMA(0, 1, At, B1); PG8_BAR; PG8_SCHED;
            PG8_LDA(At, 0, 1); PG8_STAGE(PG8_SB(0, 0), b2, voffB); PG8_STAGE(PG8_SB(0, 1), b2 + hstep, voffB); PG8_STAGE(PG8_SA(0, 0), a2, voffA);
            PG8_WAIT_V(8); PG8_WAIT_L(0); PG8_BAR; PG8_MMA(1, 0, At, B0); PG8_MMA(1, 1, At, B1); PG8_BAR; PG8_SCHED;
            PG8_LDB(B0, 1, 0); PG8_LDB(B1, 1, 1); PG8_SCHED; PG8_LDA(At, 1, 0); PG8_STAGE(PG8_SA(0, 1), a2 + hstep, voffA);
            PG8_WAIT_V(8); PG8_WAIT_L(0); PG8_BAR; PG8_MMA(0, 0, At, B0); PG8_MMA(0, 1, At, B1); PG8_BAR; PG8_SCHED;
            PG8_LDA(At, 1, 1); PG8_STAGE(PG8_SB(1, 0), b3, voffB); PG8_STAGE(PG8_SB(1, 1), b3 + hstep, voffB); PG8_STAGE(PG8_SA(1, 0), a3, voffA);
            PG8_WAIT_V(8); PG8_WAIT_L(0); PG8_BAR; PG8_MMA(1, 0, At, B0); PG8_MMA(1, 1, At, B1); PG8_BAR; PG8_SCHED;
            } else {
            PG8_LDB(B0, 0, 0); PG8_SCHED; PG8_LDA(At, 0, 0); PG8_STAGE(PG8_SA(1, 1), a1 + hstep, voffA);
            PG8_WAIT_L(8); PG8_BAR; PG8_WAIT_L(0); PG8_MMA(0, 0, At, B0); PG8_BAR; PG8_SCHED;
            PG8_LDB(B1, 0, 1); PG8_STAGE(PG8_SB(0, 0), b2, voffB);
            PG8_BAR; PG8_WAIT_L(0); PG8_MMA(0, 1, At, B1); PG8_BAR;
            PG8_LDA(At, 0, 1); PG8_STAGE(PG8_SA(0, 0), a2, voffA);
            PG8_BAR; PG8_WAIT_L(0); PG8_MMA(1, 0, At, B0); PG8_BAR; PG8_SCHED;
            PG8_STAGE(PG8_SB(0, 1), b2 + hstep, voffB);
            PG8_WAIT_V(6); PG8_BAR; PG8_MMA(1, 1, At, B1); PG8_BAR;
            PG8_LDB(B0, 1, 0); PG8_SCHED; PG8_LDA(At, 1, 0); PG8_STAGE(PG8_SA(0, 1), a2 + hstep, voffA);
            PG8_WAIT_L(8); PG8_BAR; PG8_WAIT_L(0); PG8_MMA(0, 0, At, B0); PG8_BAR; PG8_SCHED;
            PG8_LDB(B1, 1, 1); PG8_STAGE(PG8_SB(1, 0), b3, voffB);
            PG8_BAR; PG8_WAIT_L(0); PG8_MMA(0, 1, At, B1); PG8_BAR;
            PG8_LDA(At, 1, 1); PG8_STAGE(PG8_SA(1, 0), a3, voffA);
            PG8_BAR; PG8_WAIT_L(0); PG8_MMA(1, 0, At, B0); PG8_BAR; PG8_SCHED;
            PG8_STAGE(PG8_SB(1, 1), b3 + hstep, voffB);
            PG8_WAIT_V(6); PG8_BAR; PG8_MMA(1, 1, At, B1); PG8_BAR;
            }
        }
        if constexpr (ALIGN_EPI) { if (wr == 0) PG8_BAR; }
        if constexpr (!Epi::AFTER_DRAIN) { E(acc, cur, wr, wc, fr, fq); S.done(cur); }
        if (!has_next) break;
#pragma unroll
        for (int a = 0; a < 2; ++a)
#pragma unroll
            for (int b = 0; b < 2; ++b)
#pragma unroll
                for (int m = 0; m < 4; ++m)
#pragma unroll
                    for (int n = 0; n < 2; ++n) acc[a][b][m][n] = (f32x4){0.f, 0.f, 0.f, 0.f};
        cur = nxt; cA = nA; cB = nB; ++ui;
        if constexpr (ALIGN_EPI) { if (wr == 1) PG8_BAR; }
    }
    PG8_WAIT_V(0);
    if constexpr (!ALIGN_EPI) { if (wr == 0) PG8_BAR; }
    PG8_BAR;
    if constexpr (Epi::AFTER_DRAIN) { E.fused(acc, cur, wr, wc, fr, fq, lds, wid, lane); S.done(cur); }
#undef PG8_SA
#undef PG8_SB
#undef PG8_STAGE
#undef PG8_LDA
#undef PG8_LDB
#undef PG8_MMA
#undef PG8_WAIT_V
#undef PG8_WAIT_L
#undef PG8_BAR
#undef PG8_SCHED
}

__device__ __forceinline__ float rstd_of(const float* ss, int row, int fq) {
    const f32x4 v = *(const f32x4*)(ss + (size_t)row * 16 + 4 * fq);
    float s = (v[0] + v[1]) + (v[2] + v[3]);
    s += __shfl_xor(s, 16); s += __shfl_xor(s, 32);
    return __builtin_amdgcn_rsqf(s * (1.f / 1024.f) + 1e-6f);
}
template <bool NORM> struct EpiRaw {
    static constexpr bool PERM = true, AFTER_DRAIN = false;
    bf16_t* O; int ldc; const float* ss;
    __device__ __forceinline__ void operator()(const f32x4 (&acc)[2][2][4][2], const Unit& u, int wr, int wc, int fr, int fq) const {
        const int row0 = u.pm * BM + wr * 64 + fr, col0 = u.pn * BM + wc * 32 + 8 * fq;
#pragma unroll
        for (int ai = 0; ai < 2; ++ai)
#pragma unroll
            for (int m = 0; m < 4; ++m) { const int row = row0 + ai * HALF + m * 16; const float r = NORM ? rstd_of(ss, row, fq) : 1.f;
                bf16_t* rowp = O + (size_t)row * ldc + col0;
#pragma unroll
                for (int bj = 0; bj < 2; ++bj) { const f32x4 v0 = acc[ai][bj][m][0] * r, v1 = acc[ai][bj][m][1] * r;
                    u32x4 w; w.x = pk2(v0[0], v0[1]); w.y = pk2(v0[2], v0[3]); w.z = pk2(v1[0], v1[1]); w.w = pk2(v1[2], v1[3]);
                    *(u32x4*)(rowp + bj * HALF) = w; } }
    }
};
struct EpiSwiglu {
    static constexpr bool PERM = true, AFTER_DRAIN = false;
    bf16_t* H; const float* ss;
    __device__ __forceinline__ void operator()(const f32x4 (&acc)[2][2][4][2], const Unit& u, int wr, int wc, int fr, int fq) const {
        const int row0 = u.pm * BM + wr * 64 + fr, col0 = u.pn * HALF + wc * 32 + 8 * fq;
#pragma unroll
        for (int ai = 0; ai < 2; ++ai)
#pragma unroll
            for (int m = 0; m < 4; ++m) { const int row = row0 + ai * HALF + m * 16; const float r = rstd_of(ss, row, fq);
                float h[8];
#pragma unroll
                for (int n = 0; n < 2; ++n)
#pragma unroll
                    for (int e = 0; e < 4; ++e) { const float g = acc[ai][0][m][n][e] * r, uu = acc[ai][1][m][n][e] * r; h[4 * n + e] = g * sigmoidf_(g) * uu; }
                u32x4 w; w.x = pk2(h[0], h[1]); w.y = pk2(h[2], h[3]); w.z = pk2(h[4], h[5]); w.w = pk2(h[6], h[7]);
                *(u32x4*)(H + (size_t)row * FF + col0) = w; }
    }
};
template <bool GATE, bool FINAL> struct EpiResid {
    static constexpr bool PERM = true, AFTER_DRAIN = false;
    float* X; bf16_t* XBo; float* SSo; float scale; const float* ss_in; const bf16_t* P;
    __device__ __forceinline__ void operator()(const f32x4 (&acc)[2][2][4][2], const Unit& u, int wr, int wc, int fr, int fq) const {
        const int row0 = u.pm * BM + wr * 64 + fr, col0 = u.pn * BM + wc * 32 + 8 * fq;
#pragma unroll
        for (int ai = 0; ai < 2; ++ai)
#pragma unroll
            for (int m = 0; m < 4; ++m) { const int row = row0 + ai * HALF + m * 16; float r = 0.f; if (GATE) r = rstd_of(ss_in, row, fq);
                float sq = 0.f;
#pragma unroll
                for (int bj = 0; bj < 2; ++bj) { float* xp = X + (size_t)row * D + col0 + bj * HALF;
                    f32x4 x0 = *(const f32x4*)xp, x1 = *(const f32x4*)(xp + 4); const f32x4 a0 = acc[ai][bj][m][0], a1 = acc[ai][bj][m][1];
                    if (GATE) { const u32x4 pw = *(const u32x4*)(P + (size_t)row * D + col0 + bj * HALF);
                        x0[0] += sigmoidf_(a0[0] * r) * bflo(pw.x); x0[1] += sigmoidf_(a0[1] * r) * bfhi(pw.x); x0[2] += sigmoidf_(a0[2] * r) * bflo(pw.y); x0[3] += sigmoidf_(a0[3] * r) * bfhi(pw.y);
                        x1[0] += sigmoidf_(a1[0] * r) * bflo(pw.z); x1[1] += sigmoidf_(a1[1] * r) * bfhi(pw.z); x1[2] += sigmoidf_(a1[2] * r) * bflo(pw.w); x1[3] += sigmoidf_(a1[3] * r) * bfhi(pw.w);
                    } else { x0 += a0 * scale; x1 += a1 * scale; }
                    *(f32x4*)xp = x0; *(f32x4*)(xp + 4) = x1;
                    if (!FINAL) { u32x4 w; w.x = pk2(x0[0], x0[1]); w.y = pk2(x0[2], x0[3]); w.z = pk2(x1[0], x1[1]); w.w = pk2(x1[2], x1[3]);
                        *(u32x4*)(XBo + (size_t)row * D + col0 + bj * HALF) = w;
                        sq += (x0[0] * x0[0] + x0[1] * x0[1]) + (x0[2] * x0[2] + x0[3] * x0[3]) + (x1[0] * x1[0] + x1[1] * x1[1]) + (x1[2] * x1[2] + x1[3] * x1[3]); } }
                if (!FINAL) { sq += __shfl_xor(sq, 16); sq += __shfl_xor(sq, 32); if (fq == 0) SSo[(size_t)row * 16 + u.pn * 4 + wc] = sq; } }
    }
};
}
typedef pg8::StaticOrder GOrder;

#define XB_TMO      128
#define XB_XCNT(j)  (256  + 64 * (j))
#define XB_XSUB(j)  (1280 + 64 * (j))
#define XB_XGEN(j)  (2304 + 64 * (j))
#define XB_TOP      3328
#define XB_TOPGEN   3392
#define XCD_BAR_WORDS 3456
#define XB_SPIN_CAP (1u << 18)

__device__ __forceinline__ unsigned xb_ld(unsigned* p)              { return __hip_atomic_load(p, __ATOMIC_RELAXED, __HIP_MEMORY_SCOPE_AGENT); }
__device__ __forceinline__ unsigned xb_add(unsigned* p, unsigned v) { return __hip_atomic_fetch_add(p, v, __ATOMIC_RELAXED, __HIP_MEMORY_SCOPE_AGENT); }
__device__ __forceinline__ unsigned xb_xcc_id() { return (unsigned)__builtin_amdgcn_s_getreg((3 << 11) | 20) & 0xFu; }
#define XB_SPIN(cond, bar) do { unsigned _sp = 0; while (cond) { __builtin_amdgcn_s_sleep(1); \
    if ((++_sp & 255u) == 0u) { if (xb_ld(&(bar)[XB_TMO])) break; if (_sp > XB_SPIN_CAP) { atomicAdd(&(bar)[XB_TMO], 1u); break; } } } } while (0)

struct XcdBarrier {
    unsigned* bar; unsigned x;
    volatile LAS unsigned* st;
};

__device__ __forceinline__ XcdBarrier xcd_barrier_post(unsigned* bar, volatile LAS unsigned* st) {
    XcdBarrier b; b.bar = bar; b.x = xb_xcc_id(); b.st = st;
    if (threadIdx.x == 0) (void)xb_add(&bar[XB_XCNT(b.x)], 1u);
    return b;
}
__device__ __forceinline__ void xcd_barrier_complete(unsigned* bar, unsigned x, unsigned& nloc, unsigned& nx) {
    const unsigned G = gridDim.x * gridDim.y * gridDim.z;
    unsigned sum, cnt, mine, sp = 0u;
    for (;;) {
        sum = 0u; cnt = 0u; mine = 0u;
#pragma unroll
        for (unsigned j = 0; j < 16; ++j) { const unsigned c = xb_ld(&bar[XB_XCNT(j)]); sum += c; cnt += (c > 0u) ? 1u : 0u; mine = (j == x) ? c : mine; }
        if (sum == G) break;
        __builtin_amdgcn_s_sleep(1);
        if ((++sp & 255u) == 0u) { if (xb_ld(&bar[XB_TMO])) break; if (sp > XB_SPIN_CAP) { atomicAdd(&bar[XB_TMO], 1u); break; } }
    }
    nloc = mine > 0u ? mine : 1u; nx = cnt > 0u ? cnt : 1u;
}

__device__ __forceinline__ void xcd_barrier(const XcdBarrier& b) {
    asm volatile("s_waitcnt vmcnt(0)" ::: "memory");
    __syncthreads();
    if (threadIdx.x == 0) {
        unsigned* bar = b.bar;
        __builtin_amdgcn_s_waitcnt(0);
        unsigned nloc = b.st[0], nx = b.st[1];
        if (nloc == 0u) { xcd_barrier_complete(bar, b.x, nloc, nx); b.st[0] = nloc; b.st[1] = nx; }
        const unsigned old = xb_add(&bar[XB_XSUB(b.x)], 1u);
        const unsigned gen = old / nloc;
        if (old + 1u == (gen + 1u) * nloc) {
            __builtin_amdgcn_fence(__ATOMIC_RELEASE, "agent");
            asm volatile("s_waitcnt vmcnt(0)" ::: "memory");
            const unsigned og = xb_add(&bar[XB_TOP], 1u);
            const unsigned tg = og / nx;
            if (og + 1u == (tg + 1u) * nx) xb_add(&bar[XB_TOPGEN], 1u);
            else XB_SPIN(xb_ld(&bar[XB_TOPGEN]) == tg, bar);
            __builtin_amdgcn_fence(__ATOMIC_ACQUIRE, "agent");
            xb_add(&bar[XB_XGEN(b.x)], 1u);
            asm volatile("s_waitcnt vmcnt(0)" ::: "memory");
        } else {
            XB_SPIN(xb_ld(&bar[XB_XGEN(b.x)]) == gen, bar);
            __builtin_amdgcn_fence(__ATOMIC_ACQUIRE, "agent");
            asm volatile("s_waitcnt vmcnt(0)" ::: "memory");
        }
    }
    __syncthreads();
}

__device__ __forceinline__ float wave_sum(float v) {
#pragma unroll
    for (int o = 1; o < 64; o <<= 1) v += __shfl_xor(v, o);
    return v;
}
__device__ __forceinline__ void st_bf16x8(bf16* p, const float* v) { v4u w; w.x = pk2(v[0], v[1]); w.y = pk2(v[2], v[3]); w.z = pk2(v[4], v[5]); w.w = pk2(v[6], v[7]); *(v4u*)p = w; }
__device__ __forceinline__ void ld_bf16x8(const bf16* p, float* v) { const v4u w = *(const v4u*)p; v[0] = bflo(w.x); v[1] = bfhi(w.x); v[2] = bflo(w.y); v[3] = bfhi(w.y); v[4] = bflo(w.z); v[5] = bfhi(w.z); v[6] = bflo(w.w); v[7] = bfhi(w.w); }

template <int MODE> __device__ __forceinline__ int sk_brow(int cu, int j) {
    if (MODE == 0) return cu * 64 + j;
    const int T = cu >> 2, q = cu & 3; return T * 256 + q * 32 + (j & 31) + ((j >> 5) ? 128 : 0);
}
template <int MODE, class Epi>
__device__ __forceinline__ void skinny_phase(LAS unsigned char* lds, const bf16* A, const bf16* Bt, int K, int ncu, const Epi& E, int vcu, int G) {
    int tid_ = threadIdx.x; asm volatile("" : "+v"(tid_));
    const int tid = tid_, wave = __builtin_amdgcn_readfirstlane(tid >> 6), lane = tid & 63, fr = lane & 15, fq = lane >> 4;
    LAS float* part = (LAS float*)lds;
    LAS float* tile = (LAS float*)(lds + 65536);
    const int kw = K >> 3, k0 = wave * kw, nst = kw >> 5;
    for (int un = G - 1 - vcu; un < 4 * ncu; un += G) {
        const int rb = un & 3, cu = un >> 2;
        f32x4 acc[2][4];
#pragma unroll
        for (int i = 0; i < 2; ++i)
#pragma unroll
            for (int c = 0; c < 4; ++c) acc[i][c] = (f32x4){0.f, 0.f, 0.f, 0.f};
        const bf16* ap = A + (size_t)(rb * 32 + fr) * K + k0 + 8 * fq;
        const bf16* bp0 = Bt + (size_t)sk_brow<MODE>(cu, fr) * K + k0 + 8 * fq;
        const bf16* bp1 = Bt + (size_t)sk_brow<MODE>(cu, 16 + fr) * K + k0 + 8 * fq;
        const bf16* bp2 = Bt + (size_t)sk_brow<MODE>(cu, 32 + fr) * K + k0 + 8 * fq;
        const bf16* bp3 = Bt + (size_t)sk_brow<MODE>(cu, 48 + fr) * K + k0 + 8 * fq;
#pragma unroll 2
        for (int s = 0; s < nst; ++s) {
            const bf16x8 a0 = *(const bf16x8*)(ap + 32 * s), a1 = *(const bf16x8*)(ap + (size_t)16 * K + 32 * s);
            const bf16x8 b0 = *(const bf16x8*)(bp0 + 32 * s), b1 = *(const bf16x8*)(bp1 + 32 * s), b2 = *(const bf16x8*)(bp2 + 32 * s), b3 = *(const bf16x8*)(bp3 + 32 * s);
            acc[0][0] = __builtin_amdgcn_mfma_f32_16x16x32_bf16(a0, b0, acc[0][0], 0, 0, 0); acc[1][0] = __builtin_amdgcn_mfma_f32_16x16x32_bf16(a1, b0, acc[1][0], 0, 0, 0);
            acc[0][1] = __builtin_amdgcn_mfma_f32_16x16x32_bf16(a0, b1, acc[0][1], 0, 0, 0); acc[1][1] = __builtin_amdgcn_mfma_f32_16x16x32_bf16(a1, b1, acc[1][1], 0, 0, 0);
            acc[0][2] = __builtin_amdgcn_mfma_f32_16x16x32_bf16(a0, b2, acc[0][2], 0, 0, 0); acc[1][2] = __builtin_amdgcn_mfma_f32_16x16x32_bf16(a1, b2, acc[1][2], 0, 0, 0);
            acc[0][3] = __builtin_amdgcn_mfma_f32_16x16x32_bf16(a0, b3, acc[0][3], 0, 0, 0); acc[1][3] = __builtin_amdgcn_mfma_f32_16x16x32_bf16(a1, b3, acc[1][3], 0, 0, 0);
        }
#pragma unroll
        for (int i = 0; i < 2; ++i)
#pragma unroll
            for (int c = 0; c < 4; ++c)
#pragma unroll
                for (int r = 0; r < 4; ++r) part[wave * 2048 + (i * 16 + 4 * fq + r) * 64 + c * 16 + fr] = acc[i][c][r];
        __syncthreads();
        { const int row = tid >> 4, cg = tid & 15; f32x4 s = (f32x4){0.f, 0.f, 0.f, 0.f};
#pragma unroll
          for (int w = 0; w < 8; ++w) s += *(const LAS f32x4*)(part + w * 2048 + row * 64 + 4 * cg);
          *(LAS f32x4*)(tile + row * 64 + 4 * cg) = s; }
        __syncthreads();
        E(tile, rb, cu, tid);
        __syncthreads();
    }
}
__device__ __forceinline__ float sk_rstd(const float* ss, int grow, int cg) {
    float s = ss[(size_t)grow * 16 + cg];
    s += __shfl_xor(s, 1); s += __shfl_xor(s, 2); s += __shfl_xor(s, 4); s += __shfl_xor(s, 8);
    return __builtin_amdgcn_rsqf(s * (1.f / 1024.f) + 1e-6f);
}
template <bool NORM> struct SkRaw { bf16* O; int ldc; const float* ss;
    __device__ __forceinline__ void operator()(const LAS float* tile, int rb, int cu, int tid) const {
        const int row = tid >> 4, cg = tid & 15, grow = MP + rb * 32 + row; const float r = NORM ? sk_rstd(ss, grow, cg) : 1.f;
        const f32x4 v = *(const LAS f32x4*)(tile + row * 64 + 4 * cg) * r; const int col = cu * 64 + 4 * cg;
        if (col < ldc) { v2u w; w.x = pk2(v[0], v[1]); w.y = pk2(v[2], v[3]); *(v2u*)(O + (size_t)grow * ldc + col) = w; }
    } };
struct SkSwiglu { bf16* H; const float* ss;
    __device__ __forceinline__ void operator()(const LAS float* tile, int rb, int cu, int tid) const {
        const int row = tid >> 4, cg = tid & 15, grow = MP + rb * 32 + row; const float r = sk_rstd(ss, grow, cg);
        if (cg < 8) { const f32x4 g = *(const LAS f32x4*)(tile + row * 64 + 4 * cg) * r, u = *(const LAS f32x4*)(tile + row * 64 + 32 + 4 * cg) * r;
            float h[4];
#pragma unroll
            for (int e = 0; e < 4; ++e) h[e] = g[e] * sigmoidf_(g[e]) * u[e];
            v2u w; w.x = pk2(h[0], h[1]); w.y = pk2(h[2], h[3]); *(v2u*)(H + (size_t)grow * FF + cu * 32 + 4 * cg) = w; }
    } };
template <bool GATE> struct SkResid { float* X; bf16* XBo; float* SSo; float scale; const float* ss_in; const bf16* P; int fin;
    __device__ __forceinline__ void operator()(const LAS float* tile, int rb, int cu, int tid) const {
        const int row = tid >> 4, cg = tid & 15, grow = MP + rb * 32 + row, col = cu * 64 + 4 * cg; float r = 0.f; if (GATE) r = sk_rstd(ss_in, grow, cg);
        const f32x4 a = *(const LAS f32x4*)(tile + row * 64 + 4 * cg); float* xp = X + (size_t)grow * D + col; f32x4 x = *(const f32x4*)xp;
        if (GATE) { const v2u pw = *(const v2u*)(P + (size_t)grow * D + col);
            x[0] += sigmoidf_(a[0] * r) * bflo(pw.x); x[1] += sigmoidf_(a[1] * r) * bfhi(pw.x); x[2] += sigmoidf_(a[2] * r) * bflo(pw.y); x[3] += sigmoidf_(a[3] * r) * bfhi(pw.y);
        } else x += a * scale;
        *(f32x4*)xp = x;
        float sq = (x[0] * x[0] + x[1] * x[1]) + (x[2] * x[2] + x[3] * x[3]);
        sq += __shfl_xor(sq, 1); sq += __shfl_xor(sq, 2); sq += __shfl_xor(sq, 4); sq += __shfl_xor(sq, 8);
        if (!fin) { v2u w; w.x = pk2(x[0], x[1]); w.y = pk2(x[2], x[3]); *(v2u*)(XBo + (size_t)grow * D + col) = w; if (cg == 0) SSo[(size_t)grow * 16 + cu] = sq; }
    } };

__device__ __forceinline__ void transpose_item(const float* W, int K, int N, int Nd, bf16* WT, const float* gain, int mode, LAS float* scr, int item, int lane) {
    const int nblk = Nd / 32, kb = item / nblk, nb = item % nblk, k0 = 64 * kb, n0 = 32 * nb;
    const int n4 = 4 * (lane & 7), n = n0 + n4;
#pragma unroll
    for (int i = 0; i < 8; ++i) { const int kk = 8 * i + (lane >> 3); f32x4 v = (f32x4){0.f, 0.f, 0.f, 0.f}; if (n < N) v = *(const f32x4*)(W + (size_t)(k0 + kk) * N + n); if (gain) v *= gain[k0 + kk];
        scr[kk * 33 + n4] = v[0]; scr[kk * 33 + n4 + 1] = v[1]; scr[kk * 33 + n4 + 2] = v[2]; scr[kk * 33 + n4 + 3] = v[3]; }
    LDS_WAIT(); asm volatile("" ::: "memory");
    const int c = lane & 7;
#pragma unroll
    for (int j = 0; j < 4; ++j) { const int nl = (lane >> 3) + 8 * j, nn = n0 + nl; const LAS float* s = scr + (8 * c) * 33 + nl;
        int drow = nn; if (mode == 1) { const int jj = nn < FF ? nn : nn - FF; drow = (jj >> 7) * 256 + (jj & 127) + (nn < FF ? 0 : 128); }
        v4u o; o.x = pk2(s[0 * 33], s[1 * 33]); o.y = pk2(s[2 * 33], s[3 * 33]); o.z = pk2(s[4 * 33], s[5 * 33]); o.w = pk2(s[6 * 33], s[7 * 33]);
        *(GAS v4u*)(WT + (size_t)drow * K + k0 + 8 * c) = o; }
    LDS_WAIT(); asm volatile("" ::: "memory");
}
struct In {
    const float *x_prompt, *x_sample, *state_conv, *ck_cmp, *cv_cmp, *ck_sel, *cv_sel, *ck_win, *cv_win; const int* page_table; const float *p_prompt, *p_sample, *norm_g, *w_gu, *w_down,
        *w_proj, *w_gate, *cw_in, *cw, *cw_out, *nw_in, *qk_g, *cmp_pos, *cmp_w1, *cmp_w2, *nw_out;
};
__device__ __forceinline__ void sincos_d(double r, float& s, float& c) {
    const double r2 = r * r;
    double sp = 1.0, cp = 1.0;
#pragma unroll
    for (int k = 12; k >= 1; --k) { sp = 1.0 - sp * r2 / (double)((2 * k) * (2 * k + 1)); cp = 1.0 - cp * r2 / (double)((2 * k - 1) * (2 * k)); }
    s = (float)(r * sp); c = (float)cp;
}
__device__ __forceinline__ void p0_prologue(const In& I, float* out, unsigned char* ws, LAS unsigned char* lds, int vcu, int G, int wave, int lane) {
    LAS float* scr = (LAS float*)(lds + wave * 16384);
    const int gw = vcu * NWAVES + wave, NGW = G * NWAVES;
    constexpr int I_GU = (D / 64) * (NGU / 32), I_DN = (FF / 64) * (D / 32), I_SQ = (D / 64) * (D / 32), I_PR = (PLE / 64) * (D / 32), I_CI = (D / 64) * (NCV / 32), I_NI = (D / 64) * (NNSP / 32),
                  I_W1 = (4096 / 64) * (128 / 32), I_W2 = (128 / 64) * (64 / 32);
    constexpr int NITEMS = 4 * I_GU + 4 * I_DN + 2 * I_SQ + 2 * I_PR + I_CI + I_SQ + I_NI + I_SQ + 2 * I_W1 + 2 * I_W2;
#define TR(W_, K_, N_, ND_, WT_, G_, MODE_, NI_) if (r < (NI_)) { transpose_item(W_, K_, N_, ND_, WT_, G_, MODE_, scr, r, lane); continue; } r -= (NI_);
    for (int it = gw; it < NITEMS; it += NGW) {
        int r = it;
        TR(I.w_gu + (size_t)0 * D * NGU, D, NGU, NGU, (bf16*)(ws + WS_WGU + 0 * SZ_WGU), I.norm_g + 0 * D, 1, I_GU)
        TR(I.w_gu + (size_t)1 * D * NGU, D, NGU, NGU, (bf16*)(ws + WS_WGU + 1 * SZ_WGU), I.norm_g + 2 * D, 1, I_GU)
        TR(I.w_gu + (size_t)2 * D * NGU, D, NGU, NGU, (bf16*)(ws + WS_WGU + 2 * SZ_WGU), I.norm_g + 4 * D, 1, I_GU)
        TR(I.w_gu + (size_t)3 * D * NGU, D, NGU, NGU, (bf16*)(ws + WS_WGU + 3 * SZ_WGU), I.norm_g + 6 * D, 1, I_GU)
        TR(I.w_down + (size_t)0 * FF * D, FF, D, D, (bf16*)(ws + WS_WDN + 0 * SZ_WDN), nullptr, 0, I_DN)
        TR(I.w_down + (size_t)1 * FF * D, FF, D, D, (bf16*)(ws + WS_WDN + 1 * SZ_WDN), nullptr, 0, I_DN)
        TR(I.w_down + (size_t)2 * FF * D, FF, D, D, (bf16*)(ws + WS_WDN + 2 * SZ_WDN), nullptr, 0, I_DN)
        TR(I.w_down + (size_t)3 * FF * D, FF, D, D, (bf16*)(ws + WS_WDN + 3 * SZ_WDN), nullptr, 0, I_DN)
        TR(I.w_gate + (size_t)0 * D * D, D, D, D, (bf16*)(ws + WS_WGATE + 0 * SZ_WSQ), I.norm_g + 3 * D, 0, I_SQ)
        TR(I.w_gate + (size_t)1 * D * D, D, D, D, (bf16*)(ws + WS_WGATE + 1 * SZ_WSQ), I.norm_g + 7 * D, 0, I_SQ)
        TR(I.w_proj + (size_t)0 * PLE * D, PLE, D, D, (bf16*)(ws + WS_WPROJ + 0 * SZ_WPROJ), nullptr, 0, I_PR)
        TR(I.w_proj + (size_t)1 * PLE * D, PLE, D, D, (bf16*)(ws + WS_WPROJ + 1 * SZ_WPROJ), nullptr, 0, I_PR)
        TR(I.cw_in, D, NCV, NCV, (bf16*)(ws + WS_WCIN), I.norm_g + 1 * D, 0, I_CI)
        TR(I.cw_out, D, D, D, (bf16*)(ws + WS_WCOUT), nullptr, 0, I_SQ)
        TR(I.nw_in, D, NNS, NNSP, (bf16*)(ws + WS_WNIN), I.norm_g + 5 * D, 0, I_NI)
        TR(I.nw_out, D, D, D, (bf16*)(ws + WS_WNOUT), nullptr, 0, I_SQ)
        TR(I.cmp_w1 + (size_t)0 * 4096 * 128, 4096, 128, 128, (bf16*)(ws + WS_W1T) + (size_t)0 * 128 * 4096, nullptr, 0, I_W1)
        TR(I.cmp_w1 + (size_t)1 * 4096 * 128, 4096, 128, 128, (bf16*)(ws + WS_W1T) + (size_t)1 * 128 * 4096, nullptr, 0, I_W1)
        TR(I.cmp_w2 + (size_t)0 * 128 * 64, 128, 64, 64, (bf16*)(ws + WS_W2T) + (size_t)0 * 64 * 128, nullptr, 0, I_W2)
        TR(I.cmp_w2 + (size_t)1 * 128 * 64, 128, 64, 64, (bf16*)(ws + WS_W2T) + (size_t)1 * 64 * 128, nullptr, 0, I_W2)
    }
#undef TR
    bf16* XB0 = (bf16*)(ws + WS_XB); float* SS0 = (float*)(ws + WS_SS);
    for (int m = gw; m < MT; m += NGW) {
        const float* src = m < MP ? I.x_prompt + (size_t)m * D : I.x_sample + (size_t)(m - MP) * D;
        const GAS f32x4* xr = (const GAS f32x4*)src + lane; GAS f32x4* xo = (GAS f32x4*)(out + (size_t)m * D) + lane;
        GAS v2u* o8 = (GAS v2u*)(XB0 + (size_t)m * D) + lane; float s = 0.f;
#pragma unroll
        for (int j = 0; j < 4; ++j) { const f32x4 v = xr[64 * j]; xo[64 * j] = v; s += (v[0] * v[0] + v[1] * v[1]) + (v[2] * v[2] + v[3] * v[3]); v2u w; w.x = pk2(v[0], v[1]); w.y = pk2(v[2], v[3]); o8[64 * j] = w; }
        s = wave_sum(s);
        if (lane < 16) SS0[(size_t)m * 16 + lane] = lane == 0 ? s : 0.f;
    }
    bf16* PB = (bf16*)(ws + WS_PB);
    for (int r = gw; r < 2 * MT; r += NGW) { const int l = r / MT, m = r % MT;
        const float* src = m < MP ? I.p_prompt + ((size_t)l * MP + m) * PLE : I.p_sample + ((size_t)l * MS + (m - MP)) * PLE;
        const f32x4 v = ((const GAS f32x4*)src)[lane]; v2u w; w.x = pk2(v[0], v[1]); w.y = pk2(v[2], v[3]); ((GAS v2u*)(PB + (size_t)r * PLE))[lane] = w; }
    float* ROPE = (float*)(ws + WS_ROPE);
    for (int i = gw * 64 + lane; i < 8196 * 32; i += NGW * 64) { const int pos = i >> 5, d = i & 31;
        const float inv = (float)exp2(-(double)d * (13.287712379549449 / 32.0));
        const float ang = (float)pos * inv; const double a = (double)ang, k = rint(a * 0.15915494309189535), rr = a - k * 6.283185307179586;
        float s, c; sincos_d(rr, s, c); ROPE[(size_t)pos * 64 + d] = c; ROPE[(size_t)pos * 64 + 32 + d] = s; }
}

__device__ __forceinline__ void conv_post(const In& I, float* out, unsigned char* ws, int vcu, int G, int wave, int lane) {
    const bf16* CV = (const bf16*)(ws + WS_H); bf16* AC = (bf16*)(ws + WS_AC);
    const int gw = vcu * NWAVES + wave, NGW = G * NWAVES;
    constexpr int NSTRIP_P = MP / 16, NITEM = (NSTRIP_P + SB) * 2;
    for (int it = gw; it < NITEM; it += NGW) {
        const int half = it & 1, st = it >> 1, ch = half * 512 + lane * 8;
        float w0[8], w1[8], w2[8], um2[8], um1[8];
#pragma unroll
        for (int e = 0; e < 8; ++e) { w0[e] = I.cw[ch + e]; w1[e] = I.cw[D + ch + e]; w2[e] = I.cw[2 * D + ch + e]; um2[e] = 0.f; um1[e] = 0.f; }
        int row0, nrow; const bool samp = st >= NSTRIP_P;
        if (!samp) { row0 = st * 16; nrow = 16;
            if ((row0 & (SEQ - 1)) != 0) { float c[8], v[8];
                ld_bf16x8(CV + (size_t)(row0 - 2) * NCV + D + ch, c); ld_bf16x8(CV + (size_t)(row0 - 2) * NCV + 2 * D + ch, v);
#pragma unroll
                for (int e = 0; e < 8; ++e) um2[e] = c[e] * v[e];
                ld_bf16x8(CV + (size_t)(row0 - 1) * NCV + D + ch, c); ld_bf16x8(CV + (size_t)(row0 - 1) * NCV + 2 * D + ch, v);
#pragma unroll
                for (int e = 0; e < 8; ++e) um1[e] = c[e] * v[e]; }
        } else { const int bs = st - NSTRIP_P; row0 = MP + bs * 4; nrow = 4;
#pragma unroll
            for (int e = 0; e < 8; ++e) { um2[e] = I.state_conv[((size_t)bs * 2 + 0) * D + ch + e]; um1[e] = I.state_conv[((size_t)bs * 2 + 1) * D + ch + e]; } }
        for (int i = 0; i < nrow; ++i) { const int row = row0 + i; float b[8], c[8], v[8], o[8], u[8];
            ld_bf16x8(CV + (size_t)row * NCV + ch, b); ld_bf16x8(CV + (size_t)row * NCV + D + ch, c); ld_bf16x8(CV + (size_t)row * NCV + 2 * D + ch, v);
#pragma unroll
            for (int e = 0; e < 8; ++e) { u[e] = c[e] * v[e]; o[e] = b[e] * (w0[e] * um2[e] + w1[e] * um1[e] + w2[e] * u[e]); um2[e] = um1[e]; um1[e] = u[e]; }
            st_bf16x8(AC + (size_t)row * D + ch, o);
            float* so = nullptr;
            if (!samp) { const int t = row & (SEQ - 1); if (t >= SEQ - 2) so = out + O_CONVP + ((size_t)(row >> 13) * 2 + (t - (SEQ - 2))) * D + ch; }
            else if (i >= 2) so = out + O_CONVS + ((size_t)(st - NSTRIP_P) * 2 + (i - 2)) * D + ch;
            if (so) { *(f32x4*)so = (f32x4){u[0], u[1], u[2], u[3]}; *(f32x4*)(so + 4) = (f32x4){u[4], u[5], u[6], u[7]}; } }
    }
}

__device__ __forceinline__ void nsa_post(const In& I, float* out, unsigned char* ws, int vcu, int G, int wave, int lane) {
    const bf16* RAW = (const bf16*)(ws + WS_H); const float* ROPE = (const float*)(ws + WS_ROPE);
    bf16* QN = (bf16*)(ws + WS_QN); bf16* QR = (bf16*)(ws + WS_QR); bf16* KS = (bf16*)(ws + WS_KS); bf16* VS = (bf16*)(ws + WS_VS); bf16* KW = (bf16*)(ws + WS_KW); bf16* VW = (bf16*)(ws + WS_VW);
    float* GATES = (float*)(ws + WS_GATES);
    const int gw = vcu * NWAVES + wave, NGW = G * NWAVES, qd = lane >> 2, p = lane & 3;
    for (int row = gw; row < MT; row += NGW) {
        const bool samp = row >= MP; const int sr = row - MP; const int pos = samp ? PAST + (sr & 3) : (row & (SEQ - 1));
        float cs[8], sn[8];
        { const f32x4 c0 = *(const f32x4*)(ROPE + (size_t)pos * 64 + 8 * p), c1 = *(const f32x4*)(ROPE + (size_t)pos * 64 + 8 * p + 4), s0 = *(const f32x4*)(ROPE + (size_t)pos * 64 + 32 + 8 * p), s1 = *(const f32x4*)(ROPE + (size_t)pos * 64 + 36 + 8 * p);
#pragma unroll
          for (int e = 0; e < 4; ++e) { cs[e] = c0[e]; cs[4 + e] = c1[e]; sn[e] = s0[e]; sn[4 + e] = s1[e]; } }
#pragma unroll
        for (int pass = 0; pass < 3; ++pass) { const int sg = qd + 16 * pass;
            if (sg < 40) {
                float x1[8], x2[8];
                ld_bf16x8(RAW + (size_t)row * NNSP + 64 * sg + 8 * p, x1); ld_bf16x8(RAW + (size_t)row * NNSP + 64 * sg + 32 + 8 * p, x2);
                const int typ = sg < 16 ? 0 : 1 + ((sg - 16) >> 2), g4 = sg & 3;
                const bool nrm = (typ == 0 || typ == 3 || typ == 5);
                if (nrm) { const int gi = typ == 0 ? 0 : (typ == 3 ? 2 : 3); float ssq = 0.f;
#pragma unroll
                    for (int e = 0; e < 8; ++e) ssq += x1[e] * x1[e] + x2[e] * x2[e];
                    ssq += __shfl_xor(ssq, 1); ssq += __shfl_xor(ssq, 2);
                    const float rs = __builtin_amdgcn_rsqf(ssq * (1.f / 64.f) + RMS_EPS);
#pragma unroll
                    for (int e = 0; e < 8; ++e) { x1[e] *= rs * I.qk_g[gi * 64 + 8 * p + e]; x2[e] *= rs * I.qk_g[gi * 64 + 32 + 8 * p + e]; } }
                float y1[8], y2[8];
#pragma unroll
                for (int e = 0; e < 8; ++e) { y1[e] = x1[e] * cs[e] - x2[e] * sn[e]; y2[e] = x2[e] * cs[e] + x1[e] * sn[e]; }
                if (typ == 0) { float a[8], b[8];
#pragma unroll
                    for (int e = 0; e < 8; ++e) { a[e] = x1[e] * QSCALE; b[e] = x2[e] * QSCALE; }
                    st_bf16x8(QN + (size_t)row * D + 64 * sg + 8 * p, a); st_bf16x8(QN + (size_t)row * D + 64 * sg + 32 + 8 * p, b);
#pragma unroll
                    for (int e = 0; e < 8; ++e) { a[e] = y1[e] * QSCALE; b[e] = y2[e] * QSCALE; }
                    st_bf16x8(QR + (size_t)row * D + 64 * sg + 8 * p, a); st_bf16x8(QR + (size_t)row * D + 64 * sg + 32 + 8 * p, b);
                } else {
                    const bool rope = (typ == 3 || typ == 5);
                    float o1[8], o2[8];
#pragma unroll
                    for (int e = 0; e < 8; ++e) { o1[e] = rope ? y1[e] : x1[e]; o2[e] = rope ? y2[e] : x2[e]; }
                    float* fo = nullptr; bf16* bo = nullptr; const size_t co = (size_t)g4 * 64 + 8 * p;
                    if (typ <= 4) { const size_t base = samp ? (typ == 1 ? O_KCS : typ == 2 ? O_VCS : typ == 3 ? O_KSS : O_VSS) + (size_t)sr * KVW : (typ == 1 ? O_KCP : typ == 2 ? O_VCP : typ == 3 ? O_KSP : O_VSP) + (size_t)row * KVW;
                        fo = out + base + co; if (typ == 3) bo = KS + (size_t)row * KVW + co; if (typ == 4) bo = VS + (size_t)row * KVW + co;
                    } else { bo = (typ == 5 ? KW : VW) + (size_t)row * KVW + co;
                        if (samp) fo = out + (typ == 5 ? O_KWS : O_VWS) + ((size_t)(sr >> 2) * 512 + 508 + (sr & 3)) * KVW + co;
                        else { const int t = row & (SEQ - 1); if (t >= SEQ - WIN) fo = out + (typ == 5 ? O_KWP : O_VWP) + ((size_t)(row >> 13) * 512 + (t - (SEQ - WIN))) * KVW + co; } }
                    if (fo) { *(f32x4*)fo = (f32x4){o1[0], o1[1], o1[2], o1[3]}; *(f32x4*)(fo + 4) = (f32x4){o1[4], o1[5], o1[6], o1[7]};
                              *(f32x4*)(fo + 32) = (f32x4){o2[0], o2[1], o2[2], o2[3]}; *(f32x4*)(fo + 36) = (f32x4){o2[4], o2[5], o2[6], o2[7]}; }
                    if (bo) { st_bf16x8(bo, o1); st_bf16x8(bo + 32, o2); }
                }
            }
        }
        if (lane < 48) { const unsigned short rv = RAW[(size_t)row * NNSP + 2560 + lane]; GATES[(size_t)row * 48 + lane] = sigmoidf_(__uint_as_float((unsigned)rv << 16)); }
    }
    { const size_t n4 = (size_t)SB * 508 * 64; const size_t gt = (size_t)(vcu * NWAVES + wave) * 64 + lane, NT = (size_t)NGW * 64;
      for (size_t i = gt; i < 2 * n4; i += NT) { const int kv = i >= n4; const size_t j = kv ? i - n4 : i; const size_t bs = j / (508 * 64), rem = j % (508 * 64);
          const f32x4 v = ((const GAS f32x4*)(kv ? I.cv_win : I.ck_win))[bs * 512 * 64 + 4 * 64 + rem];
          ((GAS f32x4*)(out + (kv ? O_VWS : O_KWS)))[bs * 512 * 64 + rem] = v; } }
}

__device__ __forceinline__ void glds16(const void* gsrc, unsigned lds_dst) { unsigned keep;
    asm volatile("s_mov_b32 %0, m0\n\ts_mov_b32 m0, %2\n\ts_nop 0\n\tglobal_load_lds_dwordx4 %1, off\n\ts_mov_b32 m0, %0" : "=&s"(keep) : "v"(gsrc), "s"(lds_dst) : "memory"); }
__device__ __forceinline__ unsigned lds_addr(const LAS unsigned char* p) { return (unsigned)(uintptr_t)p; }

constexpr int CMP_NA = 5, CMP_NB = 3, CMP_BOFF = CMP_NA * 16384, CMP_RED_OFF = LDSCTL_OFF + 1024;
static_assert(CMP_BOFF + CMP_NB * 16384 <= RING_BYTES, "compress LDS");
__device__ __forceinline__ void cmp_bias_partials(const In& I, unsigned char* ws, int vcu, int G, int wave, int lane) {
    float* PART = (float*)(ws + WS_CPART); const int gw = vcu * NWAVES + wave, NGW = G * NWAVES;
    for (int it = gw; it < 128; it += NGW) { const int kv = it >> 6, j = it & 63; float a0 = 0.f, a1 = 0.f;
        const float* pp = I.cmp_pos + ((size_t)kv * 64 + j) * 64; const float* wp = I.cmp_w1 + ((size_t)kv * 4096 + 64 * j) * 128;
#pragma unroll 8
        for (int d = 0; d < 64; ++d) { const float p = pp[d]; a0 += p * wp[d * 128 + lane]; a1 += p * wp[d * 128 + 64 + lane]; }
        PART[(size_t)it * 128 + lane] = a0; PART[(size_t)it * 128 + 64 + lane] = a1; }
}
__device__ __forceinline__ void cmp_bias_reduce(unsigned char* ws, int vcu, int tid) {
    if (vcu != 0 || tid >= 256) return;
    const float* PART = (const float*)(ws + WS_CPART); float* BIAS = (float*)(ws + WS_CBIAS); const int kv = tid >> 7, n = tid & 127; float a = 0.f;
    for (int j = 0; j < 64; ++j) a += PART[((size_t)kv * 64 + j) * 128 + n];
    BIAS[tid] = a;
}
struct CmpSrc { const float* kbase; const float* vbase; const int* page_table; int seq0, nseq; };
__device__ __forceinline__ const float* cmp_chunk_base(const CmpSrc& S, int kv, int cid) {
    const int sq = cid >> 7, nb = cid & 127; const float* base = kv ? S.vbase : S.kbase;
    if (S.page_table) { const int pg = S.page_table[sq * NPAGE + (nb >> 1)]; return base + ((size_t)pg * 128 + (nb & 1) * 64) * KVW; }
    return base + ((size_t)sq * SEQ + nb * 64) * KVW;
}
__device__ __forceinline__ void compress_phase(const In& I, unsigned char* ws, LAS unsigned char* lds, const CmpSrc& S, int vcu, int G) {
    int tid_ = threadIdx.x; asm volatile("" : "+v"(tid_));
    const int tid = tid_, wave = __builtin_amdgcn_readfirstlane(tid >> 6), lane = tid & 63, fr = lane & 15, fq = lane >> 4, wm = wave >> 2, wn = wave & 3;
    const int upk = S.nseq * 128 / 16, nunits = 2 * upk;
    int nmine = 0; for (int u = vcu; u < nunits; u += G) ++nmine;
    if (nmine == 0) return;
    const int total = nmine * 64;
    const bf16* W1T = (const bf16*)(ws + WS_W1T); const bf16* W2T = (const bf16*)(ws + WS_W2T); const float* BIAS = (const float*)(ws + WS_CBIAS);
    unsigned aoffs[2];
#pragma unroll
    for (int i = 0; i < 2; ++i) { const int c = 2 * wave + i, r = 4 * c + (lane >> 4); aoffs[i] = (unsigned)((lane >> 4) * 256 + (((lane & 15) ^ (r & 15)) * 16)); }
    unsigned boffs[2];
#pragma unroll
    for (int i = 0; i < 2; ++i) { int R, C; pg8::stage_rc(tid * 16 + i * 8192, R, C); boffs[i] = (unsigned)(R * 4096 + C) * 2u; }
#define CMP_ISSUE_A(gs_) do { const int ui_ = (gs_) >> 6, j_ = (gs_) & 63, u_ = vcu + ui_ * G, kv_ = u_ >= upk ? 1 : 0, ul_ = u_ - kv_ * upk; \
        LAS unsigned char* st_ = lds + ((gs_) % CMP_NA) * 16384; \
        _Pragma("unroll") for (int i_ = 0; i_ < 2; ++i_) { const float* cb_ = cmp_chunk_base(S, kv_, ul_ * 16 + 2 * wave + i_); \
            glds16((const char*)cb_ + (size_t)j_ * 1024 + aoffs[i_], lds_addr(st_ + (2 * wave + i_) * 1024)); } } while (0)
#define CMP_ISSUE_B(gs_) do { const int ui_ = (gs_) >> 6, j_ = (gs_) & 63, u_ = vcu + ui_ * G, kv_ = u_ >= upk ? 1 : 0; \
        LAS unsigned char* st_ = lds + CMP_BOFF + ((gs_) % CMP_NB) * 16384; const char* wb_ = (const char*)(W1T + (size_t)kv_ * 128 * 4096) + j_ * 128; \
        _Pragma("unroll") for (int i_ = 0; i_ < 2; ++i_) glds16(wb_ + boffs[i_], lds_addr(st_ + wave * 1024 + i_ * 8192)); } while (0)
    f32x4 acc[2][2];
#pragma unroll
    for (int a = 0; a < 2; ++a)
#pragma unroll
        for (int b = 0; b < 2; ++b) acc[a][b] = (f32x4){0.f, 0.f, 0.f, 0.f};
    CMP_ISSUE_A(0); CMP_ISSUE_A(1); CMP_ISSUE_B(0); CMP_ISSUE_A(2); CMP_ISSUE_B(1); CMP_ISSUE_A(3);
    for (int gs = 0; gs < total; ++gs) {
        if (gs + 3 < total) asm volatile("s_waitcnt vmcnt(4)" ::: "memory"); else if (gs + 1 < total) asm volatile("s_waitcnt vmcnt(2)" ::: "memory"); else asm volatile("s_waitcnt vmcnt(0)" ::: "memory");
        __builtin_amdgcn_s_barrier(); asm volatile("" ::: "memory");
        if (gs + 4 < total) CMP_ISSUE_A(gs + 4);
        if (gs + 2 < total) CMP_ISSUE_B(gs + 2);
        const LAS unsigned char* st = lds + (gs % CMP_NA) * 16384; const LAS unsigned char* stb = lds + CMP_BOFF + (gs % CMP_NB) * 16384;
#pragma unroll
        for (int ks = 0; ks < 2; ++ks) {
            bf16x8 xa[2], wb[2];
#pragma unroll
            for (int rb = 0; rb < 2; ++rb) { const int row = 32 * wm + 16 * rb + fr, ch = 8 * ks + 2 * fq;
                const f32x4 lo = *(const LAS f32x4*)(st + row * 256 + ((ch ^ (row & 15)) * 16)), hi = *(const LAS f32x4*)(st + row * 256 + (((ch + 1) ^ (row & 15)) * 16));
                v4u w; w.x = pk2(lo[0], lo[1]); w.y = pk2(lo[2], lo[3]); w.z = pk2(hi[0], hi[1]); w.w = pk2(hi[2], hi[3]); xa[rb] = __builtin_bit_cast(bf16x8, w); }
#pragma unroll
            for (int cb = 0; cb < 2; ++cb) wb[cb] = *(const LAS bf16x8*)(stb + pg8::lds_byte(32 * wn + 16 * cb + fr, 32 * ks + 8 * fq));
#pragma unroll
            for (int cb = 0; cb < 2; ++cb)
#pragma unroll
                for (int rb = 0; rb < 2; ++rb) acc[cb][rb] = __builtin_amdgcn_mfma_f32_16x16x32_bf16(wb[cb], xa[rb], acc[cb][rb], 0, 0, 0);
        }
        if ((gs & 63) == 63) {
            const int ui = gs >> 6, u = vcu + ui * G, kv = u >= upk ? 1 : 0, ul = u - kv * upk;
            LAS unsigned char* hid = lds + CMP_BOFF + (gs % CMP_NB) * 16384; LAS float* red = (LAS float*)(lds + CMP_RED_OFF);
            asm volatile("s_waitcnt lgkmcnt(0)" ::: "memory"); __builtin_amdgcn_s_barrier(); asm volatile("" ::: "memory");
#pragma unroll
            for (int cb = 0; cb < 2; ++cb) { const int n0 = 32 * wn + 16 * cb + 4 * fq; const f32x4 bv = *(const f32x4*)(BIAS + kv * 128 + n0);
#pragma unroll
                for (int rb = 0; rb < 2; ++rb) { const int row = 32 * wm + 16 * rb + fr; float h[4];
#pragma unroll
                    for (int e = 0; e < 4; ++e) { const float x = acc[cb][rb][e] + bv[e]; const float t = 0.7978845608028654f * (x + 0.044715f * x * x * x); h[e] = x * sigmoidf_(2.f * t); acc[cb][rb][e] = 0.f; }
                    v2u w; w.x = pk2(h[0], h[1]); w.y = pk2(h[2], h[3]);
                    *(LAS v2u*)(hid + row * 256 + (((n0 >> 3) ^ (row & 15)) * 16) + (n0 & 7) * 2) = w; } }
            asm volatile("s_waitcnt lgkmcnt(0)" ::: "memory"); __builtin_amdgcn_s_barrier(); asm volatile("" ::: "memory");
            const int rblk = wave >> 1, oh = wave & 1;
            f32x4 o2[2] = {(f32x4){0.f, 0.f, 0.f, 0.f}, (f32x4){0.f, 0.f, 0.f, 0.f}};
#pragma unroll
            for (int ks = 0; ks < 4; ++ks) { const int row = 16 * rblk + fr, ch = 4 * ks + fq;
                const bf16x8 hb = *(const LAS bf16x8*)(hid + row * 256 + ((ch ^ (row & 15)) * 16));
#pragma unroll
                for (int ob = 0; ob < 2; ++ob) { const bf16x8 wa = *(const bf16x8*)(W2T + ((size_t)kv * 64 + 32 * oh + 16 * ob + fr) * 128 + 32 * ks + 8 * fq);
                    o2[ob] = __builtin_amdgcn_mfma_f32_16x16x32_bf16(wa, hb, o2[ob], 0, 0, 0); } }
            float ssq = 0.f;
#pragma unroll
            for (int ob = 0; ob < 2; ++ob)
#pragma unroll
                for (int e = 0; e < 4; ++e) ssq += o2[ob][e] * o2[ob][e];
            ssq += __shfl_xor(ssq, 16); ssq += __shfl_xor(ssq, 32);
            if (fq == 0) red[(16 * rblk + fr) * 2 + oh] = ssq;
            asm volatile("s_waitcnt lgkmcnt(0)" ::: "memory"); __builtin_amdgcn_s_barrier(); asm volatile("" ::: "memory");
            const int trow = 16 * rblk + fr; const float tot = red[trow * 2] + red[trow * 2 + 1];
            const float rs = kv ? 1.f : __builtin_amdgcn_rsqf(tot * (1.f / 64.f) + RMS_EPS);
            const int cid = ul * 16 + (trow >> 2), g = trow & 3, sq = S.seq0 + (cid >> 7), nb = cid & 127;
            bf16* dst = (bf16*)(ws + (kv ? WS_VC : WS_KC)) + (((size_t)sq * 4 + g) * 128 + nb) * 64;
#pragma unroll
            for (int ob = 0; ob < 2; ++ob) { const int o0 = 32 * oh + 16 * ob + 4 * fq; float y[4];
#pragma unroll
                for (int e = 0; e < 4; ++e) y[e] = o2[ob][e] * rs * (kv ? 1.f : I.qk_g[64 + o0 + e]);
                v2u w; w.x = pk2(y[0], y[1]); w.y = pk2(y[2], y[3]); *(v2u*)(dst + o0) = w; }
        }
    }
    asm volatile("s_waitcnt vmcnt(0) lgkmcnt(0)" ::: "memory"); __builtin_amdgcn_s_barrier(); asm volatile("" ::: "memory");
}

constexpr int AT_IMP = 32768  , AT_OUTS = 65536, AT_SELM = LDSCTL_OFF + 1024;
constexpr int SAT_IMP = LDSCTL_OFF + 1024, SAT_SELM = SAT_IMP + 4 * 132 * 4;
static_assert(SAT_SELM + 4 * 8 * 4 <= LDS_BYTES && AT_SELM + 64 * 16 <= LDS_BYTES && AT_OUTS + 65536 <= RING_BYTES, "attention LDS");
__device__ __forceinline__ s16x4 tr16(const LAS unsigned char* p) { typedef short v4s __attribute__((ext_vector_type(4))); return __builtin_bit_cast(s16x4, __builtin_amdgcn_ds_read_tr16_b64_v4i16((LAS v4s*)p)); }
__device__ __forceinline__ unsigned dpp_max_u32(unsigned v) {
    v = max(v, (unsigned)__builtin_amdgcn_update_dpp(0, (int)v, 0xB1, 0xF, 0xF, true));
    v = max(v, (unsigned)__builtin_amdgcn_update_dpp(0, (int)v, 0x4E, 0xF, 0xF, true));
    v = max(v, (unsigned)__builtin_amdgcn_update_dpp(0, (int)v, 0x141, 0xF, 0xF, true));
    v = max(v, (unsigned)__builtin_amdgcn_update_dpp(0, (int)v, 0x140, 0xF, 0xF, true));
    const unsigned a = __builtin_amdgcn_readlane((int)v, 0), b = __builtin_amdgcn_readlane((int)v, 16), c = __builtin_amdgcn_readlane((int)v, 32), d = __builtin_amdgcn_readlane((int)v, 48);
    return max(max(a, b), max(c, d));
}
__device__ __forceinline__ void stage_block_dma(LAS unsigned char* dst, const bf16* src_row0, int pitch_bytes, int wave, int lane) {
    const int row = 8 * wave + (lane >> 3), chunk = (lane & 7) ^ (lane >> 3);
    glds16((const char*)src_row0 + (size_t)row * pitch_bytes + chunk * 16, lds_addr(dst + wave * 1024));
}
__device__ __forceinline__ void kfrags(bf16x8 (&kf)[4][2], const LAS unsigned char* kb, int fr, int fq) {
#pragma unroll
    for (int k = 0; k < 4; ++k)
#pragma unroll
        for (int ks = 0; ks < 2; ++ks) kf[k][ks] = *(const LAS bf16x8*)(kb + (16 * k + fr) * 128 + (((4 * ks + fq) ^ (fr & 7)) * 16));
}
__device__ __forceinline__ bf16x8 pack_p(const f32x4& a, const f32x4& b) { v4u w; w.x = pk2(a[0], a[1]); w.y = pk2(a[2], a[3]); w.z = pk2(b[0], b[1]); w.w = pk2(b[2], b[3]); return __builtin_bit_cast(bf16x8, w); }
template <bool do0, bool do1>
__device__ __forceinline__ void pv_block(const LAS unsigned char* vb, const bf16x8 (&p)[2][2], f32x4 (&o)[2][4], int fr, int fq) {
    const int q4 = fr >> 2, pp = fr & 3, kk = 4 * (fq & 1) + q4;
    const LAS unsigned char* vrow = vb + (4 * fq + q4) * 128 + (pp & 1) * 8;
#pragma unroll
    for (int db = 0; db < 4; ++db) { const int xo = (((2 * db + (pp >> 1)) ^ kk) * 16);
#pragma unroll
        for (int st = 0; st < 2; ++st) {
            const s16x4 lo4 = tr16(vrow + (32 * st) * 128 + xo), hi4 = tr16(vrow + (32 * st + 16) * 128 + xo);
            const bf16x8 vf = (bf16x8){lo4[0], lo4[1], lo4[2], lo4[3], hi4[0], hi4[1], hi4[2], hi4[3]};
            if (do0) o[0][db] = __builtin_amdgcn_mfma_f32_16x16x32_bf16(vf, p[0][st], o[0][db], 0, 0, 0);
            if (do1) o[1][db] = __builtin_amdgcn_mfma_f32_16x16x32_bf16(vf, p[1][st], o[1][db], 0, 0, 0); } }
}
template <bool EDGE, bool do0, bool do1>
__device__ __forceinline__ void attn_block_t(const LAS unsigned char* kb, const LAS unsigned char* vb, const bf16x8 (&q)[2][2], const float (&bias)[2], const int (&lo)[2], const int (&hi)[2],
                                           f32x4 (&o)[2][4], float (&l)[2], int fr, int fq) {
    bf16x8 kf[4][2]; kfrags(kf, kb, fr, fq);
    f32x4 sc[2][4];
#pragma unroll
    for (int s = 0; s < 2; ++s) if (s ? do1 : do0) {
#pragma unroll
        for (int k = 0; k < 4; ++k) sc[s][k] = __builtin_amdgcn_mfma_f32_16x16x32_bf16(kf[k][0], q[s][0], (f32x4){bias[s], bias[s], bias[s], bias[s]}, 0, 0, 0); }
#pragma unroll
    for (int s = 0; s < 2; ++s) if (s ? do1 : do0) {
#pragma unroll
        for (int k = 0; k < 4; ++k) sc[s][k] = __builtin_amdgcn_mfma_f32_16x16x32_bf16(kf[k][1], q[s][1], sc[s][k], 0, 0, 0); }
    __builtin_amdgcn_sched_barrier(0);
    bf16x8 vf[4][2];
    { const int q4 = fr >> 2, pp = fr & 3, kk = 4 * (fq & 1) + q4; const LAS unsigned char* vrow = vb + (4 * fq + q4) * 128 + (pp & 1) * 8;
#pragma unroll
      for (int db = 0; db < 4; ++db) { const int xo = (((2 * db + (pp >> 1)) ^ kk) * 16);
#pragma unroll
          for (int st = 0; st < 2; ++st) { const s16x4 lo4 = tr16(vrow + (32 * st) * 128 + xo), hi4 = tr16(vrow + (32 * st + 16) * 128 + xo);
              vf[db][st] = (bf16x8){lo4[0], lo4[1], lo4[2], lo4[3], hi4[0], hi4[1], hi4[2], hi4[3]}; } } }
    __builtin_amdgcn_sched_barrier(0);
    bf16x8 p[2][2];
#pragma unroll
    for (int s = 0; s < 2; ++s) if (s ? do1 : do0) { float ls = 0.f;
#pragma unroll
        for (int k = 0; k < 4; ++k)
#pragma unroll
            for (int e = 0; e < 4; ++e) { float v = sc[s][k][e]; if (EDGE) { const int key = 16 * k + 4 * fq + e; if (key < lo[s] || key > hi[s]) v = -INFINITY; } v = fast_exp2(v); sc[s][k][e] = v; ls += v; }
        l[s] += ls; p[s][0] = pack_p(sc[s][0], sc[s][1]); p[s][1] = pack_p(sc[s][2], sc[s][3]); }
    __builtin_amdgcn_sched_barrier(0);
#pragma unroll
    for (int st = 0; st < 2; ++st)
#pragma unroll
        for (int db = 0; db < 4; ++db) {
            if (do0) o[0][db] = __builtin_amdgcn_mfma_f32_16x16x32_bf16(vf[db][st], p[0][st], o[0][db], 0, 0, 0);
            if (do1) o[1][db] = __builtin_amdgcn_mfma_f32_16x16x32_bf16(vf[db][st], p[1][st], o[1][db], 0, 0, 0); }
}
template <bool EDGE>
__device__ __forceinline__ void attn_block(const LAS unsigned char* kb, const LAS unsigned char* vb, bool do0, bool do1, const bf16x8 (&q)[2][2], const float (&bias)[2], const int (&lo)[2], const int (&hi)[2],
                                           f32x4 (&o)[2][4], float (&l)[2], int fr, int fq) {
    if (do0 && do1) attn_block_t<EDGE, true, true>(kb, vb, q, bias, lo, hi, o, l, fr, fq);
    else if (do0) attn_block_t<EDGE, true, false>(kb, vb, q, bias, lo, hi, o, l, fr, fq);
    else attn_block_t<EDGE, false, true>(kb, vb, q, bias, lo, hi, o, l, fr, fq);
}

__device__ __forceinline__ void attn_prompt_unit(unsigned char* ws, LAS unsigned char* lds, int b, int g, int qb, int wave, int lane_) {
    int lane = lane_; asm volatile("" : "+v"(lane));
    const int fr = lane & 15, fq = lane >> 4, h = fr & 3, tq = fr >> 2;
    const bf16* QN = (const bf16*)(ws + WS_QN); const bf16* QR = (const bf16*)(ws + WS_QR); const float* GATES = (const float*)(ws + WS_GATES); bf16* O = (bf16*)(ws + WS_AC);
    LAS float* IMP = (LAS float*)(lds + AT_IMP); LAS unsigned* SELM = (LAS unsigned*)(lds + AT_SELM);
    const size_t seq0 = (size_t)b * SEQ; const int hc = (g * 4 + h) * 64;
    int itok[2]; size_t row[2];
#pragma unroll
    for (int s = 0; s < 2; ++s) { itok[s] = 8 * wave + 4 * s + tq; row[s] = seq0 + 64 * qb + itok[s]; }
    LAS float* outs = (LAS float*)(lds + AT_OUTS) + wave * 2048 + lane;
    {
        const int nblk = (qb + 64) >> 6;
        const bf16* KC = (const bf16*)(ws + WS_KC) + ((size_t)b * 4 + g) * 128 * 64; const bf16* VC = (const bf16*)(ws + WS_VC) + ((size_t)b * 4 + g) * 128 * 64;
        for (int i = 0; i < nblk; ++i) { stage_block_dma(lds + i * 16384, KC + (size_t)i * 64 * 64, 128, wave, lane); stage_block_dma(lds + i * 16384 + 8192, VC + (size_t)i * 64 * 64, 128, wave, lane); }
        asm volatile("s_waitcnt vmcnt(0)" ::: "memory"); __builtin_amdgcn_s_barrier(); asm volatile("" ::: "memory");
#pragma unroll 1
        for (int s = 0; s < 2; ++s) {
            bf16x8 q[2];
#pragma unroll
            for (int ks = 0; ks < 2; ++ks) q[ks] = *(const bf16x8*)(QN + row[s] * D + hc + 32 * ks + 8 * fq);
            const int nv = qb + (itok[s] == 63 ? 1 : 0);
            f32x4 sc[2][4]; float ls = 0.f;
#pragma unroll
            for (int i = 0; i < 2; ++i) {
                if (i < nblk) { bf16x8 kf[4][2]; kfrags(kf, lds + i * 16384, fr, fq);
#pragma unroll
                    for (int k = 0; k < 4; ++k) { sc[i][k] = (f32x4){0.f, 0.f, 0.f, 0.f};
#pragma unroll
                        for (int ks = 0; ks < 2; ++ks) sc[i][k] = __builtin_amdgcn_mfma_f32_16x16x32_bf16(kf[k][ks], q[ks], sc[i][k], 0, 0, 0);
#pragma unroll
                        for (int e = 0; e < 4; ++e) { const int key = 64 * i + 16 * k + 4 * fq + e; const float v = key < nv ? fast_exp2(sc[i][k][e]) : 0.f; sc[i][k][e] = v; ls += v; } }
                } else {
#pragma unroll
                    for (int k = 0; k < 4; ++k) sc[i][k] = (f32x4){0.f, 0.f, 0.f, 0.f}; } }
            ls += __shfl_xor(ls, 16); ls += __shfl_xor(ls, 32);
            const float inv = ls > 0.f ? 1.f / ls : 0.f;
            f32x4 oc[2][4];
#pragma unroll
            for (int d = 0; d < 4; ++d) { oc[0][d] = (f32x4){0.f, 0.f, 0.f, 0.f}; oc[1][d] = oc[0][d]; }
#pragma unroll
            for (int i = 0; i < 2; ++i) if (i < nblk) {
#pragma unroll
                for (int k = 0; k < 4; ++k) { f32x4 pn = sc[i][k] * inv;
#pragma unroll
                    for (int e = 0; e < 4; ++e) { float t = pn[e]; t += __shfl_xor(t, 1); t += __shfl_xor(t, 2); pn[e] = t; }
                    if (h == 0) *(LAS f32x4*)(IMP + itok[s] * 128 + 64 * i + 16 * k + 4 * fq) = pn; }
                bf16x8 p[2][2]; p[0][0] = pack_p(sc[i][0], sc[i][1]); p[0][1] = pack_p(sc[i][2], sc[i][3]); p[1][0] = p[0][0]; p[1][1] = p[0][1];
                pv_block<true, false>(lds + i * 16384 + 8192, p, oc, fr, fq); }
            const float gc = GATES[row[s] * 48 + (g * 4 + h) * 3 + 0] * inv;
#pragma unroll
            for (int d = 0; d < 4; ++d)
#pragma unroll
                for (int e = 0; e < 4; ++e) outs[((s * 4 + d) * 4 + e) * 64] = oc[0][d][e] * gc;
        }
    }
    asm volatile("; MARK_TOPK");
    unsigned long long un_lo[2] = {0ull, 0ull}, un_hi[2] = {0ull, 0ull};
    asm volatile("s_waitcnt lgkmcnt(0)" ::: "memory");
#pragma unroll
    for (int pass = 0; pass < 2; ++pass) { const int c = lane & 15, tok = 8 * wave + 4 * pass + (lane >> 4);
        unsigned w0, w1 = 0u, w2 = 0u, w3 = 0u;
        if (qb <= 15) w0 = (2u << qb) - 1u;
        else {
            unsigned key[8];
#pragma unroll
            for (int j = 0; j < 8; ++j) { const int n = c + 16 * j; const float v = IMP[tok * 128 + n]; key[j] = (n >= 1 && n <= qb - 2) ? ((__float_as_uint(v) & ~127u) | (unsigned)(127 - n)) : 0u; }
            unsigned thr = 0xFFFFFFFFu;
#pragma unroll 1
            for (int r = 0; r < 13; ++r) { unsigned m = 0u;
#pragma unroll
                for (int j = 0; j < 8; ++j) m = max(m, key[j] < thr ? key[j] : 0u);
                m = max(m, (unsigned)__builtin_amdgcn_update_dpp(0, (int)m, 0xB1, 0xF, 0xF, true)); m = max(m, (unsigned)__builtin_amdgcn_update_dpp(0, (int)m, 0x4E, 0xF, 0xF, true));
                m = max(m, (unsigned)__builtin_amdgcn_update_dpp(0, (int)m, 0x141, 0xF, 0xF, true)); m = max(m, (unsigned)__builtin_amdgcn_update_dpp(0, (int)m, 0x140, 0xF, 0xF, true));
                thr = m; }
            unsigned b[4] = {0u, 0u, 0u, 0u};
#pragma unroll
            for (int j = 0; j < 8; ++j) b[j >> 1] |= (key[j] >= thr ? 1u : 0u) << (c + 16 * (j & 1));
#pragma unroll
            for (int w = 0; w < 4; ++w) { unsigned x = b[w];
                x |= (unsigned)__builtin_amdgcn_update_dpp(0, (int)x, 0xB1, 0xF, 0xF, true); x |= (unsigned)__builtin_amdgcn_update_dpp(0, (int)x, 0x4E, 0xF, 0xF, true);
                x |= (unsigned)__builtin_amdgcn_update_dpp(0, (int)x, 0x141, 0xF, 0xF, true); x |= (unsigned)__builtin_amdgcn_update_dpp(0, (int)x, 0x140, 0xF, 0xF, true); b[w] = x; }
            const unsigned long long flo = 1ull | (qb - 1 < 64 ? 1ull << (qb - 1) : 0ull) | (qb < 64 ? 1ull << qb : 0ull), fhi = (qb - 1 >= 64 ? 1ull << (qb - 65) : 0ull) | (qb >= 64 ? 1ull << (qb - 64) : 0ull);
            w0 = b[0] | (unsigned)flo; w1 = b[1] | (unsigned)(flo >> 32); w2 = b[2] | (unsigned)fhi; w3 = b[3] | (unsigned)(fhi >> 32);
        }
        if (c == 0) { SELM[tok * 4 + 0] = w0; SELM[tok * 4 + 1] = w1; SELM[tok * 4 + 2] = w2; SELM[tok * 4 + 3] = w3; }
        const unsigned u0 = __builtin_amdgcn_readlane((int)w0, 0) | __builtin_amdgcn_readlane((int)w0, 16) | __builtin_amdgcn_readlane((int)w0, 32) | __builtin_amdgcn_readlane((int)w0, 48);
        const unsigned u1 = __builtin_amdgcn_readlane((int)w1, 0) | __builtin_amdgcn_readlane((int)w1, 16) | __builtin_amdgcn_readlane((int)w1, 32) | __builtin_amdgcn_readlane((int)w1, 48);
        const unsigned u2 = __builtin_amdgcn_readlane((int)w2, 0) | __builtin_amdgcn_readlane((int)w2, 16) | __builtin_amdgcn_readlane((int)w2, 32) | __builtin_amdgcn_readlane((int)w2, 48);
        const unsigned u3 = __builtin_amdgcn_readlane((int)w3, 0) | __builtin_amdgcn_readlane((int)w3, 16) | __builtin_amdgcn_readlane((int)w3, 32) | __builtin_amdgcn_readlane((int)w3, 48);
        un_lo[pass] = (unsigned long long)u0 | ((unsigned long long)u1 << 32); un_hi[pass] = (unsigned long long)u2 | ((unsigned long long)u3 << 32);
    }
    asm volatile("s_waitcnt lgkmcnt(0)" ::: "memory");
    bf16x8 qr[2][2];
#pragma unroll
    for (int s = 0; s < 2; ++s)
#pragma unroll
        for (int ks = 0; ks < 2; ++ks) qr[s][ks] = *(const bf16x8*)(QR + row[s] * D + hc + 32 * ks + 8 * fq);
    float gsel[2], gwin[2];
#pragma unroll
    for (int s = 0; s < 2; ++s) { gsel[s] = GATES[row[s] * 48 + (g * 4 + h) * 3 + 1]; gwin[s] = GATES[row[s] * 48 + (g * 4 + h) * 3 + 2]; }
    asm volatile("; MARK_SEL");
    {
        const bf16* KS = (const bf16*)(ws + WS_KS) + seq0 * KVW + g * 64; const bf16* VS = (const bf16*)(ws + WS_VS) + seq0 * KVW + g * 64;
        const bf16* KW = (const bf16*)(ws + WS_KW) + seq0 * KVW + g * 64; const bf16* VW = (const bf16*)(ws + WS_VW) + seq0 * KVW + g * 64;
        const int nsel = qb + 1, n0w = qb >= 8 ? qb - 8 : 0, nit = nsel + (qb - n0w + 1);
#define AT_ISSUE(it_) do { const int it__ = (it_); const bool w__ = it__ >= nsel; const int n__ = w__ ? n0w + (it__ - nsel) : it__; LAS unsigned char* st__ = lds + (it__ & 3) * 16384; \
            stage_block_dma(st__, (w__ ? KW : KS) + (size_t)n__ * 64 * KVW, KVW * 2, wave, lane); stage_block_dma(st__ + 8192, (w__ ? VW : VS) + (size_t)n__ * 64 * KVW, KVW * 2, wave, lane); } while (0)
#define AT_FOLD(gt_) do { _Pragma("unroll") for (int s = 0; s < 2; ++s) { float ls = la[s]; ls += __shfl_xor(ls, 16); ls += __shfl_xor(ls, 32); const float gs = gt_[s] * (ls > 0.f ? 1.f / ls : 0.f); la[s] = 0.f; \
            _Pragma("unroll") for (int d = 0; d < 4; ++d) { _Pragma("unroll") for (int e = 0; e < 4; ++e) outs[((s * 4 + d) * 4 + e) * 64] += oa[s][d][e] * gs; oa[s][d] = (f32x4){0.f, 0.f, 0.f, 0.f}; } } } while (0)
        f32x4 oa[2][4]; float la[2] = {0.f, 0.f};
#pragma unroll
        for (int s = 0; s < 2; ++s)
#pragma unroll
            for (int d = 0; d < 4; ++d) oa[s][d] = (f32x4){0.f, 0.f, 0.f, 0.f};
        asm volatile("" : "+v"(qr[0][0]), "+v"(qr[0][1]), "+v"(qr[1][0]), "+v"(qr[1][1]), "+v"(gsel[0]), "+v"(gsel[1]), "+v"(gwin[0]), "+v"(gwin[1]));
        asm volatile("s_waitcnt vmcnt(0)" ::: "memory"); __builtin_amdgcn_s_barrier(); asm volatile("" ::: "memory");
        AT_ISSUE(0); AT_ISSUE(1); if (nit > 2) AT_ISSUE(2);
#pragma unroll 1
        for (int it = 0; it < nit; ++it) {
            if (it + 2 < nit) asm volatile("s_waitcnt vmcnt(4)" ::: "memory"); else if (it + 1 < nit) asm volatile("s_waitcnt vmcnt(2)" ::: "memory"); else asm volatile("s_waitcnt vmcnt(0)" ::: "memory");
            __builtin_amdgcn_s_barrier(); asm volatile("" ::: "memory");
            if (it + 3 < nit) AT_ISSUE(it + 3);
            if (it == nsel) AT_FOLD(gsel);
            const LAS unsigned char* st = lds + (it & 3) * 16384;
            if (it < nsel) { const int n = it;
                const bool do0 = ((n < 64 ? un_lo[0] >> n : un_hi[0] >> (n - 64)) & 1ull) != 0ull, do1 = ((n < 64 ? un_lo[1] >> n : un_hi[1] >> (n - 64)) & 1ull) != 0ull;
                if (do0 || do1) { float bias[2]; const int lo[2] = {0, 0}, hi[2] = {itok[0], itok[1]};
#pragma unroll
                    for (int s = 0; s < 2; ++s) { const unsigned wd = SELM[itok[s] * 4 + (n >> 5)]; bias[s] = ((wd >> (n & 31)) & 1u) ? 0.f : -INFINITY; }
                    if (n == qb) attn_block<true>(st, st + 8192, do0, do1, qr, bias, lo, hi, oa, la, fr, fq);
                    else attn_block<false>(st, st + 8192, do0, do1, qr, bias, lo, hi, oa, la, fr, fq);
#ifdef PROBE_TWICE_BLK
                    { const float nb[2] = {-INFINITY, -INFINITY}; asm volatile("" ::: "memory"); attn_block<false>(st, st + 8192, do0, do1, qr, nb, lo, hi, oa, la, fr, fq); }
#endif
                }
            } else { const int n = n0w + (it - nsel); const float bias[2] = {0.f, 0.f};
                if (n == qb || n == qb - 8) { int lo[2], hi[2];
#pragma unroll
                    for (int s = 0; s < 2; ++s) { lo[s] = (n == qb - 8) ? itok[s] + 1 : 0; hi[s] = (n == qb) ? itok[s] : 63; }
                    attn_block<true>(st, st + 8192, true, true, qr, bias, lo, hi, oa, la, fr, fq);
                } else { const int lo[2] = {0, 0}, hi[2] = {63, 63}; attn_block<false>(st, st + 8192, true, true, qr, bias, lo, hi, oa, la, fr, fq); }
#ifdef PROBE_TWICE_BLK
                { const float nb[2] = {-INFINITY, -INFINITY}; const int lo[2] = {0, 0}, hi[2] = {63, 63}; asm volatile("" ::: "memory"); attn_block<false>(st, st + 8192, true, true, qr, nb, lo, hi, oa, la, fr, fq); }
#endif
            }
        }
#pragma unroll
        for (int s = 0; s < 2; ++s) { float ls = la[s]; ls += __shfl_xor(ls, 16); ls += __shfl_xor(ls, 32); const float gw = gwin[s] * (ls > 0.f ? 1.f / ls : 0.f);
#pragma unroll
            for (int d = 0; d < 4; ++d) { float y[4];
#pragma unroll
                for (int e = 0; e < 4; ++e) y[e] = outs[((s * 4 + d) * 4 + e) * 64] + oa[s][d][e] * gw;
                v2u w; w.x = pk2(y[0], y[1]); w.y = pk2(y[2], y[3]); *(v2u*)(O + row[s] * D + hc + 16 * d + 4 * fq) = w; } }
#undef AT_ISSUE
#undef AT_FOLD
    }
    asm volatile("s_waitcnt lgkmcnt(0)" ::: "memory"); __builtin_amdgcn_s_barrier(); asm volatile("" ::: "memory");
}

__device__ __forceinline__ void stage_f32_rows(LAS unsigned char* dst, const float* src_row0  , int lane) {
#pragma unroll
    for (int half = 0; half < 2; ++half) { f32x4 v[8];
#pragma unroll
        for (int k = 0; k < 8; ++k) { const int r = 32 * half + 4 * k + (lane >> 4); v[k] = *(const f32x4*)(src_row0 + (size_t)r * KVW + 4 * (lane & 15)); }
#pragma unroll
        for (int k = 0; k < 8; ++k) { const int r = 32 * half + 4 * k + (lane >> 4), c16 = (lane & 15) >> 1; v2u w; w.x = pk2(v[k][0], v[k][1]); w.y = pk2(v[k][2], v[k][3]);
            *(LAS v2u*)(dst + r * 128 + ((c16 ^ (r & 7)) * 16) + (lane & 1) * 8) = w; } }
}
__device__ __forceinline__ void stage_bf16_rows(LAS unsigned char* dst, const bf16* src_row0, int pitch, int nvalid, int lane) {
#pragma unroll
    for (int k = 0; k < 8; ++k) { const int r = 8 * k + (lane >> 3), c = lane & 7; v4u w = (v4u){0u, 0u, 0u, 0u};
        if (r < nvalid) w = *(const v4u*)(src_row0 + (size_t)r * pitch + 8 * c);
        *(LAS v4u*)(dst + r * 128 + ((c ^ (r & 7)) * 16)) = w; }
}
__device__ __forceinline__ void attn_sample_unit(const In& I, unsigned char* ws, LAS unsigned char* lds, int bs, int g, int wave, int lane_) {
    int lane = lane_; asm volatile("" : "+v"(lane));
    const int fr = lane & 15, fq = lane >> 4, h = fr & 3, tq = fr >> 2;
    const bf16* QN = (const bf16*)(ws + WS_QN); const bf16* QR = (const bf16*)(ws + WS_QR); const float* GATES = (const float*)(ws + WS_GATES); bf16* O = (bf16*)(ws + WS_AC);
    LAS float* IMP = (LAS float*)(lds + SAT_IMP); LAS unsigned* SELM = (LAS unsigned*)(lds + SAT_SELM);
    LAS unsigned char* my = lds + wave * 16384;
    const size_t row = (size_t)MP + 4 * bs + tq; const int hc = (g * 4 + h) * 64;
    f32x4 acc[2][4]; float lsum[2] = {0.f, 0.f};
    f32x4 oc[2][4]; float lc = 0.f;
#pragma unroll
    for (int d = 0; d < 4; ++d) { acc[0][d] = (f32x4){0.f, 0.f, 0.f, 0.f}; acc[1][d] = acc[0][d]; oc[0][d] = acc[0][d]; oc[1][d] = acc[0][d]; }
    if (wave == 0) {
        const bf16* KC = (const bf16*)(ws + WS_KC) + ((size_t)(2 + bs) * 4 + g) * 128 * 64; const bf16* VC = (const bf16*)(ws + WS_VC) + ((size_t)(2 + bs) * 4 + g) * 128 * 64;
        bf16x8 q[2];
#pragma unroll
        for (int ks = 0; ks < 2; ++ks) q[ks] = *(const bf16x8*)(QN + row * D + hc + 32 * ks + 8 * fq);
        f32x4 sc[2][4];
#pragma unroll 1
        for (int i = 0; i < 2; ++i) {
            stage_bf16_rows(my, KC + (size_t)i * 64 * 64, 64, 64, lane); stage_bf16_rows(my + 8192, VC + (size_t)i * 64 * 64, 64, 64, lane);
            asm volatile("s_waitcnt lgkmcnt(0)" ::: "memory");
            bf16x8 kf[4][2]; kfrags(kf, my, fr, fq);
            f32x4 t[4];
#pragma unroll
            for (int k = 0; k < 4; ++k) { t[k] = (f32x4){0.f, 0.f, 0.f, 0.f};
#pragma unroll
                for (int ks = 0; ks < 2; ++ks) t[k] = __builtin_amdgcn_mfma_f32_16x16x32_bf16(kf[k][ks], q[ks], t[k], 0, 0, 0);
#pragma unroll
                for (int e = 0; e < 4; ++e) { t[k][e] = fast_exp2(t[k][e]); lc += t[k][e]; } }
            bf16x8 p[2][2]; p[0][0] = pack_p(t[0], t[1]); p[0][1] = pack_p(t[2], t[3]); p[1][0] = p[0][0]; p[1][1] = p[0][1];
            pv_block<true, false>(my + 8192, p, oc, fr, fq);
            asm volatile("s_waitcnt lgkmcnt(0)" ::: "memory");
#pragma unroll
            for (int k = 0; k < 4; ++k) { if (i == 0) sc[0][k] = t[k]; else sc[1][k] = t[k]; }
        }
        lc += __shfl_xor(lc, 16); lc += __shfl_xor(lc, 32);
        const float inv = 1.f / lc;
#pragma unroll
        for (int i = 0; i < 2; ++i)
#pragma unroll
            for (int k = 0; k < 4; ++k) { f32x4 pn = sc[i][k] * inv;
#pragma unroll
                for (int e = 0; e < 4; ++e) { float t = pn[e]; t += __shfl_xor(t, 1); t += __shfl_xor(t, 2); pn[e] = t; }
                if (h == 0) *(LAS f32x4*)(IMP + tq * 132 + 64 * i + 16 * k + 4 * fq) = pn; }
    }
    asm volatile("s_waitcnt lgkmcnt(0)" ::: "memory"); __builtin_amdgcn_s_barrier(); asm volatile("" ::: "memory");
    if (wave < 4) {
        const float v0 = IMP[wave * 132 + lane], v1 = IMP[wave * 132 + 64 + lane];
        unsigned u0 = (lane >= 1) ? __float_as_uint(v0) : 0u, u1 = (lane + 64 <= 126) ? __float_as_uint(v1) : 0u;
        unsigned long long mlo = 1ull, mhi = 1ull << 63;
#pragma unroll 1
        for (int r = 0; r < 13; ++r) { const unsigned m = dpp_max_u32(max(u0, u1));
            const unsigned long long b0 = __ballot(u0 == m);
            if (b0) { const int idx = __builtin_ctzll(b0); mlo |= 1ull << idx; if (lane == idx) u0 = 0u; }
            else { const unsigned long long b1 = __ballot(u1 == m); const int idx = __builtin_ctzll(b1); mhi |= 1ull << idx; if (lane == idx) u1 = 0u; } }
        if (lane == 0) { SELM[wave * 8 + 0] = (unsigned)mlo; SELM[wave * 8 + 1] = (unsigned)(mlo >> 32); SELM[wave * 8 + 2] = (unsigned)mhi; SELM[wave * 8 + 3] = (unsigned)(mhi >> 32); }
    }
    asm volatile("s_waitcnt lgkmcnt(0)" ::: "memory"); __builtin_amdgcn_s_barrier(); asm volatile("" ::: "memory");
    unsigned selw[4];
#pragma unroll
    for (int w = 0; w < 4; ++w) selw[w] = SELM[tq * 8 + w];
    unsigned long long un_lo = 0ull, un_hi = 0ull;
#pragma unroll
    for (int t = 0; t < 4; ++t) { un_lo |= (unsigned long long)SELM[t * 8 + 0] | ((unsigned long long)SELM[t * 8 + 1] << 32); un_hi |= (unsigned long long)SELM[t * 8 + 2] | ((unsigned long long)SELM[t * 8 + 3] << 32); }
    un_lo = ((unsigned long long)__builtin_amdgcn_readfirstlane((unsigned)(un_lo >> 32)) << 32) | (unsigned)__builtin_amdgcn_readfirstlane((unsigned)un_lo);
    un_hi = ((unsigned long long)__builtin_amdgcn_readfirstlane((unsigned)(un_hi >> 32)) << 32) | (unsigned)__builtin_amdgcn_readfirstlane((unsigned)un_hi);
    bf16x8 qr[2][2];
#pragma unroll
    for (int ks = 0; ks < 2; ++ks) { qr[0][ks] = *(const bf16x8*)(QR + row * D + hc + 32 * ks + 8 * fq); qr[1][ks] = qr[0][ks]; }
    int cnt = 0;
    { const int* pt = I.page_table + bs * NPAGE;
#pragma unroll 1
      for (int n = 0; n < 128; ++n) { const bool on = ((n < 64 ? un_lo >> n : un_hi >> (n - 64)) & 1ull) != 0ull; if (!on) continue;
          if ((cnt++ & 7) != wave) continue;
          const int pg = pt[n >> 1]; const size_t ro = ((size_t)pg * 128 + (n & 1) * 64) * KVW + g * 64;
          stage_f32_rows(my, I.ck_sel + ro, lane); stage_f32_rows(my + 8192, I.cv_sel + ro, lane);
          asm volatile("s_waitcnt lgkmcnt(0)" ::: "memory");
          const int wi = n >> 5; const unsigned wd = wi == 0 ? selw[0] : (wi == 1 ? selw[1] : (wi == 2 ? selw[2] : selw[3]));
          const float bias[2] = {((wd >> (n & 31)) & 1u) ? 0.f : -INFINITY, 0.f}; const int lo[2] = {0, 0}, hi[2] = {63, 63};
          attn_block<false>(my, my + 8192, true, false, qr, bias, lo, hi, acc, lsum, fr, fq);
          asm volatile("s_waitcnt lgkmcnt(0)" ::: "memory"); } }
#pragma unroll 1
    for (int wb = 0; wb < 8; ++wb) { if ((cnt++ & 7) != wave) continue;
        const size_t ro = ((size_t)bs * 512 + 64 * wb) * KVW + g * 64;
        stage_f32_rows(my, I.ck_win + ro, lane); stage_f32_rows(my + 8192, I.cv_win + ro, lane);
        asm volatile("s_waitcnt lgkmcnt(0)" ::: "memory");
        const float bias[2] = {0.f, 0.f}; const int lo[2] = {0, wb == 0 ? tq + 1 : 0}, hi[2] = {63, 63};
        attn_block<true>(my, my + 8192, false, true, qr, bias, lo, hi, acc, lsum, fr, fq);
        asm volatile("s_waitcnt lgkmcnt(0)" ::: "memory"); }
    if ((cnt++ & 7) == wave) {
        stage_bf16_rows(my, (const bf16*)(ws + WS_KS) + ((size_t)MP + 4 * bs) * KVW + g * 64, KVW, 4, lane); stage_bf16_rows(my + 8192, (const bf16*)(ws + WS_VS) + ((size_t)MP + 4 * bs) * KVW + g * 64, KVW, 4, lane);
        asm volatile("s_waitcnt lgkmcnt(0)" ::: "memory");
        const float bias[2] = {0.f, 0.f}; const int lo[2] = {0, 0}, hi[2] = {tq, tq};
        attn_block<true>(my, my + 8192, true, false, qr, bias, lo, hi, acc, lsum, fr, fq);
        asm volatile("s_waitcnt lgkmcnt(0)" ::: "memory"); }
    if ((cnt++ & 7) == wave) {
        stage_bf16_rows(my, (const bf16*)(ws + WS_KW) + ((size_t)MP + 4 * bs) * KVW + g * 64, KVW, 4, lane); stage_bf16_rows(my + 8192, (const bf16*)(ws + WS_VW) + ((size_t)MP + 4 * bs) * KVW + g * 64, KVW, 4, lane);
        asm volatile("s_waitcnt lgkmcnt(0)" ::: "memory");
        const float bias[2] = {0.f, 0.f}; const int lo[2] = {0, 0}, hi[2] = {tq, tq};
        attn_block<true>(my, my + 8192, false, true, qr, bias, lo, hi, acc, lsum, fr, fq);
        asm volatile("s_waitcnt lgkmcnt(0)" ::: "memory"); }
    __builtin_amdgcn_s_barrier(); asm volatile("" ::: "memory");
    { LAS float* red = (LAS float*)lds + wave * (2 * 17 * 64);
#pragma unroll
      for (int br = 0; br < 2; ++br) {
#pragma unroll
          for (int d = 0; d < 4; ++d)
#pragma unroll
              for (int e = 0; e < 4; ++e) red[(br * 17 + 4 * d + e) * 64 + lane] = acc[br][d][e];
          red[(br * 17 + 16) * 64 + lane] = lsum[br]; } }
    asm volatile("s_waitcnt lgkmcnt(0)" ::: "memory"); __builtin_amdgcn_s_barrier(); asm volatile("" ::: "memory");
    if (wave == 0) {
        float outv[16];
        const float gc = GATES[row * 48 + (g * 4 + h) * 3 + 0] / lc;
#pragma unroll
        for (int d = 0; d < 4; ++d)
#pragma unroll
            for (int e = 0; e < 4; ++e) outv[4 * d + e] = oc[0][d][e] * gc;
#pragma unroll
        for (int br = 0; br < 2; ++br) { float ls = 0.f; float ob[16];
#pragma unroll
            for (int k = 0; k < 16; ++k) ob[k] = 0.f;
#pragma unroll 1
            for (int w = 0; w < 8; ++w) { const LAS float* red = (const LAS float*)lds + w * (2 * 17 * 64);
#pragma unroll
                for (int k = 0; k < 16; ++k) ob[k] += red[(br * 17 + k) * 64 + lane];
                ls += red[(br * 17 + 16) * 64 + lane]; }
            ls += __shfl_xor(ls, 16); ls += __shfl_xor(ls, 32);
            const float gb = GATES[row * 48 + (g * 4 + h) * 3 + 1 + br] * (ls > 0.f ? 1.f / ls : 0.f);
#pragma unroll
            for (int k = 0; k < 16; ++k) outv[k] += ob[k] * gb; }
#pragma unroll
        for (int d = 0; d < 4; ++d) { v2u w; w.x = pk2(outv[4 * d], outv[4 * d + 1]); w.y = pk2(outv[4 * d + 2], outv[4 * d + 3]); *(v2u*)(O + row * D + hc + 16 * d + 4 * fq) = w; }
    }
    asm volatile("s_waitcnt lgkmcnt(0)" ::: "memory"); __builtin_amdgcn_s_barrier(); asm volatile("" ::: "memory");
}
__device__ __forceinline__ void attention_phase(const In& I, unsigned char* ws, LAS unsigned char* lds, int vcu, int G) {
    int tid_ = threadIdx.x; asm volatile("" : "+v"(tid_));
    const int wave = __builtin_amdgcn_readfirstlane(tid_ >> 6), lane = tid_ & 63;
#pragma unroll 1
    for (int k = vcu; k < 1024; k += G) { int bg = k & 7, qb = 127 - (k >> 3);
        if (G == 256) { const int i = k >> 8, j = vcu & 31; bg = vcu >> 5; qb = i == 0 ? 127 - j : (i == 1 ? 64 + j : (i == 2 ? 63 - j : j)); }
        asm volatile("; MARK_PROMPT_UNIT");
        attn_prompt_unit(ws, lds, bg >> 2, bg & 3, qb, wave, lane); }
#pragma unroll 1
#ifdef PROBE_TWICE_SAMPLE
    for (int rep = 0; rep < 2; ++rep)
#endif
    for (int k = (G == 256) ? ((vcu & 1) ? (vcu >> 1) : 128) : vcu; k < 128; k += G) { asm volatile("; MARK_SAMPLE_UNIT"); attn_sample_unit(I, ws, lds, k >> 2, k & 3, wave, lane); }
    asm volatile("; MARK_ATT_END");
}

#ifdef PROBE_TWICE_ATT
#define PROBE_ATT SEAM(); attention_phase(I, ws, lds, vcu, G);
#else
#define PROBE_ATT
#endif
#ifndef NSA_MIXER_BODY
#define NSA_MIXER_BODY { CmpSrc cs{out + O_KCP, out + O_VCP, nullptr, 0, 2}; compress_phase(I, ws, lds, cs, vcu, G); } SEAM(); \
    attention_phase(I, ws, lds, vcu, G); PROBE_ATT SEAM();
#endif

struct Args { const void* in[26]; float* out; unsigned char* ws; int ph_lo, ph_hi; };
__global__ void __launch_bounds__(NWAVES * 64, 2) fwd(Args args) {
    extern __shared__ __attribute__((aligned(16))) unsigned char lds_[];
    LAS unsigned char* lds = (LAS unsigned char*)lds_;
    const int tid = threadIdx.x, lane = tid & 63, wave = __builtin_amdgcn_readfirstlane(tid >> 6);
    const int G = gridDim.x; int vcu; { const int bx = blockIdx.x; vcu = (G % 8 == 0) ? (bx % 8) * (G / 8) + bx / 8 : bx; }
    unsigned char* ws = args.ws; float* out = args.out;
    gu32* ctl = (gu32*)(ws + WS_CTL);
    In I;
    I.x_prompt = (const float*)args.in[0]; I.x_sample = (const float*)args.in[1]; I.state_conv = (const float*)args.in[2]; I.ck_cmp = (const float*)args.in[3]; I.cv_cmp = (const float*)args.in[4];
    I.ck_sel = (const float*)args.in[5]; I.cv_sel = (const float*)args.in[6]; I.ck_win = (const float*)args.in[7]; I.cv_win = (const float*)args.in[8]; I.page_table = (const int*)args.in[9];
    I.p_prompt = (const float*)args.in[10]; I.p_sample = (const float*)args.in[11]; I.norm_g = (const float*)args.in[12]; I.w_gu = (const float*)args.in[13]; I.w_down = (const float*)args.in[14];
    I.w_proj = (const float*)args.in[15]; I.w_gate = (const float*)args.in[16]; I.cw_in = (const float*)args.in[17]; I.cw = (const float*)args.in[18]; I.cw_out = (const float*)args.in[19];
    I.nw_in = (const float*)args.in[20]; I.qk_g = (const float*)args.in[21]; I.cmp_pos = (const float*)args.in[22]; I.cmp_w1 = (const float*)args.in[23]; I.cmp_w2 = (const float*)args.in[24]; I.nw_out = (const float*)args.in[25];
    for (int u = tid; u < (LDS_BYTES - LDSCTL_OFF) / 4; u += NWAVES * 64) ((LAS unsigned*)(lds + LDSCTL_OFF))[u] = 0u;
    __syncthreads();
    (void)xcd_barrier_post((unsigned*)ctl + CW_BAR, (volatile LAS unsigned*)(lds + MISC_OFF) + 8);
    const int hi = args.ph_hi; int pid = 0;
#define SEAM() do { asm volatile("; SEAM_MARK %0" :: "i"(__LINE__)); ++pid; if (pid >= hi) return; XcdBarrier b_; b_.bar = (unsigned*)(ws + WS_CTL) + CW_BAR; b_.x = xb_xcc_id(); b_.st = (volatile LAS unsigned*)(lds + MISC_OFF) + 8; xcd_barrier(b_); } while (0)


    bf16* const XB_0 = (bf16*)(ws + WS_XB); bf16* const XB_1 = (bf16*)(ws + WS_XB + SZ_XB);
    float* const SS_0 = (float*)(ws + WS_SS); float* const SS_1 = (float*)(ws + WS_SS + SZ_SS);
    bf16* const Hb = (bf16*)(ws + WS_H); bf16* const ACb = (bf16*)(ws + WS_AC);
    bf16* const PBb = (bf16*)(ws + WS_PB); bf16* const Pb = (bf16*)(ws + WS_P);

#ifdef PH_HI_OVERRIDE
    { const size_t gt = (size_t)(vcu * NWAVES + wave) * 64 + lane, NT = (size_t)G * NWAVES * 64;
      for (size_t i = DBG_FILL_FROM / 4 + gt; i < O_END / 4; i += NT) ((GAS f32x4*)out)[i] = (f32x4){0.f, 0.f, 0.f, 0.f}; }
#endif
    p0_prologue(I, out, ws, lds, vcu, G, wave, lane);
    cmp_bias_partials(I, ws, vcu, G, wave, lane);
#ifdef PROBE_TWICE_PRO
    SEAM(); p0_prologue(I, out, ws, lds, vcu, G, wave, lane);
#endif
    SEAM();
#define PH_PROJ(l) { const bf16* Wp = (const bf16*)(ws + WS_WPROJ + (size_t)(l) * SZ_WPROJ); int kk_ = PLE; asm volatile("" : "+s"(kk_)); \
      pg8::Gemm g{PBb + (size_t)(l) * MT * PLE, Wp, MP, D, kk_}; GOrder S; S.init(MP, D, G, (int)blockIdx.x); pg8::EpiRaw<false> E{Pb + (size_t)(l) * MT * D, D, nullptr}; \
      pg8::gemm_phase<pg8::EpiRaw<false>, GOrder, true, true>(lds, g, S, E); \
      SkRaw<false> SE{Pb + (size_t)(l) * MT * D, D, nullptr}; skinny_phase<0>(lds, PBb + ((size_t)(l) * MT + MP) * PLE, Wp, PLE, D / 64, SE, vcu, G); }
    PH_PROJ(0)
    PH_PROJ(1)
    cmp_bias_reduce(ws, vcu, tid);
    SEAM();
    { CmpSrc cs{I.ck_cmp, I.cv_cmp, I.page_table, 2, 32}; compress_phase(I, ws, lds, cs, vcu, G); }
#ifdef PROBE_TWICE_CMP
    SEAM(); { CmpSrc cs{I.ck_cmp, I.cv_cmp, I.page_table, 2, 32}; compress_phase(I, ws, lds, cs, vcu, G); }
#endif
    SEAM();

#define XBP(c) ((bf16*)(ws + WS_XB + (size_t)(c) * SZ_XB))
#define SSP(c) ((float*)(ws + WS_SS + (size_t)(c) * SZ_SS))
#define PH_GU(l, s, c) { const bf16* Wgu = (const bf16*)(ws + WS_WGU + (size_t)((l) * 2 + (s)) * SZ_WGU); \
      pg8::Gemm g{XBP(c), Wgu, MP, NGU, D}; GOrder S; S.init(MP, NGU, G, (int)blockIdx.x); pg8::EpiSwiglu E{Hb, SSP(c)}; \
      pg8::gemm_phase<pg8::EpiSwiglu, GOrder, true, true>(lds, g, S, E); \
      SkSwiglu SE{Hb, SSP(c)}; skinny_phase<1>(lds, XBP(c) + (size_t)MP * D, Wgu, D, FF / 32, SE, vcu, G); } SEAM();
#define PH_RESID(Asrc, K_, Wt, scale, c) { pg8::Gemm g{(Asrc), (const bf16*)(Wt), MP, D, (K_)}; GOrder S; S.init(MP, D, G, (int)blockIdx.x); \
      pg8::EpiResid<false, false> E{out, XBP((c) ^ 1), SSP((c) ^ 1), (scale), nullptr, nullptr}; \
      pg8::gemm_phase<pg8::EpiResid<false, false>, GOrder, true, true>(lds, g, S, E); \
      SkResid<false> SE{out, XBP((c) ^ 1), SSP((c) ^ 1), (scale), nullptr, nullptr, 0}; skinny_phase<0>(lds, (Asrc) + (size_t)MP * (K_), (const bf16*)(Wt), (K_), D / 64, SE, vcu, G); } SEAM();
#define PH_RAW(Wt, N_, NCU_, c) { pg8::Gemm g{XBP(c), (const bf16*)(Wt), MP, (N_), D}; GOrder S; S.init(MP, (N_), G, (int)blockIdx.x); pg8::EpiRaw<true> E{Hb, (N_), SSP(c)}; \
      pg8::gemm_phase<pg8::EpiRaw<true>, GOrder, true, true>(lds, g, S, E); \
      SkRaw<true> SE{Hb, (N_), SSP(c)}; skinny_phase<0>(lds, XBP(c) + (size_t)MP * D, (const bf16*)(Wt), D, (NCU_), SE, vcu, G); } SEAM();
#define PH_GATE(l, c, FIN) { const bf16* Wg = (const bf16*)(ws + WS_WGATE + (size_t)(l) * SZ_WSQ); const bf16* Pl = Pb + (size_t)(l) * MT * D; \
      pg8::Gemm g{XBP(c), Wg, MP, D, D}; GOrder S; S.init(MP, D, G, (int)blockIdx.x); pg8::EpiResid<true, FIN> E{out, XBP((c) ^ 1), SSP((c) ^ 1), 1.0f, SSP(c), Pl}; \
      pg8::gemm_phase<pg8::EpiResid<true, FIN>, GOrder, true, true>(lds, g, S, E); \
      SkResid<true> SE{out, XBP((c) ^ 1), SSP((c) ^ 1), 1.0f, SSP(c), Pl, FIN}; skinny_phase<0>(lds, XBP(c) + (size_t)MP * D, Wg, D, D / 64, SE, vcu, G); } SEAM();

    PH_GU(0, 0, 0)
#ifdef PROBE_TWICE_GU
    PH_GU(0, 0, 0)
#endif
    PH_RESID(Hb, FF, ws + WS_WDN + 0 * SZ_WDN, 0.5f, 0)
    PH_RAW(ws + WS_WCIN, NCV, NCV / 64, 1)
    conv_post(I, out, ws, vcu, G, wave, lane); SEAM();
    PH_RESID(ACb, D, ws + WS_WCOUT, 1.0f, 1)
    PH_GU(0, 1, 0)
    PH_RESID(Hb, FF, ws + WS_WDN + 1 * SZ_WDN, 0.5f, 0)
    PH_GATE(0, 1, false)
    PH_GU(1, 0, 0)
    PH_RESID(Hb, FF, ws + WS_WDN + 2 * SZ_WDN, 0.5f, 0)
    PH_RAW(ws + WS_WNIN, NNSP, (NNS + 63) / 64, 1)
    nsa_post(I, out, ws, vcu, G, wave, lane); SEAM();
    NSA_MIXER_BODY
    PH_RESID(ACb, D, ws + WS_WNOUT, 1.0f, 1)
    PH_GU(1, 1, 0)
    PH_RESID(Hb, FF, ws + WS_WDN + 3 * SZ_WDN, 0.5f, 0)
    PH_GATE(1, 1, true)
#ifdef DBG_SCALE_FROM
    { const size_t gt = (size_t)(vcu * NWAVES + wave) * 64 + lane, NT = (size_t)G * NWAVES * 64;
      for (size_t i = (DBG_SCALE_FROM) / 4 + gt; i < (DBG_SCALE_TO) / 4; i += NT) ((GAS f32x4*)out)[i] *= 1.2f; }
#endif
#undef SEAM
}

#ifdef PH_HI_OVERRIDE
#define PH_HI PH_HI_OVERRIDE
#endif
#ifndef PH_HI
#define PH_HI 1000
#endif
extern "C" void kernel_launch(void* const* d_in, const int* in_sizes, int n_in, void* d_out, int out_size, void* d_ws, size_t ws_size, hipStream_t stream) {
    static int grid = 0;
    if (grid == 0) {
        if (n_in != 26 || out_size != (int)O_END || ws_size < WS_END) { fprintf(stderr, "kernel_launch: unexpected sizes n_in %d out %d ws %zu (need %zu)\n", n_in, out_size, ws_size, (size_t)WS_END); grid = -1; return; }
        int dev = 0, cus = 0, per_cu = 0;
        if (hipGetDevice(&dev) != hipSuccess || hipDeviceGetAttribute(&cus, hipDeviceAttributeMultiprocessorCount, dev) != hipSuccess) { grid = -1; return; }
        if (hipFuncSetAttribute((const void*)fwd, hipFuncAttributeMaxDynamicSharedMemorySize, LDS_BYTES) != hipSuccess) { fprintf(stderr, "kernel_launch: hipFuncSetAttribute failed\n"); grid = -1; return; }
        if (hipOccupancyMaxActiveBlocksPerMultiprocessor(&per_cu, (const void*)fwd, NWAVES * 64, LDS_BYTES) != hipSuccess || per_cu < 1) { fprintf(stderr, "kernel_launch: occupancy query says %d\n", per_cu); (void)hipGetLastError(); grid = -1; return; }
        grid = cus;
    }
    if (grid < 0) return;
    (void)hipMemsetAsync((char*)d_ws + WS_CTL, 0, CTL_ZERO_BYTES, stream);
    Args a{};
    for (int i = 0; i < 26; ++i) a.in[i] = d_in[i];
    a.out = (float*)d_out; a.ws = (unsigned char*)d_ws; a.ph_lo = 0; a.ph_hi = PH_HI;
    hipLaunchKernelGGL(fwd, dim3(grid), dim3(NWAVES * 64), LDS_BYTES, stream, a);
}
```

```cpp
#include <hip/hip_runtime.h>
#include <cstdio>
#include <cstdint>

#define GAS __attribute__((address_space(1)))
#define LAS __attribute__((address_space(3)))
typedef unsigned short bf16;
typedef unsigned v4u __attribute__((ext_vector_type(4)));
typedef unsigned v2u __attribute__((ext_vector_type(2)));
typedef float f32x4 __attribute__((ext_vector_type(4)));
typedef float f32x2 __attribute__((ext_vector_type(2)));
typedef short bf16x8 __attribute__((ext_vector_type(8)));
typedef short s16x4 __attribute__((ext_vector_type(4)));
typedef GAS unsigned gu32;

constexpr int D = 1024, MP = 16384, MS = 128, MT = MP + MS, FF = 2816, NGU = 2 * FF, NCV = 3072, NNS = 2608, NNSP = 2816, PLE = 256;
constexpr int SEQ = 8192, SB = 32, ST = 4, PAST = 8192, NPAGE = 64, HD = 64, KVW = 256, WIN = 512, NBT = 34  ;
constexpr float RMS_EPS = 1e-6f;
constexpr float QSCALE = 0.125f * 1.4426950408889634f;

constexpr size_t O_Y = 0, O_YS = O_Y + (size_t)MP * D, O_CONVP = O_YS + (size_t)MS * D, O_CONVS = O_CONVP + 2 * 2 * D, O_KCP = O_CONVS + 32 * 2 * D;
constexpr size_t SZ_P = (size_t)MP * KVW, SZ_WP = 2 * 512 * KVW, SZ_S = (size_t)MS * KVW, SZ_WS = 32 * 512 * KVW;
constexpr size_t O_VCP = O_KCP + SZ_P, O_KSP = O_VCP + SZ_P, O_VSP = O_KSP + SZ_P, O_KWP = O_VSP + SZ_P, O_VWP = O_KWP + SZ_WP;
constexpr size_t O_KCS = O_VWP + SZ_WP, O_VCS = O_KCS + SZ_S, O_KSS = O_VCS + SZ_S, O_VSS = O_KSS + SZ_S, O_KWS = O_VSS + SZ_S, O_VWS = O_KWS + SZ_WS, O_END = O_VWS + SZ_WS;
static_assert(O_END == 42799104, "d_out size");

constexpr size_t MiB = 1u << 20;
constexpr size_t WS_CTL = 0, CTL_ZERO_BYTES = 1 * MiB;
constexpr size_t WS_WGU = 2 * MiB;
constexpr size_t SZ_WGU = (size_t)NGU * D * 2;
constexpr size_t WS_WDN = WS_WGU + 4 * SZ_WGU;
constexpr size_t SZ_WDN = (size_t)D * FF * 2;
constexpr size_t WS_WGATE = WS_WDN + 4 * SZ_WDN;
constexpr size_t SZ_WSQ = (size_t)D * D * 2;
constexpr size_t WS_WPROJ = WS_WGATE + 2 * SZ_WSQ;
constexpr size_t SZ_WPROJ = (size_t)D * PLE * 2;
constexpr size_t WS_WCIN = WS_WPROJ + 2 * SZ_WPROJ;
constexpr size_t WS_WCOUT = WS_WCIN + (size_t)NCV * D * 2;
constexpr size_t WS_WNIN = WS_WCOUT + SZ_WSQ;
constexpr size_t WS_WNOUT = WS_WNIN + (size_t)NNSP * D * 2;
constexpr size_t WS_W1T = WS_WNOUT + SZ_WSQ;
constexpr size_t WS_W2T = WS_W1T + 2 * (size_t)128 * 4096 * 2;
constexpr size_t WS_ROPE = WS_W2T + 2 * 64 * 128 * 2;
constexpr size_t WS_SS = (WS_ROPE + (size_t)8196 * 64 * 4 + MiB - 1) / MiB * MiB;
constexpr size_t SZ_SS = (size_t)MT * 16 * 4;
constexpr size_t WS_XB = (WS_SS + 2 * SZ_SS + MiB - 1) / MiB * MiB;
constexpr size_t SZ_XB = (size_t)MT * D * 2;
constexpr size_t WS_H = (WS_XB + 2 * SZ_XB + MiB - 1) / MiB * MiB;
constexpr size_t WS_AC = (WS_H + (size_t)MT * NCV * 2 + MiB - 1) / MiB * MiB;
constexpr size_t WS_PB = (WS_AC + SZ_XB + MiB - 1) / MiB * MiB;
constexpr size_t WS_P = (WS_PB + 2 * (size_t)MT * PLE * 2 + MiB - 1) / MiB * MiB;
constexpr size_t WS_QN = (WS_P + 2 * SZ_XB + MiB - 1) / MiB * MiB;
constexpr size_t WS_QR = (WS_QN + SZ_XB + MiB - 1) / MiB * MiB;
constexpr size_t SZ_KV = (size_t)MT * KVW * 2;
constexpr size_t WS_KS = (WS_QR + SZ_XB + MiB - 1) / MiB * MiB;
constexpr size_t WS_VS = WS_KS + SZ_KV, WS_KW = WS_VS + SZ_KV, WS_VW = WS_KW + SZ_KV;
constexpr size_t WS_GATES = (WS_VW + SZ_KV + MiB - 1) / MiB * MiB;
constexpr size_t WS_KC = (WS_GATES + (size_t)MT * 48 * 4 + MiB - 1) / MiB * MiB;
constexpr size_t SZ_KC = (size_t)NBT * 4 * 128 * 64 * 2;
constexpr size_t WS_VC = (WS_KC + SZ_KC + MiB - 1) / MiB * MiB;
constexpr size_t WS_CPART = (WS_VC + SZ_KC + MiB - 1) / MiB * MiB;
constexpr size_t WS_CBIAS = WS_CPART + 2 * 64 * 128 * 4;
constexpr size_t WS_END = WS_CPART + MiB;

constexpr int CW_TMO = 0, CW_CODE = 1, CW_BAR = 4096;

constexpr int RING_BYTES = 131072, LDSCTL_OFF = 147456  , MISC_OFF = LDSCTL_OFF + 320, LDS_BYTES = 163840  ;
constexpr int NWAVES = 8;

#define RLX_AGENT __ATOMIC_RELAXED, __HIP_MEMORY_SCOPE_AGENT
#define LDS_WAIT() asm volatile("s_waitcnt lgkmcnt(0)" ::: "memory")
#define VM_WAIT() asm volatile("s_waitcnt vmcnt(0)" ::: "memory")

typedef float f2v __attribute__((ext_vector_type(2)));
typedef __bf16 b2v __attribute__((ext_vector_type(2)));
__device__ __forceinline__ unsigned pk2(float lo, float hi) { f2v v = {lo, hi}; b2v b = __builtin_convertvector(v, b2v); return __builtin_bit_cast(unsigned, b); }
__device__ __forceinline__ float bflo(unsigned u) { return __uint_as_float(u << 16); }
__device__ __forceinline__ float bfhi(unsigned u) { return __uint_as_float(u & 0xffff0000u); }
__device__ __forceinline__ float fast_exp2(float x) { return __builtin_amdgcn_exp2f(x); }
__device__ __forceinline__ float sigmoidf_(float x) { return __builtin_amdgcn_rcpf(1.f + fast_exp2(-1.4426950408889634f * x)); }

namespace pg8 {
#define PG8_LAS __attribute__((address_space(3)))
typedef unsigned short bf16_t;
typedef short bf16x8 __attribute__((ext_vector_type(8)));
typedef float f32x4 __attribute__((ext_vector_type(4)));
typedef unsigned u32x4 __attribute__((ext_vector_type(4)));
constexpr int BM = 256, BK = 64, HALF = 128, HTB = HALF * BK * 2  , STAGE_BYTES = 8 * HTB, NXCD = 8, WGM = 8;

__host__ __device__ __forceinline__ int lds_byte(int r, int c) { const int st = (r >> 4) * 2 + (c >> 5), rr = r & 15, cc = c & 31, ob = rr * 64 + cc * 2; return st * 1024 + (ob ^ (((ob >> 9) & 1) << 5)); }
__host__ __device__ __forceinline__ void stage_rc(int b, int& R, int& C) { const int st = b / 1024, sb = b % 1024, swz = sb ^ (((sb >> 9) & 1) << 5); R = (st >> 1) * 16 + swz / 64; C = (st & 1) * 32 + (swz % 64) / 2; }
__host__ __device__ __forceinline__ int perm32(int rho) { const int n = rho >> 4, i = rho & 15; return 8 * (i >> 2) + 4 * n + (i & 3); }

struct Unit { int pm, pn; };
struct Gemm { const bf16_t* A; const bf16_t* Bt; int M, N, K; };

struct StaticOrder {
    int nM, nN, nwg, G, c;
    __host__ __device__ void init(int M, int N, int G_, int c_) { nM = M / BM; nN = N / BM; nwg = nM * nN; G = G_; c = c_; }
    __host__ __device__ bool next(int i, Unit& u) const {
        const long L = (long)i * G + c; if (L >= nwg) return false;
        int wgid = (int)L; { const int q = nwg / NXCD, r = nwg % NXCD, xcd = wgid % NXCD, off = wgid / NXCD; wgid = (xcd < r ? xcd * (q + 1) : r * (q + 1) + (xcd - r) * q) + off; }
        const int nig = WGM * nN, gid = wgid / nig, fm = gid * WGM, gsz = (nM - fm) < WGM ? (nM - fm) : WGM;
        u.pm = fm + ((wgid % nig) % gsz); u.pn = (wgid % nig) / gsz; return true;
    }
    __device__ __forceinline__ void a_ready(const Unit&) const {}
    __device__ __forceinline__ void done(const Unit&) const {}
};
template <class Epi, class Sched, bool ALIGN_EPI = false, bool SP2 = false>
__device__ __forceinline__ void gemm_phase(PG8_LAS unsigned char* lds, const Gemm g, const Sched& S, const Epi& E) {
    int tid_ = threadIdx.x; asm volatile("" : "+v"(tid_));
    const int tid = tid_, wid = __builtin_amdgcn_readfirstlane(tid >> 6), lane = tid & 63, wr = wid >> 2, wc = wid & 3, fr = lane & 15, fq = lane >> 4;
    const int K = g.K, nt = K / BK;
    unsigned voffA[2], voffB[2];
#pragma unroll
    for (int i = 0; i < 2; ++i) { int R, C; stage_rc(tid * 16 + i * 8192, R, C); const int Rb = Epi::PERM ? ((R & ~31) + perm32(R & 31)) : R;
        voffA[i] = (unsigned)(R * K + C) * 2u; voffB[i] = (unsigned)(Rb * K + C) * 2u; }
    const size_t kstep = (size_t)(BK * 2);
    const size_t hstep = (size_t)HALF * K * 2;
    const size_t tstep = 2 * hstep;
    const unsigned ldsw = (unsigned)wid * 1024u;
    const int aoff = lds_byte(wr * 64 + fr, fq * 8), boff = lds_byte(wc * 32 + fr, fq * 8);
#define PG8_SA(b, h) (((b) * 2 + (h)) * HTB)
#define PG8_SB(b, h) ((4 + (b) * 2 + (h)) * HTB)
#define PG8_STAGE(bufoff, gbase, voff) do { _Pragma("unroll") for (int _i = 0; _i < 2; ++_i) \
        __builtin_amdgcn_global_load_lds((const unsigned*)((const char*)(gbase) + (voff)[_i]), (PG8_LAS unsigned*)(lds + (bufoff) + ldsw + _i * 8192), 16, 0, 0); } while (0)
#define PG8_LDA(dst, b, h) do { _Pragma("unroll") for (int m = 0; m < 4; ++m) _Pragma("unroll") for (int k = 0; k < 2; ++k) dst[m][k] = *(const PG8_LAS bf16x8*)(lds + PG8_SA(b, h) + aoff + m * 2048 + k * 1024); } while (0)
#define PG8_LDB(dst, b, h) do { _Pragma("unroll") for (int n = 0; n < 2; ++n) _Pragma("unroll") for (int k = 0; k < 2; ++k) dst[n][k] = *(const PG8_LAS bf16x8*)(lds + PG8_SB(b, h) + boff + n * 2048 + k * 1024); } while (0)
#define PG8_MMA(ai, bj, At, Bt) do { __builtin_amdgcn_s_setprio(1); _Pragma("unroll") for (int m = 0; m < 4; ++m) _Pragma("unroll") for (int n = 0; n < 2; ++n) _Pragma("unroll") for (int k = 0; k < 2; ++k) \
        acc[ai][bj][m][n] = __builtin_amdgcn_mfma_f32_16x16x32_bf16(Bt[n][k], At[m][k], acc[ai][bj][m][n], 0, 0, 0); __builtin_amdgcn_s_setprio(0); } while (0)
#define PG8_WAIT_V(n) asm volatile("s_waitcnt vmcnt(" #n ")" ::: "memory")
#define PG8_WAIT_L(n) asm volatile("s_waitcnt lgkmcnt(" #n ")" ::: "memory")
#define PG8_BAR __builtin_amdgcn_s_barrier()
#define PG8_SCHED __builtin_amdgcn_sched_barrier(0)
    Unit cur, nxt; int ui = 0;
    if (!S.next(0, cur)) return;
    f32x4 acc[2][2][4][2];
#pragma unroll
    for (int a = 0; a < 2; ++a)
#pragma unroll
        for (int b = 0; b < 2; ++b)
#pragma unroll
            for (int m = 0; m < 4; ++m)
#pragma unroll
                for (int n = 0; n < 2; ++n) acc[a][b][m][n] = (f32x4){0.f, 0.f, 0.f, 0.f};
    bf16x8 At[4][2], B0[2][2], B1[2][2];
    const char* cA = (const char*)g.A + (size_t)cur.pm * tstep; const char* cB = (const char*)g.Bt + (size_t)cur.pn * tstep;
    S.a_ready(cur);
    if constexpr (SP2) {
        PG8_STAGE(PG8_SB(0, 0), cB, voffB); PG8_STAGE(PG8_SB(0, 1), cB + hstep, voffB); PG8_STAGE(PG8_SA(0, 0), cA, voffA); PG8_STAGE(PG8_SA(0, 1), cA + hstep, voffA);
        if (wr == 1) PG8_BAR;
        PG8_WAIT_V(2); PG8_BAR;
        PG8_STAGE(PG8_SB(1, 0), cB + kstep, voffB); PG8_STAGE(PG8_SA(1, 0), cA + kstep, voffA); PG8_STAGE(PG8_SB(1, 1), cB + hstep + kstep, voffB);
        PG8_WAIT_V(6); PG8_BAR;
    } else {
        PG8_STAGE(PG8_SB(0, 0), cB, voffB); PG8_STAGE(PG8_SA(0, 0), cA, voffA); PG8_STAGE(PG8_SB(0, 1), cB + hstep, voffB); PG8_STAGE(PG8_SA(0, 1), cA + hstep, voffA);
        if (wr == 1) PG8_BAR;
        PG8_WAIT_V(4); PG8_BAR;
        PG8_STAGE(PG8_SB(1, 0), cB + kstep, voffB); PG8_STAGE(PG8_SA(1, 0), cA + kstep, voffA); PG8_STAGE(PG8_SB(1, 1), cB + hstep + kstep, voffB);
        PG8_WAIT_V(6); PG8_BAR;
    }
    for (;;) {
        const bool has_next = S.next(ui + 1, nxt);
        const char* nA = has_next ? (const char*)g.A + (size_t)nxt.pm * tstep : cA; const char* nB = has_next ? (const char*)g.Bt + (size_t)nxt.pn * tstep : cB;
        for (int t = 0; t < nt; t += 2) {
            const bool last = (t == nt - 2);
            const char* a1 = cA + (size_t)(t + 1) * kstep;
            const char* a2 = last ? nA : cA + (size_t)(t + 2) * kstep; const char* b2 = last ? nB : cB + (size_t)(t + 2) * kstep;
            const char* a3 = a2 + kstep; const char* b3 = b2 + kstep;
            if (last && has_next) S.a_ready(nxt);
            if constexpr (SP2) {
            PG8_LDB(B0, 0, 0); PG8_LDB(B1, 0, 1); PG8_SCHED; PG8_LDA(At, 0, 0); PG8_STAGE(PG8_SA(1, 1), a1 + hstep, voffA);
            PG8_WAIT_V(8); PG8_WAIT_L(0); PG8_BAR; PG8_MMA(0, 0, At, B0); PG8_MMA(0, 1, At, B1); PG8_BAR; PG8_SCHED;
            PG8_LDA(At, 0, 1); PG8_STAGE(PG8_SB(0, 0), b2, voffB); PG8_STAGE(PG8_SB(0, 1), b2 + hstep, voffB); PG8_STAGE(PG8_SA(0, 0), a2, voffA);
            PG8_WAIT_V(8); PG8_WAIT_L(0); PG8_BAR; PG8_MMA(1, 0, At, B0); PG8_MMA(1, 1, At, B1); PG8_BAR; PG8_SCHED;
            PG8_LDB(B0, 1, 0); PG8_LDB(B1, 1, 1); PG8_SCHED; PG8_LDA(At, 1, 0); PG8_STAGE(PG8_SA(0, 1), a2 + hstep, voffA);
            PG8_WAIT_V(8); PG8_WAIT_L(0); PG8_BAR; PG8_MMA(0, 0, At, B0); PG8_MMA(0, 1, At, B1); PG8_BAR; PG8_SCHED;
            PG8_LDA(At, 1, 1); PG8_STAGE(PG8_SB(1, 0), b3, voffB); PG8_STAGE(PG8_SB(1, 1), b3 + hstep, voffB); PG8_STAGE(PG8_SA(1, 0), a3, voffA);
            PG8_WAIT_V(8); PG8_WAIT_L(0); PG8_BAR; PG8_MMA(1, 0, At, B0); PG8_MMA(1, 1, At, B1); PG8_BAR; PG8_SCHED;
            } else {
            PG8_LDB(B0, 0, 0); PG8_SCHED; PG8_LDA(At, 0, 0); PG8_STAGE(PG8_SA(1, 1), a1 + hstep, voffA);
            PG8_WAIT_L(8); PG8_BAR; PG8_WAIT_L(0); PG8_MMA(0, 0, At, B0); PG8_BAR; PG8_SCHED;
            PG8_LDB(B1, 0, 1); PG8_STAGE(PG8_SB(0, 0), b2, voffB);
            PG8_BAR; PG8_WAIT_L(0); PG8_MMA(0, 1, At, B1); PG8_BAR;
            PG8_LDA(At, 0, 1); PG8_STAGE(PG8_SA(0, 0), a2, voffA);
            PG8_BAR; PG8_WAIT_L(0); PG8_MMA(1, 0, At, B0); PG8_BAR; PG8_SCHED;
            PG8_STAGE(PG8_SB(0, 1), b2 + hstep, voffB);
            PG8_WAIT_V(6); PG8_BAR; PG8_MMA(1, 1, At, B1); PG8_BAR;
            PG8_LDB(B0, 1, 0); PG8_SCHED; PG8_LDA(At, 1, 0); PG8_STAGE(PG8_SA(0, 1), a2 + hstep, voffA);
            PG8_WAIT_L(8); PG8_BAR; PG8_WAIT_L(0); PG8_MMA(0, 0, At, B0); PG8_BAR; PG8_SCHED;
            PG8_LDB(B1, 1, 1); PG8_STAGE(PG8_SB(1, 0), b3, voffB);
            PG8_BAR; PG8_WAIT_L(0); PG8_MMA(0, 1, At, B1); PG8_BAR;
            PG8_LDA(At, 1, 1); PG8_STAGE(PG8_SA(1, 0), a3, voffA);
            PG8_BAR; PG8_WAIT_L(0); PG8_MMA(1, 0, At, B0); PG8_BAR; PG8_SCHED;
            PG8_STAGE(PG8_SB(1, 1), b3 + hstep, voffB);
            PG8_WAIT_V(6); PG8_BAR; PG8_MMA(1, 1, At, B1); PG8_BAR;
            }
        }
        if constexpr (ALIGN_EPI) { if (wr == 0) PG8_BAR; }
        if constexpr (!Epi::AFTER_DRAIN) { E(acc, cur, wr, wc, fr, fq); S.done(cur); }
        if (!has_next) break;
#pragma unroll
        for (int a = 0; a < 2; ++a)
#pragma unroll
            for (int b = 0; b < 2; ++b)
#pragma unroll
                for (int m = 0; m < 4; ++m)
#pragma unroll
                    for (int n = 0; n < 2; ++n) acc[a][b][m][n] = (f32x4){0.f, 0.f, 0.f, 0.f};
        cur = nxt; cA = nA; cB = nB; ++ui;
        if constexpr (ALIGN_EPI) { if (wr == 1) PG8_BAR; }
    }
    PG8_WAIT_V(0);
    if constexpr (!ALIGN_EPI) { if (wr == 0) PG8_BAR; }
    PG8_BAR;
    if constexpr (Epi::AFTER_DRAIN) { E.fused(acc, cur, wr, wc, fr, fq, lds, wid, lane); S.done(cur); }
#undef PG8_SA
#undef PG8_SB
#undef PG8_STAGE
#undef PG8_LDA
#undef PG8_LDB
#undef PG8_MMA
#undef PG8_WAIT_V
#undef PG8_WAIT_L
#undef PG8_BAR
#undef PG8_SCHED
}

__device__ __forceinline__ float rstd_of(const float* ss, int row, int fq) {
    const f32x4 v = *(const f32x4*)(ss + (size_t)row * 16 + 4 * fq);
    float s = (v[0] + v[1]) + (v[2] + v[3]);
    s += __shfl_xor(s, 16); s += __shfl_xor(s, 32);
    return __builtin_amdgcn_rsqf(s * (1.f / 1024.f) + 1e-6f);
}
template <bool NORM> struct EpiRaw {
    static constexpr bool PERM = true, AFTER_DRAIN = false;
    bf16_t* O; int ldc; const float* ss;
    __device__ __forceinline__ void operator()(const f32x4 (&acc)[2][2][4][2], const Unit& u, int wr, int wc, int fr, int fq) const {
        const int row0 = u.pm * BM + wr * 64 + fr, col0 = u.pn * BM + wc * 32 + 8 * fq;
#pragma unroll
        for (int ai = 0; ai < 2; ++ai)
#pragma unroll
            for (int m = 0; m < 4; ++m) { const int row = row0 + ai * HALF + m * 16; const float r = NORM ? rstd_of(ss, row, fq) : 1.f;
                bf16_t* rowp = O + (size_t)row * ldc + col0;
#pragma unroll
                for (int bj = 0; bj < 2; ++bj) { const f32x4 v0 = acc[ai][bj][m][0] * r, v1 = acc[ai][bj][m][1] * r;
                    u32x4 w; w.x = pk2(v0[0], v0[1]); w.y = pk2(v0[2], v0[3]); w.z = pk2(v1[0], v1[1]); w.w = pk2(v1[2], v1[3]);
                    *(u32x4*)(rowp + bj * HALF) = w; } }
    }
};
struct EpiSwiglu {
    static constexpr bool PERM = true, AFTER_DRAIN = false;
    bf16_t* H; const float* ss;
    __device__ __forceinline__ void operator()(const f32x4 (&acc)[2][2][4][2], const Unit& u, int wr, int wc, int fr, int fq) const {
        const int row0 = u.pm * BM + wr * 64 + fr, col0 = u.pn * HALF + wc * 32 + 8 * fq;
#pragma unroll
        for (int ai = 0; ai < 2; ++ai)
#pragma unroll
            for (int m = 0; m < 4; ++m) { const int row = row0 + ai * HALF + m * 16; const float r = rstd_of(ss, row, fq);
                float h[8];
#pragma unroll
                for (int n = 0; n < 2; ++n)
#pragma unroll
                    for (int e = 0; e < 4; ++e) { const float g = acc[ai][0][m][n][e] * r, uu = acc[ai][1][m][n][e] * r; h[4 * n + e] = g * sigmoidf_(g) * uu; }
                u32x4 w; w.x = pk2(h[0], h[1]); w.y = pk2(h[2], h[3]); w.z = pk2(h[4], h[5]); w.w = pk2(h[6], h[7]);
                *(u32x4*)(H + (size_t)row * FF + col0) = w; }
    }
};
template <bool GATE, bool FINAL> struct EpiResid {
    static constexpr bool PERM = true, AFTER_DRAIN = false;
    float* X; bf16_t* XBo; float* SSo; float scale; const float* ss_in; const bf16_t* P;
    __device__ __forceinline__ void operator()(const f32x4 (&acc)[2][2][4][2], const Unit& u, int wr, int wc, int fr, int fq) const {
        const int row0 = u.pm * BM + wr * 64 + fr, col0 = u.pn * BM + wc * 32 + 8 * fq;
#pragma unroll
        for (int ai = 0; ai < 2; ++ai)
#pragma unroll
            for (int m = 0; m < 4; ++m) { const int row = row0 + ai * HALF + m * 16; float r = 0.f; if (GATE) r = rstd_of(ss_in, row, fq);
                float sq = 0.f;
#pragma unroll
                for (int bj = 0; bj < 2; ++bj) { float* xp = X + (size_t)row * D + col0 + bj * HALF;
                    f32x4 x0 = *(const f32x4*)xp, x1 = *(const f32x4*)(xp + 4); const f32x4 a0 = acc[ai][bj][m][0], a1 = acc[ai][bj][m][1];
                    if (GATE) { const u32x4 pw = *(const u32x4*)(P + (size_t)row * D + col0 + bj * HALF);
                        x0[0] += sigmoidf_(a0[0] * r) * bflo(pw.x); x0[1] += sigmoidf_(a0[1] * r) * bfhi(pw.x); x0[2] += sigmoidf_(a0[2] * r) * bflo(pw.y); x0[3] += sigmoidf_(a0[3] * r) * bfhi(pw.y);
                        x1[0] += sigmoidf_(a1[0] * r) * bflo(pw.z); x1[1] += sigmoidf_(a1[1] * r) * bfhi(pw.z); x1[2] += sigmoidf_(a1[2] * r) * bflo(pw.w); x1[3] += sigmoidf_(a1[3] * r) * bfhi(pw.w);
                    } else { x0 += a0 * scale; x1 += a1 * scale; }
                    *(f32x4*)xp = x0; *(f32x4*)(xp + 4) = x1;
                    if (!FINAL) { u32x4 w; w.x = pk2(x0[0], x0[1]); w.y = pk2(x0[2], x0[3]); w.z = pk2(x1[0], x1[1]); w.w = pk2(x1[2], x1[3]);
                        *(u32x4*)(XBo + (size_t)row * D + col0 + bj * HALF) = w;
                        sq += (x0[0] * x0[0] + x0[1] * x0[1]) + (x0[2] * x0[2] + x0[3] * x0[3]) + (x1[0] * x1[0] + x1[1] * x1[1]) + (x1[2] * x1[2] + x1[3] * x1[3]); } }
                if (!FINAL) { sq += __shfl_xor(sq, 16); sq += __shfl_xor(sq, 32); if (fq == 0) SSo[(size_t)row * 16 + u.pn * 4 + wc] = sq; } }
    }
};
}
typedef pg8::StaticOrder GOrder;

#define XB_TMO      128
#define XB_XCNT(j)  (256  + 64 * (j))
#define XB_XSUB(j)  (1280 + 64 * (j))
#define XB_XGEN(j)  (2304 + 64 * (j))
#define XB_TOP      3328
#define XB_TOPGEN   3392
#define XCD_BAR_WORDS 3456
#define XB_SPIN_CAP (1u << 18)

__device__ __forceinline__ unsigned xb_ld(unsigned* p)              { return __hip_atomic_load(p, __ATOMIC_RELAXED, __HIP_MEMORY_SCOPE_AGENT); }
__device__ __forceinline__ unsigned xb_add(unsigned* p, unsigned v) { return __hip_atomic_fetch_add(p, v, __ATOMIC_RELAXED, __HIP_MEMORY_SCOPE_AGENT); }
__device__ __forceinline__ unsigned xb_xcc_id() { return (unsigned)__builtin_amdgcn_s_getreg((3 << 11) | 20) & 0xFu; }
#define XB_SPIN(cond, bar) do { unsigned _sp = 0; while (cond) { __builtin_amdgcn_s_sleep(1); \
    if ((++_sp & 255u) == 0u) { if (xb_ld(&(bar)[XB_TMO])) break; if (_sp > XB_SPIN_CAP) { atomicAdd(&(bar)[XB_TMO], 1u); break; } } } } while (0)

struct XcdBarrier {
    unsigned* bar; unsigned x;
    volatile LAS unsigned* st;
};

__device__ __forceinline__ XcdBarrier xcd_barrier_post(unsigned* bar, volatile LAS unsigned* st) {
    XcdBarrier b; b.bar = bar; b.x = xb_xcc_id(); b.st = st;
    if (threadIdx.x == 0) (void)xb_add(&bar[XB_XCNT(b.x)], 1u);
    return b;
}
__device__ __forceinline__ void xcd_barrier_complete(unsigned* bar, unsigned x, unsigned& nloc, unsigned& nx) {
    const unsigned G = gridDim.x * gridDim.y * gridDim.z;
    unsigned sum, cnt, mine, sp = 0u;
    for (;;) {
        sum = 0u; cnt = 0u; mine = 0u;
#pragma unroll
        for (unsigned j = 0; j < 16; ++j) { const unsigned c = xb_ld(&bar[XB_XCNT(j)]); sum += c; cnt += (c > 0u) ? 1u : 0u; mine = (j == x) ? c : mine; }
        if (sum == G) break;
        __builtin_amdgcn_s_sleep(1);
        if ((++sp & 255u) == 0u) { if (xb_ld(&bar[XB_TMO])) break; if (sp > XB_SPIN_CAP) { atomicAdd(&bar[XB_TMO], 1u); break; } }
    }
    nloc = mine > 0u ? mine : 1u; nx = cnt > 0u ? cnt : 1u;
}

__device__ __forceinline__ void xcd_barrier(const XcdBarrier& b) {
    asm volatile("s_waitcnt vmcnt(0)" ::: "memory");
    __syncthreads();
    if (threadIdx.x == 0) {
        unsigned* bar = b.bar;
        __builtin_amdgcn_s_waitcnt(0);
        unsigned nloc = b.st[0], nx = b.st[1];
        if (nloc == 0u) { xcd_barrier_complete(bar, b.x, nloc, nx); b.st[0] = nloc; b.st[1] = nx; }
        const unsigned old = xb_add(&bar[XB_XSUB(b.x)], 1u);
        const unsigned gen = old / nloc;
        if (old + 1u == (gen + 1u) * nloc) {
            __builtin_amdgcn_fence(__ATOMIC_RELEASE, "agent");
            asm volatile("s_waitcnt vmcnt(0)" ::: "memory");
            const unsigned og = xb_add(&bar[XB_TOP], 1u);
            const unsigned tg = og / nx;
            if (og + 1u == (tg + 1u) * nx) xb_add(&bar[XB_TOPGEN], 1u);
            else XB_SPIN(xb_ld(&bar[XB_TOPGEN]) == tg, bar);
            __builtin_amdgcn_fence(__ATOMIC_ACQUIRE, "agent");
            xb_add(&bar[XB_XGEN(b.x)], 1u);
            asm volatile("s_waitcnt vmcnt(0)" ::: "memory");
        } else {
            XB_SPIN(xb_ld(&bar[XB_XGEN(b.x)]) == gen, bar);
            __builtin_amdgcn_fence(__ATOMIC_ACQUIRE, "agent");
            asm volatile("s_waitcnt vmcnt(0)" ::: "memory");
        }
    }
    __syncthreads();
}

__device__ __forceinline__ float wave_sum(float v) {
#pragma unroll
    for (int o = 1; o < 64; o <<= 1) v += __shfl_xor(v, o);
    return v;
}
__device__ __forceinline__ void st_bf16x8(bf16* p, const float* v) { v4u w; w.x = pk2(v[0], v[1]); w.y = pk2(v[2], v[3]); w.z = pk2(v[4], v[5]); w.w = pk2(v[6], v[7]); *(v4u*)p = w; }
__device__ __forceinline__ void ld_bf16x8(const bf16* p, float* v) { const v4u w = *(const v4u*)p; v[0] = bflo(w.x); v[1] = bfhi(w.x); v[2] = bflo(w.y); v[3] = bfhi(w.y); v[4] = bflo(w.z); v[5] = bfhi(w.z); v[6] = bflo(w.w); v[7] = bfhi(w.w); }

template <int MODE> __device__ __forceinline__ int sk_brow(int cu, int j) {
    if (MODE == 0) return cu * 64 + j;
    const int T = cu >> 2, q = cu & 3; return T * 256 + q * 32 + (j & 31) + ((j >> 5) ? 128 : 0);
}
template <int MODE, class Epi>
__device__ __forceinline__ void skinny_phase(LAS unsigned char* lds, const bf16* A, const bf16* Bt, int K, int ncu, const Epi& E, int vcu, int G) {
    int tid_ = threadIdx.x; asm volatile("" : "+v"(tid_));
    const int tid = tid_, wave = __builtin_amdgcn_readfirstlane(tid >> 6), lane = tid & 63, fr = lane & 15, fq = lane >> 4;
    LAS float* part = (LAS float*)lds;
    LAS float* tile = (LAS float*)(lds + 65536);
    const int kw = K >> 3, k0 = wave * kw, nst = kw >> 5;
    for (int un = G - 1 - vcu; un < 4 * ncu; un += G) {
        const int rb = un & 3, cu = un >> 2;
        f32x4 acc[2][4];
#pragma unroll
        for (int i = 0; i < 2; ++i)
#pragma unroll
            for (int c = 0; c < 4; ++c) acc[i][c] = (f32x4){0.f, 0.f, 0.f, 0.f};
        const bf16* ap = A + (size_t)(rb * 32 + fr) * K + k0 + 8 * fq;
        const bf16* bp0 = Bt + (size_t)sk_brow<MODE>(cu, fr) * K + k0 + 8 * fq;
        const bf16* bp1 = Bt + (size_t)sk_brow<MODE>(cu, 16 + fr) * K + k0 + 8 * fq;
        const bf16* bp2 = Bt + (size_t)sk_brow<MODE>(cu, 32 + fr) * K + k0 + 8 * fq;
        const bf16* bp3 = Bt + (size_t)sk_brow<MODE>(cu, 48 + fr) * K + k0 + 8 * fq;
#pragma unroll 2
        for (int s = 0; s < nst; ++s) {
            const bf16x8 a0 = *(const bf16x8*)(ap + 32 * s), a1 = *(const bf16x8*)(ap + (size_t)16 * K + 32 * s);
            const bf16x8 b0 = *(const bf16x8*)(bp0 + 32 * s), b1 = *(const bf16x8*)(bp1 + 32 * s), b2 = *(const bf16x8*)(bp2 + 32 * s), b3 = *(const bf16x8*)(bp3 + 32 * s);
            acc[0][0] = __builtin_amdgcn_mfma_f32_16x16x32_bf16(a0, b0, acc[0][0], 0, 0, 0); acc[1][0] = __builtin_amdgcn_mfma_f32_16x16x32_bf16(a1, b0, acc[1][0], 0, 0, 0);
            acc[0][1] = __builtin_amdgcn_mfma_f32_16x16x32_bf16(a0, b1, acc[0][1], 0, 0, 0); acc[1][1] = __builtin_amdgcn_mfma_f32_16x16x32_bf16(a1, b1, acc[1][1], 0, 0, 0);
            acc[0][2] = __builtin_amdgcn_mfma_f32_16x16x32_bf16(a0, b2, acc[0][2], 0, 0, 0); acc[1][2] = __builtin_amdgcn_mfma_f32_16x16x32_bf16(a1, b2, acc[1][2], 0, 0, 0);
            acc[0][3] = __builtin_amdgcn_mfma_f32_16x16x32_bf16(a0, b3, acc[0][3], 0, 0, 0); acc[1][3] = __builtin_amdgcn_mfma_f32_16x16x32_bf16(a1, b3, acc[1][3], 0, 0, 0);
        }
#pragma unroll
        for (int i = 0; i < 2; ++i)
#pragma unroll
            for (int c = 0; c < 4; ++c)
#pragma unroll
                for (int r = 0; r < 4; ++r) part[wave * 2048 + (i * 16 + 4 * fq + r) * 64 + c * 16 + fr] = acc[i][c][r];
        __syncthreads();
        { const int row = tid >> 4, cg = tid & 15; f32x4 s = (f32x4){0.f, 0.f, 0.f, 0.f};
#pragma unroll
          for (int w = 0; w < 8; ++w) s += *(const LAS f32x4*)(part + w * 2048 + row * 64 + 4 * cg);
          *(LAS f32x4*)(tile + row * 64 + 4 * cg) = s; }
        __syncthreads();
        E(tile, rb, cu, tid);
        __syncthreads();
    }
}
__device__ __forceinline__ float sk_rstd(const float* ss, int grow, int cg) {
    float s = ss[(size_t)grow * 16 + cg];
    s += __shfl_xor(s, 1); s += __shfl_xor(s, 2); s += __shfl_xor(s, 4); s += __shfl_xor(s, 8);
    return __builtin_amdgcn_rsqf(s * (1.f / 1024.f) + 1e-6f);
}
template <bool NORM> struct SkRaw { bf16* O; int ldc; const float* ss;
    __device__ __forceinline__ void operator()(const LAS float* tile, int rb, int cu, int tid) const {
        const int row = tid >> 4, cg = tid & 15, grow = MP + rb * 32 + row; const float r = NORM ? sk_rstd(ss, grow, cg) : 1.f;
        const f32x4 v = *(const LAS f32x4*)(tile + row * 64 + 4 * cg) * r; const int col = cu * 64 + 4 * cg;
        if (col < ldc) { v2u w; w.x = pk2(v[0], v[1]); w.y = pk2(v[2], v[3]); *(v2u*)(O + (size_t)grow * ldc + col) = w; }
    } };
struct SkSwiglu { bf16* H; const float* ss;
    __device__ __forceinline__ void operator()(const LAS float* tile, int rb, int cu, int tid) const {
        const int row = tid >> 4, cg = tid & 15, grow = MP + rb * 32 + row; const float r = sk_rstd(ss, grow, cg);
        if (cg < 8) { const f32x4 g = *(const LAS f32x4*)(tile + row * 64 + 4 * cg) * r, u = *(const LAS f32x4*)(tile + row * 64 + 32 + 4 * cg) * r;
            float h[4];
#pragma unroll
            for (int e = 0; e < 4; ++e) h[e] = g[e] * sigmoidf_(g[e]) * u[e];
            v2u w; w.x = pk2(h[0], h[1]); w.y = pk2(h[2], h[3]); *(v2u*)(H + (size_t)grow * FF + cu * 32 + 4 * cg) = w; }
    } };
template <bool GATE> struct SkResid { float* X; bf16* XBo; float* SSo; float scale; const float* ss_in; const bf16* P; int fin;
    __device__ __forceinline__ void operator()(const LAS float* tile, int rb, int cu, int tid) const {
        const int row = tid >> 4, cg = tid & 15, grow = MP + rb * 32 + row, col = cu * 64 + 4 * cg; float r = 0.f; if (GATE) r = sk_rstd(ss_in, grow, cg);
        const f32x4 a = *(const LAS f32x4*)(tile + row * 64 + 4 * cg); float* xp = X + (size_t)grow * D + col; f32x4 x = *(const f32x4*)xp;
        if (GATE) { const v2u pw = *(const v2u*)(P + (size_t)grow * D + col);
            x[0] += sigmoidf_(a[0] * r) * bflo(pw.x); x[1] += sigmoidf_(a[1] * r) * bfhi(pw.x); x[2] += sigmoidf_(a[2] * r) * bflo(pw.y); x[3] += sigmoidf_(a[3] * r) * bfhi(pw.y);
        } else x += a * scale;
        *(f32x4*)xp = x;
        float sq = (x[0] * x[0] + x[1] * x[1]) + (x[2] * x[2] + x[3] * x[3]);
        sq += __shfl_xor(sq, 1); sq += __shfl_xor(sq, 2); sq += __shfl_xor(sq, 4); sq += __shfl_xor(sq, 8);
        if (!fin) { v2u w; w.x = pk2(x[0], x[1]); w.y = pk2(x[2], x[3]); *(v2u*)(XBo + (size_t)grow * D + col) = w; if (cg == 0) SSo[(size_t)grow * 16 + cu] = sq; }
    } };

__device__ __forceinline__ void transpose_item(const float* W, int K, int N, int Nd, bf16* WT, const float* gain, int mode, LAS float* scr, int item, int lane) {
    const int nblk = Nd / 32, kb = item / nblk, nb = item % nblk, k0 = 64 * kb, n0 = 32 * nb;
    const int n4 = 4 * (lane & 7), n = n0 + n4;
#pragma unroll
    for (int i = 0; i < 8; ++i) { const int kk = 8 * i + (lane >> 3); f32x4 v = (f32x4){0.f, 0.f, 0.f, 0.f}; if (n < N) v = *(const f32x4*)(W + (size_t)(k0 + kk) * N + n); if (gain) v *= gain[k0 + kk];
        scr[kk * 33 + n4] = v[0]; scr[kk * 33 + n4 + 1] = v[1]; scr[kk * 33 + n4 + 2] = v[2]; scr[kk * 33 + n4 + 3] = v[3]; }
    LDS_WAIT(); asm volatile("" ::: "memory");
    const int c = lane & 7;
#pragma unroll
    for (int j = 0; j < 4; ++j) { const int nl = (lane >> 3) + 8 * j, nn = n0 + nl; const LAS float* s = scr + (8 * c) * 33 + nl;
        int drow = nn; if (mode == 1) { const int jj = nn < FF ? nn : nn - FF; drow = (jj >> 7) * 256 + (jj & 127) + (nn < FF ? 0 : 128); }
        v4u o; o.x = pk2(s[0 * 33], s[1 * 33]); o.y = pk2(s[2 * 33], s[3 * 33]); o.z = pk2(s[4 * 33], s[5 * 33]); o.w = pk2(s[6 * 33], s[7 * 33]);
        *(GAS v4u*)(WT + (size_t)drow * K + k0 + 8 * c) = o; }
    LDS_WAIT(); asm volatile("" ::: "memory");
}
struct In {
    const float *x_prompt, *x_sample, *state_conv, *ck_cmp, *cv_cmp, *ck_sel, *cv_sel, *ck_win, *cv_win; const int* page_table; const float *p_prompt, *p_sample, *norm_g, *w_gu, *w_down,
        *w_proj, *w_gate, *cw_in, *cw, *cw_out, *nw_in, *qk_g, *cmp_pos, *cmp_w1, *cmp_w2, *nw_out;
};
__device__ __forceinline__ void sincos_d(double r, float& s, float& c) {
    const double r2 = r * r;
    double sp = 1.0, cp = 1.0;
#pragma unroll
    for (int k = 12; k >= 1; --k) { sp = 1.0 - sp * r2 / (double)((2 * k) * (2 * k + 1)); cp = 1.0 - cp * r2 / (double)((2 * k - 1) * (2 * k)); }
    s = (float)(r * sp); c = (float)cp;
}
__device__ __forceinline__ void p0_prologue(const In& I, float* out, unsigned char* ws, LAS unsigned char* lds, int vcu, int G, int wave, int lane) {
    LAS float* scr = (LAS float*)(lds + wave * 16384);
    const int gw = vcu * NWAVES + wave, NGW = G * NWAVES;
    constexpr int I_GU = (D / 64) * (NGU / 32), I_DN = (FF / 64) * (D / 32), I_SQ = (D / 64) * (D / 32), I_PR = (PLE / 64) * (D / 32), I_CI = (D / 64) * (NCV / 32), I_NI = (D / 64) * (NNSP / 32),
                  I_W1 = (4096 / 64) * (128 / 32), I_W2 = (128 / 64) * (64 / 32);
    constexpr int NITEMS = 4 * I_GU + 4 * I_DN + 2 * I_SQ + 2 * I_PR + I_CI + I_SQ + I_NI + I_SQ + 2 * I_W1 + 2 * I_W2;
#define TR(W_, K_, N_, ND_, WT_, G_, MODE_, NI_) if (r < (NI_)) { transpose_item(W_, K_, N_, ND_, WT_, G_, MODE_, scr, r, lane); continue; } r -= (NI_);
    for (int it = gw; it < NITEMS; it += NGW) {
        int r = it;
        TR(I.w_gu + (size_t)0 * D * NGU, D, NGU, NGU, (bf16*)(ws + WS_WGU + 0 * SZ_WGU), I.norm_g + 0 * D, 1, I_GU)
        TR(I.w_gu + (size_t)1 * D * NGU, D, NGU, NGU, (bf16*)(ws + WS_WGU + 1 * SZ_WGU), I.norm_g + 2 * D, 1, I_GU)
        TR(I.w_gu + (size_t)2 * D * NGU, D, NGU, NGU, (bf16*)(ws + WS_WGU + 2 * SZ_WGU), I.norm_g + 4 * D, 1, I_GU)
        TR(I.w_gu + (size_t)3 * D * NGU, D, NGU, NGU, (bf16*)(ws + WS_WGU + 3 * SZ_WGU), I.norm_g + 6 * D, 1, I_GU)
        TR(I.w_down + (size_t)0 * FF * D, FF, D, D, (bf16*)(ws + WS_WDN + 0 * SZ_WDN), nullptr, 0, I_DN)
        TR(I.w_down + (size_t)1 * FF * D, FF, D, D, (bf16*)(ws + WS_WDN + 1 * SZ_WDN), nullptr, 0, I_DN)
        TR(I.w_down + (size_t)2 * FF * D, FF, D, D, (bf16*)(ws + WS_WDN + 2 * SZ_WDN), nullptr, 0, I_DN)
        TR(I.w_down + (size_t)3 * FF * D, FF, D, D, (bf16*)(ws + WS_WDN + 3 * SZ_WDN), nullptr, 0, I_DN)
        TR(I.w_gate + (size_t)0 * D * D, D, D, D, (bf16*)(ws + WS_WGATE + 0 * SZ_WSQ), I.norm_g + 3 * D, 0, I_SQ)
        TR(I.w_gate + (size_t)1 * D * D, D, D, D, (bf16*)(ws + WS_WGATE + 1 * SZ_WSQ), I.norm_g + 7 * D, 0, I_SQ)
        TR(I.w_proj + (size_t)0 * PLE * D, PLE, D, D, (bf16*)(ws + WS_WPROJ + 0 * SZ_WPROJ), nullptr, 0, I_PR)
        TR(I.w_proj + (size_t)1 * PLE * D, PLE, D, D, (bf16*)(ws + WS_WPROJ + 1 * SZ_WPROJ), nullptr, 0, I_PR)
        TR(I.cw_in, D, NCV, NCV, (bf16*)(ws + WS_WCIN), I.norm_g + 1 * D, 0, I_CI)
        TR(I.cw_out, D, D, D, (bf16*)(ws + WS_WCOUT), nullptr, 0, I_SQ)
        TR(I.nw_in, D, NNS, NNSP, (bf16*)(ws + WS_WNIN), I.norm_g + 5 * D, 0, I_NI)
        TR(I.nw_out, D, D, D, (bf16*)(ws + WS_WNOUT), nullptr, 0, I_SQ)
        TR(I.cmp_w1 + (size_t)0 * 4096 * 128, 4096, 128, 128, (bf16*)(ws + WS_W1T) + (size_t)0 * 128 * 4096, nullptr, 0, I_W1)
        TR(I.cmp_w1 + (size_t)1 * 4096 * 128, 4096, 128, 128, (bf16*)(ws + WS_W1T) + (size_t)1 * 128 * 4096, nullptr, 0, I_W1)
        TR(I.cmp_w2 + (size_t)0 * 128 * 64, 128, 64, 64, (bf16*)(ws + WS_W2T) + (size_t)0 * 64 * 128, nullptr, 0, I_W2)
        TR(I.cmp_w2 + (size_t)1 * 128 * 64, 128, 64, 64, (bf16*)(ws + WS_W2T) + (size_t)1 * 64 * 128, nullptr, 0, I_W2)
    }
#undef TR
    bf16* XB0 = (bf16*)(ws + WS_XB); float* SS0 = (float*)(ws + WS_SS);
    for (int m = gw; m < MT; m += NGW) {
        const float* src = m < MP ? I.x_prompt + (size_t)m * D : I.x_sample + (size_t)(m - MP) * D;
        const GAS f32x4* xr = (const GAS f32x4*)src + lane; GAS f32x4* xo = (GAS f32x4*)(out + (size_t)m * D) + lane;
        GAS v2u* o8 = (GAS v2u*)(XB0 + (size_t)m * D) + lane; float s = 0.f;
#pragma unroll
        for (int j = 0; j < 4; ++j) { const f32x4 v = xr[64 * j]; xo[64 * j] = v; s += (v[0] * v[0] + v[1] * v[1]) + (v[2] * v[2] + v[3] * v[3]); v2u w; w.x = pk2(v[0], v[1]); w.y = pk2(v[2], v[3]); o8[64 * j] = w; }
        s = wave_sum(s);
        if (lane < 16) SS0[(size_t)m * 16 + lane] = lane == 0 ? s : 0.f;
    }
    bf16* PB = (bf16*)(ws + WS_PB);
    for (int r = gw; r < 2 * MT; r += NGW) { const int l = r / MT, m = r % MT;
        const float* src = m < MP ? I.p_prompt + ((size_t)l * MP + m) * PLE : I.p_sample + ((size_t)l * MS + (m - MP)) * PLE;
        const f32x4 v = ((const GAS f32x4*)src)[lane]; v2u w; w.x = pk2(v[0], v[1]); w.y = pk2(v[2], v[3]); ((GAS v2u*)(PB + (size_t)r * PLE))[lane] = w; }
    float* ROPE = (float*)(ws + WS_ROPE);
    for (int i = gw * 64 + lane; i < 8196 * 32; i += NGW * 64) { const int pos = i >> 5, d = i & 31;
        const float inv = (float)exp2(-(double)d * (13.287712379549449 / 32.0));
        const float ang = (float)pos * inv; const double a = (double)ang, k = rint(a * 0.15915494309189535), rr = a - k * 6.283185307179586;
        float s, c; sincos_d(rr, s, c); ROPE[(size_t)pos * 64 + d] = c; ROPE[(size_t)pos * 64 + 32 + d] = s; }
}

__device__ __forceinline__ void conv_post(const In& I, float* out, unsigned char* ws, int vcu, int G, int wave, int lane) {
    const bf16* CV = (const bf16*)(ws + WS_H); bf16* AC = (bf16*)(ws + WS_AC);
    const int gw = vcu * NWAVES + wave, NGW = G * NWAVES;
    constexpr int NSTRIP_P = MP / 16, NITEM = (NSTRIP_P + SB) * 2;
    for (int it = gw; it < NITEM; it += NGW) {
        const int half = it & 1, st = it >> 1, ch = half * 512 + lane * 8;
        float w0[8], w1[8], w2[8], um2[8], um1[8];
#pragma unroll
        for (int e = 0; e < 8; ++e) { w0[e] = I.cw[ch + e]; w1[e] = I.cw[D + ch + e]; w2[e] = I.cw[2 * D + ch + e]; um2[e] = 0.f; um1[e] = 0.f; }
        int row0, nrow; const bool samp = st >= NSTRIP_P;
        if (!samp) { row0 = st * 16; nrow = 16;
            if ((row0 & (SEQ - 1)) != 0) { float c[8], v[8];
                ld_bf16x8(CV + (size_t)(row0 - 2) * NCV + D + ch, c); ld_bf16x8(CV + (size_t)(row0 - 2) * NCV + 2 * D + ch, v);
#pragma unroll
                for (int e = 0; e < 8; ++e) um2[e] = c[e] * v[e];
                ld_bf16x8(CV + (size_t)(row0 - 1) * NCV + D + ch, c); ld_bf16x8(CV + (size_t)(row0 - 1) * NCV + 2 * D + ch, v);
#pragma unroll
                for (int e = 0; e < 8; ++e) um1[e] = c[e] * v[e]; }
        } else { const int bs = st - NSTRIP_P; row0 = MP + bs * 4; nrow = 4;
#pragma unroll
            for (int e = 0; e < 8; ++e) { um2[e] = I.state_conv[((size_t)bs * 2 + 0) * D + ch + e]; um1[e] = I.state_conv[((size_t)bs * 2 + 1) * D + ch + e]; } }
        for (int i = 0; i < nrow; ++i) { const int row = row0 + i; float b[8], c[8], v[8], o[8], u[8];
            ld_bf16x8(CV + (size_t)row * NCV + ch, b); ld_bf16x8(CV + (size_t)row * NCV + D + ch, c); ld_bf16x8(CV + (size_t)row * NCV + 2 * D + ch, v);
#pragma unroll
            for (int e = 0; e < 8; ++e) { u[e] = c[e] * v[e]; o[e] = b[e] * (w0[e] * um2[e] + w1[e] * um1[e] + w2[e] * u[e]); um2[e] = um1[e]; um1[e] = u[e]; }
            st_bf16x8(AC + (size_t)row * D + ch, o);
            float* so = nullptr;
            if (!samp) { const int t = row & (SEQ - 1); if (t >= SEQ - 2) so = out + O_CONVP + ((size_t)(row >> 13) * 2 + (t - (SEQ - 2))) * D + ch; }
            else if (i >= 2) so = out + O_CONVS + ((size_t)(st - NSTRIP_P) * 2 + (i - 2)) * D + ch;
            if (so) { *(f32x4*)so = (f32x4){u[0], u[1], u[2], u[3]}; *(f32x4*)(so + 4) = (f32x4){u[4], u[5], u[6], u[7]}; } }
    }
}

__device__ __forceinline__ void nsa_post(const In& I, float* out, unsigned char* ws, int vcu, int G, int wave, int lane) {
    const bf16* RAW = (const bf16*)(ws + WS_H); const float* ROPE = (const float*)(ws + WS_ROPE);
    bf16* QN = (bf16*)(ws + WS_QN); bf16* QR = (bf16*)(ws + WS_QR); bf16* KS = (bf16*)(ws + WS_KS); bf16* VS = (bf16*)(ws + WS_VS); bf16* KW = (bf16*)(ws + WS_KW); bf16* VW = (bf16*)(ws + WS_VW);
    float* GATES = (float*)(ws + WS_GATES);
    const int gw = vcu * NWAVES + wave, NGW = G * NWAVES, qd = lane >> 2, p = lane & 3;
    for (int row = gw; row < MT; row += NGW) {
        const bool samp = row >= MP; const int sr = row - MP; const int pos = samp ? PAST + (sr & 3) : (row & (SEQ - 1));
        float cs[8], sn[8];
        { const f32x4 c0 = *(const f32x4*)(ROPE + (size_t)pos * 64 + 8 * p), c1 = *(const f32x4*)(ROPE + (size_t)pos * 64 + 8 * p + 4), s0 = *(const f32x4*)(ROPE + (size_t)pos * 64 + 32 + 8 * p), s1 = *(const f32x4*)(ROPE + (size_t)pos * 64 + 36 + 8 * p);
#pragma unroll
          for (int e = 0; e < 4; ++e) { cs[e] = c0[e]; cs[4 + e] = c1[e]; sn[e] = s0[e]; sn[4 + e] = s1[e]; } }
#pragma unroll
        for (int pass = 0; pass < 3; ++pass) { const int sg = qd + 16 * pass;
            if (sg < 40) {
                float x1[8], x2[8];
                ld_bf16x8(RAW + (size_t)row * NNSP + 64 * sg + 8 * p, x1); ld_bf16x8(RAW + (size_t)row * NNSP + 64 * sg + 32 + 8 * p, x2);
                const int typ = sg < 16 ? 0 : 1 + ((sg - 16) >> 2), g4 = sg & 3;
                const bool nrm = (typ == 0 || typ == 3 || typ == 5);
                if (nrm) { const int gi = typ == 0 ? 0 : (typ == 3 ? 2 : 3); float ssq = 0.f;
#pragma unroll
                    for (int e = 0; e < 8; ++e) ssq += x1[e] * x1[e] + x2[e] * x2[e];
                    ssq += __shfl_xor(ssq, 1); ssq += __shfl_xor(ssq, 2);
                    const float rs = __builtin_amdgcn_rsqf(ssq * (1.f / 64.f) + RMS_EPS);
#pragma unroll
                    for (int e = 0; e < 8; ++e) { x1[e] *= rs * I.qk_g[gi * 64 + 8 * p + e]; x2[e] *= rs * I.qk_g[gi * 64 + 32 + 8 * p + e]; } }
                float y1[8], y2[8];
#pragma unroll
                for (int e = 0; e < 8; ++e) { y1[e] = x1[e] * cs[e] - x2[e] * sn[e]; y2[e] = x2[e] * cs[e] + x1[e] * sn[e]; }
                if (typ == 0) { float a[8], b[8];
#pragma unroll
                    for (int e = 0; e < 8; ++e) { a[e] = x1[e] * QSCALE; b[e] = x2[e] * QSCALE; }
                    st_bf16x8(QN + (size_t)row * D + 64 * sg + 8 * p, a); st_bf16x8(QN + (size_t)row * D + 64 * sg + 32 + 8 * p, b);
#pragma unroll
                    for (int e = 0; e < 8; ++e) { a[e] = y1[e] * QSCALE; b[e] = y2[e] * QSCALE; }
                    st_bf16x8(QR + (size_t)row * D + 64 * sg + 8 * p, a); st_bf16x8(QR + (size_t)row * D + 64 * sg + 32 + 8 * p, b);
                } else {
                    const bool rope = (typ == 3 || typ == 5);
                    float o1[8], o2[8];
#pragma unroll
                    for (int e = 0; e < 8; ++e) { o1[e] = rope ? y1[e] : x1[e]; o2[e] = rope ? y2[e] : x2[e]; }
                    float* fo = nullptr; bf16* bo = nullptr; const size_t co = (size_t)g4 * 64 + 8 * p;
                    if (typ <= 4) { const size_t base = samp ? (typ == 1 ? O_KCS : typ == 2 ? O_VCS : typ == 3 ? O_KSS : O_VSS) + (size_t)sr * KVW : (typ == 1 ? O_KCP : typ == 2 ? O_VCP : typ == 3 ? O_KSP : O_VSP) + (size_t)row * KVW;
                        fo = out + base + co; if (typ == 3) bo = KS + (size_t)row * KVW + co; if (typ == 4) bo = VS + (size_t)row * KVW + co;
                    } else { bo = (typ == 5 ? KW : VW) + (size_t)row * KVW + co;
                        if (samp) fo = out + (typ == 5 ? O_KWS : O_VWS) + ((size_t)(sr >> 2) * 512 + 508 + (sr & 3)) * KVW + co;
                        else { const int t = row & (SEQ - 1); if (t >= SEQ - WIN) fo = out + (typ == 5 ? O_KWP : O_VWP) + ((size_t)(row >> 13) * 512 + (t - (SEQ - WIN))) * KVW + co; } }
                    if (fo) { *(f32x4*)fo = (f32x4){o1[0], o1[1], o1[2], o1[3]}; *(f32x4*)(fo + 4) = (f32x4){o1[4], o1[5], o1[6], o1[7]};
                              *(f32x4*)(fo + 32) = (f32x4){o2[0], o2[1], o2[2], o2[3]}; *(f32x4*)(fo + 36) = (f32x4){o2[4], o2[5], o2[6], o2[7]}; }
                    if (bo) { st_bf16x8(bo, o1); st_bf16x8(bo + 32, o2); }
                }
            }
        }
        if (lane < 48) { const unsigned short rv = RAW[(size_t)row * NNSP + 2560 + lane]; GATES[(size_t)row * 48 + lane] = sigmoidf_(__uint_as_float((unsigned)rv << 16)); }
    }
    { const size_t n4 = (size_t)SB * 508 * 64; const size_t gt = (size_t)(vcu * NWAVES + wave) * 64 + lane, NT = (size_t)NGW * 64;
      for (size_t i = gt; i < 2 * n4; i += NT) { const int kv = i >= n4; const size_t j = kv ? i - n4 : i; const size_t bs = j / (508 * 64), rem = j % (508 * 64);
          const f32x4 v = ((const GAS f32x4*)(kv ? I.cv_win : I.ck_win))[bs * 512 * 64 + 4 * 64 + rem];
          ((GAS f32x4*)(out + (kv ? O_VWS : O_KWS)))[bs * 512 * 64 + rem] = v; } }
}

__device__ __forceinline__ void glds16(const void* gsrc, unsigned lds_dst) { unsigned keep;
    asm volatile("s_mov_b32 %0, m0\n\ts_mov_b32 m0, %2\n\ts_nop 0\n\tglobal_load_lds_dwordx4 %1, off\n\ts_mov_b32 m0, %0" : "=&s"(keep) : "v"(gsrc), "s"(lds_dst) : "memory"); }
__device__ __forceinline__ unsigned lds_addr(const LAS unsigned char* p) { return (unsigned)(uintptr_t)p; }

constexpr int CMP_NA = 5, CMP_NB = 3, CMP_BOFF = CMP_NA * 16384, CMP_RED_OFF = LDSCTL_OFF + 1024;
static_assert(CMP_BOFF + CMP_NB * 16384 <= RING_BYTES, "compress LDS");
__device__ __forceinline__ void cmp_bias_partials(const In& I, unsigned char* ws, int vcu, int G, int wave, int lane) {
    float* PART = (float*)(ws + WS_CPART); const int gw = vcu * NWAVES + wave, NGW = G * NWAVES;
    for (int it = gw; it < 128; it += NGW) { const int kv = it >> 6, j = it & 63; float a0 = 0.f, a1 = 0.f;
        const float* pp = I.cmp_pos + ((size_t)kv * 64 + j) * 64; const float* wp = I.cmp_w1 + ((size_t)kv * 4096 + 64 * j) * 128;
#pragma unroll 8
        for (int d = 0; d < 64; ++d) { const float p = pp[d]; a0 += p * wp[d * 128 + lane]; a1 += p * wp[d * 128 + 64 + lane]; }
        PART[(size_t)it * 128 + lane] = a0; PART[(size_t)it * 128 + 64 + lane] = a1; }
}
__device__ __forceinline__ void cmp_bias_reduce(unsigned char* ws, int vcu, int tid) {
    if (vcu != 0 || tid >= 256) return;
    const float* PART = (const float*)(ws + WS_CPART); float* BIAS = (float*)(ws + WS_CBIAS); const int kv = tid >> 7, n = tid & 127; float a = 0.f;
    for (int j = 0; j < 64; ++j) a += PART[((size_t)kv * 64 + j) * 128 + n];
    BIAS[tid] = a;
}
struct CmpSrc { const float* kbase; const float* vbase; const int* page_table; int seq0, nseq; };
__device__ __forceinline__ const float* cmp_chunk_base(const CmpSrc& S, int kv, int cid) {
    const int sq = cid >> 7, nb = cid & 127; const float* base = kv ? S.vbase : S.kbase;
    if (S.page_table) { const int pg = S.page_table[sq * NPAGE + (nb >> 1)]; return base + ((size_t)pg * 128 + (nb & 1) * 64) * KVW; }
    return base + ((size_t)sq * SEQ + nb * 64) * KVW;
}
__device__ __forceinline__ void compress_phase(const In& I, unsigned char* ws, LAS unsigned char* lds, const CmpSrc& S, int vcu, int G) {
    int tid_ = threadIdx.x; asm volatile("" : "+v"(tid_));
    const int tid = tid_, wave = __builtin_amdgcn_readfirstlane(tid >> 6), lane = tid & 63, fr = lane & 15, fq = lane >> 4, wm = wave >> 2, wn = wave & 3;
    const int upk = S.nseq * 128 / 16, nunits = 2 * upk;
    int nmine = 0; for (int u = vcu; u < nunits; u += G) ++nmine;
    if (nmine == 0) return;
    const int total = nmine * 64;
    const bf16* W1T = (const bf16*)(ws + WS_W1T); const bf16* W2T = (const bf16*)(ws + WS_W2T); const float* BIAS = (const float*)(ws + WS_CBIAS);
    unsigned aoffs[2];
#pragma unroll
    for (int i = 0; i < 2; ++i) { const int c = 2 * wave + i, r = 4 * c + (lane >> 4); aoffs[i] = (unsigned)((lane >> 4) * 256 + (((lane & 15) ^ (r & 15)) * 16)); }
    unsigned boffs[2];
#pragma unroll
    for (int i = 0; i < 2; ++i) { int R, C; pg8::stage_rc(tid * 16 + i * 8192, R, C); boffs[i] = (unsigned)(R * 4096 + C) * 2u; }
#define CMP_ISSUE_A(gs_) do { const int ui_ = (gs_) >> 6, j_ = (gs_) & 63, u_ = vcu + ui_ * G, kv_ = u_ >= upk ? 1 : 0, ul_ = u_ - kv_ * upk; \
        LAS unsigned char* st_ = lds + ((gs_) % CMP_NA) * 16384; \
        if (j_ == 0) { cb0 = cmp_chunk_base(S, kv_, ul_ * 16 + 2 * wave); cb1 = cmp_chunk_base(S, kv_, ul_ * 16 + 2 * wave + 1); }     \
        glds16((const char*)cb0 + (size_t)j_ * 1024 + aoffs[0], lds_addr(st_ + (2 * wave) * 1024)); glds16((const char*)cb1 + (size_t)j_ * 1024 + aoffs[1], lds_addr(st_ + (2 * wave + 1) * 1024)); } while (0)
#define CMP_ISSUE_B(gs_) do { const int ui_ = (gs_) >> 6, j_ = (gs_) & 63, u_ = vcu + ui_ * G, kv_ = u_ >= upk ? 1 : 0; \
        LAS unsigned char* st_ = lds + CMP_BOFF + ((gs_) % CMP_NB) * 16384; const char* wb_ = (const char*)(W1T + (size_t)kv_ * 128 * 4096) + j_ * 128; \
        _Pragma("unroll") for (int i_ = 0; i_ < 2; ++i_) glds16(wb_ + boffs[i_], lds_addr(st_ + wave * 1024 + i_ * 8192)); } while (0)
    f32x4 acc[2][2];
#pragma unroll
    for (int a = 0; a < 2; ++a)
#pragma unroll
        for (int b = 0; b < 2; ++b) acc[a][b] = (f32x4){0.f, 0.f, 0.f, 0.f};
    const float* cb0 = nullptr; const float* cb1 = nullptr;
    CMP_ISSUE_A(0); CMP_ISSUE_A(1); CMP_ISSUE_B(0); CMP_ISSUE_A(2); CMP_ISSUE_B(1); CMP_ISSUE_A(3);
    for (int gs = 0; gs < total; ++gs) {
        if (gs + 3 < total) asm volatile("s_waitcnt vmcnt(4)" ::: "memory"); else if (gs + 1 < total) asm volatile("s_waitcnt vmcnt(2)" ::: "memory"); else asm volatile("s_waitcnt vmcnt(0)" ::: "memory");
        __builtin_amdgcn_s_barrier(); asm volatile("" ::: "memory");
        if (gs + 4 < total) CMP_ISSUE_A(gs + 4);
        if (gs + 2 < total) CMP_ISSUE_B(gs + 2);
        const LAS unsigned char* st = lds + (gs % CMP_NA) * 16384; const LAS unsigned char* stb = lds + CMP_BOFF + (gs % CMP_NB) * 16384;
#pragma unroll
        for (int ks = 0; ks < 2; ++ks) {
            bf16x8 xa[2], wb[2];
#pragma unroll
            for (int rb = 0; rb < 2; ++rb) { const int row = 32 * wm + 16 * rb + fr, ch = 8 * ks + 2 * fq;
                const f32x4 lo = *(const LAS f32x4*)(st + row * 256 + ((ch ^ (row & 15)) * 16)), hi = *(const LAS f32x4*)(st + row * 256 + (((ch + 1) ^ (row & 15)) * 16));
                v4u w; w.x = pk2(lo[0], lo[1]); w.y = pk2(lo[2], lo[3]); w.z = pk2(hi[0], hi[1]); w.w = pk2(hi[2], hi[3]); xa[rb] = __builtin_bit_cast(bf16x8, w); }
#pragma unroll
            for (int cb = 0; cb < 2; ++cb) wb[cb] = *(const LAS bf16x8*)(stb + pg8::lds_byte(32 * wn + 16 * cb + fr, 32 * ks + 8 * fq));
#pragma unroll
            for (int cb = 0; cb < 2; ++cb)
#pragma unroll
                for (int rb = 0; rb < 2; ++rb) acc[cb][rb] = __builtin_amdgcn_mfma_f32_16x16x32_bf16(wb[cb], xa[rb], acc[cb][rb], 0, 0, 0);
        }
        if ((gs & 63) == 63) {
            const int ui = gs >> 6, u = vcu + ui * G, kv = u >= upk ? 1 : 0, ul = u - kv * upk;
            LAS unsigned char* hid = lds + CMP_BOFF + (gs % CMP_NB) * 16384; LAS float* red = (LAS float*)(lds + CMP_RED_OFF);
            asm volatile("s_waitcnt lgkmcnt(0)" ::: "memory"); __builtin_amdgcn_s_barrier(); asm volatile("" ::: "memory");
#pragma unroll
            for (int cb = 0; cb < 2; ++cb) { const int n0 = 32 * wn + 16 * cb + 4 * fq; const f32x4 bv = *(const f32x4*)(BIAS + kv * 128 + n0);
#pragma unroll
                for (int rb = 0; rb < 2; ++rb) { const int row = 32 * wm + 16 * rb + fr; float h[4];
#pragma unroll
                    for (int e = 0; e < 4; ++e) { const float x = acc[cb][rb][e] + bv[e]; const float t = 0.7978845608028654f * (x + 0.044715f * x * x * x); h[e] = x * sigmoidf_(2.f * t); acc[cb][rb][e] = 0.f; }
                    v2u w; w.x = pk2(h[0], h[1]); w.y = pk2(h[2], h[3]);
                    *(LAS v2u*)(hid + row * 256 + (((n0 >> 3) ^ (row & 15)) * 16) + (n0 & 7) * 2) = w; } }
            asm volatile("s_waitcnt lgkmcnt(0)" ::: "memory"); __builtin_amdgcn_s_barrier(); asm volatile("" ::: "memory");
            const int rblk = wave >> 1, oh = wave & 1;
            f32x4 o2[2] = {(f32x4){0.f, 0.f, 0.f, 0.f}, (f32x4){0.f, 0.f, 0.f, 0.f}};
#pragma unroll
            for (int ks = 0; ks < 4; ++ks) { const int row = 16 * rblk + fr, ch = 4 * ks + fq;
                const bf16x8 hb = *(const LAS bf16x8*)(hid + row * 256 + ((ch ^ (row & 15)) * 16));
#pragma unroll
                for (int ob = 0; ob < 2; ++ob) { const bf16x8 wa = *(const bf16x8*)(W2T + ((size_t)kv * 64 + 32 * oh + 16 * ob + fr) * 128 + 32 * ks + 8 * fq);
                    o2[ob] = __builtin_amdgcn_mfma_f32_16x16x32_bf16(wa, hb, o2[ob], 0, 0, 0); } }
            float ssq = 0.f;
#pragma unroll
            for (int ob = 0; ob < 2; ++ob)
#pragma unroll
                for (int e = 0; e < 4; ++e) ssq += o2[ob][e] * o2[ob][e];
            ssq += __shfl_xor(ssq, 16); ssq += __shfl_xor(ssq, 32);
            if (fq == 0) red[(16 * rblk + fr) * 2 + oh] = ssq;
            asm volatile("s_waitcnt lgkmcnt(0)" ::: "memory"); __builtin_amdgcn_s_barrier(); asm volatile("" ::: "memory");
            const int trow = 16 * rblk + fr; const float tot = red[trow * 2] + red[trow * 2 + 1];
            const float rs = kv ? 1.f : __builtin_amdgcn_rsqf(tot * (1.f / 64.f) + RMS_EPS);
            const int cid = ul * 16 + (trow >> 2), g = trow & 3, sq = S.seq0 + (cid >> 7), nb = cid & 127;
            bf16* dst = (bf16*)(ws + (kv ? WS_VC : WS_KC)) + (((size_t)sq * 4 + g) * 128 + nb) * 64;
#pragma unroll
            for (int ob = 0; ob < 2; ++ob) { const int o0 = 32 * oh + 16 * ob + 4 * fq; float y[4];
#pragma unroll
                for (int e = 0; e < 4; ++e) y[e] = o2[ob][e] * rs * (kv ? 1.f : I.qk_g[64 + o0 + e]);
                v2u w; w.x = pk2(y[0], y[1]); w.y = pk2(y[2], y[3]); *(v2u*)(dst + o0) = w; }
        }
    }
    asm volatile("s_waitcnt vmcnt(0) lgkmcnt(0)" ::: "memory"); __builtin_amdgcn_s_barrier(); asm volatile("" ::: "memory");
}

constexpr int AT_IMP = 32768  , AT_OUTS = 65536, AT_SELM = LDSCTL_OFF + 1024;
constexpr int SAT_IMP = LDSCTL_OFF + 1024, SAT_SELM = SAT_IMP + 4 * 132 * 4;
static_assert(SAT_SELM + 4 * 8 * 4 <= LDS_BYTES && AT_SELM + 64 * 16 <= LDS_BYTES && AT_OUTS + 65536 <= RING_BYTES, "attention LDS");
__device__ __forceinline__ s16x4 tr16(const LAS unsigned char* p) { typedef short v4s __attribute__((ext_vector_type(4))); return __builtin_bit_cast(s16x4, __builtin_amdgcn_ds_read_tr16_b64_v4i16((LAS v4s*)p)); }
__device__ __forceinline__ unsigned dpp_max_u32(unsigned v) {
    v = max(v, (unsigned)__builtin_amdgcn_update_dpp(0, (int)v, 0xB1, 0xF, 0xF, true));
    v = max(v, (unsigned)__builtin_amdgcn_update_dpp(0, (int)v, 0x4E, 0xF, 0xF, true));
    v = max(v, (unsigned)__builtin_amdgcn_update_dpp(0, (int)v, 0x141, 0xF, 0xF, true));
    v = max(v, (unsigned)__builtin_amdgcn_update_dpp(0, (int)v, 0x140, 0xF, 0xF, true));
    const unsigned a = __builtin_amdgcn_readlane((int)v, 0), b = __builtin_amdgcn_readlane((int)v, 16), c = __builtin_amdgcn_readlane((int)v, 32), d = __builtin_amdgcn_readlane((int)v, 48);
    return max(max(a, b), max(c, d));
}
__device__ __forceinline__ void stage_block_dma(LAS unsigned char* dst, const bf16* src_row0, int pitch_bytes, int wave, int lane) {
    const int row = 8 * wave + (lane >> 3), chunk = (lane & 7) ^ (lane >> 3);
    glds16((const char*)src_row0 + (size_t)row * pitch_bytes + chunk * 16, lds_addr(dst + wave * 1024));
}
__device__ __forceinline__ void kfrags(bf16x8 (&kf)[4][2], const LAS unsigned char* kb, int fr, int fq) {
#pragma unroll
    for (int k = 0; k < 4; ++k)
#pragma unroll
        for (int ks = 0; ks < 2; ++ks) kf[k][ks] = *(const LAS bf16x8*)(kb + (16 * k + fr) * 128 + (((4 * ks + fq) ^ (fr & 7)) * 16));
}
__device__ __forceinline__ bf16x8 pack_p(const f32x4& a, const f32x4& b) { v4u w; w.x = pk2(a[0], a[1]); w.y = pk2(a[2], a[3]); w.z = pk2(b[0], b[1]); w.w = pk2(b[2], b[3]); return __builtin_bit_cast(bf16x8, w); }
template <bool do0, bool do1>
__device__ __forceinline__ void pv_block(const LAS unsigned char* vb, const bf16x8 (&p)[2][2], f32x4 (&o)[2][4], int fr, int fq) {
    const int q4 = fr >> 2, pp = fr & 3, kk = 4 * (fq & 1) + q4;
    const LAS unsigned char* vrow = vb + (4 * fq + q4) * 128 + (pp & 1) * 8;
#pragma unroll
    for (int db = 0; db < 4; ++db) { const int xo = (((2 * db + (pp >> 1)) ^ kk) * 16);
#pragma unroll
        for (int st = 0; st < 2; ++st) {
            const s16x4 lo4 = tr16(vrow + (32 * st) * 128 + xo), hi4 = tr16(vrow + (32 * st + 16) * 128 + xo);
            const bf16x8 vf = (bf16x8){lo4[0], lo4[1], lo4[2], lo4[3], hi4[0], hi4[1], hi4[2], hi4[3]};
            if (do0) o[0][db] = __builtin_amdgcn_mfma_f32_16x16x32_bf16(vf, p[0][st], o[0][db], 0, 0, 0);
            if (do1) o[1][db] = __builtin_amdgcn_mfma_f32_16x16x32_bf16(vf, p[1][st], o[1][db], 0, 0, 0); } }
}
template <bool EDGE, bool do0, bool do1>
__device__ __forceinline__ void attn_block_t(const LAS unsigned char* kb, const LAS unsigned char* vb, const bf16x8 (&q)[2][2], const float (&bias)[2], const int (&lo)[2], const int (&hi)[2],
                                           f32x4 (&o)[2][4], float (&l)[2], int fr, int fq) {
    bf16x8 kf[4][2]; kfrags(kf, kb, fr, fq);
    f32x4 sc[2][4];
#pragma unroll
    for (int s = 0; s < 2; ++s) if (s ? do1 : do0) {
#pragma unroll
        for (int k = 0; k < 4; ++k) sc[s][k] = __builtin_amdgcn_mfma_f32_16x16x32_bf16(kf[k][0], q[s][0], (f32x4){bias[s], bias[s], bias[s], bias[s]}, 0, 0, 0); }
#pragma unroll
    for (int s = 0; s < 2; ++s) if (s ? do1 : do0) {
#pragma unroll
        for (int k = 0; k < 4; ++k) sc[s][k] = __builtin_amdgcn_mfma_f32_16x16x32_bf16(kf[k][1], q[s][1], sc[s][k], 0, 0, 0); }
    __builtin_amdgcn_sched_barrier(0);
    bf16x8 vf[4][2];
    { const int q4 = fr >> 2, pp = fr & 3, kk = 4 * (fq & 1) + q4; const LAS unsigned char* vrow = vb + (4 * fq + q4) * 128 + (pp & 1) * 8;
#pragma unroll
      for (int db = 0; db < 4; ++db) { const int xo = (((2 * db + (pp >> 1)) ^ kk) * 16);
#pragma unroll
          for (int st = 0; st < 2; ++st) { const s16x4 lo4 = tr16(vrow + (32 * st) * 128 + xo), hi4 = tr16(vrow + (32 * st + 16) * 128 + xo);
              vf[db][st] = (bf16x8){lo4[0], lo4[1], lo4[2], lo4[3], hi4[0], hi4[1], hi4[2], hi4[3]}; } } }
    __builtin_amdgcn_sched_barrier(0);
    bf16x8 p[2][2];
#pragma unroll
    for (int s = 0; s < 2; ++s) if (s ? do1 : do0) { float ls = 0.f;
#pragma unroll
        for (int k = 0; k < 4; ++k)
#pragma unroll
            for (int e = 0; e < 4; ++e) { float v = sc[s][k][e]; if (EDGE) { const int key = 16 * k + 4 * fq + e; if (key < lo[s] || key > hi[s]) v = -INFINITY; } v = fast_exp2(v); sc[s][k][e] = v; ls += v; }
        l[s] += ls; p[s][0] = pack_p(sc[s][0], sc[s][1]); p[s][1] = pack_p(sc[s][2], sc[s][3]); }
    __builtin_amdgcn_sched_barrier(0);
#pragma unroll
    for (int st = 0; st < 2; ++st)
#pragma unroll
        for (int db = 0; db < 4; ++db) {
            if (do0) o[0][db] = __builtin_amdgcn_mfma_f32_16x16x32_bf16(vf[db][st], p[0][st], o[0][db], 0, 0, 0);
            if (do1) o[1][db] = __builtin_amdgcn_mfma_f32_16x16x32_bf16(vf[db][st], p[1][st], o[1][db], 0, 0, 0); }
}
template <bool EDGE>
__device__ __forceinline__ void attn_block(const LAS unsigned char* kb, const LAS unsigned char* vb, bool do0, bool do1, const bf16x8 (&q)[2][2], const float (&bias)[2], const int (&lo)[2], const int (&hi)[2],
                                           f32x4 (&o)[2][4], float (&l)[2], int fr, int fq) {
    if (do0 && do1) attn_block_t<EDGE, true, true>(kb, vb, q, bias, lo, hi, o, l, fr, fq);
    else if (do0) attn_block_t<EDGE, true, false>(kb, vb, q, bias, lo, hi, o, l, fr, fq);
    else attn_block_t<EDGE, false, true>(kb, vb, q, bias, lo, hi, o, l, fr, fq);
}

__device__ __forceinline__ void attn_prompt_unit(unsigned char* ws, LAS unsigned char* lds, int b, int g, int qb, int wave, int lane_) {
    int lane = lane_; asm volatile("" : "+v"(lane));
    const int fr = lane & 15, fq = lane >> 4, h = fr & 3, tq = fr >> 2;
    const bf16* QN = (const bf16*)(ws + WS_QN); const bf16* QR = (const bf16*)(ws + WS_QR); const float* GATES = (const float*)(ws + WS_GATES); bf16* O = (bf16*)(ws + WS_AC);
    LAS float* IMP = (LAS float*)(lds + AT_IMP); LAS unsigned* SELM = (LAS unsigned*)(lds + AT_SELM);
    const size_t seq0 = (size_t)b * SEQ; const int hc = (g * 4 + h) * 64;
    int itok[2]; size_t row[2];
#pragma unroll
    for (int s = 0; s < 2; ++s) { itok[s] = 8 * wave + 4 * s + tq; row[s] = seq0 + 64 * qb + itok[s]; }
    LAS float* outs = (LAS float*)(lds + AT_OUTS) + wave * 2048 + lane;
    {
        const int nblk = (qb + 64) >> 6;
        const bf16* KC = (const bf16*)(ws + WS_KC) + ((size_t)b * 4 + g) * 128 * 64; const bf16* VC = (const bf16*)(ws + WS_VC) + ((size_t)b * 4 + g) * 128 * 64;
        for (int i = 0; i < nblk; ++i) { stage_block_dma(lds + i * 16384, KC + (size_t)i * 64 * 64, 128, wave, lane); stage_block_dma(lds + i * 16384 + 8192, VC + (size_t)i * 64 * 64, 128, wave, lane); }
        asm volatile("s_waitcnt vmcnt(0)" ::: "memory"); __builtin_amdgcn_s_barrier(); asm volatile("" ::: "memory");
#pragma unroll 1
        for (int s = 0; s < 2; ++s) {
            bf16x8 q[2];
#pragma unroll
            for (int ks = 0; ks < 2; ++ks) q[ks] = *(const bf16x8*)(QN + row[s] * D + hc + 32 * ks + 8 * fq);
            const int nv = qb + (itok[s] == 63 ? 1 : 0);
            f32x4 sc[2][4]; float ls = 0.f;
#pragma unroll
            for (int i = 0; i < 2; ++i) {
                if (i < nblk) { bf16x8 kf[4][2]; kfrags(kf, lds + i * 16384, fr, fq);
#pragma unroll
                    for (int k = 0; k < 4; ++k) { sc[i][k] = (f32x4){0.f, 0.f, 0.f, 0.f};
#pragma unroll
                        for (int ks = 0; ks < 2; ++ks) sc[i][k] = __builtin_amdgcn_mfma_f32_16x16x32_bf16(kf[k][ks], q[ks], sc[i][k], 0, 0, 0);
#pragma unroll
                        for (int e = 0; e < 4; ++e) { const int key = 64 * i + 16 * k + 4 * fq + e; const float v = key < nv ? fast_exp2(sc[i][k][e]) : 0.f; sc[i][k][e] = v; ls += v; } }
                } else {
#pragma unroll
                    for (int k = 0; k < 4; ++k) sc[i][k] = (f32x4){0.f, 0.f, 0.f, 0.f}; } }
            ls += __shfl_xor(ls, 16); ls += __shfl_xor(ls, 32);
            const float inv = ls > 0.f ? 1.f / ls : 0.f;
            f32x4 oc[2][4];
#pragma unroll
            for (int d = 0; d < 4; ++d) { oc[0][d] = (f32x4){0.f, 0.f, 0.f, 0.f}; oc[1][d] = oc[0][d]; }
#pragma unroll
            for (int i = 0; i < 2; ++i) if (i < nblk) {
#pragma unroll
                for (int k = 0; k < 4; ++k) { f32x4 pn = sc[i][k] * inv;
#pragma unroll
                    for (int e = 0; e < 4; ++e) { float t = pn[e]; t += __shfl_xor(t, 1); t += __shfl_xor(t, 2); pn[e] = t; }
                    if (h == 0) *(LAS f32x4*)(IMP + itok[s] * 128 + 64 * i + 16 * k + 4 * fq) = pn; }
                bf16x8 p[2][2]; p[0][0] = pack_p(sc[i][0], sc[i][1]); p[0][1] = pack_p(sc[i][2], sc[i][3]); p[1][0] = p[0][0]; p[1][1] = p[0][1];
                pv_block<true, false>(lds + i * 16384 + 8192, p, oc, fr, fq); }
            const float gc = GATES[row[s] * 48 + (g * 4 + h) * 3 + 0] * inv;
#pragma unroll
            for (int d = 0; d < 4; ++d)
#pragma unroll
                for (int e = 0; e < 4; ++e) outs[((s * 4 + d) * 4 + e) * 64] = oc[0][d][e] * gc;
        }
    }
    asm volatile("; MARK_TOPK");
    unsigned long long un_lo[2] = {0ull, 0ull}, un_hi[2] = {0ull, 0ull};
    asm volatile("s_waitcnt lgkmcnt(0)" ::: "memory");
#pragma unroll
    for (int pass = 0; pass < 2; ++pass) { const int c = lane & 15, tok = 8 * wave + 4 * pass + (lane >> 4);
        unsigned w0, w1 = 0u, w2 = 0u, w3 = 0u;
        if (qb <= 15) w0 = (2u << qb) - 1u;
        else {
            unsigned key[8];
#pragma unroll
            for (int j = 0; j < 8; ++j) { const int n = c + 16 * j; const float v = IMP[tok * 128 + n]; key[j] = (n >= 1 && n <= qb - 2) ? ((__float_as_uint(v) & ~127u) | (unsigned)(127 - n)) : 0u; }
            unsigned thr = 0xFFFFFFFFu;
#pragma unroll 1
            for (int r = 0; r < 13; ++r) { unsigned m = 0u;
#pragma unroll
                for (int j = 0; j < 8; ++j) m = max(m, key[j] < thr ? key[j] : 0u);
                m = max(m, (unsigned)__builtin_amdgcn_update_dpp(0, (int)m, 0xB1, 0xF, 0xF, true)); m = max(m, (unsigned)__builtin_amdgcn_update_dpp(0, (int)m, 0x4E, 0xF, 0xF, true));
                m = max(m, (unsigned)__builtin_amdgcn_update_dpp(0, (int)m, 0x141, 0xF, 0xF, true)); m = max(m, (unsigned)__builtin_amdgcn_update_dpp(0, (int)m, 0x140, 0xF, 0xF, true));
                thr = m; }
            unsigned b[4] = {0u, 0u, 0u, 0u};
#pragma unroll
            for (int j = 0; j < 8; ++j) b[j >> 1] |= (key[j] >= thr ? 1u : 0u) << (c + 16 * (j & 1));
#pragma unroll
            for (int w = 0; w < 4; ++w) { unsigned x = b[w];
                x |= (unsigned)__builtin_amdgcn_update_dpp(0, (int)x, 0xB1, 0xF, 0xF, true); x |= (unsigned)__builtin_amdgcn_update_dpp(0, (int)x, 0x4E, 0xF, 0xF, true);
                x |= (unsigned)__builtin_amdgcn_update_dpp(0, (int)x, 0x141, 0xF, 0xF, true); x |= (unsigned)__builtin_amdgcn_update_dpp(0, (int)x, 0x140, 0xF, 0xF, true); b[w] = x; }
            const unsigned long long flo = 1ull | (qb - 1 < 64 ? 1ull << (qb - 1) : 0ull) | (qb < 64 ? 1ull << qb : 0ull), fhi = (qb - 1 >= 64 ? 1ull << (qb - 65) : 0ull) | (qb >= 64 ? 1ull << (qb - 64) : 0ull);
            w0 = b[0] | (unsigned)flo; w1 = b[1] | (unsigned)(flo >> 32); w2 = b[2] | (unsigned)fhi; w3 = b[3] | (unsigned)(fhi >> 32);
        }
        if (c == 0) { SELM[tok * 4 + 0] = w0; SELM[tok * 4 + 1] = w1; SELM[tok * 4 + 2] = w2; SELM[tok * 4 + 3] = w3; }
        const unsigned u0 = __builtin_amdgcn_readlane((int)w0, 0) | __builtin_amdgcn_readlane((int)w0, 16) | __builtin_amdgcn_readlane((int)w0, 32) | __builtin_amdgcn_readlane((int)w0, 48);
        const unsigned u1 = __builtin_amdgcn_readlane((int)w1, 0) | __builtin_amdgcn_readlane((int)w1, 16) | __builtin_amdgcn_readlane((int)w1, 32) | __builtin_amdgcn_readlane((int)w1, 48);
        const unsigned u2 = __builtin_amdgcn_readlane((int)w2, 0) | __builtin_amdgcn_readlane((int)w2, 16) | __builtin_amdgcn_readlane((int)w2, 32) | __builtin_amdgcn_readlane((int)w2, 48);
        const unsigned u3 = __builtin_amdgcn_readlane((int)w3, 0) | __builtin_amdgcn_readlane((int)w3, 16) | __builtin_amdgcn_readlane((int)w3, 32) | __builtin_amdgcn_readlane((int)w3, 48);
        un_lo[pass] = (unsigned long long)u0 | ((unsigned long long)u1 << 32); un_hi[pass] = (unsigned long long)u2 | ((unsigned long long)u3 << 32);
    }
    asm volatile("s_waitcnt lgkmcnt(0)" ::: "memory");
    bf16x8 qr[2][2];
#pragma unroll
    for (int s = 0; s < 2; ++s)
#pragma unroll
        for (int ks = 0; ks < 2; ++ks) qr[s][ks] = *(const bf16x8*)(QR + row[s] * D + hc + 32 * ks + 8 * fq);
    float gsel[2], gwin[2];
#pragma unroll
    for (int s = 0; s < 2; ++s) { gsel[s] = GATES[row[s] * 48 + (g * 4 + h) * 3 + 1]; gwin[s] = GATES[row[s] * 48 + (g * 4 + h) * 3 + 2]; }
    asm volatile("; MARK_SEL");
    {
        const bf16* KS = (const bf16*)(ws + WS_KS) + seq0 * KVW + g * 64; const bf16* VS = (const bf16*)(ws + WS_VS) + seq0 * KVW + g * 64;
        const bf16* KW = (const bf16*)(ws + WS_KW) + seq0 * KVW + g * 64; const bf16* VW = (const bf16*)(ws + WS_VW) + seq0 * KVW + g * 64;
        const int nsel = qb + 1, n0w = qb >= 8 ? qb - 8 : 0, nit = nsel + (qb - n0w + 1);
#define AT_ISSUE(it_) do { const int it__ = (it_); const bool w__ = it__ >= nsel; const int n__ = w__ ? n0w + (it__ - nsel) : it__; LAS unsigned char* st__ = lds + (it__ & 3) * 16384; \
            stage_block_dma(st__, (w__ ? KW : KS) + (size_t)n__ * 64 * KVW, KVW * 2, wave, lane); stage_block_dma(st__ + 8192, (w__ ? VW : VS) + (size_t)n__ * 64 * KVW, KVW * 2, wave, lane); } while (0)
#define AT_FOLD(gt_) do { _Pragma("unroll") for (int s = 0; s < 2; ++s) { float ls = la[s]; ls += __shfl_xor(ls, 16); ls += __shfl_xor(ls, 32); const float gs = gt_[s] * (ls > 0.f ? 1.f / ls : 0.f); la[s] = 0.f; \
            _Pragma("unroll") for (int d = 0; d < 4; ++d) { _Pragma("unroll") for (int e = 0; e < 4; ++e) outs[((s * 4 + d) * 4 + e) * 64] += oa[s][d][e] * gs; oa[s][d] = (f32x4){0.f, 0.f, 0.f, 0.f}; } } } while (0)
        f32x4 oa[2][4]; float la[2] = {0.f, 0.f};
#pragma unroll
        for (int s = 0; s < 2; ++s)
#pragma unroll
            for (int d = 0; d < 4; ++d) oa[s][d] = (f32x4){0.f, 0.f, 0.f, 0.f};
        asm volatile("" : "+v"(qr[0][0]), "+v"(qr[0][1]), "+v"(qr[1][0]), "+v"(qr[1][1]), "+v"(gsel[0]), "+v"(gsel[1]), "+v"(gwin[0]), "+v"(gwin[1]));
        asm volatile("s_waitcnt vmcnt(0)" ::: "memory"); __builtin_amdgcn_s_barrier(); asm volatile("" ::: "memory");
        AT_ISSUE(0); AT_ISSUE(1);
#pragma unroll 1
        for (int it = 0; it < nit; ++it) {
            if ((it & 1) == 0) {
                asm volatile("s_waitcnt vmcnt(0)" ::: "memory"); __builtin_amdgcn_s_barrier(); asm volatile("" ::: "memory");
                if (it + 2 < nit) AT_ISSUE(it + 2);
                if (it + 3 < nit) AT_ISSUE(it + 3); }
            if (it == nsel) AT_FOLD(gsel);
            const LAS unsigned char* st = lds + (it & 3) * 16384;
            if (it < nsel) { const int n = it;
                const bool do0 = ((n < 64 ? un_lo[0] >> n : un_hi[0] >> (n - 64)) & 1ull) != 0ull, do1 = ((n < 64 ? un_lo[1] >> n : un_hi[1] >> (n - 64)) & 1ull) != 0ull;
                if (do0 || do1) { float bias[2]; const int lo[2] = {0, 0}, hi[2] = {itok[0], itok[1]};
#pragma unroll
                    for (int s = 0; s < 2; ++s) { const unsigned wd = SELM[itok[s] * 4 + (n >> 5)]; bias[s] = ((wd >> (n & 31)) & 1u) ? 0.f : -INFINITY; }
                    if (n == qb) attn_block<true>(st, st + 8192, do0, do1, qr, bias, lo, hi, oa, la, fr, fq);
                    else attn_block<false>(st, st + 8192, do0, do1, qr, bias, lo, hi, oa, la, fr, fq);
#ifdef PROBE_TWICE_BLK
                    { const float nb[2] = {-INFINITY, -INFINITY}; asm volatile("" ::: "memory"); attn_block<false>(st, st + 8192, do0, do1, qr, nb, lo, hi, oa, la, fr, fq); }
#endif
                }
            } else { const int n = n0w + (it - nsel); const float bias[2] = {0.f, 0.f};
                if (n == qb || n == qb - 8) { int lo[2], hi[2];
#pragma unroll
                    for (int s = 0; s < 2; ++s) { lo[s] = (n == qb - 8) ? itok[s] + 1 : 0; hi[s] = (n == qb) ? itok[s] : 63; }
                    attn_block<true>(st, st + 8192, true, true, qr, bias, lo, hi, oa, la, fr, fq);
                } else { const int lo[2] = {0, 0}, hi[2] = {63, 63}; attn_block<false>(st, st + 8192, true, true, qr, bias, lo, hi, oa, la, fr, fq); }
#ifdef PROBE_TWICE_BLK
                { const float nb[2] = {-INFINITY, -INFINITY}; const int lo[2] = {0, 0}, hi[2] = {63, 63}; asm volatile("" ::: "memory"); attn_block<false>(st, st + 8192, true, true, qr, nb, lo, hi, oa, la, fr, fq); }
#endif
            }
        }
#pragma unroll
        for (int s = 0; s < 2; ++s) { float ls = la[s]; ls += __shfl_xor(ls, 16); ls += __shfl_xor(ls, 32); const float gw = gwin[s] * (ls > 0.f ? 1.f / ls : 0.f);
#pragma unroll
            for (int d = 0; d < 4; ++d) { float y[4];
#pragma unroll
                for (int e = 0; e < 4; ++e) y[e] = outs[((s * 4 + d) * 4 + e) * 64] + oa[s][d][e] * gw;
                v2u w; w.x = pk2(y[0], y[1]); w.y = pk2(y[2], y[3]); *(v2u*)(O + row[s] * D + hc + 16 * d + 4 * fq) = w; } }
#undef AT_ISSUE
#undef AT_FOLD
    }
    asm volatile("s_waitcnt lgkmcnt(0)" ::: "memory"); __builtin_amdgcn_s_barrier(); asm volatile("" ::: "memory");
}

__device__ __forceinline__ void stage_f32_rows(LAS unsigned char* dst, const float* src_row0  , int lane) {
#pragma unroll
    for (int half = 0; half < 2; ++half) { f32x4 v[8];
#pragma unroll
        for (int k = 0; k < 8; ++k) { const int r = 32 * half + 4 * k + (lane >> 4); v[k] = *(const f32x4*)(src_row0 + (size_t)r * KVW + 4 * (lane & 15)); }
#pragma unroll
        for (int k = 0; k < 8; ++k) { const int r = 32 * half + 4 * k + (lane >> 4), c16 = (lane & 15) >> 1; v2u w; w.x = pk2(v[k][0], v[k][1]); w.y = pk2(v[k][2], v[k][3]);
            *(LAS v2u*)(dst + r * 128 + ((c16 ^ (r & 7)) * 16) + (lane & 1) * 8) = w; } }
}
__device__ __forceinline__ void stage_bf16_rows(LAS unsigned char* dst, const bf16* src_row0, int pitch, int nvalid, int lane) {
#pragma unroll
    for (int k = 0; k < 8; ++k) { const int r = 8 * k + (lane >> 3), c = lane & 7; v4u w = (v4u){0u, 0u, 0u, 0u};
        if (r < nvalid) w = *(const v4u*)(src_row0 + (size_t)r * pitch + 8 * c);
        *(LAS v4u*)(dst + r * 128 + ((c ^ (r & 7)) * 16)) = w; }
}
__device__ __forceinline__ void attn_sample_unit(const In& I, unsigned char* ws, LAS unsigned char* lds, int bs, int g, int wave, int lane_) {
    int lane = lane_; asm volatile("" : "+v"(lane));
    const int fr = lane & 15, fq = lane >> 4, h = fr & 3, tq = fr >> 2;
    const bf16* QN = (const bf16*)(ws + WS_QN); const bf16* QR = (const bf16*)(ws + WS_QR); const float* GATES = (const float*)(ws + WS_GATES); bf16* O = (bf16*)(ws + WS_AC);
    LAS float* IMP = (LAS float*)(lds + SAT_IMP); LAS unsigned* SELM = (LAS unsigned*)(lds + SAT_SELM);
    LAS unsigned char* my = lds + wave * 16384;
    const size_t row = (size_t)MP + 4 * bs + tq; const int hc = (g * 4 + h) * 64;
    f32x4 acc[2][4]; float lsum[2] = {0.f, 0.f};
    f32x4 oc[2][4]; float lc = 0.f;
#pragma unroll
    for (int d = 0; d < 4; ++d) { acc[0][d] = (f32x4){0.f, 0.f, 0.f, 0.f}; acc[1][d] = acc[0][d]; oc[0][d] = acc[0][d]; oc[1][d] = acc[0][d]; }
    if (wave == 0) {
        const bf16* KC = (const bf16*)(ws + WS_KC) + ((size_t)(2 + bs) * 4 + g) * 128 * 64; const bf16* VC = (const bf16*)(ws + WS_VC) + ((size_t)(2 + bs) * 4 + g) * 128 * 64;
        bf16x8 q[2];
#pragma unroll
        for (int ks = 0; ks < 2; ++ks) q[ks] = *(const bf16x8*)(QN + row * D + hc + 32 * ks + 8 * fq);
        f32x4 sc[2][4];
#pragma unroll 1
        for (int i = 0; i < 2; ++i) {
            stage_bf16_rows(my, KC + (size_t)i * 64 * 64, 64, 64, lane); stage_bf16_rows(my + 8192, VC + (size_t)i * 64 * 64, 64, 64, lane);
            asm volatile("s_waitcnt lgkmcnt(0)" ::: "memory");
            bf16x8 kf[4][2]; kfrags(kf, my, fr, fq);
            f32x4 t[4];
#pragma unroll
            for (int k = 0; k < 4; ++k) { t[k] = (f32x4){0.f, 0.f, 0.f, 0.f};
#pragma unroll
                for (int ks = 0; ks < 2; ++ks) t[k] = __builtin_amdgcn_mfma_f32_16x16x32_bf16(kf[k][ks], q[ks], t[k], 0, 0, 0);
#pragma unroll
                for (int e = 0; e < 4; ++e) { t[k][e] = fast_exp2(t[k][e]); lc += t[k][e]; } }
            bf16x8 p[2][2]; p[0][0] = pack_p(t[0], t[1]); p[0][1] = pack_p(t[2], t[3]); p[1][0] = p[0][0]; p[1][1] = p[0][1];
            pv_block<true, false>(my + 8192, p, oc, fr, fq);
            asm volatile("s_waitcnt lgkmcnt(0)" ::: "memory");
#pragma unroll
            for (int k = 0; k < 4; ++k) { if (i == 0) sc[0][k] = t[k]; else sc[1][k] = t[k]; }
        }
        lc += __shfl_xor(lc, 16); lc += __shfl_xor(lc, 32);
        const float inv = 1.f / lc;
#pragma unroll
        for (int i = 0; i < 2; ++i)
#pragma unroll
            for (int k = 0; k < 4; ++k) { f32x4 pn = sc[i][k] * inv;
#pragma unroll
                for (int e = 0; e < 4; ++e) { float t = pn[e]; t += __shfl_xor(t, 1); t += __shfl_xor(t, 2); pn[e] = t; }
                if (h == 0) *(LAS f32x4*)(IMP + tq * 132 + 64 * i + 16 * k + 4 * fq) = pn; }
    }
    asm volatile("s_waitcnt lgkmcnt(0)" ::: "memory"); __builtin_amdgcn_s_barrier(); asm volatile("" ::: "memory");
    if (wave < 4) {
        const float v0 = IMP[wave * 132 + lane], v1 = IMP[wave * 132 + 64 + lane];
        unsigned u0 = (lane >= 1) ? __float_as_uint(v0) : 0u, u1 = (lane + 64 <= 126) ? __float_as_uint(v1) : 0u;
        unsigned long long mlo = 1ull, mhi = 1ull << 63;
#pragma unroll 1
        for (int r = 0; r < 13; ++r) { const unsigned m = dpp_max_u32(max(u0, u1));
            const unsigned long long b0 = __ballot(u0 == m);
            if (b0) { const int idx = __builtin_ctzll(b0); mlo |= 1ull << idx; if (lane == idx) u0 = 0u; }
            else { const unsigned long long b1 = __ballot(u1 == m); const int idx = __builtin_ctzll(b1); mhi |= 1ull << idx; if (lane == idx) u1 = 0u; } }
        if (lane == 0) { SELM[wave * 8 + 0] = (unsigned)mlo; SELM[wave * 8 + 1] = (unsigned)(mlo >> 32); SELM[wave * 8 + 2] = (unsigned)mhi; SELM[wave * 8 + 3] = (unsigned)(mhi >> 32); }
    }
    asm volatile("s_waitcnt lgkmcnt(0)" ::: "memory"); __builtin_amdgcn_s_barrier(); asm volatile("" ::: "memory");
    unsigned selw[4];
#pragma unroll
    for (int w = 0; w < 4; ++w) selw[w] = SELM[tq * 8 + w];
    unsigned long long un_lo = 0ull, un_hi = 0ull;
#pragma unroll
    for (int t = 0; t < 4; ++t) { un_lo |= (unsigned long long)SELM[t * 8 + 0] | ((unsigned long long)SELM[t * 8 + 1] << 32); un_hi |= (unsigned long long)SELM[t * 8 + 2] | ((unsigned long long)SELM[t * 8 + 3] << 32); }
    un_lo = ((unsigned long long)__builtin_amdgcn_readfirstlane((unsigned)(un_lo >> 32)) << 32) | (unsigned)__builtin_amdgcn_readfirstlane((unsigned)un_lo);
    un_hi = ((unsigned long long)__builtin_amdgcn_readfirstlane((unsigned)(un_hi >> 32)) << 32) | (unsigned)__builtin_amdgcn_readfirstlane((unsigned)un_hi);
    bf16x8 qr[2][2];
#pragma unroll
    for (int ks = 0; ks < 2; ++ks) { qr[0][ks] = *(const bf16x8*)(QR + row * D + hc + 32 * ks + 8 * fq); qr[1][ks] = qr[0][ks]; }
    int cnt = 0;
    { const int* pt = I.page_table + bs * NPAGE;
#pragma unroll 1
      for (int n = 0; n < 128; ++n) { const bool on = ((n < 64 ? un_lo >> n : un_hi >> (n - 64)) & 1ull) != 0ull; if (!on) continue;
          if ((cnt++ & 7) != wave) continue;
          const int pg = pt[n >> 1]; const size_t ro = ((size_t)pg * 128 + (n & 1) * 64) * KVW + g * 64;
          stage_f32_rows(my, I.ck_sel + ro, lane); stage_f32_rows(my + 8192, I.cv_sel + ro, lane);
          asm volatile("s_waitcnt lgkmcnt(0)" ::: "memory");
          const int wi = n >> 5; const unsigned wd = wi == 0 ? selw[0] : (wi == 1 ? selw[1] : (wi == 2 ? selw[2] : selw[3]));
          const float bias[2] = {((wd >> (n & 31)) & 1u) ? 0.f : -INFINITY, 0.f}; const int lo[2] = {0, 0}, hi[2] = {63, 63};
          attn_block<false>(my, my + 8192, true, false, qr, bias, lo, hi, acc, lsum, fr, fq);
          asm volatile("s_waitcnt lgkmcnt(0)" ::: "memory"); } }
#pragma unroll 1
    for (int wb = 0; wb < 8; ++wb) { if ((cnt++ & 7) != wave) continue;
        const size_t ro = ((size_t)bs * 512 + 64 * wb) * KVW + g * 64;
        stage_f32_rows(my, I.ck_win + ro, lane); stage_f32_rows(my + 8192, I.cv_win + ro, lane);
        asm volatile("s_waitcnt lgkmcnt(0)" ::: "memory");
        const float bias[2] = {0.f, 0.f}; const int lo[2] = {0, wb == 0 ? tq + 1 : 0}, hi[2] = {63, 63};
        attn_block<true>(my, my + 8192, false, true, qr, bias, lo, hi, acc, lsum, fr, fq);
        asm volatile("s_waitcnt lgkmcnt(0)" ::: "memory"); }
    if ((cnt++ & 7) == wave) {
        stage_bf16_rows(my, (const bf16*)(ws + WS_KS) + ((size_t)MP + 4 * bs) * KVW + g * 64, KVW, 4, lane); stage_bf16_rows(my + 8192, (const bf16*)(ws + WS_VS) + ((size_t)MP + 4 * bs) * KVW + g * 64, KVW, 4, lane);
        asm volatile("s_waitcnt lgkmcnt(0)" ::: "memory");
        const float bias[2] = {0.f, 0.f}; const int lo[2] = {0, 0}, hi[2] = {tq, tq};
        attn_block<true>(my, my + 8192, true, false, qr, bias, lo, hi, acc, lsum, fr, fq);
        asm volatile("s_waitcnt lgkmcnt(0)" ::: "memory"); }
    if ((cnt++ & 7) == wave) {
        stage_bf16_rows(my, (const bf16*)(ws + WS_KW) + ((size_t)MP + 4 * bs) * KVW + g * 64, KVW, 4, lane); stage_bf16_rows(my + 8192, (const bf16*)(ws + WS_VW) + ((size_t)MP + 4 * bs) * KVW + g * 64, KVW, 4, lane);
        asm volatile("s_waitcnt lgkmcnt(0)" ::: "memory");
        const float bias[2] = {0.f, 0.f}; const int lo[2] = {0, 0}, hi[2] = {tq, tq};
        attn_block<true>(my, my + 8192, false, true, qr, bias, lo, hi, acc, lsum, fr, fq);
        asm volatile("s_waitcnt lgkmcnt(0)" ::: "memory"); }
    __builtin_amdgcn_s_barrier(); asm volatile("" ::: "memory");
    { LAS float* red = (LAS float*)lds + wave * (2 * 17 * 64);
#pragma unroll
      for (int br = 0; br < 2; ++br) {
#pragma unroll
          for (int d = 0; d < 4; ++d)
#pragma unroll
              for (int e = 0; e < 4; ++e) red[(br * 17 + 4 * d + e) * 64 + lane] = acc[br][d][e];
          red[(br * 17 + 16) * 64 + lane] = lsum[br]; } }
    asm volatile("s_waitcnt lgkmcnt(0)" ::: "memory"); __builtin_amdgcn_s_barrier(); asm volatile("" ::: "memory");
    if (wave == 0) {
        float outv[16];
        const float gc = GATES[row * 48 + (g * 4 + h) * 3 + 0] / lc;
#pragma unroll
        for (int d = 0; d < 4; ++d)
#pragma unroll
            for (int e = 0; e < 4; ++e) outv[4 * d + e] = oc[0][d][e] * gc;
#pragma unroll
        for (int br = 0; br < 2; ++br) { float ls = 0.f; float ob[16];
#pragma unroll
            for (int k = 0; k < 16; ++k) ob[k] = 0.f;
#pragma unroll 1
            for (int w = 0; w < 8; ++w) { const LAS float* red = (const LAS float*)lds + w * (2 * 17 * 64);
#pragma unroll
                for (int k = 0; k < 16; ++k) ob[k] += red[(br * 17 + k) * 64 + lane];
                ls += red[(br * 17 + 16) * 64 + lane]; }
            ls += __shfl_xor(ls, 16); ls += __shfl_xor(ls, 32);
            const float gb = GATES[row * 48 + (g * 4 + h) * 3 + 1 + br] * (ls > 0.f ? 1.f / ls : 0.f);
#pragma unroll
            for (int k = 0; k < 16; ++k) outv[k] += ob[k] * gb; }
#pragma unroll
        for (int d = 0; d < 4; ++d) { v2u w; w.x = pk2(outv[4 * d], outv[4 * d + 1]); w.y = pk2(outv[4 * d + 2], outv[4 * d + 3]); *(v2u*)(O + row * D + hc + 16 * d + 4 * fq) = w; }
    }
    asm volatile("s_waitcnt lgkmcnt(0)" ::: "memory"); __builtin_amdgcn_s_barrier(); asm volatile("" ::: "memory");
}
__device__ __forceinline__ void attention_phase(const In& I, unsigned char* ws, LAS unsigned char* lds, int vcu, int G) {
    int tid_ = threadIdx.x; asm volatile("" : "+v"(tid_));
    const int wave = __builtin_amdgcn_readfirstlane(tid_ >> 6), lane = tid_ & 63;
#pragma unroll 1
    for (int k = vcu; k < 1024; k += G) { int bg = k & 7, qb = 127 - (k >> 3);
        if (G == 256) { const int i = k >> 8, j = vcu & 31; bg = vcu >> 5; qb = i == 0 ? 127 - j : (i == 1 ? 64 + j : (i == 2 ? 63 - j : j)); }
        asm volatile("; MARK_PROMPT_UNIT");
        attn_prompt_unit(ws, lds, bg >> 2, bg & 3, qb, wave, lane); }
#pragma unroll 1
#ifdef PROBE_TWICE_SAMPLE
    for (int rep = 0; rep < 2; ++rep)
#endif
    for (int k = (G == 256) ? ((vcu & 1) ? (vcu >> 1) : 128) : vcu; k < 128; k += G) { asm volatile("; MARK_SAMPLE_UNIT"); attn_sample_unit(I, ws, lds, k >> 2, k & 3, wave, lane); }
    asm volatile("; MARK_ATT_END");
}

#ifdef PROBE_TWICE_ATT
#define PROBE_ATT SEAM(); attention_phase(I, ws, lds, vcu, G);
#else
#define PROBE_ATT
#endif
#ifndef NSA_MIXER_BODY
#define NSA_MIXER_BODY { CmpSrc cs{out + O_KCP, out + O_VCP, nullptr, 0, 2}; compress_phase(I, ws, lds, cs, vcu, G); } SEAM(); \
    attention_phase(I, ws, lds, vcu, G); PROBE_ATT SEAM();
#endif

struct Args { const void* in[26]; float* out; unsigned char* ws; int ph_lo, ph_hi; };
__global__ void __launch_bounds__(NWAVES * 64, 2) fwd(Args args) {
    extern __shared__ __attribute__((aligned(16))) unsigned char lds_[];
    LAS unsigned char* lds = (LAS unsigned char*)lds_;
    const int tid = threadIdx.x, lane = tid & 63, wave = __builtin_amdgcn_readfirstlane(tid >> 6);
    const int G = gridDim.x; int vcu; { const int bx = blockIdx.x; vcu = (G % 8 == 0) ? (bx % 8) * (G / 8) + bx / 8 : bx; }
    unsigned char* ws = args.ws; float* out = args.out;
    gu32* ctl = (gu32*)(ws + WS_CTL);
    In I;
    I.x_prompt = (const float*)args.in[0]; I.x_sample = (const float*)args.in[1]; I.state_conv = (const float*)args.in[2]; I.ck_cmp = (const float*)args.in[3]; I.cv_cmp = (const float*)args.in[4];
    I.ck_sel = (const float*)args.in[5]; I.cv_sel = (const float*)args.in[6]; I.ck_win = (const float*)args.in[7]; I.cv_win = (const float*)args.in[8]; I.page_table = (const int*)args.in[9];
    I.p_prompt = (const float*)args.in[10]; I.p_sample = (const float*)args.in[11]; I.norm_g = (const float*)args.in[12]; I.w_gu = (const float*)args.in[13]; I.w_down = (const float*)args.in[14];
    I.w_proj = (const float*)args.in[15]; I.w_gate = (const float*)args.in[16]; I.cw_in = (const float*)args.in[17]; I.cw = (const float*)args.in[18]; I.cw_out = (const float*)args.in[19];
    I.nw_in = (const float*)args.in[20]; I.qk_g = (const float*)args.in[21]; I.cmp_pos = (const float*)args.in[22]; I.cmp_w1 = (const float*)args.in[23]; I.cmp_w2 = (const float*)args.in[24]; I.nw_out = (const float*)args.in[25];
    for (int u = tid; u < (LDS_BYTES - LDSCTL_OFF) / 4; u += NWAVES * 64) ((LAS unsigned*)(lds + LDSCTL_OFF))[u] = 0u;
    __syncthreads();
    (void)xcd_barrier_post((unsigned*)ctl + CW_BAR, (volatile LAS unsigned*)(lds + MISC_OFF) + 8);
    const int hi = args.ph_hi; int pid = 0;
#define SEAM() do { asm volatile("; SEAM_MARK %0" :: "i"(__LINE__)); ++pid; if (pid >= hi) return; XcdBarrier b_; b_.bar = (unsigned*)(ws + WS_CTL) + CW_BAR; b_.x = xb_xcc_id(); b_.st = (volatile LAS unsigned*)(lds + MISC_OFF) + 8; xcd_barrier(b_); } while (0)


    bf16* const XB_0 = (bf16*)(ws + WS_XB); bf16* const XB_1 = (bf16*)(ws + WS_XB + SZ_XB);
    float* const SS_0 = (float*)(ws + WS_SS); float* const SS_1 = (float*)(ws + WS_SS + SZ_SS);
    bf16* const Hb = (bf16*)(ws + WS_H); bf16* const ACb = (bf16*)(ws + WS_AC);
    bf16* const PBb = (bf16*)(ws + WS_PB); bf16* const Pb = (bf16*)(ws + WS_P);

#ifdef PH_HI_OVERRIDE
    { const size_t gt = (size_t)(vcu * NWAVES + wave) * 64 + lane, NT = (size_t)G * NWAVES * 64;
      for (size_t i = DBG_FILL_FROM / 4 + gt; i < O_END / 4; i += NT) ((GAS f32x4*)out)[i] = (f32x4){0.f, 0.f, 0.f, 0.f}; }
#endif
    p0_prologue(I, out, ws, lds, vcu, G, wave, lane);
    cmp_bias_partials(I, ws, vcu, G, wave, lane);
#ifdef PROBE_TWICE_PRO
    SEAM(); p0_prologue(I, out, ws, lds, vcu, G, wave, lane);
#endif
    SEAM();
#define PH_PROJ(l) { const bf16* Wp = (const bf16*)(ws + WS_WPROJ + (size_t)(l) * SZ_WPROJ); int kk_ = PLE; asm volatile("" : "+s"(kk_)); \
      pg8::Gemm g{PBb + (size_t)(l) * MT * PLE, Wp, MP, D, kk_}; GOrder S; S.init(MP, D, G, (int)blockIdx.x); pg8::EpiRaw<false> E{Pb + (size_t)(l) * MT * D, D, nullptr}; \
      pg8::gemm_phase<pg8::EpiRaw<false>, GOrder, true, true>(lds, g, S, E); \
      SkRaw<false> SE{Pb + (size_t)(l) * MT * D, D, nullptr}; skinny_phase<0>(lds, PBb + ((size_t)(l) * MT + MP) * PLE, Wp, PLE, D / 64, SE, vcu, G); }
    PH_PROJ(0)
    PH_PROJ(1)
    cmp_bias_reduce(ws, vcu, tid);
    SEAM();
    { CmpSrc cs{I.ck_cmp, I.cv_cmp, I.page_table, 2, 32}; compress_phase(I, ws, lds, cs, vcu, G); }
#ifdef PROBE_TWICE_CMP
    SEAM(); { CmpSrc cs{I.ck_cmp, I.cv_cmp, I.page_table, 2, 32}; compress_phase(I, ws, lds, cs, vcu, G); }
#endif
    SEAM();

#define XBP(c) ((bf16*)(ws + WS_XB + (size_t)(c) * SZ_XB))
#define SSP(c) ((float*)(ws + WS_SS + (size_t)(c) * SZ_SS))
#define PH_GU(l, s, c) { const bf16* Wgu = (const bf16*)(ws + WS_WGU + (size_t)((l) * 2 + (s)) * SZ_WGU); \
      pg8::Gemm g{XBP(c), Wgu, MP, NGU, D}; GOrder S; S.init(MP, NGU, G, (int)blockIdx.x); pg8::EpiSwiglu E{Hb, SSP(c)}; \
      pg8::gemm_phase<pg8::EpiSwiglu, GOrder, true, true>(lds, g, S, E); \
      SkSwiglu SE{Hb, SSP(c)}; skinny_phase<1>(lds, XBP(c) + (size_t)MP * D, Wgu, D, FF / 32, SE, vcu, G); } SEAM();
#define PH_RESID(Asrc, K_, Wt, scale, c) { pg8::Gemm g{(Asrc), (const bf16*)(Wt), MP, D, (K_)}; GOrder S; S.init(MP, D, G, (int)blockIdx.x); \
      pg8::EpiResid<false, false> E{out, XBP((c) ^ 1), SSP((c) ^ 1), (scale), nullptr, nullptr}; \
      pg8::gemm_phase<pg8::EpiResid<false, false>, GOrder, true, true>(lds, g, S, E); \
      SkResid<false> SE{out, XBP((c) ^ 1), SSP((c) ^ 1), (scale), nullptr, nullptr, 0}; skinny_phase<0>(lds, (Asrc) + (size_t)MP * (K_), (const bf16*)(Wt), (K_), D / 64, SE, vcu, G); } SEAM();
#define PH_RAW(Wt, N_, NCU_, c) { pg8::Gemm g{XBP(c), (const bf16*)(Wt), MP, (N_), D}; GOrder S; S.init(MP, (N_), G, (int)blockIdx.x); pg8::EpiRaw<true> E{Hb, (N_), SSP(c)}; \
      pg8::gemm_phase<pg8::EpiRaw<true>, GOrder, true, true>(lds, g, S, E); \
      SkRaw<true> SE{Hb, (N_), SSP(c)}; skinny_phase<0>(lds, XBP(c) + (size_t)MP * D, (const bf16*)(Wt), D, (NCU_), SE, vcu, G); } SEAM();
#define PH_GATE(l, c, FIN) { const bf16* Wg = (const bf16*)(ws + WS_WGATE + (size_t)(l) * SZ_WSQ); const bf16* Pl = Pb + (size_t)(l) * MT * D; \
      pg8::Gemm g{XBP(c), Wg, MP, D, D}; GOrder S; S.init(MP, D, G, (int)blockIdx.x); pg8::EpiResid<true, FIN> E{out, XBP((c) ^ 1), SSP((c) ^ 1), 1.0f, SSP(c), Pl}; \
      pg8::gemm_phase<pg8::EpiResid<true, FIN>, GOrder, true, true>(lds, g, S, E); \
      SkResid<true> SE{out, XBP((c) ^ 1), SSP((c) ^ 1), 1.0f, SSP(c), Pl, FIN}; skinny_phase<0>(lds, XBP(c) + (size_t)MP * D, Wg, D, D / 64, SE, vcu, G); } SEAM();

    PH_GU(0, 0, 0)
#ifdef PROBE_TWICE_GU
    PH_GU(0, 0, 0)
#endif
    PH_RESID(Hb, FF, ws + WS_WDN + 0 * SZ_WDN, 0.5f, 0)
    PH_RAW(ws + WS_WCIN, NCV, NCV / 64, 1)
    conv_post(I, out, ws, vcu, G, wave, lane); SEAM();
    PH_RESID(ACb, D, ws + WS_WCOUT, 1.0f, 1)
    PH_GU(0, 1, 0)
    PH_RESID(Hb, FF, ws + WS_WDN + 1 * SZ_WDN, 0.5f, 0)
    PH_GATE(0, 1, false)
    PH_GU(1, 0, 0)
    PH_RESID(Hb, FF, ws + WS_WDN + 2 * SZ_WDN, 0.5f, 0)
    PH_RAW(ws + WS_WNIN, NNSP, (NNS + 63) / 64, 1)
    nsa_post(I, out, ws, vcu, G, wave, lane); SEAM();
    NSA_MIXER_BODY
    PH_RESID(ACb, D, ws + WS_WNOUT, 1.0f, 1)
    PH_GU(1, 1, 0)
    PH_RESID(Hb, FF, ws + WS_WDN + 3 * SZ_WDN, 0.5f, 0)
    PH_GATE(1, 1, true)
#ifdef DBG_SCALE_FROM
    { const size_t gt = (size_t)(vcu * NWAVES + wave) * 64 + lane, NT = (size_t)G * NWAVES * 64;
      for (size_t i = (DBG_SCALE_FROM) / 4 + gt; i < (DBG_SCALE_TO) / 4; i += NT) ((GAS f32x4*)out)[i] *= 1.2f; }
#endif
#undef SEAM
}

#ifdef PH_HI_OVERRIDE
#define PH_HI PH_HI_OVERRIDE
#endif
#ifndef PH_HI
#define PH_HI 1000
#endif
extern "C" void kernel_launch(void* const* d_in, const int* in_sizes, int n_in, void* d_out, int out_size, void* d_ws, size_t ws_size, hipStream_t stream) {
    static int grid = 0;
    if (grid == 0) {
        if (n_in != 26 || out_size != (int)O_END || ws_size < WS_END) { fprintf(stderr, "kernel_launch: unexpected sizes n_in %d out %d ws %zu (need %zu)\n", n_in, out_size, ws_size, (size_t)WS_END); grid = -1; return; }
        int dev = 0, cus = 0, per_cu = 0;
        if (hipGetDevice(&dev) != hipSuccess || hipDeviceGetAttribute(&cus, hipDeviceAttributeMultiprocessorCount, dev) != hipSuccess) { grid = -1; return; }
        if (hipFuncSetAttribute((const void*)fwd, hipFuncAttributeMaxDynamicSharedMemorySize, LDS_BYTES) != hipSuccess) { fprintf(stderr, "kernel_launch: hipFuncSetAttribute failed\n"); grid = -1; return; }
        if (hipOccupancyMaxActiveBlocksPerMultiprocessor(&per_cu, (const void*)fwd, NWAVES * 64, LDS_BYTES) != hipSuccess || per_cu < 1) { fprintf(stderr, "kernel_launch: occupancy query says %d\n", per_cu); (void)hipGetLastError(); grid = -1; return; }
        grid = cus;
    }
    if (grid < 0) return;
    (void)hipMemsetAsync((char*)d_ws + WS_CTL, 0, CTL_ZERO_BYTES, stream);
    Args a{};
    for (int i = 0; i < 26; ++i) a.in[i] = d_in[i];
    a.out = (float*)d_out; a.ws = (unsigned char*)d_ws; a.ph_lo = 0; a.ph_hi = PH_HI;
    hipLaunchKernelGGL(fwd, dim3(grid), dim3(NWAVES * 64), LDS_BYTES, stream, a);
}
```

```cpp
#include <hip/hip_runtime.h>
#include <cstdio>
#include <cstdint>

#define GAS __attribute__((address_space(1)))
#define LAS __attribute__((address_space(3)))
typedef unsigned short bf16;
typedef unsigned v4u __attribute__((ext_vector_type(4)));
typedef unsigned v2u __attribute__((ext_vector_type(2)));
typedef float f32x4 __attribute__((ext_vector_type(4)));
typedef float f32x2 __attribute__((ext_vector_type(2)));
typedef short bf16x8 __attribute__((ext_vector_type(8)));
typedef short s16x4 __attribute__((ext_vector_type(4)));
typedef GAS unsigned gu32;

constexpr int D = 1024, MP = 16384, MS = 128, MT = MP + MS, FF = 2816, NGU = 2 * FF, NCV = 3072, NNS = 2608, NNSP = 2816, PLE = 256;
constexpr int SEQ = 8192, SB = 32, ST = 4, PAST = 8192, NPAGE = 64, HD = 64, KVW = 256, WIN = 512, NBT = 34  ;
constexpr float RMS_EPS = 1e-6f;
constexpr float QSCALE = 0.125f * 1.4426950408889634f;

constexpr size_t O_Y = 0, O_YS = O_Y + (size_t)MP * D, O_CONVP = O_YS + (size_t)MS * D, O_CONVS = O_CONVP + 2 * 2 * D, O_KCP = O_CONVS + 32 * 2 * D;
constexpr size_t SZ_P = (size_t)MP * KVW, SZ_WP = 2 * 512 * KVW, SZ_S = (size_t)MS * KVW, SZ_WS = 32 * 512 * KVW;
constexpr size_t O_VCP = O_KCP + SZ_P, O_KSP = O_VCP + SZ_P, O_VSP = O_KSP + SZ_P, O_KWP = O_VSP + SZ_P, O_VWP = O_KWP + SZ_WP;
constexpr size_t O_KCS = O_VWP + SZ_WP, O_VCS = O_KCS + SZ_S, O_KSS = O_VCS + SZ_S, O_VSS = O_KSS + SZ_S, O_KWS = O_VSS + SZ_S, O_VWS = O_KWS + SZ_WS, O_END = O_VWS + SZ_WS;
static_assert(O_END == 42799104, "d_out size");

constexpr size_t MiB = 1u << 20;
constexpr size_t WS_CTL = 0, CTL_ZERO_BYTES = 1 * MiB;
constexpr size_t WS_WGU = 2 * MiB;
constexpr size_t SZ_WGU = (size_t)NGU * D * 2;
constexpr size_t WS_WDN = WS_WGU + 4 * SZ_WGU;
constexpr size_t SZ_WDN = (size_t)D * FF * 2;
constexpr size_t WS_WGATE = WS_WDN + 4 * SZ_WDN;
constexpr size_t SZ_WSQ = (size_t)D * D * 2;
constexpr size_t WS_WPROJ = WS_WGATE + 2 * SZ_WSQ;
constexpr size_t SZ_WPROJ = (size_t)D * PLE * 2;
constexpr size_t WS_WCIN = WS_WPROJ + 2 * SZ_WPROJ;
constexpr size_t WS_WCOUT = WS_WCIN + (size_t)NCV * D * 2;
constexpr size_t WS_WNIN = WS_WCOUT + SZ_WSQ;
constexpr size_t WS_WNOUT = WS_WNIN + (size_t)NNSP * D * 2;
constexpr size_t WS_W1T = WS_WNOUT + SZ_WSQ;
constexpr size_t WS_W2T = WS_W1T + 2 * (size_t)128 * 4096 * 2;
constexpr size_t WS_ROPE = WS_W2T + 2 * 64 * 128 * 2;
constexpr size_t WS_SS = (WS_ROPE + (size_t)8196 * 64 * 4 + MiB - 1) / MiB * MiB;
constexpr size_t SZ_SS = (size_t)MT * 16 * 4;
constexpr size_t WS_XB = (WS_SS + 2 * SZ_SS + MiB - 1) / MiB * MiB;
constexpr size_t SZ_XB = (size_t)MT * D * 2;
constexpr size_t WS_H = (WS_XB + 2 * SZ_XB + MiB - 1) / MiB * MiB;
constexpr size_t WS_AC = (WS_H + (size_t)MT * NCV * 2 + MiB - 1) / MiB * MiB;
constexpr size_t WS_PB = (WS_AC + SZ_XB + MiB - 1) / MiB * MiB;
constexpr size_t WS_P = (WS_PB + 2 * (size_t)MT * PLE * 2 + MiB - 1) / MiB * MiB;
constexpr size_t WS_QN = (WS_P + 2 * SZ_XB + MiB - 1) / MiB * MiB;
constexpr size_t WS_QR = (WS_QN + SZ_XB + MiB - 1) / MiB * MiB;
constexpr size_t SZ_KV = (size_t)MT * KVW * 2;
constexpr size_t WS_KS = (WS_QR + SZ_XB + MiB - 1) / MiB * MiB;
constexpr size_t WS_VS = WS_KS + SZ_KV, WS_KW = WS_VS + SZ_KV, WS_VW = WS_KW + SZ_KV;
constexpr size_t WS_GATES = (WS_VW + SZ_KV + MiB - 1) / MiB * MiB;
constexpr size_t WS_KC = (WS_GATES + (size_t)MT * 48 * 4 + MiB - 1) / MiB * MiB;
constexpr size_t SZ_KC = (size_t)NBT * 4 * 128 * 64 * 2;
constexpr size_t WS_VC = (WS_KC + SZ_KC + MiB - 1) / MiB * MiB;
constexpr size_t WS_CPART = (WS_VC + SZ_KC + MiB - 1) / MiB * MiB;
constexpr size_t WS_CBIAS = WS_CPART + 2 * 64 * 128 * 4;
constexpr size_t WS_END = WS_CPART + MiB;

constexpr int CW_TMO = 0, CW_CODE = 1, CW_BAR = 4096;

constexpr int RING_BYTES = 131072, LDSCTL_OFF = 147456  , MISC_OFF = LDSCTL_OFF + 320, LDS_BYTES = 163840  ;
constexpr int NWAVES = 8;

#define RLX_AGENT __ATOMIC_RELAXED, __HIP_MEMORY_SCOPE_AGENT
#define LDS_WAIT() asm volatile("s_waitcnt lgkmcnt(0)" ::: "memory")
#define VM_WAIT() asm volatile("s_waitcnt vmcnt(0)" ::: "memory")

typedef float f2v __attribute__((ext_vector_type(2)));
typedef __bf16 b2v __attribute__((ext_vector_type(2)));
__device__ __forceinline__ unsigned pk2(float lo, float hi) { f2v v = {lo, hi}; b2v b = __builtin_convertvector(v, b2v); return __builtin_bit_cast(unsigned, b); }
__device__ __forceinline__ float bflo(unsigned u) { return __uint_as_float(u << 16); }
__device__ __forceinline__ float bfhi(unsigned u) { return __uint_as_float(u & 0xffff0000u); }
__device__ __forceinline__ float fast_exp2(float x) { return __builtin_amdgcn_exp2f(x); }
__device__ __forceinline__ float sigmoidf_(float x) { return __builtin_amdgcn_rcpf(1.f + fast_exp2(-1.4426950408889634f * x)); }

namespace pg8 {
#define PG8_LAS __attribute__((address_space(3)))
typedef unsigned short bf16_t;
typedef short bf16x8 __attribute__((ext_vector_type(8)));
typedef float f32x4 __attribute__((ext_vector_type(4)));
typedef unsigned u32x4 __attribute__((ext_vector_type(4)));
constexpr int BM = 256, BK = 64, HALF = 128, HTB = HALF * BK * 2  , STAGE_BYTES = 8 * HTB, NXCD = 8, WGM = 8;

__host__ __device__ __forceinline__ int lds_byte(int r, int c) { const int st = (r >> 4) * 2 + (c >> 5), rr = r & 15, cc = c & 31, ob = rr * 64 + cc * 2; return st * 1024 + (ob ^ (((ob >> 9) & 1) << 5)); }
__host__ __device__ __forceinline__ void stage_rc(int b, int& R, int& C) { const int st = b / 1024, sb = b % 1024, swz = sb ^ (((sb >> 9) & 1) << 5); R = (st >> 1) * 16 + swz / 64; C = (st & 1) * 32 + (swz % 64) / 2; }
__host__ __device__ __forceinline__ int perm32(int rho) { const int n = rho >> 4, i = rho & 15; return 8 * (i >> 2) + 4 * n + (i & 3); }

struct Unit { int pm, pn; };
struct Gemm { const bf16_t* A; const bf16_t* Bt; int M, N, K; };

struct StaticOrder {
    int nM, nN, nwg, G, c;
    __host__ __device__ void init(int M, int N, int G_, int c_) { nM = M / BM; nN = N / BM; nwg = nM * nN; G = G_; c = c_; }
    __host__ __device__ bool next(int i, Unit& u) const {
        const long L = (long)i * G + c; if (L >= nwg) return false;
        int wgid = (int)L; { const int q = nwg / NXCD, r = nwg % NXCD, xcd = wgid % NXCD, off = wgid / NXCD; wgid = (xcd < r ? xcd * (q + 1) : r * (q + 1) + (xcd - r) * q) + off; }
        const int nig = WGM * nN, gid = wgid / nig, fm = gid * WGM, gsz = (nM - fm) < WGM ? (nM - fm) : WGM;
        u.pm = fm + ((wgid % nig) % gsz); u.pn = (wgid % nig) / gsz; return true;
    }
    __device__ __forceinline__ void a_ready(const Unit&) const {}
    __device__ __forceinline__ void done(const Unit&) const {}
};
template <class Epi, class Sched, bool ALIGN_EPI = false, bool SP2 = false>
__device__ __forceinline__ void gemm_phase(PG8_LAS unsigned char* lds, const Gemm g, const Sched& S, const Epi& E) {
    int tid_ = threadIdx.x; asm volatile("" : "+v"(tid_));
    const int tid = tid_, wid = __builtin_amdgcn_readfirstlane(tid >> 6), lane = tid & 63, wr = wid >> 2, wc = wid & 3, fr = lane & 15, fq = lane >> 4;
    const int K = g.K, nt = K / BK;
    unsigned voffA[2], voffB[2];
#pragma unroll
    for (int i = 0; i < 2; ++i) { int R, C; stage_rc(tid * 16 + i * 8192, R, C); const int Rb = Epi::PERM ? ((R & ~31) + perm32(R & 31)) : R;
        voffA[i] = (unsigned)(R * K + C) * 2u; voffB[i] = (unsigned)(Rb * K + C) * 2u; }
    const size_t kstep = (size_t)(BK * 2);
    const size_t hstep = (size_t)HALF * K * 2;
    const size_t tstep = 2 * hstep;
    const unsigned ldsw = (unsigned)wid * 1024u;
    const int aoff = lds_byte(wr * 64 + fr, fq * 8), boff = lds_byte(wc * 32 + fr, fq * 8);
#define PG8_SA(b, h) (((b) * 2 + (h)) * HTB)
#define PG8_SB(b, h) ((4 + (b) * 2 + (h)) * HTB)
#define PG8_STAGE(bufoff, gbase, voff) do { _Pragma("unroll") for (int _i = 0; _i < 2; ++_i) \
        __builtin_amdgcn_global_load_lds((const unsigned*)((const char*)(gbase) + (voff)[_i]), (PG8_LAS unsigned*)(lds + (bufoff) + ldsw + _i * 8192), 16, 0, 0); } while (0)
#define PG8_LDA(dst, b, h) do { _Pragma("unroll") for (int m = 0; m < 4; ++m) _Pragma("unroll") for (int k = 0; k < 2; ++k) dst[m][k] = *(const PG8_LAS bf16x8*)(lds + PG8_SA(b, h) + aoff + m * 2048 + k * 1024); } while (0)
#define PG8_LDB(dst, b, h) do { _Pragma("unroll") for (int n = 0; n < 2; ++n) _Pragma("unroll") for (int k = 0; k < 2; ++k) dst[n][k] = *(const PG8_LAS bf16x8*)(lds + PG8_SB(b, h) + boff + n * 2048 + k * 1024); } while (0)
#define PG8_MMA(ai, bj, At, Bt) do { __builtin_amdgcn_s_setprio(1); _Pragma("unroll") for (int m = 0; m < 4; ++m) _Pragma("unroll") for (int n = 0; n < 2; ++n) _Pragma("unroll") for (int k = 0; k < 2; ++k) \
        acc[ai][bj][m][n] = __builtin_amdgcn_mfma_f32_16x16x32_bf16(Bt[n][k], At[m][k], acc[ai][bj][m][n], 0, 0, 0); __builtin_amdgcn_s_setprio(0); } while (0)
#define PG8_WAIT_V(n) asm volatile("s_waitcnt vmcnt(" #n ")" ::: "memory")
#define PG8_WAIT_L(n) asm volatile("s_waitcnt lgkmcnt(" #n ")" ::: "memory")
#define PG8_BAR __builtin_amdgcn_s_barrier()
#define PG8_SCHED __builtin_amdgcn_sched_barrier(0)
    Unit cur, nxt; int ui = 0;
    if (!S.next(0, cur)) return;
    f32x4 acc[2][2][4][2];
#pragma unroll
    for (int a = 0; a < 2; ++a)
#pragma unroll
        for (int b = 0; b < 2; ++b)
#pragma unroll
            for (int m = 0; m < 4; ++m)
#pragma unroll
                for (int n = 0; n < 2; ++n) acc[a][b][m][n] = (f32x4){0.f, 0.f, 0.f, 0.f};
    bf16x8 At[4][2], B0[2][2], B1[2][2];
    const char* cA = (const char*)g.A + (size_t)cur.pm * tstep; const char* cB = (const char*)g.Bt + (size_t)cur.pn * tstep;
    S.a_ready(cur);
    if constexpr (SP2) {
        PG8_STAGE(PG8_SB(0, 0), cB, voffB); PG8_STAGE(PG8_SB(0, 1), cB + hstep, voffB); PG8_STAGE(PG8_SA(0, 0), cA, voffA); PG8_STAGE(PG8_SA(0, 1), cA + hstep, voffA);
        if (wr == 1) PG8_BAR;
        PG8_WAIT_V(2); PG8_BAR;
        PG8_STAGE(PG8_SB(1, 0), cB + kstep, voffB); PG8_STAGE(PG8_SA(1, 0), cA + kstep, voffA); PG8_STAGE(PG8_SB(1, 1), cB + hstep + kstep, voffB);
        PG8_WAIT_V(6); PG8_BAR;
    } else {
        PG8_STAGE(PG8_SB(0, 0), cB, voffB); PG8_STAGE(PG8_SA(0, 0), cA, voffA); PG8_STAGE(PG8_SB(0, 1), cB + hstep, voffB); PG8_STAGE(PG8_SA(0, 1), cA + hstep, voffA);
        if (wr == 1) PG8_BAR;
        PG8_WAIT_V(4); PG8_BAR;
        PG8_STAGE(PG8_SB(1, 0), cB + kstep, voffB); PG8_STAGE(PG8_SA(1, 0), cA + kstep, voffA); PG8_STAGE(PG8_SB(1, 1), cB + hstep + kstep, voffB);
        PG8_WAIT_V(6); PG8_BAR;
    }
    for (;;) {
        const bool has_next = S.next(ui + 1, nxt);
        const char* nA = has_next ? (const char*)g.A + (size_t)nxt.pm * tstep : cA; const char* nB = has_next ? (const char*)g.Bt + (size_t)nxt.pn * tstep : cB;
        for (int t = 0; t < nt; t += 2) {
            const bool last = (t == nt - 2);
            const char* a1 = cA + (size_t)(t + 1) * kstep;
            const char* a2 = last ? nA : cA + (size_t)(t + 2) * kstep; const char* b2 = last ? nB : cB + (size_t)(t + 2) * kstep;
            const char* a3 = a2 + kstep; const char* b3 = b2 + kstep;
            if (last && has_next) S.a_ready(nxt);
            if constexpr (SP2) {
            PG8_LDB(B0, 0, 0); PG8_LDB(B1, 0, 1); PG8_SCHED; PG8_LDA(At, 0, 0); PG8_STAGE(PG8_SA(1, 1), a1 + hstep, voffA);
            PG8_WAIT_V(8); PG8_WAIT_L(0); PG8_BAR; PG8_MMA(0, 0, At, B0); PG8_MMA(0, 1, At, B1); PG8_BAR; PG8_SCHED;
            PG8_LDA(At, 0, 1); PG8_STAGE(PG8_SB(0, 0), b2, voffB); PG8_STAGE(PG8_SB(0, 1), b2 + hstep, voffB); PG8_STAGE(PG8_SA(0, 0), a2, voffA);
            PG8_WAIT_V(8); PG8_WAIT_L(0); PG8_BAR; PG8_MMA(1, 0, At, B0); PG8_MMA(1, 1, At, B1); PG8_BAR; PG8_SCHED;
            PG8_LDB(B0, 1, 0); PG8_LDB(B1, 1, 1); PG8_SCHED; PG8_LDA(At, 1, 0); PG8_STAGE(PG8_SA(0, 1), a2 + hstep, voffA);
            PG8_WAIT_V(8); PG8_WAIT_L(0); PG8_BAR; PG8_MMA(0, 0, At, B0); PG8_MMA(0, 1, At, B1); PG8_BAR; PG8_SCHED;
            PG8_LDA(At, 1, 1); PG8_STAGE(PG8_SB(1, 0), b3, voffB); PG8_STAGE(PG8_SB(1, 1), b3 + hstep, voffB); PG8_STAGE(PG8_SA(1, 0), a3, voffA);
            PG8_WAIT_V(8); PG8_WAIT_L(0); PG8_BAR; PG8_MMA(1, 0, At, B0); PG8_MMA(1, 1, At, B1); PG8_BAR; PG8_SCHED;
            } else {
            PG8_LDB(B0, 0, 0); PG8_SCHED; PG8_LDA(At, 0, 0); PG8_STAGE(PG8_SA(1, 1), a1 + hstep, voffA);
            PG8_WAIT_L(8); PG8_BAR; PG8_WAIT_L(0); PG8_MMA(0, 0, At, B0); PG8_BAR; PG8_SCHED;
            PG8_LDB(B1, 0, 1); PG8_STAGE(PG8_SB(0, 0), b2, voffB);
            PG8_BAR; PG8_WAIT_L(0); PG8_MMA(0, 1, At, B1); PG8_BAR;
            PG8_LDA(At, 0, 1); PG8_STAGE(PG8_SA(0, 0), a2, voffA);
            PG8_BAR; PG8_WAIT_L(0); PG8_MMA(1, 0, At, B0); PG8_BAR; PG8_SCHED;
            PG8_STAGE(PG8_SB(0, 1), b2 + hstep, voffB);
            PG8_WAIT_V(6); PG8_BAR; PG8_MMA(1, 1, At, B1); PG8_BAR;
            PG8_LDB(B0, 1, 0); PG8_SCHED; PG8_LDA(At, 1, 0); PG8_STAGE(PG8_SA(0, 1), a2 + hstep, voffA);
            PG8_WAIT_L(8); PG8_BAR; PG8_WAIT_L(0); PG8_MMA(0, 0, At, B0); PG8_BAR; PG8_SCHED;
            PG8_LDB(B1, 1, 1); PG8_STAGE(PG8_SB(1, 0), b3, voffB);
            PG8_BAR; PG8_WAIT_L(0); PG8_MMA(0, 1, At, B1); PG8_BAR;
            PG8_LDA(At, 1, 1); PG8_STAGE(PG8_SA(1, 0), a3, voffA);
            PG8_BAR; PG8_WAIT_L(0); PG8_MMA(1, 0, At, B0); PG8_BAR; PG8_SCHED;
            PG8_STAGE(PG8_SB(1, 1), b3 + hstep, voffB);
            PG8_WAIT_V(6); PG8_BAR; PG8_MMA(1, 1, At, B1); PG8_BAR;
            }
        }
        if constexpr (ALIGN_EPI) { if (wr == 0) PG8_BAR; }
        if constexpr (!Epi::AFTER_DRAIN) { E(acc, cur, wr, wc, fr, fq); S.done(cur); }
        if (!has_next) break;
#pragma unroll
        for (int a = 0; a < 2; ++a)
#pragma unroll
            for (int b = 0; b < 2; ++b)
#pragma unroll
                for (int m = 0; m < 4; ++m)
#pragma unroll
                    for (int n = 0; n < 2; ++n) acc[a][b][m][n] = (f32x4){0.f, 0.f, 0.f, 0.f};
        cur = nxt; cA = nA; cB = nB; ++ui;
        if constexpr (ALIGN_EPI) { if (wr == 1) PG8_BAR; }
    }
    PG8_WAIT_V(0);
    if constexpr (!ALIGN_EPI) { if (wr == 0) PG8_BAR; }
    PG8_BAR;
    if constexpr (Epi::AFTER_DRAIN) { E.fused(acc, cur, wr, wc, fr, fq, lds, wid, lane); S.done(cur); }
#undef PG8_SA
#undef PG8_SB
#undef PG8_STAGE
#undef PG8_LDA
#undef PG8_LDB
#undef PG8_MMA
#undef PG8_WAIT_V
#undef PG8_WAIT_L
#undef PG8_BAR
#undef PG8_SCHED
}

__device__ __forceinline__ float rstd_of(const float* ss, int row, int fq) {
    const f32x4 v = *(const f32x4*)(ss + (size_t)row * 16 + 4 * fq);
    float s = (v[0] + v[1]) + (v[2] + v[3]);
    s += __shfl_xor(s, 16); s += __shfl_xor(s, 32);
    return __builtin_amdgcn_rsqf(s * (1.f / 1024.f) + 1e-6f);
}
template <bool NORM> struct EpiRaw {
    static constexpr bool PERM = true, AFTER_DRAIN = false;
    bf16_t* O; int ldc; const float* ss;
    __device__ __forceinline__ void operator()(const f32x4 (&acc)[2][2][4][2], const Unit& u, int wr, int wc, int fr, int fq) const {
        const int row0 = u.pm * BM + wr * 64 + fr, col0 = u.pn * BM + wc * 32 + 8 * fq;
#pragma unroll
        for (int ai = 0; ai < 2; ++ai)
#pragma unroll
            for (int m = 0; m < 4; ++m) { const int row = row0 + ai * HALF + m * 16; const float r = NORM ? rstd_of(ss, row, fq) : 1.f;
                bf16_t* rowp = O + (size_t)row * ldc + col0;
#pragma unroll
                for (int bj = 0; bj < 2; ++bj) { const f32x4 v0 = acc[ai][bj][m][0] * r, v1 = acc[ai][bj][m][1] * r;
                    u32x4 w; w.x = pk2(v0[0], v0[1]); w.y = pk2(v0[2], v0[3]); w.z = pk2(v1[0], v1[1]); w.w = pk2(v1[2], v1[3]);
                    *(u32x4*)(rowp + bj * HALF) = w; } }
    }
};
struct EpiSwiglu {
    static constexpr bool PERM = true, AFTER_DRAIN = false;
    bf16_t* H; const float* ss;
    __device__ __forceinline__ void operator()(const f32x4 (&acc)[2][2][4][2], const Unit& u, int wr, int wc, int fr, int fq) const {
        const int row0 = u.pm * BM + wr * 64 + fr, col0 = u.pn * HALF + wc * 32 + 8 * fq;
#pragma unroll
        for (int ai = 0; ai < 2; ++ai)
#pragma unroll
            for (int m = 0; m < 4; ++m) { const int row = row0 + ai * HALF + m * 16; const float r = rstd_of(ss, row, fq);
                float h[8];
#pragma unroll
                for (int n = 0; n < 2; ++n)
#pragma unroll
                    for (int e = 0; e < 4; ++e) { const float g = acc[ai][0][m][n][e] * r, uu = acc[ai][1][m][n][e] * r; h[4 * n + e] = g * sigmoidf_(g) * uu; }
                u32x4 w; w.x = pk2(h[0], h[1]); w.y = pk2(h[2], h[3]); w.z = pk2(h[4], h[5]); w.w = pk2(h[6], h[7]);
                *(u32x4*)(H + (size_t)row * FF + col0) = w; }
    }
};
template <bool GATE, bool FINAL> struct EpiResid {
    static constexpr bool PERM = true, AFTER_DRAIN = false;
    const bf16_t* XBi; float* Y; bf16_t* XBo; float* SSo; float scale; const float* ss_in; const bf16_t* P;
    __device__ __forceinline__ void operator()(const f32x4 (&acc)[2][2][4][2], const Unit& u, int wr, int wc, int fr, int fq) const {
        const int row0 = u.pm * BM + wr * 64 + fr, col0 = u.pn * BM + wc * 32 + 8 * fq;
#pragma unroll
        for (int ai = 0; ai < 2; ++ai)
#pragma unroll
            for (int m = 0; m < 4; ++m) { const int row = row0 + ai * HALF + m * 16; float r = 0.f; if (GATE) r = rstd_of(ss_in, row, fq);
                float sq = 0.f;
#pragma unroll
                for (int bj = 0; bj < 2; ++bj) { const size_t off = (size_t)row * D + col0 + bj * HALF; const u32x4 xw = *(const u32x4*)(XBi + off);
                    f32x4 x0 = (f32x4){bflo(xw.x), bfhi(xw.x), bflo(xw.y), bfhi(xw.y)}, x1 = (f32x4){bflo(xw.z), bfhi(xw.z), bflo(xw.w), bfhi(xw.w)}; const f32x4 a0 = acc[ai][bj][m][0], a1 = acc[ai][bj][m][1];
                    if (GATE) { const u32x4 pw = *(const u32x4*)(P + off);
                        x0[0] += sigmoidf_(a0[0] * r) * bflo(pw.x); x0[1] += sigmoidf_(a0[1] * r) * bfhi(pw.x); x0[2] += sigmoidf_(a0[2] * r) * bflo(pw.y); x0[3] += sigmoidf_(a0[3] * r) * bfhi(pw.y);
                        x1[0] += sigmoidf_(a1[0] * r) * bflo(pw.z); x1[1] += sigmoidf_(a1[1] * r) * bfhi(pw.z); x1[2] += sigmoidf_(a1[2] * r) * bflo(pw.w); x1[3] += sigmoidf_(a1[3] * r) * bfhi(pw.w);
                    } else { x0 += a0 * scale; x1 += a1 * scale; }
                    if (FINAL) { *(f32x4*)(Y + off) = x0; *(f32x4*)(Y + off + 4) = x1; }
                    else { u32x4 w; w.x = pk2(x0[0], x0[1]); w.y = pk2(x0[2], x0[3]); w.z = pk2(x1[0], x1[1]); w.w = pk2(x1[2], x1[3]);
                        *(u32x4*)(XBo + off) = w;
                        sq += (x0[0] * x0[0] + x0[1] * x0[1]) + (x0[2] * x0[2] + x0[3] * x0[3]) + (x1[0] * x1[0] + x1[1] * x1[1]) + (x1[2] * x1[2] + x1[3] * x1[3]); } }
                if (!FINAL) { sq += __shfl_xor(sq, 16); sq += __shfl_xor(sq, 32); if (fq == 0) SSo[(size_t)row * 16 + u.pn * 4 + wc] = sq; } }
    }
};
}
typedef pg8::StaticOrder GOrder;

#define XB_TMO      128
#define XB_XCNT(j)  (256  + 64 * (j))
#define XB_XSUB(j)  (1280 + 64 * (j))
#define XB_XGEN(j)  (2304 + 64 * (j))
#define XB_TOP      3328
#define XB_TOPGEN   3392
#define XCD_BAR_WORDS 3456
#define XB_SPIN_CAP (1u << 18)

__device__ __forceinline__ unsigned xb_ld(unsigned* p)              { return __hip_atomic_load(p, __ATOMIC_RELAXED, __HIP_MEMORY_SCOPE_AGENT); }
__device__ __forceinline__ unsigned xb_add(unsigned* p, unsigned v) { return __hip_atomic_fetch_add(p, v, __ATOMIC_RELAXED, __HIP_MEMORY_SCOPE_AGENT); }
__device__ __forceinline__ unsigned xb_xcc_id() { return (unsigned)__builtin_amdgcn_s_getreg((3 << 11) | 20) & 0xFu; }
#define XB_SPIN(cond, bar) do { unsigned _sp = 0; while (cond) { __builtin_amdgcn_s_sleep(1); \
    if ((++_sp & 255u) == 0u) { if (xb_ld(&(bar)[XB_TMO])) break; if (_sp > XB_SPIN_CAP) { atomicAdd(&(bar)[XB_TMO], 1u); break; } } } } while (0)

struct XcdBarrier {
    unsigned* bar; unsigned x;
    volatile LAS unsigned* st;
};

__device__ __forceinline__ XcdBarrier xcd_barrier_post(unsigned* bar, volatile LAS unsigned* st) {
    XcdBarrier b; b.bar = bar; b.x = xb_xcc_id(); b.st = st;
    if (threadIdx.x == 0) (void)xb_add(&bar[XB_XCNT(b.x)], 1u);
    return b;
}
__device__ __forceinline__ void xcd_barrier_complete(unsigned* bar, unsigned x, unsigned& nloc, unsigned& nx) {
    const unsigned G = gridDim.x * gridDim.y * gridDim.z;
    unsigned sum, cnt, mine, sp = 0u;
    for (;;) {
        sum = 0u; cnt = 0u; mine = 0u;
#pragma unroll
        for (unsigned j = 0; j < 16; ++j) { const unsigned c = xb_ld(&bar[XB_XCNT(j)]); sum += c; cnt += (c > 0u) ? 1u : 0u; mine = (j == x) ? c : mine; }
        if (sum == G) break;
        __builtin_amdgcn_s_sleep(1);
        if ((++sp & 255u) == 0u) { if (xb_ld(&bar[XB_TMO])) break; if (sp > XB_SPIN_CAP) { atomicAdd(&bar[XB_TMO], 1u); break; } }
    }
    nloc = mine > 0u ? mine : 1u; nx = cnt > 0u ? cnt : 1u;
}

__device__ __forceinline__ void xcd_barrier(const XcdBarrier& b) {
    asm volatile("s_waitcnt vmcnt(0)" ::: "memory");
    __syncthreads();
    if (threadIdx.x == 0) {
        unsigned* bar = b.bar;
        __builtin_amdgcn_s_waitcnt(0);
        unsigned nloc = b.st[0], nx = b.st[1];
        if (nloc == 0u) { xcd_barrier_complete(bar, b.x, nloc, nx); b.st[0] = nloc; b.st[1] = nx; }
        const unsigned old = xb_add(&bar[XB_XSUB(b.x)], 1u);
        const unsigned gen = old / nloc;
        if (old + 1u == (gen + 1u) * nloc) {
            __builtin_amdgcn_fence(__ATOMIC_RELEASE, "agent");
            asm volatile("s_waitcnt vmcnt(0)" ::: "memory");
            const unsigned og = xb_add(&bar[XB_TOP], 1u);
            const unsigned tg = og / nx;
            if (og + 1u == (tg + 1u) * nx) xb_add(&bar[XB_TOPGEN], 1u);
            else XB_SPIN(xb_ld(&bar[XB_TOPGEN]) == tg, bar);
            __builtin_amdgcn_fence(__ATOMIC_ACQUIRE, "agent");
            xb_add(&bar[XB_XGEN(b.x)], 1u);
            asm volatile("s_waitcnt vmcnt(0)" ::: "memory");
        } else {
            XB_SPIN(xb_ld(&bar[XB_XGEN(b.x)]) == gen, bar);
            __builtin_amdgcn_fence(__ATOMIC_ACQUIRE, "agent");
            asm volatile("s_waitcnt vmcnt(0)" ::: "memory");
        }
    }
    __syncthreads();
}

__device__ __forceinline__ float wave_sum(float v) {
#pragma unroll
    for (int o = 1; o < 64; o <<= 1) v += __shfl_xor(v, o);
    return v;
}
__device__ __forceinline__ void st_bf16x8(bf16* p, const float* v) { v4u w; w.x = pk2(v[0], v[1]); w.y = pk2(v[2], v[3]); w.z = pk2(v[4], v[5]); w.w = pk2(v[6], v[7]); *(v4u*)p = w; }
__device__ __forceinline__ void ld_bf16x8(const bf16* p, float* v) { const v4u w = *(const v4u*)p; v[0] = bflo(w.x); v[1] = bfhi(w.x); v[2] = bflo(w.y); v[3] = bfhi(w.y); v[4] = bflo(w.z); v[5] = bfhi(w.z); v[6] = bflo(w.w); v[7] = bfhi(w.w); }

template <int MODE> __device__ __forceinline__ int sk_brow(int cu, int j) {
    if (MODE == 0) return cu * 64 + j;
    const int T = cu >> 2, q = cu & 3; return T * 256 + q * 32 + (j & 31) + ((j >> 5) ? 128 : 0);
}
template <int MODE, class Epi>
__device__ __forceinline__ void skinny_phase(LAS unsigned char* lds, const bf16* A, const bf16* Bt, int K, int ncu, const Epi& E, int first, int stride) {
    int tid_ = threadIdx.x; asm volatile("" : "+v"(tid_));
    const int tid = tid_, wave = __builtin_amdgcn_readfirstlane(tid >> 6), lane = tid & 63, fr = lane & 15, fq = lane >> 4;
    LAS float* part = (LAS float*)lds;
    LAS float* tile = (LAS float*)(lds + 65536);
    const int kw = K >> 3, k0 = wave * kw, nst = kw >> 5;
    for (int un = first; un < 4 * ncu; un += stride) {
        const int rb = un & 3, cu = un >> 2;
        f32x4 acc[2][4];
#pragma unroll
        for (int i = 0; i < 2; ++i)
#pragma unroll
            for (int c = 0; c < 4; ++c) acc[i][c] = (f32x4){0.f, 0.f, 0.f, 0.f};
        const bf16* ap = A + (size_t)(rb * 32 + fr) * K + k0 + 8 * fq;
        const bf16* bp0 = Bt + (size_t)sk_brow<MODE>(cu, fr) * K + k0 + 8 * fq;
        const bf16* bp1 = Bt + (size_t)sk_brow<MODE>(cu, 16 + fr) * K + k0 + 8 * fq;
        const bf16* bp2 = Bt + (size_t)sk_brow<MODE>(cu, 32 + fr) * K + k0 + 8 * fq;
        const bf16* bp3 = Bt + (size_t)sk_brow<MODE>(cu, 48 + fr) * K + k0 + 8 * fq;
#pragma unroll 2
        for (int s = 0; s < nst; ++s) {
            const bf16x8 a0 = *(const bf16x8*)(ap + 32 * s), a1 = *(const bf16x8*)(ap + (size_t)16 * K + 32 * s);
            const bf16x8 b0 = *(const bf16x8*)(bp0 + 32 * s), b1 = *(const bf16x8*)(bp1 + 32 * s), b2 = *(const bf16x8*)(bp2 + 32 * s), b3 = *(const bf16x8*)(bp3 + 32 * s);
            acc[0][0] = __builtin_amdgcn_mfma_f32_16x16x32_bf16(a0, b0, acc[0][0], 0, 0, 0); acc[1][0] = __builtin_amdgcn_mfma_f32_16x16x32_bf16(a1, b0, acc[1][0], 0, 0, 0);
            acc[0][1] = __builtin_amdgcn_mfma_f32_16x16x32_bf16(a0, b1, acc[0][1], 0, 0, 0); acc[1][1] = __builtin_amdgcn_mfma_f32_16x16x32_bf16(a1, b1, acc[1][1], 0, 0, 0);
            acc[0][2] = __builtin_amdgcn_mfma_f32_16x16x32_bf16(a0, b2, acc[0][2], 0, 0, 0); acc[1][2] = __builtin_amdgcn_mfma_f32_16x16x32_bf16(a1, b2, acc[1][2], 0, 0, 0);
            acc[0][3] = __builtin_amdgcn_mfma_f32_16x16x32_bf16(a0, b3, acc[0][3], 0, 0, 0); acc[1][3] = __builtin_amdgcn_mfma_f32_16x16x32_bf16(a1, b3, acc[1][3], 0, 0, 0);
        }
#pragma unroll
        for (int i = 0; i < 2; ++i)
#pragma unroll
            for (int c = 0; c < 4; ++c)
#pragma unroll
                for (int r = 0; r < 4; ++r) part[wave * 2048 + (i * 16 + 4 * fq + r) * 64 + c * 16 + fr] = acc[i][c][r];
        __syncthreads();
        { const int row = tid >> 4, cg = tid & 15; f32x4 s = (f32x4){0.f, 0.f, 0.f, 0.f};
#pragma unroll
          for (int w = 0; w < 8; ++w) s += *(const LAS f32x4*)(part + w * 2048 + row * 64 + 4 * cg);
          *(LAS f32x4*)(tile + row * 64 + 4 * cg) = s; }
        __syncthreads();
        E(tile, rb, cu, tid);
        __syncthreads();
    }
}
__device__ __forceinline__ float sk_rstd(const float* ss, int grow, int cg) {
    float s = ss[(size_t)grow * 16 + cg];
    s += __shfl_xor(s, 1); s += __shfl_xor(s, 2); s += __shfl_xor(s, 4); s += __shfl_xor(s, 8);
    return __builtin_amdgcn_rsqf(s * (1.f / 1024.f) + 1e-6f);
}
template <bool NORM> struct SkRaw { bf16* O; int ldc; const float* ss;
    __device__ __forceinline__ void operator()(const LAS float* tile, int rb, int cu, int tid) const {
        const int row = tid >> 4, cg = tid & 15, grow = MP + rb * 32 + row; const float r = NORM ? sk_rstd(ss, grow, cg) : 1.f;
        const f32x4 v = *(const LAS f32x4*)(tile + row * 64 + 4 * cg) * r; const int col = cu * 64 + 4 * cg;
        if (col < ldc) { v2u w; w.x = pk2(v[0], v[1]); w.y = pk2(v[2], v[3]); *(v2u*)(O + (size_t)grow * ldc + col) = w; }
    } };
struct SkSwiglu { bf16* H; const float* ss;
    __device__ __forceinline__ void operator()(const LAS float* tile, int rb, int cu, int tid) const {
        const int row = tid >> 4, cg = tid & 15, grow = MP + rb * 32 + row; const float r = sk_rstd(ss, grow, cg);
        if (cg < 8) { const f32x4 g = *(const LAS f32x4*)(tile + row * 64 + 4 * cg) * r, u = *(const LAS f32x4*)(tile + row * 64 + 32 + 4 * cg) * r;
            float h[4];
#pragma unroll
            for (int e = 0; e < 4; ++e) h[e] = g[e] * sigmoidf_(g[e]) * u[e];
            v2u w; w.x = pk2(h[0], h[1]); w.y = pk2(h[2], h[3]); *(v2u*)(H + (size_t)grow * FF + cu * 32 + 4 * cg) = w; }
    } };
template <bool GATE> struct SkResid { const bf16* XBi; float* Y; bf16* XBo; float* SSo; float scale; const float* ss_in; const bf16* P; int fin;
    __device__ __forceinline__ void operator()(const LAS float* tile, int rb, int cu, int tid) const {
        const int row = tid >> 4, cg = tid & 15, grow = MP + rb * 32 + row, col = cu * 64 + 4 * cg; float r = 0.f; if (GATE) r = sk_rstd(ss_in, grow, cg);
        const f32x4 a = *(const LAS f32x4*)(tile + row * 64 + 4 * cg); const size_t off = (size_t)grow * D + col; const v2u xw = *(const v2u*)(XBi + off);
        f32x4 x = (f32x4){bflo(xw.x), bfhi(xw.x), bflo(xw.y), bfhi(xw.y)};
        if (GATE) { const v2u pw = *(const v2u*)(P + off);
            x[0] += sigmoidf_(a[0] * r) * bflo(pw.x); x[1] += sigmoidf_(a[1] * r) * bfhi(pw.x); x[2] += sigmoidf_(a[2] * r) * bflo(pw.y); x[3] += sigmoidf_(a[3] * r) * bfhi(pw.y);
        } else x += a * scale;
        float sq = (x[0] * x[0] + x[1] * x[1]) + (x[2] * x[2] + x[3] * x[3]);
        sq += __shfl_xor(sq, 1); sq += __shfl_xor(sq, 2); sq += __shfl_xor(sq, 4); sq += __shfl_xor(sq, 8);
        if (fin) *(f32x4*)(Y + off) = x;
        else { v2u w; w.x = pk2(x[0], x[1]); w.y = pk2(x[2], x[3]); *(v2u*)(XBo + off) = w; if (cg == 0) SSo[(size_t)grow * 16 + cu] = sq; }
    } };

__device__ __forceinline__ void transpose_item(const float* W, int K, int N, int Nd, bf16* WT, const float* gain, int mode, LAS float* scr, int item, int lane) {
    const int nblk = Nd / 32, kb = item / nblk, nb = item % nblk, k0 = 64 * kb, n0 = 32 * nb;
    const int n4 = 4 * (lane & 7), n = n0 + n4;
#pragma unroll
    for (int i = 0; i < 8; ++i) { const int kk = 8 * i + (lane >> 3); f32x4 v = (f32x4){0.f, 0.f, 0.f, 0.f}; if (n < N) v = *(const f32x4*)(W + (size_t)(k0 + kk) * N + n); if (gain) v *= gain[k0 + kk];
        scr[kk * 33 + n4] = v[0]; scr[kk * 33 + n4 + 1] = v[1]; scr[kk * 33 + n4 + 2] = v[2]; scr[kk * 33 + n4 + 3] = v[3]; }
    LDS_WAIT(); asm volatile("" ::: "memory");
    const int c = lane & 7;
#pragma unroll
    for (int j = 0; j < 4; ++j) { const int nl = (lane >> 3) + 8 * j, nn = n0 + nl; const LAS float* s = scr + (8 * c) * 33 + nl;
        int drow = nn; if (mode == 1) { const int jj = nn < FF ? nn : nn - FF; drow = (jj >> 7) * 256 + (jj & 127) + (nn < FF ? 0 : 128); }
        v4u o; o.x = pk2(s[0 * 33], s[1 * 33]); o.y = pk2(s[2 * 33], s[3 * 33]); o.z = pk2(s[4 * 33], s[5 * 33]); o.w = pk2(s[6 * 33], s[7 * 33]);
        *(GAS v4u*)(WT + (size_t)drow * K + k0 + 8 * c) = o; }
    LDS_WAIT(); asm volatile("" ::: "memory");
}
struct In {
    const float *x_prompt, *x_sample, *state_conv, *ck_cmp, *cv_cmp, *ck_sel, *cv_sel, *ck_win, *cv_win; const int* page_table; const float *p_prompt, *p_sample, *norm_g, *w_gu, *w_down,
        *w_proj, *w_gate, *cw_in, *cw, *cw_out, *nw_in, *qk_g, *cmp_pos, *cmp_w1, *cmp_w2, *nw_out;
};
__device__ __forceinline__ void sincos_d(double r, float& s, float& c) {
    const double r2 = r * r;
    double sp = 1.0, cp = 1.0;
#pragma unroll
    for (int k = 12; k >= 1; --k) { sp = 1.0 - sp * r2 / (double)((2 * k) * (2 * k + 1)); cp = 1.0 - cp * r2 / (double)((2 * k - 1) * (2 * k)); }
    s = (float)(r * sp); c = (float)cp;
}
__device__ __forceinline__ void p0_prologue(const In& I, float* out, unsigned char* ws, LAS unsigned char* lds, int vcu, int G, int wave, int lane) {
    LAS float* scr = (LAS float*)(lds + wave * 16384);
    const int gw = vcu * NWAVES + wave, NGW = G * NWAVES;
    constexpr int I_GU = (D / 64) * (NGU / 32), I_DN = (FF / 64) * (D / 32), I_SQ = (D / 64) * (D / 32), I_PR = (PLE / 64) * (D / 32), I_CI = (D / 64) * (NCV / 32), I_NI = (D / 64) * (NNSP / 32),
                  I_W1 = (4096 / 64) * (128 / 32), I_W2 = (128 / 64) * (64 / 32);
    constexpr int NITEMS = 4 * I_GU + 4 * I_DN + 2 * I_SQ + 2 * I_PR + I_CI + I_SQ + I_NI + I_SQ + 2 * I_W1 + 2 * I_W2;
#define TR(W_, K_, N_, ND_, WT_, G_, MODE_, NI_) if (r < (NI_)) { transpose_item(W_, K_, N_, ND_, WT_, G_, MODE_, scr, r, lane); continue; } r -= (NI_);
    for (int it = gw; it < NITEMS; it += NGW) {
        int r = it;
        TR(I.w_gu + (size_t)0 * D * NGU, D, NGU, NGU, (bf16*)(ws + WS_WGU + 0 * SZ_WGU), I.norm_g + 0 * D, 1, I_GU)
        TR(I.w_gu + (size_t)1 * D * NGU, D, NGU, NGU, (bf16*)(ws + WS_WGU + 1 * SZ_WGU), I.norm_g + 2 * D, 1, I_GU)
        TR(I.w_gu + (size_t)2 * D * NGU, D, NGU, NGU, (bf16*)(ws + WS_WGU + 2 * SZ_WGU), I.norm_g + 4 * D, 1, I_GU)
        TR(I.w_gu + (size_t)3 * D * NGU, D, NGU, NGU, (bf16*)(ws + WS_WGU + 3 * SZ_WGU), I.norm_g + 6 * D, 1, I_GU)
        TR(I.w_down + (size_t)0 * FF * D, FF, D, D, (bf16*)(ws + WS_WDN + 0 * SZ_WDN), nullptr, 0, I_DN)
        TR(I.w_down + (size_t)1 * FF * D, FF, D, D, (bf16*)(ws + WS_WDN + 1 * SZ_WDN), nullptr, 0, I_DN)
        TR(I.w_down + (size_t)2 * FF * D, FF, D, D, (bf16*)(ws + WS_WDN + 2 * SZ_WDN), nullptr, 0, I_DN)
        TR(I.w_down + (size_t)3 * FF * D, FF, D, D, (bf16*)(ws + WS_WDN + 3 * SZ_WDN), nullptr, 0, I_DN)
        TR(I.w_gate + (size_t)0 * D * D, D, D, D, (bf16*)(ws + WS_WGATE + 0 * SZ_WSQ), I.norm_g + 3 * D, 0, I_SQ)
        TR(I.w_gate + (size_t)1 * D * D, D, D, D, (bf16*)(ws + WS_WGATE + 1 * SZ_WSQ), I.norm_g + 7 * D, 0, I_SQ)
        TR(I.w_proj + (size_t)0 * PLE * D, PLE, D, D, (bf16*)(ws + WS_WPROJ + 0 * SZ_WPROJ), nullptr, 0, I_PR)
        TR(I.w_proj + (size_t)1 * PLE * D, PLE, D, D, (bf16*)(ws + WS_WPROJ + 1 * SZ_WPROJ), nullptr, 0, I_PR)
        TR(I.cw_in, D, NCV, NCV, (bf16*)(ws + WS_WCIN), I.norm_g + 1 * D, 0, I_CI)
        TR(I.cw_out, D, D, D, (bf16*)(ws + WS_WCOUT), nullptr, 0, I_SQ)
        TR(I.nw_in, D, NNS, NNSP, (bf16*)(ws + WS_WNIN), I.norm_g + 5 * D, 0, I_NI)
        TR(I.nw_out, D, D, D, (bf16*)(ws + WS_WNOUT), nullptr, 0, I_SQ)
        TR(I.cmp_w1 + (size_t)0 * 4096 * 128, 4096, 128, 128, (bf16*)(ws + WS_W1T) + (size_t)0 * 128 * 4096, nullptr, 0, I_W1)
        TR(I.cmp_w1 + (size_t)1 * 4096 * 128, 4096, 128, 128, (bf16*)(ws + WS_W1T) + (size_t)1 * 128 * 4096, nullptr, 0, I_W1)
        TR(I.cmp_w2 + (size_t)0 * 128 * 64, 128, 64, 64, (bf16*)(ws + WS_W2T) + (size_t)0 * 64 * 128, nullptr, 0, I_W2)
        TR(I.cmp_w2 + (size_t)1 * 128 * 64, 128, 64, 64, (bf16*)(ws + WS_W2T) + (size_t)1 * 64 * 128, nullptr, 0, I_W2)
    }
#undef TR
    bf16* XB0 = (bf16*)(ws + WS_XB); float* SS0 = (float*)(ws + WS_SS);
    for (int m = gw; m < MT; m += NGW) {
        const float* src = m < MP ? I.x_prompt + (size_t)m * D : I.x_sample + (size_t)(m - MP) * D;
        const GAS f32x4* xr = (const GAS f32x4*)src + lane;
        GAS v2u* o8 = (GAS v2u*)(XB0 + (size_t)m * D) + lane; float s = 0.f;
#pragma unroll
        for (int j = 0; j < 4; ++j) { const f32x4 v = xr[64 * j]; s += (v[0] * v[0] + v[1] * v[1]) + (v[2] * v[2] + v[3] * v[3]); v2u w; w.x = pk2(v[0], v[1]); w.y = pk2(v[2], v[3]); o8[64 * j] = w; }
        s = wave_sum(s);
        if (lane < 16) SS0[(size_t)m * 16 + lane] = lane == 0 ? s : 0.f;
    }
    bf16* PB = (bf16*)(ws + WS_PB);
    for (int r = gw; r < 2 * MT; r += NGW) { const int l = r / MT, m = r % MT;
        const float* src = m < MP ? I.p_prompt + ((size_t)l * MP + m) * PLE : I.p_sample + ((size_t)l * MS + (m - MP)) * PLE;
        const f32x4 v = ((const GAS f32x4*)src)[lane]; v2u w; w.x = pk2(v[0], v[1]); w.y = pk2(v[2], v[3]); ((GAS v2u*)(PB + (size_t)r * PLE))[lane] = w; }
    float* ROPE = (float*)(ws + WS_ROPE);
    for (int i = gw * 64 + lane; i < 8196 * 32; i += NGW * 64) { const int pos = i >> 5, d = i & 31;
        const float inv = (float)exp2(-(double)d * (13.287712379549449 / 32.0));
        const float ang = (float)pos * inv; const double a = (double)ang, k = rint(a * 0.15915494309189535), rr = a - k * 6.283185307179586;
        float s, c; sincos_d(rr, s, c); ROPE[(size_t)pos * 64 + d] = c; ROPE[(size_t)pos * 64 + 32 + d] = s; }
}

__device__ __forceinline__ void conv_post(const In& I, float* out, unsigned char* ws, int vcu, int G, int wave, int lane) {
    const bf16* CV = (const bf16*)(ws + WS_H); bf16* AC = (bf16*)(ws + WS_AC);
    const int gw = vcu * NWAVES + wave, NGW = G * NWAVES;
    constexpr int NSTRIP_P = MP / 16, NITEM = (NSTRIP_P + SB) * 2;
    for (int it = gw; it < NITEM; it += NGW) {
        const int half = it & 1, st = it >> 1, ch = half * 512 + lane * 8;
        float w0[8], w1[8], w2[8], um2[8], um1[8];
#pragma unroll
        for (int e = 0; e < 8; ++e) { w0[e] = I.cw[ch + e]; w1[e] = I.cw[D + ch + e]; w2[e] = I.cw[2 * D + ch + e]; um2[e] = 0.f; um1[e] = 0.f; }
        int row0, nrow; const bool samp = st >= NSTRIP_P;
        if (!samp) { row0 = st * 16; nrow = 16;
            if ((row0 & (SEQ - 1)) != 0) { float c[8], v[8];
                ld_bf16x8(CV + (size_t)(row0 - 2) * NCV + D + ch, c); ld_bf16x8(CV + (size_t)(row0 - 2) * NCV + 2 * D + ch, v);
#pragma unroll
                for (int e = 0; e < 8; ++e) um2[e] = c[e] * v[e];
                ld_bf16x8(CV + (size_t)(row0 - 1) * NCV + D + ch, c); ld_bf16x8(CV + (size_t)(row0 - 1) * NCV + 2 * D + ch, v);
#pragma unroll
                for (int e = 0; e < 8; ++e) um1[e] = c[e] * v[e]; }
        } else { const int bs = st - NSTRIP_P; row0 = MP + bs * 4; nrow = 4;
#pragma unroll
            for (int e = 0; e < 8; ++e) { um2[e] = I.state_conv[((size_t)bs * 2 + 0) * D + ch + e]; um1[e] = I.state_conv[((size_t)bs * 2 + 1) * D + ch + e]; } }
        for (int i = 0; i < nrow; ++i) { const int row = row0 + i; float b[8], c[8], v[8], o[8], u[8];
            ld_bf16x8(CV + (size_t)row * NCV + ch, b); ld_bf16x8(CV + (size_t)row * NCV + D + ch, c); ld_bf16x8(CV + (size_t)row * NCV + 2 * D + ch, v);
#pragma unroll
            for (int e = 0; e < 8; ++e) { u[e] = c[e] * v[e]; o[e] = b[e] * (w0[e] * um2[e] + w1[e] * um1[e] + w2[e] * u[e]); um2[e] = um1[e]; um1[e] = u[e]; }
            st_bf16x8(AC + (size_t)row * D + ch, o);
            float* so = nullptr;
            if (!samp) { const int t = row & (SEQ - 1); if (t >= SEQ - 2) so = out + O_CONVP + ((size_t)(row >> 13) * 2 + (t - (SEQ - 2))) * D + ch; }
            else if (i >= 2) so = out + O_CONVS + ((size_t)(st - NSTRIP_P) * 2 + (i - 2)) * D + ch;
            if (so) { *(f32x4*)so = (f32x4){u[0], u[1], u[2], u[3]}; *(f32x4*)(so + 4) = (f32x4){u[4], u[5], u[6], u[7]}; } }
    }
}

__device__ __forceinline__ void nsa_post(const In& I, float* out, unsigned char* ws, int vcu, int G, int wave, int lane) {
    const bf16* RAW = (const bf16*)(ws + WS_H); const float* ROPE = (const float*)(ws + WS_ROPE);
    bf16* QN = (bf16*)(ws + WS_QN); bf16* QR = (bf16*)(ws + WS_QR); bf16* KS = (bf16*)(ws + WS_KS); bf16* VS = (bf16*)(ws + WS_VS); bf16* KW = (bf16*)(ws + WS_KW); bf16* VW = (bf16*)(ws + WS_VW);
    float* GATES = (float*)(ws + WS_GATES);
    const int gw = vcu * NWAVES + wave, NGW = G * NWAVES, qd = lane >> 2, p = lane & 3;
    for (int row = gw; row < MT; row += NGW) {
        const bool samp = row >= MP; const int sr = row - MP; const int pos = samp ? PAST + (sr & 3) : (row & (SEQ - 1));
        float cs[8], sn[8];
        { const f32x4 c0 = *(const f32x4*)(ROPE + (size_t)pos * 64 + 8 * p), c1 = *(const f32x4*)(ROPE + (size_t)pos * 64 + 8 * p + 4), s0 = *(const f32x4*)(ROPE + (size_t)pos * 64 + 32 + 8 * p), s1 = *(const f32x4*)(ROPE + (size_t)pos * 64 + 36 + 8 * p);
#pragma unroll
          for (int e = 0; e < 4; ++e) { cs[e] = c0[e]; cs[4 + e] = c1[e]; sn[e] = s0[e]; sn[4 + e] = s1[e]; } }
#pragma unroll
        for (int pass = 0; pass < 3; ++pass) { const int sg = qd + 16 * pass;
            if (sg < 40) {
                float x1[8], x2[8];
                ld_bf16x8(RAW + (size_t)row * NNSP + 64 * sg + 8 * p, x1); ld_bf16x8(RAW + (size_t)row * NNSP + 64 * sg + 32 + 8 * p, x2);
                const int typ = sg < 16 ? 0 : 1 + ((sg - 16) >> 2), g4 = sg & 3;
                const bool nrm = (typ == 0 || typ == 3 || typ == 5);
                if (nrm) { const int gi = typ == 0 ? 0 : (typ == 3 ? 2 : 3); float ssq = 0.f;
#pragma unroll
                    for (int e = 0; e < 8; ++e) ssq += x1[e] * x1[e] + x2[e] * x2[e];
                    ssq += __shfl_xor(ssq, 1); ssq += __shfl_xor(ssq, 2);
                    const float rs = __builtin_amdgcn_rsqf(ssq * (1.f / 64.f) + RMS_EPS);
#pragma unroll
                    for (int e = 0; e < 8; ++e) { x1[e] *= rs * I.qk_g[gi * 64 + 8 * p + e]; x2[e] *= rs * I.qk_g[gi * 64 + 32 + 8 * p + e]; } }
                float y1[8], y2[8];
#pragma unroll
                for (int e = 0; e < 8; ++e) { y1[e] = x1[e] * cs[e] - x2[e] * sn[e]; y2[e] = x2[e] * cs[e] + x1[e] * sn[e]; }
                if (typ == 0) { float a[8], b[8];
#pragma unroll
                    for (int e = 0; e < 8; ++e) { a[e] = x1[e] * QSCALE; b[e] = x2[e] * QSCALE; }
                    st_bf16x8(QN + (size_t)row * D + 64 * sg + 8 * p, a); st_bf16x8(QN + (size_t)row * D + 64 * sg + 32 + 8 * p, b);
#pragma unroll
                    for (int e = 0; e < 8; ++e) { a[e] = y1[e] * QSCALE; b[e] = y2[e] * QSCALE; }
                    st_bf16x8(QR + (size_t)row * D + 64 * sg + 8 * p, a); st_bf16x8(QR + (size_t)row * D + 64 * sg + 32 + 8 * p, b);
                } else {
                    const bool rope = (typ == 3 || typ == 5);
                    float o1[8], o2[8];
#pragma unroll
                    for (int e = 0; e < 8; ++e) { o1[e] = rope ? y1[e] : x1[e]; o2[e] = rope ? y2[e] : x2[e]; }
                    float* fo = nullptr; bf16* bo = nullptr; const size_t co = (size_t)g4 * 64 + 8 * p;
                    if (typ <= 4) { const size_t base = samp ? (typ == 1 ? O_KCS : typ == 2 ? O_VCS : typ == 3 ? O_KSS : O_VSS) + (size_t)sr * KVW : (typ == 1 ? O_KCP : typ == 2 ? O_VCP : typ == 3 ? O_KSP : O_VSP) + (size_t)row * KVW;
                        fo = out + base + co; if (typ == 3) bo = KS + (size_t)row * KVW + co; if (typ == 4) bo = VS + (size_t)row * KVW + co;
                    } else { bo = (typ == 5 ? KW : VW) + (size_t)row * KVW + co;
                        if (samp) fo = out + (typ == 5 ? O_KWS : O_VWS) + ((size_t)(sr >> 2) * 512 + 508 + (sr & 3)) * KVW + co;
                        else { const int t = row & (SEQ - 1); if (t >= SEQ - WIN) fo = out + (typ == 5 ? O_KWP : O_VWP) + ((size_t)(row >> 13) * 512 + (t - (SEQ - WIN))) * KVW + co; } }
                    if (fo) { *(f32x4*)fo = (f32x4){o1[0], o1[1], o1[2], o1[3]}; *(f32x4*)(fo + 4) = (f32x4){o1[4], o1[5], o1[6], o1[7]};
                              *(f32x4*)(fo + 32) = (f32x4){o2[0], o2[1], o2[2], o2[3]}; *(f32x4*)(fo + 36) = (f32x4){o2[4], o2[5], o2[6], o2[7]}; }
                    if (bo) { st_bf16x8(bo, o1); st_bf16x8(bo + 32, o2); }
                }
            }
        }
        if (lane < 48) { const unsigned short rv = RAW[(size_t)row * NNSP + 2560 + lane]; GATES[(size_t)row * 48 + lane] = sigmoidf_(__uint_as_float((unsigned)rv << 16)); }
    }
    { const size_t n4 = (size_t)SB * 508 * 64; const size_t gt = (size_t)(vcu * NWAVES + wave) * 64 + lane, NT = (size_t)NGW * 64;
      for (size_t i = gt; i < 2 * n4; i += NT) { const int kv = i >= n4; const size_t j = kv ? i - n4 : i; const size_t bs = j / (508 * 64), rem = j % (508 * 64);
          const f32x4 v = ((const GAS f32x4*)(kv ? I.cv_win : I.ck_win))[bs * 512 * 64 + 4 * 64 + rem];
          ((GAS f32x4*)(out + (kv ? O_VWS : O_KWS)))[bs * 512 * 64 + rem] = v; } }
}

__device__ __forceinline__ void glds16(const void* gsrc, unsigned lds_dst) { unsigned keep;
    asm volatile("s_mov_b32 %0, m0\n\ts_mov_b32 m0, %2\n\ts_nop 0\n\tglobal_load_lds_dwordx4 %1, off\n\ts_mov_b32 m0, %0" : "=&s"(keep) : "v"(gsrc), "s"(lds_dst) : "memory"); }
__device__ __forceinline__ unsigned lds_addr(const LAS unsigned char* p) { return (unsigned)(uintptr_t)p; }

constexpr int CMP_NA = 5, CMP_NB = 3, CMP_BOFF = CMP_NA * 16384, CMP_RED_OFF = LDSCTL_OFF + 1024;
static_assert(CMP_BOFF + CMP_NB * 16384 <= RING_BYTES, "compress LDS");
__device__ __forceinline__ void cmp_bias_partials(const In& I, unsigned char* ws, int vcu, int G, int wave, int lane) {
    float* PART = (float*)(ws + WS_CPART); const int gw = vcu * NWAVES + wave, NGW = G * NWAVES;
    for (int it = gw; it < 128; it += NGW) { const int kv = it >> 6, j = it & 63; float a0 = 0.f, a1 = 0.f;
        const float* pp = I.cmp_pos + ((size_t)kv * 64 + j) * 64; const float* wp = I.cmp_w1 + ((size_t)kv * 4096 + 64 * j) * 128;
#pragma unroll 8
        for (int d = 0; d < 64; ++d) { const float p = pp[d]; a0 += p * wp[d * 128 + lane]; a1 += p * wp[d * 128 + 64 + lane]; }
        PART[(size_t)it * 128 + lane] = a0; PART[(size_t)it * 128 + 64 + lane] = a1; }
}
__device__ __forceinline__ void cmp_bias_reduce(unsigned char* ws, int vcu, int tid) {
    if (vcu != 0 || tid >= 256) return;
    const float* PART = (const float*)(ws + WS_CPART); float* BIAS = (float*)(ws + WS_CBIAS); const int kv = tid >> 7, n = tid & 127; float a = 0.f;
    for (int j = 0; j < 64; ++j) a += PART[((size_t)kv * 64 + j) * 128 + n];
    BIAS[tid] = a;
}
struct CmpSrc { const float* kbase; const float* vbase; const int* page_table; int seq0, nseq, cpu; };
__device__ __forceinline__ const float* cmp_chunk_base(const CmpSrc& S, int kv, int cid) {
    const int sq = cid >> 7, nb = cid & 127; const float* base = kv ? S.vbase : S.kbase;
    if (S.page_table) { const int pg = S.page_table[sq * NPAGE + (nb >> 1)]; return base + ((size_t)pg * 128 + (nb & 1) * 64) * KVW; }
    return base + ((size_t)sq * SEQ + nb * 64) * KVW;
}
__device__ __forceinline__ void compress_phase(const In& I, unsigned char* ws, LAS unsigned char* lds, const CmpSrc& S, int vcu, int G) {
    int tid_ = threadIdx.x; asm volatile("" : "+v"(tid_));
    const int tid = tid_, wave = __builtin_amdgcn_readfirstlane(tid >> 6), lane = tid & 63, fr = lane & 15, fq = lane >> 4, wm = wave >> 2, wn = wave & 3;
    const int cpu = S.cpu, upk = S.nseq * 128 / cpu, nunits = 2 * upk;
    int nmine = 0; for (int u = vcu; u < nunits; u += G) ++nmine;
    if (nmine == 0) return;
    const int total = nmine * 64;
    const bf16* W1T = (const bf16*)(ws + WS_W1T); const bf16* W2T = (const bf16*)(ws + WS_W2T);
    LAS float* BIAS = (LAS float*)(lds + CMP_RED_OFF + 1024);
    if (tid < 256) { const float* PART = (const float*)(ws + WS_CPART); const int kv = tid >> 7, n = tid & 127; float a = 0.f;
#pragma unroll 8
        for (int j = 0; j < 64; ++j) a += PART[((size_t)kv * 64 + j) * 128 + n];
        BIAS[tid] = a; }
    asm volatile("s_waitcnt vmcnt(0) lgkmcnt(0)" ::: "memory"); __builtin_amdgcn_s_barrier(); asm volatile("" ::: "memory");
    unsigned aoffs[2];
#pragma unroll
    for (int i = 0; i < 2; ++i) { const int c = 2 * wave + i, r = 4 * c + (lane >> 4); aoffs[i] = (unsigned)((lane >> 4) * 256 + (((lane & 15) ^ (r & 15)) * 16)); }
    unsigned boffs[2];
#pragma unroll
    for (int i = 0; i < 2; ++i) { int R, C; pg8::stage_rc(tid * 16 + i * 8192, R, C); boffs[i] = (unsigned)(R * 4096 + C) * 2u; }
#define CMP_ISSUE_A(gs_) do { const int ui_ = (gs_) >> 6, j_ = (gs_) & 63, u_ = vcu + ui_ * G, kv_ = u_ >= upk ? 1 : 0, ul_ = u_ - kv_ * upk; \
        LAS unsigned char* st_ = lds + ((gs_) % CMP_NA) * 16384; \
        if (j_ == 0) { cb0 = cmp_chunk_base(S, kv_, ul_ * cpu + (2 * wave < cpu ? 2 * wave : 0)); cb1 = cmp_chunk_base(S, kv_, ul_ * cpu + (2 * wave + 1 < cpu ? 2 * wave + 1 : 0)); }     \
        glds16((const char*)cb0 + (size_t)j_ * 1024 + aoffs[0], lds_addr(st_ + (2 * wave) * 1024)); glds16((const char*)cb1 + (size_t)j_ * 1024 + aoffs[1], lds_addr(st_ + (2 * wave + 1) * 1024)); } while (0)
#define CMP_ISSUE_B(gs_) do { const int ui_ = (gs_) >> 6, j_ = (gs_) & 63, u_ = vcu + ui_ * G, kv_ = u_ >= upk ? 1 : 0; \
        LAS unsigned char* st_ = lds + CMP_BOFF + ((gs_) % CMP_NB) * 16384; const char* wb_ = (const char*)(W1T + (size_t)kv_ * 128 * 4096) + j_ * 128; \
        _Pragma("unroll") for (int i_ = 0; i_ < 2; ++i_) glds16(wb_ + boffs[i_], lds_addr(st_ + wave * 1024 + i_ * 8192)); } while (0)
    f32x4 acc[2][2];
#pragma unroll
    for (int a = 0; a < 2; ++a)
#pragma unroll
        for (int b = 0; b < 2; ++b) acc[a][b] = (f32x4){0.f, 0.f, 0.f, 0.f};
    const float* cb0 = nullptr; const float* cb1 = nullptr;
    CMP_ISSUE_A(0); CMP_ISSUE_A(1); CMP_ISSUE_B(0); CMP_ISSUE_A(2); CMP_ISSUE_B(1); CMP_ISSUE_A(3);
    for (int gs = 0; gs < total; ++gs) {
        if (gs + 3 < total) asm volatile("s_waitcnt vmcnt(4)" ::: "memory"); else if (gs + 1 < total) asm volatile("s_waitcnt vmcnt(2)" ::: "memory"); else asm volatile("s_waitcnt vmcnt(0)" ::: "memory");
        __builtin_amdgcn_s_barrier(); asm volatile("" ::: "memory");
        if (gs + 4 < total) CMP_ISSUE_A(gs + 4);
        if (gs + 2 < total) CMP_ISSUE_B(gs + 2);
        const LAS unsigned char* st = lds + (gs % CMP_NA) * 16384; const LAS unsigned char* stb = lds + CMP_BOFF + (gs % CMP_NB) * 16384;
#pragma unroll
        for (int ks = 0; ks < 2; ++ks) {
            bf16x8 xa[2], wb[2];
#pragma unroll
            for (int rb = 0; rb < 2; ++rb) { const int row = 32 * wm + 16 * rb + fr, ch = 8 * ks + 2 * fq;
                const f32x4 lo = *(const LAS f32x4*)(st + row * 256 + ((ch ^ (row & 15)) * 16)), hi = *(const LAS f32x4*)(st + row * 256 + (((ch + 1) ^ (row & 15)) * 16));
                v4u w; w.x = pk2(lo[0], lo[1]); w.y = pk2(lo[2], lo[3]); w.z = pk2(hi[0], hi[1]); w.w = pk2(hi[2], hi[3]); xa[rb] = __builtin_bit_cast(bf16x8, w); }
#pragma unroll
            for (int cb = 0; cb < 2; ++cb) wb[cb] = *(const LAS bf16x8*)(stb + pg8::lds_byte(32 * wn + 16 * cb + fr, 32 * ks + 8 * fq));
#pragma unroll
            for (int cb = 0; cb < 2; ++cb)
#pragma unroll
                for (int rb = 0; rb < 2; ++rb) acc[cb][rb] = __builtin_amdgcn_mfma_f32_16x16x32_bf16(wb[cb], xa[rb], acc[cb][rb], 0, 0, 0);
        }
        if ((gs & 63) == 63) {
            const int ui = gs >> 6, u = vcu + ui * G, kv = u >= upk ? 1 : 0, ul = u - kv * upk;
            LAS unsigned char* hid = lds + CMP_BOFF + (gs % CMP_NB) * 16384; LAS float* red = (LAS float*)(lds + CMP_RED_OFF);
            asm volatile("s_waitcnt lgkmcnt(0)" ::: "memory"); __builtin_amdgcn_s_barrier(); asm volatile("" ::: "memory");
#pragma unroll
            for (int cb = 0; cb < 2; ++cb) { const int n0 = 32 * wn + 16 * cb + 4 * fq; const f32x4 bv = *(const LAS f32x4*)(BIAS + kv * 128 + n0);
#pragma unroll
                for (int rb = 0; rb < 2; ++rb) { const int row = 32 * wm + 16 * rb + fr; float h[4];
#pragma unroll
                    for (int e = 0; e < 4; ++e) { const float x = acc[cb][rb][e] + bv[e]; const float t = 0.7978845608028654f * (x + 0.044715f * x * x * x); h[e] = x * sigmoidf_(2.f * t); acc[cb][rb][e] = 0.f; }
                    v2u w; w.x = pk2(h[0], h[1]); w.y = pk2(h[2], h[3]);
                    *(LAS v2u*)(hid + row * 256 + (((n0 >> 3) ^ (row & 15)) * 16) + (n0 & 7) * 2) = w; } }
            asm volatile("s_waitcnt lgkmcnt(0)" ::: "memory"); __builtin_amdgcn_s_barrier(); asm volatile("" ::: "memory");
            const int rblk = wave >> 1, oh = wave & 1;
            f32x4 o2[2] = {(f32x4){0.f, 0.f, 0.f, 0.f}, (f32x4){0.f, 0.f, 0.f, 0.f}};
#pragma unroll
            for (int ks = 0; ks < 4; ++ks) { const int row = 16 * rblk + fr, ch = 4 * ks + fq;
                const bf16x8 hb = *(const LAS bf16x8*)(hid + row * 256 + ((ch ^ (row & 15)) * 16));
#pragma unroll
                for (int ob = 0; ob < 2; ++ob) { const bf16x8 wa = *(const bf16x8*)(W2T + ((size_t)kv * 64 + 32 * oh + 16 * ob + fr) * 128 + 32 * ks + 8 * fq);
                    o2[ob] = __builtin_amdgcn_mfma_f32_16x16x32_bf16(wa, hb, o2[ob], 0, 0, 0); } }
            float ssq = 0.f;
#pragma unroll
            for (int ob = 0; ob < 2; ++ob)
#pragma unroll
                for (int e = 0; e < 4; ++e) ssq += o2[ob][e] * o2[ob][e];
            ssq += __shfl_xor(ssq, 16); ssq += __shfl_xor(ssq, 32);
            if (fq == 0) red[(16 * rblk + fr) * 2 + oh] = ssq;
            asm volatile("s_waitcnt lgkmcnt(0)" ::: "memory"); __builtin_amdgcn_s_barrier(); asm volatile("" ::: "memory");
            const int trow = 16 * rblk + fr; const float tot = red[trow * 2] + red[trow * 2 + 1];
            const float rs = kv ? 1.f : __builtin_amdgcn_rsqf(tot * (1.f / 64.f) + RMS_EPS);
            const bool rvalid = (trow >> 2) < cpu; const int cid = ul * cpu + (rvalid ? (trow >> 2) : 0), g = trow & 3, sq = S.seq0 + (cid >> 7), nb = cid & 127;
            bf16* dst = (bf16*)(ws + (kv ? WS_VC : WS_KC)) + (((size_t)sq * 4 + g) * 128 + nb) * 64;
#pragma unroll
            for (int ob = 0; ob < 2; ++ob) { const int o0 = 32 * oh + 16 * ob + 4 * fq; float y[4];
#pragma unroll
                for (int e = 0; e < 4; ++e) y[e] = o2[ob][e] * rs * (kv ? 1.f : I.qk_g[64 + o0 + e]);
                v2u w; w.x = pk2(y[0], y[1]); w.y = pk2(y[2], y[3]); if (rvalid) *(v2u*)(dst + o0) = w; }
        }
    }
    asm volatile("s_waitcnt vmcnt(0) lgkmcnt(0)" ::: "memory"); __builtin_amdgcn_s_barrier(); asm volatile("" ::: "memory");
}

constexpr int AT_IMP = 32768  , AT_OUTS = 65536, AT_SELM = LDSCTL_OFF + 1024;
constexpr int SAT_IMP = LDSCTL_OFF + 1024, SAT_SELM = SAT_IMP + 4 * 132 * 4;
static_assert(SAT_SELM + 4 * 8 * 4 <= LDS_BYTES && AT_SELM + 64 * 16 <= LDS_BYTES && AT_OUTS + 65536 <= RING_BYTES, "attention LDS");
__device__ __forceinline__ s16x4 tr16(const LAS unsigned char* p) { typedef short v4s __attribute__((ext_vector_type(4))); return __builtin_bit_cast(s16x4, __builtin_amdgcn_ds_read_tr16_b64_v4i16((LAS v4s*)p)); }
__device__ __forceinline__ unsigned dpp_max_u32(unsigned v) {
    v = max(v, (unsigned)__builtin_amdgcn_update_dpp(0, (int)v, 0xB1, 0xF, 0xF, true));
    v = max(v, (unsigned)__builtin_amdgcn_update_dpp(0, (int)v, 0x4E, 0xF, 0xF, true));
    v = max(v, (unsigned)__builtin_amdgcn_update_dpp(0, (int)v, 0x141, 0xF, 0xF, true));
    v = max(v, (unsigned)__builtin_amdgcn_update_dpp(0, (int)v, 0x140, 0xF, 0xF, true));
    const unsigned a = __builtin_amdgcn_readlane((int)v, 0), b = __builtin_amdgcn_readlane((int)v, 16), c = __builtin_amdgcn_readlane((int)v, 32), d = __builtin_amdgcn_readlane((int)v, 48);
    return max(max(a, b), max(c, d));
}
__device__ __forceinline__ void stage_block_dma(LAS unsigned char* dst, const bf16* src_row0, int pitch_bytes, int wave, int lane) {
    const int row = 8 * wave + (lane >> 3), chunk = (lane & 7) ^ (lane >> 3);
    glds16((const char*)src_row0 + (size_t)row * pitch_bytes + chunk * 16, lds_addr(dst + wave * 1024));
}
__device__ __forceinline__ void kfrags(bf16x8 (&kf)[4][2], const LAS unsigned char* kb, int fr, int fq) {
#pragma unroll
    for (int k = 0; k < 4; ++k)
#pragma unroll
        for (int ks = 0; ks < 2; ++ks) kf[k][ks] = *(const LAS bf16x8*)(kb + (16 * k + fr) * 128 + (((4 * ks + fq) ^ (fr & 7)) * 16));
}
__device__ __forceinline__ bf16x8 pack_p(const f32x4& a, const f32x4& b) { v4u w; w.x = pk2(a[0], a[1]); w.y = pk2(a[2], a[3]); w.z = pk2(b[0], b[1]); w.w = pk2(b[2], b[3]); return __builtin_bit_cast(bf16x8, w); }
template <bool do0, bool do1>
__device__ __forceinline__ void pv_block(const LAS unsigned char* vb, const bf16x8 (&p)[2][2], f32x4 (&o)[2][4], int fr, int fq) {
    const int q4 = fr >> 2, pp = fr & 3, kk = 4 * (fq & 1) + q4;
    const LAS unsigned char* vrow = vb + (4 * fq + q4) * 128 + (pp & 1) * 8;
#pragma unroll
    for (int db = 0; db < 4; ++db) { const int xo = (((2 * db + (pp >> 1)) ^ kk) * 16);
#pragma unroll
        for (int st = 0; st < 2; ++st) {
            const s16x4 lo4 = tr16(vrow + (32 * st) * 128 + xo), hi4 = tr16(vrow + (32 * st + 16) * 128 + xo);
            const bf16x8 vf = (bf16x8){lo4[0], lo4[1], lo4[2], lo4[3], hi4[0], hi4[1], hi4[2], hi4[3]};
            if (do0) o[0][db] = __builtin_amdgcn_mfma_f32_16x16x32_bf16(vf, p[0][st], o[0][db], 0, 0, 0);
            if (do1) o[1][db] = __builtin_amdgcn_mfma_f32_16x16x32_bf16(vf, p[1][st], o[1][db], 0, 0, 0); } }
}
template <bool EDGE, bool do0, bool do1>
__device__ __forceinline__ void attn_block_t(const LAS unsigned char* kb, const LAS unsigned char* vb, const bf16x8 (&q)[2][2], const float (&bias)[2], const int (&lo)[2], const int (&hi)[2],
                                           f32x4 (&o)[2][4], float (&l)[2], int fr, int fq) {
    bf16x8 kf[4][2]; kfrags(kf, kb, fr, fq);
    f32x4 sc[2][4];
#pragma unroll
    for (int s = 0; s < 2; ++s) if (s ? do1 : do0) {
#pragma unroll
        for (int k = 0; k < 4; ++k) sc[s][k] = __builtin_amdgcn_mfma_f32_16x16x32_bf16(kf[k][0], q[s][0], (f32x4){bias[s], bias[s], bias[s], bias[s]}, 0, 0, 0); }
#pragma unroll
    for (int s = 0; s < 2; ++s) if (s ? do1 : do0) {
#pragma unroll
        for (int k = 0; k < 4; ++k) sc[s][k] = __builtin_amdgcn_mfma_f32_16x16x32_bf16(kf[k][1], q[s][1], sc[s][k], 0, 0, 0); }
    __builtin_amdgcn_sched_barrier(0);
    bf16x8 vf[4][2];
    { const int q4 = fr >> 2, pp = fr & 3, kk = 4 * (fq & 1) + q4; const LAS unsigned char* vrow = vb + (4 * fq + q4) * 128 + (pp & 1) * 8;
#pragma unroll
      for (int db = 0; db < 4; ++db) { const int xo = (((2 * db + (pp >> 1)) ^ kk) * 16);
#pragma unroll
          for (int st = 0; st < 2; ++st) { const s16x4 lo4 = tr16(vrow + (32 * st) * 128 + xo), hi4 = tr16(vrow + (32 * st + 16) * 128 + xo);
              vf[db][st] = (bf16x8){lo4[0], lo4[1], lo4[2], lo4[3], hi4[0], hi4[1], hi4[2], hi4[3]}; } } }
    __builtin_amdgcn_sched_barrier(0);
    bf16x8 p[2][2];
#pragma unroll
    for (int s = 0; s < 2; ++s) if (s ? do1 : do0) { float ls = 0.f;
#pragma unroll
        for (int k = 0; k < 4; ++k)
#pragma unroll
            for (int e = 0; e < 4; ++e) { float v = sc[s][k][e]; if (EDGE) { const int key = 16 * k + 4 * fq + e; if (key < lo[s] || key > hi[s]) v = -INFINITY; } v = fast_exp2(v); sc[s][k][e] = v; ls += v; }
        l[s] += ls; p[s][0] = pack_p(sc[s][0], sc[s][1]); p[s][1] = pack_p(sc[s][2], sc[s][3]); }
    __builtin_amdgcn_sched_barrier(0);
#pragma unroll
    for (int st = 0; st < 2; ++st)
#pragma unroll
        for (int db = 0; db < 4; ++db) {
            if (do0) o[0][db] = __builtin_amdgcn_mfma_f32_16x16x32_bf16(vf[db][st], p[0][st], o[0][db], 0, 0, 0);
            if (do1) o[1][db] = __builtin_amdgcn_mfma_f32_16x16x32_bf16(vf[db][st], p[1][st], o[1][db], 0, 0, 0); }
}
template <bool EDGE>
__device__ __forceinline__ void attn_block(const LAS unsigned char* kb, const LAS unsigned char* vb, bool do0, bool do1, const bf16x8 (&q)[2][2], const float (&bias)[2], const int (&lo)[2], const int (&hi)[2],
                                           f32x4 (&o)[2][4], float (&l)[2], int fr, int fq) {
    if (do0 && do1) attn_block_t<EDGE, true, true>(kb, vb, q, bias, lo, hi, o, l, fr, fq);
    else if (do0) attn_block_t<EDGE, true, false>(kb, vb, q, bias, lo, hi, o, l, fr, fq);
    else attn_block_t<EDGE, false, true>(kb, vb, q, bias, lo, hi, o, l, fr, fq);
}

__device__ __forceinline__ void attn_prompt_unit(unsigned char* ws, LAS unsigned char* lds, int b, int g, int qb, int wave, int lane_) {
    int lane = lane_; asm volatile("" : "+v"(lane));
    const int fr = lane & 15, fq = lane >> 4, h = fr & 3, tq = fr >> 2;
    const bf16* QN = (const bf16*)(ws + WS_QN); const bf16* QR = (const bf16*)(ws + WS_QR); const float* GATES = (const float*)(ws + WS_GATES); bf16* O = (bf16*)(ws + WS_AC);
    LAS float* IMP = (LAS float*)(lds + AT_IMP); LAS unsigned* SELM = (LAS unsigned*)(lds + AT_SELM);
    const size_t seq0 = (size_t)b * SEQ; const int hc = (g * 4 + h) * 64;
    int itok[2]; size_t row[2];
#pragma unroll
    for (int s = 0; s < 2; ++s) { itok[s] = 8 * wave + 4 * s + tq; row[s] = seq0 + 64 * qb + itok[s]; }
    f32x4 out[2][4];
    {
        const int nblk = (qb + 64) >> 6;
        const bf16* KC = (const bf16*)(ws + WS_KC) + ((size_t)b * 4 + g) * 128 * 64; const bf16* VC = (const bf16*)(ws + WS_VC) + ((size_t)b * 4 + g) * 128 * 64;
        for (int i = 0; i < nblk; ++i) { stage_block_dma(lds + i * 16384, KC + (size_t)i * 64 * 64, 128, wave, lane); stage_block_dma(lds + i * 16384 + 8192, VC + (size_t)i * 64 * 64, 128, wave, lane); }
        asm volatile("s_waitcnt vmcnt(0)" ::: "memory"); __builtin_amdgcn_s_barrier(); asm volatile("" ::: "memory");
#pragma unroll
        for (int s = 0; s < 2; ++s) {
            bf16x8 q[2];
#pragma unroll
            for (int ks = 0; ks < 2; ++ks) q[ks] = *(const bf16x8*)(QN + row[s] * D + hc + 32 * ks + 8 * fq);
            const int nv = qb + (itok[s] == 63 ? 1 : 0);
            f32x4 sc[2][4]; float ls = 0.f;
#pragma unroll
            for (int i = 0; i < 2; ++i) {
                if (i < nblk) { bf16x8 kf[4][2]; kfrags(kf, lds + i * 16384, fr, fq);
#pragma unroll
                    for (int k = 0; k < 4; ++k) { sc[i][k] = (f32x4){0.f, 0.f, 0.f, 0.f};
#pragma unroll
                        for (int ks = 0; ks < 2; ++ks) sc[i][k] = __builtin_amdgcn_mfma_f32_16x16x32_bf16(kf[k][ks], q[ks], sc[i][k], 0, 0, 0);
#pragma unroll
                        for (int e = 0; e < 4; ++e) { const int key = 64 * i + 16 * k + 4 * fq + e; const float v = key < nv ? fast_exp2(sc[i][k][e]) : 0.f; sc[i][k][e] = v; ls += v; } }
                } else {
#pragma unroll
                    for (int k = 0; k < 4; ++k) sc[i][k] = (f32x4){0.f, 0.f, 0.f, 0.f}; } }
            ls += __shfl_xor(ls, 16); ls += __shfl_xor(ls, 32);
            const float inv = ls > 0.f ? 1.f / ls : 0.f;
            f32x4 oc[2][4];
#pragma unroll
            for (int d = 0; d < 4; ++d) { oc[0][d] = (f32x4){0.f, 0.f, 0.f, 0.f}; oc[1][d] = oc[0][d]; }
#pragma unroll
            for (int i = 0; i < 2; ++i) if (i < nblk) {
#pragma unroll
                for (int k = 0; k < 4; ++k) { f32x4 pn = sc[i][k] * inv;
#pragma unroll
                    for (int e = 0; e < 4; ++e) { float t = pn[e]; t += __shfl_xor(t, 1); t += __shfl_xor(t, 2); pn[e] = t; }
                    if (h == 0) *(LAS f32x4*)(IMP + itok[s] * 128 + 64 * i + 16 * k + 4 * fq) = pn; }
                bf16x8 p[2][2]; p[0][0] = pack_p(sc[i][0], sc[i][1]); p[0][1] = pack_p(sc[i][2], sc[i][3]); p[1][0] = p[0][0]; p[1][1] = p[0][1];
                pv_block<true, false>(lds + i * 16384 + 8192, p, oc, fr, fq); }
            const float gc = GATES[row[s] * 48 + (g * 4 + h) * 3 + 0] * inv;
#pragma unroll
            for (int d = 0; d < 4; ++d)
#pragma unroll
                for (int e = 0; e < 4; ++e) out[s][d][e] = oc[0][d][e] * gc;
        }
    }
    asm volatile("; MARK_TOPK");
    unsigned long long un_lo[2] = {0ull, 0ull}, un_hi[2] = {0ull, 0ull};
    asm volatile("s_waitcnt lgkmcnt(0)" ::: "memory");
#pragma unroll
    for (int pass = 0; pass < 2; ++pass) { const int c = lane & 15, tok = 8 * wave + 4 * pass + (lane >> 4);
        unsigned w0, w1 = 0u, w2 = 0u, w3 = 0u;
        if (qb <= 15) w0 = (2u << qb) - 1u;
        else {
            unsigned key[8];
#pragma unroll
            for (int j = 0; j < 8; ++j) { const int n = c + 16 * j; const float v = IMP[tok * 128 + n]; key[j] = (n >= 1 && n <= qb - 2) ? ((__float_as_uint(v) & ~127u) | (unsigned)(127 - n)) : 0u; }
            unsigned thr = 0xFFFFFFFFu;
#pragma unroll 1
            for (int r = 0; r < 13; ++r) { unsigned m = 0u;
#pragma unroll
                for (int j = 0; j < 8; ++j) m = max(m, key[j] < thr ? key[j] : 0u);
                m = max(m, (unsigned)__builtin_amdgcn_update_dpp(0, (int)m, 0xB1, 0xF, 0xF, true)); m = max(m, (unsigned)__builtin_amdgcn_update_dpp(0, (int)m, 0x4E, 0xF, 0xF, true));
                m = max(m, (unsigned)__builtin_amdgcn_update_dpp(0, (int)m, 0x141, 0xF, 0xF, true)); m = max(m, (unsigned)__builtin_amdgcn_update_dpp(0, (int)m, 0x140, 0xF, 0xF, true));
                thr = m; }
            unsigned b[4] = {0u, 0u, 0u, 0u};
#pragma unroll
            for (int j = 0; j < 8; ++j) b[j >> 1] |= (key[j] >= thr ? 1u : 0u) << (c + 16 * (j & 1));
#pragma unroll
            for (int w = 0; w < 4; ++w) { unsigned x = b[w];
                x |= (unsigned)__builtin_amdgcn_update_dpp(0, (int)x, 0xB1, 0xF, 0xF, true); x |= (unsigned)__builtin_amdgcn_update_dpp(0, (int)x, 0x4E, 0xF, 0xF, true);
                x |= (unsigned)__builtin_amdgcn_update_dpp(0, (int)x, 0x141, 0xF, 0xF, true); x |= (unsigned)__builtin_amdgcn_update_dpp(0, (int)x, 0x140, 0xF, 0xF, true); b[w] = x; }
            const unsigned long long flo = 1ull | (qb - 1 < 64 ? 1ull << (qb - 1) : 0ull) | (qb < 64 ? 1ull << qb : 0ull), fhi = (qb - 1 >= 64 ? 1ull << (qb - 65) : 0ull) | (qb >= 64 ? 1ull << (qb - 64) : 0ull);
            w0 = b[0] | (unsigned)flo; w1 = b[1] | (unsigned)(flo >> 32); w2 = b[2] | (unsigned)fhi; w3 = b[3] | (unsigned)(fhi >> 32);
        }
        if (c == 0) { SELM[tok * 4 + 0] = w0; SELM[tok * 4 + 1] = w1; SELM[tok * 4 + 2] = w2; SELM[tok * 4 + 3] = w3; }
        const unsigned u0 = __builtin_amdgcn_readlane((int)w0, 0) | __builtin_amdgcn_readlane((int)w0, 16) | __builtin_amdgcn_readlane((int)w0, 32) | __builtin_amdgcn_readlane((int)w0, 48);
        const unsigned u1 = __builtin_amdgcn_readlane((int)w1, 0) | __builtin_amdgcn_readlane((int)w1, 16) | __builtin_amdgcn_readlane((int)w1, 32) | __builtin_amdgcn_readlane((int)w1, 48);
        const unsigned u2 = __builtin_amdgcn_readlane((int)w2, 0) | __builtin_amdgcn_readlane((int)w2, 16) | __builtin_amdgcn_readlane((int)w2, 32) | __builtin_amdgcn_readlane((int)w2, 48);
        const unsigned u3 = __builtin_amdgcn_readlane((int)w3, 0) | __builtin_amdgcn_readlane((int)w3, 16) | __builtin_amdgcn_readlane((int)w3, 32) | __builtin_amdgcn_readlane((int)w3, 48);
        un_lo[pass] = (unsigned long long)u0 | ((unsigned long long)u1 << 32); un_hi[pass] = (unsigned long long)u2 | ((unsigned long long)u3 << 32);
    }
    asm volatile("s_waitcnt lgkmcnt(0)" ::: "memory");
    bf16x8 qr[2][2];
#pragma unroll
    for (int s = 0; s < 2; ++s)
#pragma unroll
        for (int ks = 0; ks < 2; ++ks) qr[s][ks] = *(const bf16x8*)(QR + row[s] * D + hc + 32 * ks + 8 * fq);
    float gsel[2], gwin[2];
#pragma unroll
    for (int s = 0; s < 2; ++s) { gsel[s] = GATES[row[s] * 48 + (g * 4 + h) * 3 + 1]; gwin[s] = GATES[row[s] * 48 + (g * 4 + h) * 3 + 2]; }
    asm volatile("; MARK_SEL");
    {
        const bf16* KS = (const bf16*)(ws + WS_KS) + seq0 * KVW + g * 64; const bf16* VS = (const bf16*)(ws + WS_VS) + seq0 * KVW + g * 64;
        const bf16* KW = (const bf16*)(ws + WS_KW) + seq0 * KVW + g * 64; const bf16* VW = (const bf16*)(ws + WS_VW) + seq0 * KVW + g * 64;
        const int nsel = qb + 1, n0w = qb >= 8 ? qb - 8 : 0, nit = nsel + (qb - n0w + 1);
#define AT_ISSUE(it_) do { const int it__ = (it_); const bool w__ = it__ >= nsel; const int n__ = w__ ? n0w + (it__ - nsel) : it__; LAS unsigned char* st__ = lds + (it__ & 7) * 16384; \
            stage_block_dma(st__, (w__ ? KW : KS) + (size_t)n__ * 64 * KVW, KVW * 2, wave, lane); stage_block_dma(st__ + 8192, (w__ ? VW : VS) + (size_t)n__ * 64 * KVW, KVW * 2, wave, lane); } while (0)
#define AT_FOLD(gt_) do { _Pragma("unroll") for (int s = 0; s < 2; ++s) { float ls = la[s]; ls += __shfl_xor(ls, 16); ls += __shfl_xor(ls, 32); const float gs = gt_[s] * (ls > 0.f ? 1.f / ls : 0.f); la[s] = 0.f; \
            _Pragma("unroll") for (int d = 0; d < 4; ++d) { out[s][d] += oa[s][d] * gs; oa[s][d] = (f32x4){0.f, 0.f, 0.f, 0.f}; } } } while (0)
        f32x4 oa[2][4]; float la[2] = {0.f, 0.f};
#pragma unroll
        for (int s = 0; s < 2; ++s)
#pragma unroll
            for (int d = 0; d < 4; ++d) oa[s][d] = (f32x4){0.f, 0.f, 0.f, 0.f};
        asm volatile("" : "+v"(qr[0][0]), "+v"(qr[0][1]), "+v"(qr[1][0]), "+v"(qr[1][1]), "+v"(gsel[0]), "+v"(gsel[1]), "+v"(gwin[0]), "+v"(gwin[1]));
        asm volatile("s_waitcnt vmcnt(0)" ::: "memory"); __builtin_amdgcn_s_barrier(); asm volatile("" ::: "memory");
        AT_ISSUE(0); AT_ISSUE(1); if (nit > 2) AT_ISSUE(2); if (nit > 3) AT_ISSUE(3);
#pragma unroll 1
        for (int it = 0; it < nit; ++it) {
            if ((it & 3) == 0) {
                asm volatile("s_waitcnt vmcnt(0)" ::: "memory"); __builtin_amdgcn_s_barrier(); asm volatile("" ::: "memory");
#pragma unroll
                for (int j = 4; j < 8; ++j) if (it + j < nit) AT_ISSUE(it + j); }
            if (it == nsel) AT_FOLD(gsel);
            const LAS unsigned char* st = lds + (it & 7) * 16384;
            if (it < nsel) { const int n = it;
                const bool do0 = ((n < 64 ? un_lo[0] >> n : un_hi[0] >> (n - 64)) & 1ull) != 0ull, do1 = ((n < 64 ? un_lo[1] >> n : un_hi[1] >> (n - 64)) & 1ull) != 0ull;
                if (do0 || do1) { float bias[2]; const int lo[2] = {0, 0}, hi[2] = {itok[0], itok[1]};
#pragma unroll
                    for (int s = 0; s < 2; ++s) { const unsigned wd = SELM[itok[s] * 4 + (n >> 5)]; bias[s] = ((wd >> (n & 31)) & 1u) ? 0.f : -INFINITY; }
                    if (n == qb) attn_block<true>(st, st + 8192, do0, do1, qr, bias, lo, hi, oa, la, fr, fq);
                    else attn_block<false>(st, st + 8192, do0, do1, qr, bias, lo, hi, oa, la, fr, fq);
#ifdef PROBE_TWICE_BLK
                    { const float nb[2] = {-INFINITY, -INFINITY}; asm volatile("" ::: "memory"); attn_block<false>(st, st + 8192, do0, do1, qr, nb, lo, hi, oa, la, fr, fq); }
#endif
                }
            } else { const int n = n0w + (it - nsel); const float bias[2] = {0.f, 0.f};
                if (n == qb || n == qb - 8) { int lo[2], hi[2];
#pragma unroll
                    for (int s = 0; s < 2; ++s) { lo[s] = (n == qb - 8) ? itok[s] + 1 : 0; hi[s] = (n == qb) ? itok[s] : 63; }
                    attn_block<true>(st, st + 8192, true, true, qr, bias, lo, hi, oa, la, fr, fq);
                } else { const int lo[2] = {0, 0}, hi[2] = {63, 63}; attn_block<false>(st, st + 8192, true, true, qr, bias, lo, hi, oa, la, fr, fq); }
#ifdef PROBE_TWICE_BLK
                { const float nb[2] = {-INFINITY, -INFINITY}; const int lo[2] = {0, 0}, hi[2] = {63, 63}; asm volatile("" ::: "memory"); attn_block<false>(st, st + 8192, true, true, qr, nb, lo, hi, oa, la, fr, fq); }
#endif
            }
        }
#pragma unroll
        for (int s = 0; s < 2; ++s) { float ls = la[s]; ls += __shfl_xor(ls, 16); ls += __shfl_xor(ls, 32); const float gw = gwin[s] * (ls > 0.f ? 1.f / ls : 0.f);
#pragma unroll
            for (int d = 0; d < 4; ++d) { float y[4];
#pragma unroll
                for (int e = 0; e < 4; ++e) y[e] = out[s][d][e] + oa[s][d][e] * gw;
                v2u w; w.x = pk2(y[0], y[1]); w.y = pk2(y[2], y[3]); *(v2u*)(O + row[s] * D + hc + 16 * d + 4 * fq) = w; } }
#undef AT_ISSUE
#undef AT_FOLD
    }
    asm volatile("s_waitcnt lgkmcnt(0)" ::: "memory"); __builtin_amdgcn_s_barrier(); asm volatile("" ::: "memory");
}

__device__ __forceinline__ void stage_f32_rows(LAS unsigned char* dst, const float* src_row0  , int lane) {
#pragma unroll
    for (int half = 0; half < 2; ++half) { f32x4 v[8];
#pragma unroll
        for (int k = 0; k < 8; ++k) { const int r = 32 * half + 4 * k + (lane >> 4); v[k] = *(const f32x4*)(src_row0 + (size_t)r * KVW + 4 * (lane & 15)); }
#pragma unroll
        for (int k = 0; k < 8; ++k) { const int r = 32 * half + 4 * k + (lane >> 4), c16 = (lane & 15) >> 1; v2u w; w.x = pk2(v[k][0], v[k][1]); w.y = pk2(v[k][2], v[k][3]);
            *(LAS v2u*)(dst + r * 128 + ((c16 ^ (r & 7)) * 16) + (lane & 1) * 8) = w; } }
}
__device__ __forceinline__ void stage_bf16_rows(LAS unsigned char* dst, const bf16* src_row0, int pitch, int nvalid, int lane) {
#pragma unroll
    for (int k = 0; k < 8; ++k) { const int r = 8 * k + (lane >> 3), c = lane & 7; v4u w = (v4u){0u, 0u, 0u, 0u};
        if (r < nvalid) w = *(const v4u*)(src_row0 + (size_t)r * pitch + 8 * c);
        *(LAS v4u*)(dst + r * 128 + ((c ^ (r & 7)) * 16)) = w; }
}
__device__ __forceinline__ void attn_sample_unit(const In& I, unsigned char* ws, LAS unsigned char* lds, int bs, int g, int wave, int lane_) {
    int lane = lane_; asm volatile("" : "+v"(lane));
    const int fr = lane & 15, fq = lane >> 4, h = fr & 3, tq = fr >> 2;
    const bf16* QN = (const bf16*)(ws + WS_QN); const bf16* QR = (const bf16*)(ws + WS_QR); const float* GATES = (const float*)(ws + WS_GATES); bf16* O = (bf16*)(ws + WS_AC);
    LAS float* IMP = (LAS float*)(lds + SAT_IMP); LAS unsigned* SELM = (LAS unsigned*)(lds + SAT_SELM);
    LAS unsigned char* my = lds + wave * 16384;
    const size_t row = (size_t)MP + 4 * bs + tq; const int hc = (g * 4 + h) * 64;
    f32x4 acc[2][4]; float lsum[2] = {0.f, 0.f};
    f32x4 oc[2][4]; float lc = 0.f;
#pragma unroll
    for (int d = 0; d < 4; ++d) { acc[0][d] = (f32x4){0.f, 0.f, 0.f, 0.f}; acc[1][d] = acc[0][d]; oc[0][d] = acc[0][d]; oc[1][d] = acc[0][d]; }
    if (wave == 0) {
        const bf16* KC = (const bf16*)(ws + WS_KC) + ((size_t)(2 + bs) * 4 + g) * 128 * 64; const bf16* VC = (const bf16*)(ws + WS_VC) + ((size_t)(2 + bs) * 4 + g) * 128 * 64;
        bf16x8 q[2];
#pragma unroll
        for (int ks = 0; ks < 2; ++ks) q[ks] = *(const bf16x8*)(QN + row * D + hc + 32 * ks + 8 * fq);
        f32x4 sc[2][4];
#pragma unroll 1
        for (int i = 0; i < 2; ++i) {
            stage_bf16_rows(my, KC + (size_t)i * 64 * 64, 64, 64, lane); stage_bf16_rows(my + 8192, VC + (size_t)i * 64 * 64, 64, 64, lane);
            asm volatile("s_waitcnt lgkmcnt(0)" ::: "memory");
            bf16x8 kf[4][2]; kfrags(kf, my, fr, fq);
            f32x4 t[4];
#pragma unroll
            for (int k = 0; k < 4; ++k) { t[k] = (f32x4){0.f, 0.f, 0.f, 0.f};
#pragma unroll
                for (int ks = 0; ks < 2; ++ks) t[k] = __builtin_amdgcn_mfma_f32_16x16x32_bf16(kf[k][ks], q[ks], t[k], 0, 0, 0);
#pragma unroll
                for (int e = 0; e < 4; ++e) { t[k][e] = fast_exp2(t[k][e]); lc += t[k][e]; } }
            bf16x8 p[2][2]; p[0][0] = pack_p(t[0], t[1]); p[0][1] = pack_p(t[2], t[3]); p[1][0] = p[0][0]; p[1][1] = p[0][1];
            pv_block<true, false>(my + 8192, p, oc, fr, fq);
            asm volatile("s_waitcnt lgkmcnt(0)" ::: "memory");
#pragma unroll
            for (int k = 0; k < 4; ++k) { if (i == 0) sc[0][k] = t[k]; else sc[1][k] = t[k]; }
        }
        lc += __shfl_xor(lc, 16); lc += __shfl_xor(lc, 32);
        const float inv = 1.f / lc;
#pragma unroll
        for (int i = 0; i < 2; ++i)
#pragma unroll
            for (int k = 0; k < 4; ++k) { f32x4 pn = sc[i][k] * inv;
#pragma unroll
                for (int e = 0; e < 4; ++e) { float t = pn[e]; t += __shfl_xor(t, 1); t += __shfl_xor(t, 2); pn[e] = t; }
                if (h == 0) *(LAS f32x4*)(IMP + tq * 132 + 64 * i + 16 * k + 4 * fq) = pn; }
    }
    asm volatile("s_waitcnt lgkmcnt(0)" ::: "memory"); __builtin_amdgcn_s_barrier(); asm volatile("" ::: "memory");
    if (wave < 4) {
        const float v0 = IMP[wave * 132 + lane], v1 = IMP[wave * 132 + 64 + lane];
        unsigned u0 = (lane >= 1) ? __float_as_uint(v0) : 0u, u1 = (lane + 64 <= 126) ? __float_as_uint(v1) : 0u;
        unsigned long long mlo = 1ull, mhi = 1ull << 63;
#pragma unroll 1
        for (int r = 0; r < 13; ++r) { const unsigned m = dpp_max_u32(max(u0, u1));
            const unsigned long long b0 = __ballot(u0 == m);
            if (b0) { const int idx = __builtin_ctzll(b0); mlo |= 1ull << idx; if (lane == idx) u0 = 0u; }
            else { const unsigned long long b1 = __ballot(u1 == m); const int idx = __builtin_ctzll(b1); mhi |= 1ull << idx; if (lane == idx) u1 = 0u; } }
        if (lane == 0) { SELM[wave * 8 + 0] = (unsigned)mlo; SELM[wave * 8 + 1] = (unsigned)(mlo >> 32); SELM[wave * 8 + 2] = (unsigned)mhi; SELM[wave * 8 + 3] = (unsigned)(mhi >> 32); }
    }
    asm volatile("s_waitcnt lgkmcnt(0)" ::: "memory"); __builtin_amdgcn_s_barrier(); asm volatile("" ::: "memory");
    unsigned selw[4];
#pragma unroll
    for (int w = 0; w < 4; ++w) selw[w] = SELM[tq * 8 + w];
    unsigned long long un_lo = 0ull, un_hi = 0ull;
#pragma unroll
    for (int t = 0; t < 4; ++t) { un_lo |= (unsigned long long)SELM[t * 8 + 0] | ((unsigned long long)SELM[t * 8 + 1] << 32); un_hi |= (unsigned long long)SELM[t * 8 + 2] | ((unsigned long long)SELM[t * 8 + 3] << 32); }
    un_lo = ((unsigned long long)__builtin_amdgcn_readfirstlane((unsigned)(un_lo >> 32)) << 32) | (unsigned)__builtin_amdgcn_readfirstlane((unsigned)un_lo);
    un_hi = ((unsigned long long)__builtin_amdgcn_readfirstlane((unsigned)(un_hi >> 32)) << 32) | (unsigned)__builtin_amdgcn_readfirstlane((unsigned)un_hi);
    bf16x8 qr[2][2];
#pragma unroll
    for (int ks = 0; ks < 2; ++ks) { qr[0][ks] = *(const bf16x8*)(QR + row * D + hc + 32 * ks + 8 * fq); qr[1][ks] = qr[0][ks]; }
    int cnt = 0;
    { const int* pt = I.page_table + bs * NPAGE;
#pragma unroll 1
      for (int n = 0; n < 128; ++n) { const bool on = ((n < 64 ? un_lo >> n : un_hi >> (n - 64)) & 1ull) != 0ull; if (!on) continue;
          if ((cnt++ & 7) != wave) continue;
          const int pg = pt[n >> 1]; const size_t ro = ((size_t)pg * 128 + (n & 1) * 64) * KVW + g * 64;
          stage_f32_rows(my, I.ck_sel + ro, lane); stage_f32_rows(my + 8192, I.cv_sel + ro, lane);
          asm volatile("s_waitcnt lgkmcnt(0)" ::: "memory");
          const int wi = n >> 5; const unsigned wd = wi == 0 ? selw[0] : (wi == 1 ? selw[1] : (wi == 2 ? selw[2] : selw[3]));
          const float bias[2] = {((wd >> (n & 31)) & 1u) ? 0.f : -INFINITY, 0.f}; const int lo[2] = {0, 0}, hi[2] = {63, 63};
          attn_block<false>(my, my + 8192, true, false, qr, bias, lo, hi, acc, lsum, fr, fq);
          asm volatile("s_waitcnt lgkmcnt(0)" ::: "memory"); } }
#pragma unroll 1
    for (int wb = 0; wb < 8; ++wb) { if ((cnt++ & 7) != wave) continue;
        const size_t ro = ((size_t)bs * 512 + 64 * wb) * KVW + g * 64;
        stage_f32_rows(my, I.ck_win + ro, lane); stage_f32_rows(my + 8192, I.cv_win + ro, lane);
        asm volatile("s_waitcnt lgkmcnt(0)" ::: "memory");
        const float bias[2] = {0.f, 0.f}; const int lo[2] = {0, wb == 0 ? tq + 1 : 0}, hi[2] = {63, 63};
        attn_block<true>(my, my + 8192, false, true, qr, bias, lo, hi, acc, lsum, fr, fq);
        asm volatile("s_waitcnt lgkmcnt(0)" ::: "memory"); }
    if ((cnt++ & 7) == wave) {
        stage_bf16_rows(my, (const bf16*)(ws + WS_KS) + ((size_t)MP + 4 * bs) * KVW + g * 64, KVW, 4, lane); stage_bf16_rows(my + 8192, (const bf16*)(ws + WS_VS) + ((size_t)MP + 4 * bs) * KVW + g * 64, KVW, 4, lane);
        asm volatile("s_waitcnt lgkmcnt(0)" ::: "memory");
        const float bias[2] = {0.f, 0.f}; const int lo[2] = {0, 0}, hi[2] = {tq, tq};
        attn_block<true>(my, my + 8192, true, false, qr, bias, lo, hi, acc, lsum, fr, fq);
        asm volatile("s_waitcnt lgkmcnt(0)" ::: "memory"); }
    if ((cnt++ & 7) == wave) {
        stage_bf16_rows(my, (const bf16*)(ws + WS_KW) + ((size_t)MP + 4 * bs) * KVW + g * 64, KVW, 4, lane); stage_bf16_rows(my + 8192, (const bf16*)(ws + WS_VW) + ((size_t)MP + 4 * bs) * KVW + g * 64, KVW, 4, lane);
        asm volatile("s_waitcnt lgkmcnt(0)" ::: "memory");
        const float bias[2] = {0.f, 0.f}; const int lo[2] = {0, 0}, hi[2] = {tq, tq};
        attn_block<true>(my, my + 8192, false, true, qr, bias, lo, hi, acc, lsum, fr, fq);
        asm volatile("s_waitcnt lgkmcnt(0)" ::: "memory"); }
    __builtin_amdgcn_s_barrier(); asm volatile("" ::: "memory");
    { LAS float* red = (LAS float*)lds + wave * (2 * 17 * 64);
#pragma unroll
      for (int br = 0; br < 2; ++br) {
#pragma unroll
          for (int d = 0; d < 4; ++d)
#pragma unroll
              for (int e = 0; e < 4; ++e) red[(br * 17 + 4 * d + e) * 64 + lane] = acc[br][d][e];
          red[(br * 17 + 16) * 64 + lane] = lsum[br]; } }
    asm volatile("s_waitcnt lgkmcnt(0)" ::: "memory"); __builtin_amdgcn_s_barrier(); asm volatile("" ::: "memory");
    if (wave == 0) {
        float outv[16];
        const float gc = GATES[row * 48 + (g * 4 + h) * 3 + 0] / lc;
#pragma unroll
        for (int d = 0; d < 4; ++d)
#pragma unroll
            for (int e = 0; e < 4; ++e) outv[4 * d + e] = oc[0][d][e] * gc;
#pragma unroll
        for (int br = 0; br < 2; ++br) { float ls = 0.f; float ob[16];
#pragma unroll
            for (int k = 0; k < 16; ++k) ob[k] = 0.f;
#pragma unroll 1
            for (int w = 0; w < 8; ++w) { const LAS float* red = (const LAS float*)lds + w * (2 * 17 * 64);
#pragma unroll
                for (int k = 0; k < 16; ++k) ob[k] += red[(br * 17 + k) * 64 + lane];
                ls += red[(br * 17 + 16) * 64 + lane]; }
            ls += __shfl_xor(ls, 16); ls += __shfl_xor(ls, 32);
            const float gb = GATES[row * 48 + (g * 4 + h) * 3 + 1 + br] * (ls > 0.f ? 1.f / ls : 0.f);
#pragma unroll
            for (int k = 0; k < 16; ++k) outv[k] += ob[k] * gb; }
#pragma unroll
        for (int d = 0; d < 4; ++d) { v2u w; w.x = pk2(outv[4 * d], outv[4 * d + 1]); w.y = pk2(outv[4 * d + 2], outv[4 * d + 3]); *(v2u*)(O + row * D + hc + 16 * d + 4 * fq) = w; }
    }
    asm volatile("s_waitcnt lgkmcnt(0)" ::: "memory"); __builtin_amdgcn_s_barrier(); asm volatile("" ::: "memory");
}
__device__ __forceinline__ void attention_phase(const In& I, unsigned char* ws, LAS unsigned char* lds, int vcu, int G) {
    int tid_ = threadIdx.x; asm volatile("" : "+v"(tid_));
    const int wave = __builtin_amdgcn_readfirstlane(tid_ >> 6), lane = tid_ & 63;
#pragma unroll 1
    for (int k = vcu; k < 1024; k += G) { int bg = k & 7, qb = 127 - (k >> 3);
        if (G == 256) { const int i = k >> 8, j = vcu & 31; bg = vcu >> 5; qb = i == 0 ? 127 - j : (i == 1 ? 64 + j : (i == 2 ? 63 - j : j)); }
        asm volatile("; MARK_PROMPT_UNIT");
        attn_prompt_unit(ws, lds, bg >> 2, bg & 3, qb, wave, lane); }
#pragma unroll 1
#ifdef PROBE_TWICE_SAMPLE
    for (int rep = 0; rep < 2; ++rep)
#endif
    for (int k = (G == 256) ? ((vcu & 1) ? (vcu >> 1) : 128) : vcu; k < 128; k += G) { asm volatile("; MARK_SAMPLE_UNIT"); attn_sample_unit(I, ws, lds, k >> 2, k & 3, wave, lane); }
    asm volatile("; MARK_ATT_END");
}

#ifdef PROBE_TWICE_ATT
#define PROBE_ATT SEAM(); attention_phase(I, ws, lds, vcu, G);
#else
#define PROBE_ATT
#endif
#ifndef NSA_MIXER_BODY
#define NSA_MIXER_BODY { CmpSrc cs{out + O_KCP, out + O_VCP, nullptr, 0, 2, 2}; compress_phase(I, ws, lds, cs, vcu, G); } SEAM(); \
    attention_phase(I, ws, lds, vcu, G); PROBE_ATT SEAM();
#endif

struct Args { const void* in[26]; float* out; unsigned char* ws; int ph_lo, ph_hi; };
__global__ void __launch_bounds__(NWAVES * 64, 2) fwd(Args args) {
    extern __shared__ __attribute__((aligned(16))) unsigned char lds_[];
    LAS unsigned char* lds = (LAS unsigned char*)lds_;
    const int tid = threadIdx.x, lane = tid & 63, wave = __builtin_amdgcn_readfirstlane(tid >> 6);
    const int G = gridDim.x; int vcu; { const int bx = blockIdx.x; vcu = (G % 8 == 0) ? (bx % 8) * (G / 8) + bx / 8 : bx; }
    unsigned char* ws = args.ws; float* out = args.out;
    gu32* ctl = (gu32*)(ws + WS_CTL);
    In I;
    I.x_prompt = (const float*)args.in[0]; I.x_sample = (const float*)args.in[1]; I.state_conv = (const float*)args.in[2]; I.ck_cmp = (const float*)args.in[3]; I.cv_cmp = (const float*)args.in[4];
    I.ck_sel = (const float*)args.in[5]; I.cv_sel = (const float*)args.in[6]; I.ck_win = (const float*)args.in[7]; I.cv_win = (const float*)args.in[8]; I.page_table = (const int*)args.in[9];
    I.p_prompt = (const float*)args.in[10]; I.p_sample = (const float*)args.in[11]; I.norm_g = (const float*)args.in[12]; I.w_gu = (const float*)args.in[13]; I.w_down = (const float*)args.in[14];
    I.w_proj = (const float*)args.in[15]; I.w_gate = (const float*)args.in[16]; I.cw_in = (const float*)args.in[17]; I.cw = (const float*)args.in[18]; I.cw_out = (const float*)args.in[19];
    I.nw_in = (const float*)args.in[20]; I.qk_g = (const float*)args.in[21]; I.cmp_pos = (const float*)args.in[22]; I.cmp_w1 = (const float*)args.in[23]; I.cmp_w2 = (const float*)args.in[24]; I.nw_out = (const float*)args.in[25];
    for (int u = tid; u < (LDS_BYTES - LDSCTL_OFF) / 4; u += NWAVES * 64) ((LAS unsigned*)(lds + LDSCTL_OFF))[u] = 0u;
    __syncthreads();
    (void)xcd_barrier_post((unsigned*)ctl + CW_BAR, (volatile LAS unsigned*)(lds + MISC_OFF) + 8);
    const int hi = args.ph_hi; int pid = 0;
#define SEAM() do { asm volatile("; SEAM_MARK %0" :: "i"(__LINE__)); ++pid; if (pid >= hi) return; XcdBarrier b_; b_.bar = (unsigned*)(ws + WS_CTL) + CW_BAR; b_.x = xb_xcc_id(); b_.st = (volatile LAS unsigned*)(lds + MISC_OFF) + 8; xcd_barrier(b_); } while (0)


    bf16* const XB_0 = (bf16*)(ws + WS_XB); bf16* const XB_1 = (bf16*)(ws + WS_XB + SZ_XB);
    float* const SS_0 = (float*)(ws + WS_SS); float* const SS_1 = (float*)(ws + WS_SS + SZ_SS);
    bf16* const Hb = (bf16*)(ws + WS_H); bf16* const ACb = (bf16*)(ws + WS_AC);
    bf16* const PBb = (bf16*)(ws + WS_PB); bf16* const Pb = (bf16*)(ws + WS_P);

#ifdef PH_HI_OVERRIDE
    { const size_t gt = (size_t)(vcu * NWAVES + wave) * 64 + lane, NT = (size_t)G * NWAVES * 64;
      for (size_t i = DBG_FILL_FROM / 4 + gt; i < O_END / 4; i += NT) ((GAS f32x4*)out)[i] = (f32x4){0.f, 0.f, 0.f, 0.f}; }
#endif
    p0_prologue(I, out, ws, lds, vcu, G, wave, lane);
    cmp_bias_partials(I, ws, vcu, G, wave, lane);
#ifdef PROBE_TWICE_PRO
    SEAM(); p0_prologue(I, out, ws, lds, vcu, G, wave, lane);
#endif
    SEAM();
#define SK_REM(units_) ((units_) % G)
#define SK_FIRST(units_) ((SK_REM(units_) == 0 || (int)blockIdx.x >= SK_REM(units_)) ? (G - 1 - (int)blockIdx.x) : 0x3fffffff)
#define SK_STRIDE(units_) (SK_REM(units_) == 0 ? G : G - SK_REM(units_))
#define PH_PROJ(l) { const bf16* Wp = (const bf16*)(ws + WS_WPROJ + (size_t)(l) * SZ_WPROJ); int kk_ = PLE; asm volatile("" : "+s"(kk_)); \
      pg8::Gemm g{PBb + (size_t)(l) * MT * PLE, Wp, MP, D, kk_}; GOrder S; S.init(MP, D, G, (int)blockIdx.x); pg8::EpiRaw<false> E{Pb + (size_t)(l) * MT * D, D, nullptr}; \
      pg8::gemm_phase<pg8::EpiRaw<false>, GOrder, true, true>(lds, g, S, E); \
      SkRaw<false> SE{Pb + (size_t)(l) * MT * D, D, nullptr}; skinny_phase<0>(lds, PBb + ((size_t)(l) * MT + MP) * PLE, Wp, PLE, D / 64, SE, SK_FIRST(256), SK_STRIDE(256)); }
    PH_PROJ(0)
    PH_PROJ(1)
    { CmpSrc cs{I.ck_cmp, I.cv_cmp, I.page_table, 2, 32, 16}; compress_phase(I, ws, lds, cs, vcu, G); }
#ifdef PROBE_TWICE_CMP
    SEAM(); { CmpSrc cs{I.ck_cmp, I.cv_cmp, I.page_table, 2, 32, 16}; compress_phase(I, ws, lds, cs, vcu, G); }
#endif
    SEAM();

#define XBP(c) ((bf16*)(ws + WS_XB + (size_t)(c) * SZ_XB))
#define SSP(c) ((float*)(ws + WS_SS + (size_t)(c) * SZ_SS))
#define PH_GU(l, s, c) { const bf16* Wgu = (const bf16*)(ws + WS_WGU + (size_t)((l) * 2 + (s)) * SZ_WGU); \
      pg8::Gemm g{XBP(c), Wgu, MP, NGU, D}; GOrder S; S.init(MP, NGU, G, (int)blockIdx.x); pg8::EpiSwiglu E{Hb, SSP(c)}; \
      pg8::gemm_phase<pg8::EpiSwiglu, GOrder, true, true>(lds, g, S, E); \
      SkSwiglu SE{Hb, SSP(c)}; skinny_phase<1>(lds, XBP(c) + (size_t)MP * D, Wgu, D, FF / 32, SE, SK_FIRST(64 * (NGU / 256)), SK_STRIDE(64 * (NGU / 256))); } SEAM();
#define PH_RESID(Asrc, K_, Wt, scale, c) { pg8::Gemm g{(Asrc), (const bf16*)(Wt), MP, D, (K_)}; GOrder S; S.init(MP, D, G, (int)blockIdx.x); \
      pg8::EpiResid<false, false> E{XBP(c), nullptr, XBP((c) ^ 1), SSP((c) ^ 1), (scale), nullptr, nullptr}; \
      pg8::gemm_phase<pg8::EpiResid<false, false>, GOrder, true, true>(lds, g, S, E); \
      SkResid<false> SE{XBP(c), nullptr, XBP((c) ^ 1), SSP((c) ^ 1), (scale), nullptr, nullptr, 0}; skinny_phase<0>(lds, (Asrc) + (size_t)MP * (K_), (const bf16*)(Wt), (K_), D / 64, SE, SK_FIRST(256), SK_STRIDE(256)); } SEAM();
#define PH_RAW(Wt, N_, NCU_, c) { pg8::Gemm g{XBP(c), (const bf16*)(Wt), MP, (N_), D}; GOrder S; S.init(MP, (N_), G, (int)blockIdx.x); pg8::EpiRaw<true> E{Hb, (N_), SSP(c)}; \
      pg8::gemm_phase<pg8::EpiRaw<true>, GOrder, true, true>(lds, g, S, E); \
      SkRaw<true> SE{Hb, (N_), SSP(c)}; skinny_phase<0>(lds, XBP(c) + (size_t)MP * D, (const bf16*)(Wt), D, (NCU_), SE, SK_FIRST(64 * ((N_) / 256)), SK_STRIDE(64 * ((N_) / 256))); } SEAM();
#define PH_GATE(l, c, FIN) { const bf16* Wg = (const bf16*)(ws + WS_WGATE + (size_t)(l) * SZ_WSQ); const bf16* Pl = Pb + (size_t)(l) * MT * D; \
      pg8::Gemm g{XBP(c), Wg, MP, D, D}; GOrder S; S.init(MP, D, G, (int)blockIdx.x); pg8::EpiResid<true, FIN> E{XBP(c), out, XBP((c) ^ 1), SSP((c) ^ 1), 1.0f, SSP(c), Pl}; \
      pg8::gemm_phase<pg8::EpiResid<true, FIN>, GOrder, true, true>(lds, g, S, E); \
      SkResid<true> SE{XBP(c), out, XBP((c) ^ 1), SSP((c) ^ 1), 1.0f, SSP(c), Pl, FIN}; skinny_phase<0>(lds, XBP(c) + (size_t)MP * D, Wg, D, D / 64, SE, SK_FIRST(256), SK_STRIDE(256)); } SEAM();

    PH_GU(0, 0, 0)
#ifdef PROBE_TWICE_GU
    PH_GU(0, 0, 0)
#endif
    PH_RESID(Hb, FF, ws + WS_WDN + 0 * SZ_WDN, 0.5f, 0)
    PH_RAW(ws + WS_WCIN, NCV, NCV / 64, 1)
    conv_post(I, out, ws, vcu, G, wave, lane); SEAM();
#ifdef PROBE_TWICE_POST
    conv_post(I, out, ws, vcu, G, wave, lane); SEAM();
#endif
    PH_RESID(ACb, D, ws + WS_WCOUT, 1.0f, 1)
    PH_GU(0, 1, 0)
    PH_RESID(Hb, FF, ws + WS_WDN + 1 * SZ_WDN, 0.5f, 0)
    PH_GATE(0, 1, false)
    PH_GU(1, 0, 0)
    PH_RESID(Hb, FF, ws + WS_WDN + 2 * SZ_WDN, 0.5f, 0)
    PH_RAW(ws + WS_WNIN, NNSP, (NNS + 63) / 64, 1)
    nsa_post(I, out, ws, vcu, G, wave, lane); SEAM();
#ifdef PROBE_TWICE_POST
    nsa_post(I, out, ws, vcu, G, wave, lane); SEAM();
#endif
    NSA_MIXER_BODY
    PH_RESID(ACb, D, ws + WS_WNOUT, 1.0f, 1)
    PH_GU(1, 1, 0)
    PH_RESID(Hb, FF, ws + WS_WDN + 3 * SZ_WDN, 0.5f, 0)
    PH_GATE(1, 1, true)
#ifdef DBG_SCALE_FROM
    { const size_t gt = (size_t)(vcu * NWAVES + wave) * 64 + lane, NT = (size_t)G * NWAVES * 64;
      for (size_t i = (DBG_SCALE_FROM) / 4 + gt; i < (DBG_SCALE_TO) / 4; i += NT) ((GAS f32x4*)out)[i] *= 1.2f; }
#endif
#undef SEAM
}

#ifdef PH_HI_OVERRIDE
#define PH_HI PH_HI_OVERRIDE
#endif
#ifndef PH_HI
#define PH_HI 1000
#endif
extern "C" void kernel_launch(void* const* d_in, const int* in_sizes, int n_in, void* d_out, int out_size, void* d_ws, size_t ws_size, hipStream_t stream) {
    static int grid = 0;
    if (grid == 0) {
        if (n_in != 26 || out_size != (int)O_END || ws_size < WS_END) { fprintf(stderr, "kernel_launch: unexpected sizes n_in %d out %d ws %zu (need %zu)\n", n_in, out_size, ws_size, (size_t)WS_END); grid = -1; return; }
        int dev = 0, cus = 0, per_cu = 0;
        if (hipGetDevice(&dev) != hipSuccess || hipDeviceGetAttribute(&cus, hipDeviceAttributeMultiprocessorCount, dev) != hipSuccess) { grid = -1; return; }
        if (hipFuncSetAttribute((const void*)fwd, hipFuncAttributeMaxDynamicSharedMemorySize, LDS_BYTES) != hipSuccess) { fprintf(stderr, "kernel_launch: hipFuncSetAttribute failed\n"); grid = -1; return; }
        if (hipOccupancyMaxActiveBlocksPerMultiprocessor(&per_cu, (const void*)fwd, NWAVES * 64, LDS_BYTES) != hipSuccess || per_cu < 1) { fprintf(stderr, "kernel_launch: occupancy query says %d\n", per_cu); (void)hipGetLastError(); grid = -1; return; }
        grid = cus;
    }
    if (grid < 0) return;
    (void)hipMemsetAsync((char*)d_ws + WS_CTL, 0, CTL_ZERO_BYTES, stream);
    Args a{};
    for (int i = 0; i < 26; ++i) a.in[i] = d_in[i];
    a.out = (float*)d_out; a.ws = (unsigned char*)d_ws; a.ph_lo = 0; a.ph_hi = PH_HI;
    hipLaunchKernelGGL(fwd, dim3(grid), dim3(NWAVES * 64), LDS_BYTES, stream, a);
}
```

```cpp
#define NSA_KERNEL_ONE_LAUNCH 1
#include <hip/hip_runtime.h>
#include <cstdio>
#include <cstdint>

#define GAS __attribute__((address_space(1)))
#define LAS __attribute__((address_space(3)))
typedef unsigned short bf16;
typedef unsigned v4u __attribute__((ext_vector_type(4)));
typedef unsigned v2u __attribute__((ext_vector_type(2)));
typedef float v2f __attribute__((ext_vector_type(2)));
typedef float f32x4 __attribute__((ext_vector_type(4)));
typedef float f32x2 __attribute__((ext_vector_type(2)));
typedef short bf16x8 __attribute__((ext_vector_type(8)));
typedef short s16x4 __attribute__((ext_vector_type(4)));
typedef GAS unsigned gu32;

constexpr int D = 1024, MP = 16384, MS = 128, MT = MP + MS, FF = 2816, NGU = 2 * FF, NCV = 3072, NNS = 2608, NNSP = 2816, PLE = 256;
constexpr int SEQ = 8192, SB = 32, ST = 4, PAST = 8192, NPAGE = 64, HD = 64, KVW = 256, WIN = 512, NBT = 34  ;
constexpr float RMS_EPS = 1e-6f;
constexpr float QSCALE = 0.125f * 1.4426950408889634f;

constexpr size_t O_Y = 0, O_YS = O_Y + (size_t)MP * D, O_CONVP = O_YS + (size_t)MS * D, O_CONVS = O_CONVP + 2 * 2 * D, O_KCP = O_CONVS + 32 * 2 * D;
constexpr size_t SZ_P = (size_t)MP * KVW, SZ_WP = 2 * 512 * KVW, SZ_S = (size_t)MS * KVW, SZ_WS = 32 * 512 * KVW;
constexpr size_t O_VCP = O_KCP + SZ_P, O_KSP = O_VCP + SZ_P, O_VSP = O_KSP + SZ_P, O_KWP = O_VSP + SZ_P, O_VWP = O_KWP + SZ_WP;
constexpr size_t O_KCS = O_VWP + SZ_WP, O_VCS = O_KCS + SZ_S, O_KSS = O_VCS + SZ_S, O_VSS = O_KSS + SZ_S, O_KWS = O_VSS + SZ_S, O_VWS = O_KWS + SZ_WS, O_END = O_VWS + SZ_WS;
static_assert(O_END == 42799104, "d_out size");

constexpr size_t MiB = 1u << 20;
constexpr size_t WS_CTL = 0, CTL_ZERO_BYTES = 1 * MiB;
constexpr size_t WS_WGU = 2 * MiB;
constexpr size_t SZ_WGU = (size_t)NGU * D * 2;
constexpr size_t WS_WDN = WS_WGU + 4 * SZ_WGU;
constexpr size_t SZ_WDN = (size_t)D * FF * 2;
constexpr size_t WS_WGATE = WS_WDN + 4 * SZ_WDN;
constexpr size_t SZ_WSQ = (size_t)D * D * 2;
constexpr size_t WS_WPROJ = WS_WGATE + 2 * SZ_WSQ;
constexpr size_t SZ_WPROJ = (size_t)D * PLE * 2;
constexpr size_t WS_WCIN = WS_WPROJ + 2 * SZ_WPROJ;
constexpr size_t WS_WCOUT = WS_WCIN + (size_t)NCV * D * 2;
constexpr size_t WS_WNIN = WS_WCOUT + SZ_WSQ;
constexpr size_t WS_WNOUT = WS_WNIN + (size_t)NNSP * D * 2;
constexpr size_t WS_W1T = WS_WNOUT + SZ_WSQ;
constexpr size_t WS_W2T = WS_W1T + 2 * (size_t)128 * 4096 * 2;
constexpr size_t WS_ROPE = WS_W2T + 2 * 64 * 128 * 2;
constexpr size_t WS_SS = (WS_ROPE + (size_t)8196 * 64 * 4 + MiB - 1) / MiB * MiB;
constexpr size_t SZ_SS = (size_t)MT * 16 * 4;
constexpr size_t WS_XB = (WS_SS + 2 * SZ_SS + MiB - 1) / MiB * MiB;
constexpr size_t SZ_XB = (size_t)MT * D * 2;
constexpr size_t WS_H = (WS_XB + 2 * SZ_XB + MiB - 1) / MiB * MiB;
constexpr size_t WS_AC = (WS_H + (size_t)MT * NCV * 2 + MiB - 1) / MiB * MiB;
constexpr size_t WS_PB = (WS_AC + SZ_XB + MiB - 1) / MiB * MiB;
constexpr size_t WS_P = (WS_PB + 2 * (size_t)MT * PLE * 2 + MiB - 1) / MiB * MiB;
constexpr size_t WS_QN = (WS_P + 2 * SZ_XB + MiB - 1) / MiB * MiB;
constexpr size_t WS_QR = (WS_QN + SZ_XB + MiB - 1) / MiB * MiB;
constexpr size_t SZ_KV = (size_t)MT * KVW * 2;
constexpr size_t WS_KS = (WS_QR + SZ_XB + MiB - 1) / MiB * MiB;
constexpr size_t WS_VS = WS_KS + SZ_KV, WS_KW = WS_VS + SZ_KV, WS_VW = WS_KW + SZ_KV;
constexpr size_t WS_GATES = (WS_VW + SZ_KV + MiB - 1) / MiB * MiB;
constexpr size_t WS_KC = (WS_GATES + (size_t)MT * 48 * 4 + MiB - 1) / MiB * MiB;
constexpr size_t SZ_KC = (size_t)NBT * 4 * 128 * 64 * 2;
constexpr size_t WS_VC = (WS_KC + SZ_KC + MiB - 1) / MiB * MiB;
constexpr size_t WS_CPART = (WS_VC + SZ_KC + MiB - 1) / MiB * MiB;
constexpr size_t WS_CBIAS = WS_CPART + 2 * 64 * 128 * 4;
constexpr size_t WS_SSS = WS_CPART + 256 * 1024, SZ_SSS = (size_t)MS * 32 * 4;
constexpr size_t WS_END = WS_CPART + MiB;
constexpr size_t WS_CV = WS_QN;
static_assert(WS_CV + (size_t)MT * NCV * 2 <= WS_GATES, "CV alias");

constexpr int CW_TMO = 0, CW_CODE = 1, CW_BAR = 4096;
constexpr int CW_TEAM = 8192  , CW_XCC = 12288  , CW_SKCNT = 12800  ;

constexpr int RING_BYTES = 131072, LDSCTL_OFF = 147456  , MISC_OFF = LDSCTL_OFF + 320, LDS_BYTES = 163840  ;
constexpr int NWAVES = 8;

#define RLX_AGENT __ATOMIC_RELAXED, __HIP_MEMORY_SCOPE_AGENT
#define LDS_WAIT() asm volatile("s_waitcnt lgkmcnt(0)" ::: "memory")
#define VM_WAIT() asm volatile("s_waitcnt vmcnt(0)" ::: "memory")

typedef float f2v __attribute__((ext_vector_type(2)));
typedef __bf16 b2v __attribute__((ext_vector_type(2)));
__device__ __forceinline__ unsigned pk2(float lo, float hi) { f2v v = {lo, hi}; b2v b = __builtin_convertvector(v, b2v); return __builtin_bit_cast(unsigned, b); }
__device__ __forceinline__ float bflo(unsigned u) { return __uint_as_float(u << 16); }
__device__ __forceinline__ float bfhi(unsigned u) { return __uint_as_float(u & 0xffff0000u); }
__device__ __forceinline__ float fast_exp2(float x) { return __builtin_amdgcn_exp2f(x); }
__device__ __forceinline__ float sigmoidf_(float x) { return __builtin_amdgcn_rcpf(1.f + fast_exp2(-1.4426950408889634f * x)); }

#ifdef PROBE_EPI_TICKS
#ifndef PROBE_COND
#define PROBE_COND (blockIdx.x == 0)
#endif
#ifndef PROBE_MUL
#define PROBE_MUL 1.0f
#endif
#ifndef PROBE_BLOCK
#define PROBE_BLOCK 0
#endif
#define PROBE_THREAD 0
__device__ unsigned long long g_ticks_store;
#define g_probe_ticks (&g_ticks_store)
#endif
namespace pg8 {
#define PG8_LAS __attribute__((address_space(3)))
typedef unsigned short bf16_t;
typedef short bf16x8 __attribute__((ext_vector_type(8)));
typedef float f32x4 __attribute__((ext_vector_type(4)));
typedef unsigned u32x4 __attribute__((ext_vector_type(4)));
constexpr int BM = 256, BK = 64, HALF = 128, HTB = HALF * BK * 2  , STAGE_BYTES = 8 * HTB, NXCD = 8, WGM = 8;

__host__ __device__ __forceinline__ int lds_byte(int r, int c) { const int st = (r >> 4) * 2 + (c >> 5), rr = r & 15, cc = c & 31, ob = rr * 64 + cc * 2; return st * 1024 + (ob ^ (((ob >> 9) & 1) << 5)); }
__host__ __device__ __forceinline__ void stage_rc(int b, int& R, int& C) { const int st = b / 1024, sb = b % 1024, swz = sb ^ (((sb >> 9) & 1) << 5); R = (st >> 1) * 16 + swz / 64; C = (st & 1) * 32 + (swz % 64) / 2; }
__host__ __device__ __forceinline__ int perm32(int rho) { const int n = rho >> 4, i = rho & 15; return 8 * (i >> 2) + 4 * n + (i & 3); }

struct Unit { int pm, pn; };
struct Gemm { const bf16_t* A; const bf16_t* Bt; int M, N, K; };

struct StaticOrder {
    int nM, nN, nwg, G, c;
    __host__ __device__ void init(int M, int N, int G_, int c_) { nM = M / BM; nN = N / BM; nwg = nM * nN; G = G_; c = c_; }
    __host__ __device__ bool next(int i, Unit& u) const {
        const long L = (long)i * G + c; if (L >= nwg) return false;
        int wgid = (int)L; { const int q = nwg / NXCD, r = nwg % NXCD, xcd = wgid % NXCD, off = wgid / NXCD; wgid = (xcd < r ? xcd * (q + 1) : r * (q + 1) + (xcd - r) * q) + off; }
        const int nig = WGM * nN, gid = wgid / nig, fm = gid * WGM, gsz = (nM - fm) < WGM ? (nM - fm) : WGM;
        u.pm = fm + ((wgid % nig) % gsz); u.pn = (wgid % nig) / gsz; return true;
    }
    __device__ __forceinline__ void a_ready(const Unit&) const {}
    __device__ __forceinline__ void done(const Unit&) const {}
};
template <class Epi, class Sched, bool ALIGN_EPI = false, bool SP2 = false>
__device__ __forceinline__ void gemm_phase(PG8_LAS unsigned char* lds, const Gemm g, const Sched& S, const Epi& E) {
    int tid_ = threadIdx.x; asm volatile("" : "+v"(tid_));
    const int tid = tid_, wid = __builtin_amdgcn_readfirstlane(tid >> 6), lane = tid & 63, wr = wid >> 2, wc = wid & 3, fr = lane & 15, fq = lane >> 4;
    const int K = g.K, nt = K / BK;
    unsigned voffA[2], voffB[2];
#pragma unroll
    for (int i = 0; i < 2; ++i) { int R, C; stage_rc(tid * 16 + i * 8192, R, C); const int Rb = Epi::PERM ? ((R & ~31) + perm32(R & 31)) : R;
        voffA[i] = (unsigned)(R * K + C) * 2u; voffB[i] = (unsigned)(Rb * K + C) * 2u; }
    const size_t kstep = (size_t)(BK * 2);
    const size_t hstep = (size_t)HALF * K * 2;
    const size_t tstep = 2 * hstep;
    const unsigned ldsw = (unsigned)wid * 1024u;
    const int aoff = lds_byte(wr * 64 + fr, fq * 8), boff = lds_byte(wc * 32 + fr, fq * 8);
#define PG8_SA(b, h) (((b) * 2 + (h)) * HTB)
#define PG8_SB(b, h) ((4 + (b) * 2 + (h)) * HTB)
#define PG8_STAGE(bufoff, gbase, voff) do { _Pragma("unroll") for (int _i = 0; _i < 2; ++_i) \
        __builtin_amdgcn_global_load_lds((const unsigned*)((const char*)(gbase) + (voff)[_i]), (PG8_LAS unsigned*)(lds + (bufoff) + ldsw + _i * 8192), 16, 0, 0); } while (0)
#define PG8_LDA(dst, b, h) do { _Pragma("unroll") for (int m = 0; m < 4; ++m) _Pragma("unroll") for (int k = 0; k < 2; ++k) dst[m][k] = *(const PG8_LAS bf16x8*)(lds + PG8_SA(b, h) + aoff + m * 2048 + k * 1024); } while (0)
#define PG8_LDB(dst, b, h) do { _Pragma("unroll") for (int n = 0; n < 2; ++n) _Pragma("unroll") for (int k = 0; k < 2; ++k) dst[n][k] = *(const PG8_LAS bf16x8*)(lds + PG8_SB(b, h) + boff + n * 2048 + k * 1024); } while (0)
#define PG8_MMA(ai, bj, At, Bt) do { __builtin_amdgcn_s_setprio(1); _Pragma("unroll") for (int m = 0; m < 4; ++m) _Pragma("unroll") for (int n = 0; n < 2; ++n) _Pragma("unroll") for (int k = 0; k < 2; ++k) \
        acc[ai][bj][m][n] = __builtin_amdgcn_mfma_f32_16x16x32_bf16(Bt[n][k], At[m][k], acc[ai][bj][m][n], 0, 0, 0); __builtin_amdgcn_s_setprio(0); } while (0)
#define PG8_WAIT_V(n) asm volatile("s_waitcnt vmcnt(" #n ")" ::: "memory")
#define PG8_WAIT_L(n) asm volatile("s_waitcnt lgkmcnt(" #n ")" ::: "memory")
#define PG8_BAR __builtin_amdgcn_s_barrier()
#define PG8_SCHED __builtin_amdgcn_sched_barrier(0)
    Unit cur, nxt; int ui = 0;
    if (!S.next(0, cur)) return;
    f32x4 acc[2][2][4][2];
#pragma unroll
    for (int a = 0; a < 2; ++a)
#pragma unroll
        for (int b = 0; b < 2; ++b)
#pragma unroll
            for (int m = 0; m < 4; ++m)
#pragma unroll
                for (int n = 0; n < 2; ++n) acc[a][b][m][n] = (f32x4){0.f, 0.f, 0.f, 0.f};
    bf16x8 At[4][2], B0[2][2], B1[2][2];
    const char* cA = (const char*)g.A + (size_t)cur.pm * tstep; const char* cB = (const char*)g.Bt + (size_t)cur.pn * tstep;
    S.a_ready(cur);
    if constexpr (SP2) {
        PG8_STAGE(PG8_SB(0, 0), cB, voffB); PG8_STAGE(PG8_SB(0, 1), cB + hstep, voffB); PG8_STAGE(PG8_SA(0, 0), cA, voffA); PG8_STAGE(PG8_SA(0, 1), cA + hstep, voffA);
        if (wr == 1) PG8_BAR;
        PG8_WAIT_V(2); PG8_BAR;
        PG8_STAGE(PG8_SB(1, 0), cB + kstep, voffB); PG8_STAGE(PG8_SA(1, 0), cA + kstep, voffA); PG8_STAGE(PG8_SB(1, 1), cB + hstep + kstep, voffB);
        PG8_WAIT_V(6); PG8_BAR;
    } else {
        PG8_STAGE(PG8_SB(0, 0), cB, voffB); PG8_STAGE(PG8_SA(0, 0), cA, voffA); PG8_STAGE(PG8_SB(0, 1), cB + hstep, voffB); PG8_STAGE(PG8_SA(0, 1), cA + hstep, voffA);
        if (wr == 1) PG8_BAR;
        PG8_WAIT_V(4); PG8_BAR;
        PG8_STAGE(PG8_SB(1, 0), cB + kstep, voffB); PG8_STAGE(PG8_SA(1, 0), cA + kstep, voffA); PG8_STAGE(PG8_SB(1, 1), cB + hstep + kstep, voffB);
        PG8_WAIT_V(6); PG8_BAR;
    }
    for (;;) {
        const bool has_next = S.next(ui + 1, nxt);
        const char* nA = has_next ? (const char*)g.A + (size_t)nxt.pm * tstep : cA; const char* nB = has_next ? (const char*)g.Bt + (size_t)nxt.pn * tstep : cB;
        for (int t = 0; t < nt; t += 2) {
            const bool last = (t == nt - 2);
            const char* a1 = cA + (size_t)(t + 1) * kstep;
            const char* a2 = last ? nA : cA + (size_t)(t + 2) * kstep; const char* b2 = last ? nB : cB + (size_t)(t + 2) * kstep;
            const char* a3 = a2 + kstep; const char* b3 = b2 + kstep;
            if (last && has_next) S.a_ready(nxt);
            if constexpr (SP2) {
            PG8_LDB(B0, 0, 0); PG8_LDB(B1, 0, 1); PG8_SCHED; PG8_LDA(At, 0, 0); PG8_STAGE(PG8_SA(1, 1), a1 + hstep, voffA);
            PG8_WAIT_V(8); PG8_WAIT_L(0); PG8_BAR; PG8_MMA(0, 0, At, B0); PG8_MMA(0, 1, At, B1); PG8_BAR; PG8_SCHED;
            PG8_LDA(At, 0, 1); PG8_STAGE(PG8_SB(0, 0), b2, voffB); PG8_STAGE(PG8_SB(0, 1), b2 + hstep, voffB); PG8_STAGE(PG8_SA(0, 0), a2, voffA);
            PG8_WAIT_V(8); PG8_WAIT_L(0); PG8_BAR; PG8_MMA(1, 0, At, B0); PG8_MMA(1, 1, At, B1); PG8_BAR; PG8_SCHED;
            PG8_LDB(B0, 1, 0); PG8_LDB(B1, 1, 1); PG8_SCHED; PG8_LDA(At, 1, 0); PG8_STAGE(PG8_SA(0, 1), a2 + hstep, voffA);
            PG8_WAIT_V(8); PG8_WAIT_L(0); PG8_BAR; PG8_MMA(0, 0, At, B0); PG8_MMA(0, 1, At, B1); PG8_BAR; PG8_SCHED;
            PG8_LDA(At, 1, 1); PG8_STAGE(PG8_SB(1, 0), b3, voffB); PG8_STAGE(PG8_SB(1, 1), b3 + hstep, voffB); PG8_STAGE(PG8_SA(1, 0), a3, voffA);
            PG8_WAIT_V(8); PG8_WAIT_L(0); PG8_BAR; PG8_MMA(1, 0, At, B0); PG8_MMA(1, 1, At, B1); PG8_BAR; PG8_SCHED;
            } else {
            PG8_LDB(B0, 0, 0); PG8_SCHED; PG8_LDA(At, 0, 0); PG8_STAGE(PG8_SA(1, 1), a1 + hstep, voffA);
            PG8_WAIT_L(8); PG8_BAR; PG8_WAIT_L(0); PG8_MMA(0, 0, At, B0); PG8_BAR; PG8_SCHED;
            PG8_LDB(B1, 0, 1); PG8_STAGE(PG8_SB(0, 0), b2, voffB);
            PG8_BAR; PG8_WAIT_L(0); PG8_MMA(0, 1, At, B1); PG8_BAR;
            PG8_LDA(At, 0, 1); PG8_STAGE(PG8_SA(0, 0), a2, voffA);
            PG8_BAR; PG8_WAIT_L(0); PG8_MMA(1, 0, At, B0); PG8_BAR; PG8_SCHED;
            PG8_STAGE(PG8_SB(0, 1), b2 + hstep, voffB);
            PG8_WAIT_V(6); PG8_BAR; PG8_MMA(1, 1, At, B1); PG8_BAR;
            PG8_LDB(B0, 1, 0); PG8_SCHED; PG8_LDA(At, 1, 0); PG8_STAGE(PG8_SA(0, 1), a2 + hstep, voffA);
            PG8_WAIT_L(8); PG8_BAR; PG8_WAIT_L(0); PG8_MMA(0, 0, At, B0); PG8_BAR; PG8_SCHED;
            PG8_LDB(B1, 1, 1); PG8_STAGE(PG8_SB(1, 0), b3, voffB);
            PG8_BAR; PG8_WAIT_L(0); PG8_MMA(0, 1, At, B1); PG8_BAR;
            PG8_LDA(At, 1, 1); PG8_STAGE(PG8_SA(1, 0), a3, voffA);
            PG8_BAR; PG8_WAIT_L(0); PG8_MMA(1, 0, At, B0); PG8_BAR; PG8_SCHED;
            PG8_STAGE(PG8_SB(1, 1), b3 + hstep, voffB);
            PG8_WAIT_V(6); PG8_BAR; PG8_MMA(1, 1, At, B1); PG8_BAR;
            }
        }
        if constexpr (ALIGN_EPI) { if (wr == 0) PG8_BAR; }
#ifdef PROBE_GEMM_EPI_TICKS
        const unsigned long long pt0_ = __builtin_amdgcn_s_memrealtime();
#endif
        if constexpr (!Epi::AFTER_DRAIN) { E(acc, cur, wr, wc, fr, fq); S.done(cur); }
#ifdef PROBE_GEMM_EPI_TICKS
        if (blockIdx.x == PROBE_BLOCK && threadIdx.x == PROBE_THREAD && PROBE_EPI_TICKS) atomicAdd(g_probe_ticks, (unsigned long long)(__builtin_amdgcn_s_memrealtime() - pt0_));
#endif
        if (!has_next) break;
#pragma unroll
        for (int a = 0; a < 2; ++a)
#pragma unroll
            for (int b = 0; b < 2; ++b)
#pragma unroll
                for (int m = 0; m < 4; ++m)
#pragma unroll
                    for (int n = 0; n < 2; ++n) acc[a][b][m][n] = (f32x4){0.f, 0.f, 0.f, 0.f};
        cur = nxt; cA = nA; cB = nB; ++ui;
        if constexpr (ALIGN_EPI) { if (wr == 1) PG8_BAR; }
    }
    PG8_WAIT_V(0);
    if constexpr (!ALIGN_EPI) { if (wr == 0) PG8_BAR; }
    PG8_BAR;
    if constexpr (Epi::AFTER_DRAIN) { E.fused(acc, cur, wr, wc, fr, fq, lds, wid, lane); S.done(cur); }
#undef PG8_SA
#undef PG8_SB
#undef PG8_STAGE
#undef PG8_LDA
#undef PG8_LDB
#undef PG8_MMA
#undef PG8_WAIT_V
#undef PG8_WAIT_L
#undef PG8_BAR
#undef PG8_SCHED
}

__device__ __forceinline__ void rstd8(const float* ss, int row0, int fq, float (&r)[8]) {
    f32x4 v[8];
#pragma unroll
    for (int i = 0; i < 8; ++i) v[i] = *(const f32x4*)(ss + (size_t)(row0 + (i >> 2) * HALF + (i & 3) * 16) * 16 + 4 * fq);
#pragma unroll
    for (int i = 0; i < 8; ++i) { float s = (v[i][0] + v[i][1]) + (v[i][2] + v[i][3]); s += __shfl_xor(s, 16); s += __shfl_xor(s, 32); r[i] = __builtin_amdgcn_rsqf(s * (1.f / 1024.f) + 1e-6f); }
#pragma unroll
    for (int i = 0; i < 8; ++i) asm volatile("" : "+v"(r[i]));
}
template <bool NORM> struct EpiRaw {
    static constexpr bool PERM = true, AFTER_DRAIN = false;
    bf16_t* O; int ldc; const float* ss;
    __device__ __forceinline__ void operator()(const f32x4 (&acc)[2][2][4][2], const Unit& u, int wr, int wc, int fr, int fq) const {
        const int row0 = u.pm * BM + wr * 64 + fr, col0 = u.pn * BM + wc * 32 + 8 * fq;
        float rr[8];
        if (NORM) rstd8(ss, row0, fq, rr);
#pragma unroll
        for (int ai = 0; ai < 2; ++ai)
#pragma unroll
            for (int m = 0; m < 4; ++m) { const int row = row0 + ai * HALF + m * 16; const float r = NORM ? rr[ai * 4 + m] : 1.f;
                bf16_t* rowp = O + (size_t)row * ldc + col0;
#pragma unroll
                for (int bj = 0; bj < 2; ++bj) { const f32x4 v0 = acc[ai][bj][m][0] * r, v1 = acc[ai][bj][m][1] * r;
                    u32x4 w; w.x = pk2(v0[0], v0[1]); w.y = pk2(v0[2], v0[3]); w.z = pk2(v1[0], v1[1]); w.w = pk2(v1[2], v1[3]);
                    if (NORM) *(u32x4*)(rowp + bj * HALF) = w; else __builtin_nontemporal_store(w, (u32x4*)(rowp + bj * HALF)); } }
    }
};
struct EpiSwiglu {
    static constexpr bool PERM = true, AFTER_DRAIN = false;
    bf16_t* H; const float* ss;
    __device__ __forceinline__ void operator()(const f32x4 (&acc)[2][2][4][2], const Unit& u, int wr, int wc, int fr, int fq) const {
        const int row0 = u.pm * BM + wr * 64 + fr, col0 = u.pn * HALF + wc * 32 + 8 * fq;
        float rr[8]; rstd8(ss, row0, fq, rr);
#pragma unroll
        for (int ai = 0; ai < 2; ++ai)
#pragma unroll
            for (int m = 0; m < 4; ++m) { const int row = row0 + ai * HALF + m * 16; const float r = rr[ai * 4 + m];
                float h[8];
#pragma unroll
                for (int n = 0; n < 2; ++n)
#pragma unroll
                    for (int e = 0; e < 4; ++e) { const float g = acc[ai][0][m][n][e] * r, uu = acc[ai][1][m][n][e] * r; h[4 * n + e] = g * sigmoidf_(g) * uu; }
                u32x4 w; w.x = pk2(h[0], h[1]); w.y = pk2(h[2], h[3]); w.z = pk2(h[4], h[5]); w.w = pk2(h[6], h[7]);
                *(u32x4*)(H + (size_t)row * FF + col0) = w; }
    }
};
template <bool GATE, bool FINAL> struct EpiResid {
    static constexpr bool PERM = true, AFTER_DRAIN = false;
    const bf16_t* XBi; float* Y; bf16_t* XBo; float* SSo; float scale; const float* ss_in; const bf16_t* P;
    __device__ __forceinline__ void operator()(const f32x4 (&acc)[2][2][4][2], const Unit& u, int wr, int wc, int fr, int fq) const {
        const int row0 = u.pm * BM + wr * 64 + fr, col0 = u.pn * BM + wc * 32 + 8 * fq;
        float rr[8];
        if (GATE) rstd8(ss_in, row0, fq, rr);
        constexpr int RB = GATE ? 2 : 4;
#pragma unroll
        for (int g8 = 0; g8 < 8; g8 += RB) {
            u32x4 xw[RB][2], pw[RB][2];
#pragma unroll
            for (int mi = 0; mi < RB; ++mi)
#pragma unroll
                for (int bj = 0; bj < 2; ++bj) { const int i = g8 + mi; const size_t off = (size_t)(row0 + (i >> 2) * HALF + (i & 3) * 16) * D + col0 + bj * HALF; xw[mi][bj] = GATE ? *(const u32x4*)(XBi + off) : __builtin_nontemporal_load((const u32x4*)(XBi + off)); if (GATE) pw[mi][bj] = __builtin_nontemporal_load((const u32x4*)(P + off)); }
#pragma unroll
            for (int mi = 0; mi < RB; ++mi)
#pragma unroll
                for (int bj = 0; bj < 2; ++bj) { asm volatile("" : "+v"(xw[mi][bj])); if (GATE) asm volatile("" : "+v"(pw[mi][bj])); }
#pragma unroll
            for (int mi = 0; mi < RB; ++mi) { const int i = g8 + mi, ai = i >> 2, m = i & 3; const int row = row0 + ai * HALF + m * 16; const float r = GATE ? rr[i] : 0.f;
                float sq = 0.f;
#pragma unroll
                for (int bj = 0; bj < 2; ++bj) { const size_t off = (size_t)row * D + col0 + bj * HALF; const u32x4 xv = xw[mi][bj];
                    f32x4 x0 = (f32x4){bflo(xv.x), bfhi(xv.x), bflo(xv.y), bfhi(xv.y)}, x1 = (f32x4){bflo(xv.z), bfhi(xv.z), bflo(xv.w), bfhi(xv.w)}; const f32x4 a0 = acc[ai][bj][m][0], a1 = acc[ai][bj][m][1];
                    if (GATE) { const u32x4 pv = pw[mi][bj];
                        x0[0] += sigmoidf_(a0[0] * r) * bflo(pv.x); x0[1] += sigmoidf_(a0[1] * r) * bfhi(pv.x); x0[2] += sigmoidf_(a0[2] * r) * bflo(pv.y); x0[3] += sigmoidf_(a0[3] * r) * bfhi(pv.y);
                        x1[0] += sigmoidf_(a1[0] * r) * bflo(pv.z); x1[1] += sigmoidf_(a1[1] * r) * bfhi(pv.z); x1[2] += sigmoidf_(a1[2] * r) * bflo(pv.w); x1[3] += sigmoidf_(a1[3] * r) * bfhi(pv.w);
                    } else { x0 += a0 * scale; x1 += a1 * scale; }
                    if (FINAL) { __builtin_nontemporal_store(x0, (f32x4*)(Y + off)); __builtin_nontemporal_store(x1, (f32x4*)(Y + off + 4)); }
                    else { u32x4 w; w.x = pk2(x0[0], x0[1]); w.y = pk2(x0[2], x0[3]); w.z = pk2(x1[0], x1[1]); w.w = pk2(x1[2], x1[3]);
                        *(u32x4*)(XBo + off) = w;
                        sq += (x0[0] * x0[0] + x0[1] * x0[1]) + (x0[2] * x0[2] + x0[3] * x0[3]) + (x1[0] * x1[0] + x1[1] * x1[1]) + (x1[2] * x1[2] + x1[3] * x1[3]); } }
                if (!FINAL) { sq += __shfl_xor(sq, 16); sq += __shfl_xor(sq, 32); if (fq == 0) SSo[(size_t)row * 16 + u.pn * 4 + wc] = sq; } }
        }
    }
};
}
typedef pg8::StaticOrder GOrder;

#define XB_TMO      128
#define XB_XCNT(j)  (256  + 64 * (j))
#define XB_XSUB(j)  (1280 + 64 * (j))
#define XB_XGEN(j)  (2304 + 64 * (j))
#define XB_TOP      3328
#define XB_TOPGEN   3392
#define XCD_BAR_WORDS 3456
#define XB_SPIN_CAP (1u << 18)

__device__ __forceinline__ unsigned xb_ld(unsigned* p)              { return __hip_atomic_load(p, __ATOMIC_RELAXED, __HIP_MEMORY_SCOPE_AGENT); }
__device__ __forceinline__ unsigned xb_add(unsigned* p, unsigned v) { return __hip_atomic_fetch_add(p, v, __ATOMIC_RELAXED, __HIP_MEMORY_SCOPE_AGENT); }
__device__ __forceinline__ unsigned xb_xcc_id() { return (unsigned)__builtin_amdgcn_s_getreg((3 << 11) | 20) & 0xFu; }
#define XB_SPIN(cond, bar) do { unsigned _sp = 0; while (cond) { __builtin_amdgcn_s_sleep(1); \
    if ((++_sp & 255u) == 0u) { if (xb_ld(&(bar)[XB_TMO])) break; if (_sp > XB_SPIN_CAP) { atomicAdd(&(bar)[XB_TMO], 1u); break; } } } } while (0)

struct XcdBarrier {
    unsigned* bar; unsigned x;
    volatile LAS unsigned* st;
};

__device__ __forceinline__ XcdBarrier xcd_barrier_post(unsigned* bar, volatile LAS unsigned* st) {
    XcdBarrier b; b.bar = bar; b.x = xb_xcc_id(); b.st = st;
    if (threadIdx.x == 0) (void)xb_add(&bar[XB_XCNT(b.x)], 1u);
    return b;
}
__device__ __forceinline__ void xcd_barrier_complete(unsigned* bar, unsigned x, unsigned& nloc, unsigned& nx) {
    const unsigned G = gridDim.x * gridDim.y * gridDim.z;
    unsigned sum, cnt, mine, sp = 0u;
    for (;;) {
        sum = 0u; cnt = 0u; mine = 0u;
#pragma unroll
        for (unsigned j = 0; j < 16; ++j) { const unsigned c = xb_ld(&bar[XB_XCNT(j)]); sum += c; cnt += (c > 0u) ? 1u : 0u; mine = (j == x) ? c : mine; }
        if (sum == G) break;
        __builtin_amdgcn_s_sleep(1);
        if ((++sp & 255u) == 0u) { if (xb_ld(&bar[XB_TMO])) break; if (sp > XB_SPIN_CAP) { atomicAdd(&bar[XB_TMO], 1u); break; } }
    }
    nloc = mine > 0u ? mine : 1u; nx = cnt > 0u ? cnt : 1u;
}

__device__ __forceinline__ void xcd_barrier(const XcdBarrier& b) {
    asm volatile("s_waitcnt vmcnt(0)" ::: "memory");
    __syncthreads();
    if (threadIdx.x == 0) {
        unsigned* bar = b.bar;
        __builtin_amdgcn_s_waitcnt(0);
        unsigned nloc = b.st[0], nx = b.st[1];
        if (nloc == 0u) { xcd_barrier_complete(bar, b.x, nloc, nx); b.st[0] = nloc; b.st[1] = nx; }
        const unsigned old = xb_add(&bar[XB_XSUB(b.x)], 1u);
        const unsigned gen = old / nloc;
        if (old + 1u == (gen + 1u) * nloc) {
            __builtin_amdgcn_fence(__ATOMIC_RELEASE, "agent");
            asm volatile("s_waitcnt vmcnt(0)" ::: "memory");
            const unsigned og = xb_add(&bar[XB_TOP], 1u);
            const unsigned tg = og / nx;
            if (og + 1u == (tg + 1u) * nx) xb_add(&bar[XB_TOPGEN], 1u);
            else XB_SPIN(xb_ld(&bar[XB_TOPGEN]) == tg, bar);
            __builtin_amdgcn_fence(__ATOMIC_ACQUIRE, "agent");
            xb_add(&bar[XB_XGEN(b.x)], 1u);
            asm volatile("s_waitcnt vmcnt(0)" ::: "memory");
        } else {
            XB_SPIN(xb_ld(&bar[XB_XGEN(b.x)]) == gen, bar);
            __builtin_amdgcn_fence(__ATOMIC_ACQUIRE, "agent");
            asm volatile("s_waitcnt vmcnt(0)" ::: "memory");
        }
    }
    __syncthreads();
}

__device__ __forceinline__ void team_barrier(unsigned* ctlw, unsigned target, volatile LAS unsigned* same, unsigned pend) {
    asm volatile("s_waitcnt vmcnt(0)" ::: "memory");
    __syncthreads();
    if (threadIdx.x == 0) {
        const int bx = blockIdx.x; unsigned* tb = ctlw + CW_TEAM + 64 * ((bx & 7) * 8 + ((bx >> 3) & 7));
        __builtin_amdgcn_s_waitcnt(0);
        if (*same != 1u) { __builtin_amdgcn_fence(__ATOMIC_RELEASE, "agent"); asm volatile("s_waitcnt vmcnt(0)" ::: "memory"); }
        if (pend) (void)xb_add(ctlw + CW_SKCNT, pend);
        (void)xb_add(tb, 1u);
        XB_SPIN(xb_ld(tb) < target, ctlw + CW_BAR);
        __builtin_amdgcn_fence(__ATOMIC_ACQUIRE, "agent");
        asm volatile("s_waitcnt vmcnt(0)" ::: "memory");
    }
    __syncthreads();
}

__device__ __forceinline__ void team_arrive(unsigned* ctlw, volatile LAS unsigned* same) {
    asm volatile("s_waitcnt vmcnt(0)" ::: "memory");
    __syncthreads();
    if (threadIdx.x == 0) {
        const int bx = blockIdx.x; unsigned* tb = ctlw + CW_TEAM + 64 * ((bx & 7) * 8 + ((bx >> 3) & 7));
        __builtin_amdgcn_s_waitcnt(0);
        if (*same != 1u) { __builtin_amdgcn_fence(__ATOMIC_RELEASE, "agent"); asm volatile("s_waitcnt vmcnt(0)" ::: "memory"); }
        (void)xb_add(tb, 1u);
    }
}
__device__ __forceinline__ void team_wait(unsigned* ctlw, unsigned target, unsigned pend) {
    if (pend) { asm volatile("s_waitcnt vmcnt(0)" ::: "memory"); __syncthreads(); }
    if (threadIdx.x == 0) {
        const int bx = blockIdx.x; unsigned* tb = ctlw + CW_TEAM + 64 * ((bx & 7) * 8 + ((bx >> 3) & 7));
        if (pend) (void)xb_add(ctlw + CW_SKCNT, pend);
        XB_SPIN(xb_ld(tb) < target, ctlw + CW_BAR);
        __builtin_amdgcn_fence(__ATOMIC_ACQUIRE, "agent");
        asm volatile("s_waitcnt vmcnt(0)" ::: "memory");
    }
    __syncthreads();
}

__device__ __forceinline__ float wave_sum(float v) {
#pragma unroll
    for (int o = 1; o < 64; o <<= 1) v += __shfl_xor(v, o);
    return v;
}
__device__ __forceinline__ void st_bf16x8(bf16* p, const float* v) { v4u w; w.x = pk2(v[0], v[1]); w.y = pk2(v[2], v[3]); w.z = pk2(v[4], v[5]); w.w = pk2(v[6], v[7]); *(v4u*)p = w; }
__device__ __forceinline__ void ld_bf16x8_nt(const bf16* p, float* v) { const v4u w = __builtin_nontemporal_load((const v4u*)p); v[0] = bflo(w.x); v[1] = bfhi(w.x); v[2] = bflo(w.y); v[3] = bfhi(w.y); v[4] = bflo(w.z); v[5] = bfhi(w.z); v[6] = bflo(w.w); v[7] = bfhi(w.w); }
__device__ __forceinline__ void ld_bf16x8(const bf16* p, float* v) { const v4u w = *(const v4u*)p; v[0] = bflo(w.x); v[1] = bfhi(w.x); v[2] = bflo(w.y); v[3] = bfhi(w.y); v[4] = bflo(w.z); v[5] = bfhi(w.z); v[6] = bflo(w.w); v[7] = bfhi(w.w); }

template <int MODE, int NB> __device__ __forceinline__ int sk_brow(int cu, int j) {
    if (MODE == 0) return cu * (16 * NB) + j;
    const int T = cu >> 2, q = cu & 3; return T * 256 + q * 32 + (j & 31) + ((j >> 5) ? 128 : 0);
}
#ifdef PROBE_SKW_TICKS
#define PROBE_SKW_T0 if (threadIdx.x == 0) ((volatile LAS unsigned*)(lds + MISC_OFF))[14] = (unsigned)__builtin_amdgcn_s_memrealtime();
#define PROBE_SKW_T1 if (threadIdx.x == 0) ((volatile LAS unsigned*)(lds + MISC_OFF))[13] += (unsigned)__builtin_amdgcn_s_memrealtime() - ((volatile LAS unsigned*)(lds + MISC_OFF))[14];
#else
#define PROBE_SKW_T0
#define PROBE_SKW_T1
#endif
template <int MODE, int NB, class Epi>
__device__ __forceinline__ void skinny_phase(LAS unsigned char* lds, const bf16* A, const bf16* Bt, int K, int ncu, const Epi& E, int first, int stride, unsigned* ctlw, unsigned need, unsigned& pend, int lim = 0x7fffffff) {
    int tid_ = threadIdx.x; asm volatile("" : "+v"(tid_));
    const int tid = tid_, wave = __builtin_amdgcn_readfirstlane(tid >> 6), lane = tid & 63, fr = lane & 15, fq = lane >> 4;
    constexpr int NC = 16 * NB;
    LAS float* part = (LAS float*)lds;
    LAS float* tile = (LAS float*)(lds + 65536);
    const int kw = K >> 3, k0 = wave * kw, nst = kw >> 5;
    lim = lim < 4 * ncu ? lim : 4 * ncu;
    const bool mine = first < lim;
    if (ctlw != nullptr && mine && need > 0u) {
        PROBE_SKW_T0
        if (threadIdx.x == 0) { XB_SPIN(xb_ld(ctlw + CW_SKCNT) < need, ctlw + CW_BAR); __builtin_amdgcn_fence(__ATOMIC_ACQUIRE, "agent"); asm volatile("s_waitcnt vmcnt(0)" ::: "memory"); }
        PROBE_SKW_T1
        __syncthreads();
    }
    unsigned ndone = 0u;
    for (int un = first; un < lim; un += stride) {
        const int rb = un & 3, cu = un >> 2; ++ndone;
        typename Epi::Pre pre = E.pre(rb, cu, tid);
        f32x4 acc[2][NB];
#pragma unroll
        for (int i = 0; i < 2; ++i)
#pragma unroll
            for (int c = 0; c < NB; ++c) acc[i][c] = (f32x4){0.f, 0.f, 0.f, 0.f};
        const bf16* ap = A + (size_t)(rb * 32 + fr) * K + k0 + 8 * fq;
        const bf16* bp[NB];
#pragma unroll
        for (int c = 0; c < NB; ++c) bp[c] = Bt + (size_t)sk_brow<MODE, NB>(cu, 16 * c + fr) * K + k0 + 8 * fq;
        constexpr int SKB = NB == 4 ? 6 : 11;
#pragma unroll 1
        for (int s0 = 0; s0 < nst; s0 += SKB) {
            bf16x8 a0[SKB], a1[SKB], b[SKB][NB];
#pragma unroll
            for (int j = 0; j < SKB; ++j) if (s0 + j < nst) { const int s = s0 + j;
                a0[j] = *(const bf16x8*)(ap + 32 * s); a1[j] = *(const bf16x8*)(ap + (size_t)16 * K + 32 * s);
#pragma unroll
                for (int c = 0; c < NB; ++c) b[j][c] = *(const bf16x8*)(bp[c] + 32 * s); }
#pragma unroll
            for (int j = 0; j < SKB; ++j) if (s0 + j < nst) {
#pragma unroll
                for (int c = 0; c < NB; ++c) { acc[0][c] = __builtin_amdgcn_mfma_f32_16x16x32_bf16(a0[j], b[j][c], acc[0][c], 0, 0, 0); acc[1][c] = __builtin_amdgcn_mfma_f32_16x16x32_bf16(a1[j], b[j][c], acc[1][c], 0, 0, 0); } }
        }
#pragma unroll
        for (int i = 0; i < 2; ++i)
#pragma unroll
            for (int c = 0; c < NB; ++c)
#pragma unroll
                for (int r = 0; r < 4; ++r) part[wave * (32 * NC) + (i * 16 + 4 * fq + r) * NC + c * 16 + fr] = acc[i][c][r];
        __syncthreads();
        if (tid < 8 * NC) { const int row = tid / (NC / 4), cg = tid % (NC / 4); f32x4 s = (f32x4){0.f, 0.f, 0.f, 0.f};
#pragma unroll
          for (int w = 0; w < 8; ++w) s += *(const LAS f32x4*)(part + w * (32 * NC) + row * NC + 4 * cg);
          *(LAS f32x4*)(tile + row * NC + 4 * cg) = s; }
        __syncthreads();
        E(tile, rb, cu, tid, pre);
        __syncthreads();
    }
    if (ctlw != nullptr) pend += ndone;
}
__device__ __forceinline__ void st_wt8(void* p, v2u w) { __hip_atomic_store((unsigned long long*)p, (unsigned long long)w.x | ((unsigned long long)w.y << 32), __ATOMIC_RELAXED, __HIP_MEMORY_SCOPE_AGENT); }
__device__ __forceinline__ void st_wt4(float* p, float v) { __hip_atomic_store(p, v, __ATOMIC_RELAXED, __HIP_MEMORY_SCOPE_AGENT); }
__device__ __forceinline__ float sk_ss_load(const float* sss, int srow, int cg) { const v2f v = *(const v2f*)(sss + (size_t)srow * 32 + 2 * cg); return v.x + v.y; }
__device__ __forceinline__ float sk_rstd_finish(float s) {
    s += __shfl_xor(s, 1); s += __shfl_xor(s, 2); s += __shfl_xor(s, 4); s += __shfl_xor(s, 8);
    return __builtin_amdgcn_rsqf(s * (1.f / 1024.f) + 1e-6f);
}
template <bool NORM> struct SkRaw { bf16* O; int ldc; const float* sss;
    struct Pre { float s; };
    __device__ __forceinline__ Pre pre(int rb, int cu, int tid) const { Pre p; p.s = NORM ? sk_ss_load(sss, rb * 32 + (tid >> 4), tid & 15) : 0.f; return p; }
    __device__ __forceinline__ void operator()(const LAS float* tile, int rb, int cu, int tid, const Pre& p) const {
        const int row = tid >> 4, cg = tid & 15, grow = MP + rb * 32 + row; const float r = NORM ? sk_rstd_finish(p.s) : 1.f;
        const f32x4 v = *(const LAS f32x4*)(tile + row * 64 + 4 * cg) * r; const int col = cu * 64 + 4 * cg;
        if (col < ldc) { v2u w; w.x = pk2(v[0], v[1]); w.y = pk2(v[2], v[3]); st_wt8(O + (size_t)grow * ldc + col, w); }
    } };
struct SkSwiglu { bf16* H; const float* sss;
    struct Pre { float s; };
    __device__ __forceinline__ Pre pre(int rb, int cu, int tid) const { Pre p; p.s = sk_ss_load(sss, rb * 32 + (tid >> 4), tid & 15); return p; }
    __device__ __forceinline__ void operator()(const LAS float* tile, int rb, int cu, int tid, const Pre& p) const {
        const int row = tid >> 4, cg = tid & 15, grow = MP + rb * 32 + row; const float r = sk_rstd_finish(p.s);
        if (cg < 8) { const f32x4 g = *(const LAS f32x4*)(tile + row * 64 + 4 * cg) * r, u = *(const LAS f32x4*)(tile + row * 64 + 32 + 4 * cg) * r;
            float h[4];
#pragma unroll
            for (int e = 0; e < 4; ++e) h[e] = g[e] * sigmoidf_(g[e]) * u[e];
            v2u w; w.x = pk2(h[0], h[1]); w.y = pk2(h[2], h[3]); st_wt8(H + (size_t)grow * FF + cu * 32 + 4 * cg, w); }
    } };
template <bool GATE> struct SkResid { const bf16* XBi; float* Y; bf16* XBo; float* SSSo; float scale; const float* sss_in; const bf16* P; int fin;
    struct Pre { v2u xw, pw; float s; };
    __device__ __forceinline__ Pre pre(int rb, int cu, int tid) const { Pre p; const int t = tid & 255, row = t >> 3, cg = t & 7; const size_t off = (size_t)(MP + rb * 32 + row) * D + cu * 32 + 4 * cg;
        p.xw = *(const v2u*)(XBi + off); p.pw = p.xw; p.s = 0.f;
        if (GATE) { p.pw = *(const v2u*)(P + off); const f32x4 v = *(const f32x4*)(sss_in + (size_t)(rb * 32 + row) * 32 + 4 * cg); p.s = (v[0] + v[1]) + (v[2] + v[3]); }
        return p; }
    __device__ __forceinline__ void operator()(const LAS float* tile, int rb, int cu, int tid, const Pre& p) const {
        const int t = tid & 255, row = t >> 3, cg = t & 7, srow = rb * 32 + row; float r = 0.f;
        if (GATE) { float s = p.s; s += __shfl_xor(s, 1); s += __shfl_xor(s, 2); s += __shfl_xor(s, 4); r = __builtin_amdgcn_rsqf(s * (1.f / 1024.f) + 1e-6f); }
        const f32x4 a = *(const LAS f32x4*)(tile + row * 32 + 4 * cg); const size_t off = (size_t)(MP + srow) * D + cu * 32 + 4 * cg;
        f32x4 x = (f32x4){bflo(p.xw.x), bfhi(p.xw.x), bflo(p.xw.y), bfhi(p.xw.y)};
        if (GATE) { x[0] += sigmoidf_(a[0] * r) * bflo(p.pw.x); x[1] += sigmoidf_(a[1] * r) * bfhi(p.pw.x); x[2] += sigmoidf_(a[2] * r) * bflo(p.pw.y); x[3] += sigmoidf_(a[3] * r) * bfhi(p.pw.y);
        } else x += a * scale;
        float sq = (x[0] * x[0] + x[1] * x[1]) + (x[2] * x[2] + x[3] * x[3]);
        sq += __shfl_xor(sq, 1); sq += __shfl_xor(sq, 2); sq += __shfl_xor(sq, 4);
        if (tid < 256) {
            if (fin) *(f32x4*)(Y + off) = x;
            else { v2u w; w.x = pk2(x[0], x[1]); w.y = pk2(x[2], x[3]); st_wt8(XBo + off, w); if (cg == 0) st_wt4(SSSo + (size_t)srow * 32 + cu, sq); } }
    } };

__device__ __forceinline__ void transpose_item(const float* W, int K, int N, int Nd, bf16* WT, const float* gain, int mode, LAS float* scr, int item, int lane) {
    const int nblk = Nd / 64, kb = item / nblk, nb = item % nblk, k0 = 64 * kb, n0 = 64 * nb;
    const int n4 = 4 * (lane & 15), n = n0 + n4;
    f32x4 v[16];
#pragma unroll
    for (int i = 0; i < 16; ++i) { const int kk = 4 * i + (lane >> 4); v[i] = (f32x4){0.f, 0.f, 0.f, 0.f}; if (n < N) v[i] = __builtin_nontemporal_load((const f32x4*)(W + (size_t)(k0 + kk) * N + n)); }
    if (gain) {
#pragma unroll
        for (int i = 0; i < 16; ++i) v[i] *= gain[k0 + 4 * i + (lane >> 4)]; }
#pragma unroll
    for (int i = 0; i < 16; ++i) { const int kk = 4 * i + (lane >> 4); scr[kk * 65 + n4] = v[i][0]; scr[kk * 65 + n4 + 1] = v[i][1]; scr[kk * 65 + n4 + 2] = v[i][2]; scr[kk * 65 + n4 + 3] = v[i][3]; }
    LDS_WAIT(); asm volatile("" ::: "memory");
    const int c = lane & 7;
#pragma unroll
    for (int j = 0; j < 8; ++j) { const int nl = (lane >> 3) + 8 * j, nn = n0 + nl; const LAS float* s = scr + (8 * c) * 65 + nl;
        int drow = nn; if (mode == 1) { const int jj = nn < FF ? nn : nn - FF; drow = (jj >> 7) * 256 + (jj & 127) + (nn < FF ? 0 : 128); }
        v4u o; o.x = pk2(s[0 * 65], s[1 * 65]); o.y = pk2(s[2 * 65], s[3 * 65]); o.z = pk2(s[4 * 65], s[5 * 65]); o.w = pk2(s[6 * 65], s[7 * 65]);
        *(GAS v4u*)(WT + (size_t)drow * K + k0 + 8 * c) = o; }
    LDS_WAIT(); asm volatile("" ::: "memory");
}
struct In {
    const float *x_prompt, *x_sample, *state_conv, *ck_cmp, *cv_cmp, *ck_sel, *cv_sel, *ck_win, *cv_win; const int* page_table; const float *p_prompt, *p_sample, *norm_g, *w_gu, *w_down,
        *w_proj, *w_gate, *cw_in, *cw, *cw_out, *nw_in, *qk_g, *cmp_pos, *cmp_w1, *cmp_w2, *nw_out;
};
__device__ __forceinline__ void sincos_d(double r, float& s, float& c) {
    const double r2 = r * r;
    double sp = 1.0, cp = 1.0;
#pragma unroll
    for (int k = 12; k >= 1; --k) { sp = 1.0 - sp * r2 / (double)((2 * k) * (2 * k + 1)); cp = 1.0 - cp * r2 / (double)((2 * k - 1) * (2 * k)); }
    s = (float)(r * sp); c = (float)cp;
}
__device__ __forceinline__ void p0_prologue(const In& I, float* out, unsigned char* ws, LAS unsigned char* lds, int vcu, int G, int wave, int lane) {
    LAS float* scr = (LAS float*)(lds + wave * 17408);
    const int gw = vcu * NWAVES + wave, NGW = G * NWAVES;
    constexpr int I_GU = (D / 64) * (NGU / 64), I_DN = (FF / 64) * (D / 64), I_SQ = (D / 64) * (D / 64), I_PR = (PLE / 64) * (D / 64), I_CI = (D / 64) * (NCV / 64), I_NI = (D / 64) * (NNSP / 64),
                  I_W1 = (4096 / 64) * (128 / 64), I_W2 = (128 / 64) * (64 / 64);
    constexpr int NITEMS = 4 * I_GU + 4 * I_DN + 2 * I_SQ + 2 * I_PR + I_CI + I_SQ + I_NI + I_SQ + 2 * I_W1 + 2 * I_W2;
#define TR(W_, K_, N_, ND_, WT_, G_, MODE_, NI_) if (r < (NI_)) { transpose_item(W_, K_, N_, ND_, WT_, G_, MODE_, scr, r, lane); continue; } r -= (NI_);
    for (int it = gw; it < NITEMS; it += NGW) {
        int r = it;
        TR(I.w_gu + (size_t)0 * D * NGU, D, NGU, NGU, (bf16*)(ws + WS_WGU + 0 * SZ_WGU), I.norm_g + 0 * D, 1, I_GU)
        TR(I.w_gu + (size_t)1 * D * NGU, D, NGU, NGU, (bf16*)(ws + WS_WGU + 1 * SZ_WGU), I.norm_g + 2 * D, 1, I_GU)
        TR(I.w_gu + (size_t)2 * D * NGU, D, NGU, NGU, (bf16*)(ws + WS_WGU + 2 * SZ_WGU), I.norm_g + 4 * D, 1, I_GU)
        TR(I.w_gu + (size_t)3 * D * NGU, D, NGU, NGU, (bf16*)(ws + WS_WGU + 3 * SZ_WGU), I.norm_g + 6 * D, 1, I_GU)
        TR(I.w_down + (size_t)0 * FF * D, FF, D, D, (bf16*)(ws + WS_WDN + 0 * SZ_WDN), nullptr, 0, I_DN)
        TR(I.w_down + (size_t)1 * FF * D, FF, D, D, (bf16*)(ws + WS_WDN + 1 * SZ_WDN), nullptr, 0, I_DN)
        TR(I.w_down + (size_t)2 * FF * D, FF, D, D, (bf16*)(ws + WS_WDN + 2 * SZ_WDN), nullptr, 0, I_DN)
        TR(I.w_down + (size_t)3 * FF * D, FF, D, D, (bf16*)(ws + WS_WDN + 3 * SZ_WDN), nullptr, 0, I_DN)
        TR(I.w_gate + (size_t)0 * D * D, D, D, D, (bf16*)(ws + WS_WGATE + 0 * SZ_WSQ), I.norm_g + 3 * D, 0, I_SQ)
        TR(I.w_gate + (size_t)1 * D * D, D, D, D, (bf16*)(ws + WS_WGATE + 1 * SZ_WSQ), I.norm_g + 7 * D, 0, I_SQ)
        TR(I.w_proj + (size_t)0 * PLE * D, PLE, D, D, (bf16*)(ws + WS_WPROJ + 0 * SZ_WPROJ), nullptr, 0, I_PR)
        TR(I.w_proj + (size_t)1 * PLE * D, PLE, D, D, (bf16*)(ws + WS_WPROJ + 1 * SZ_WPROJ), nullptr, 0, I_PR)
        TR(I.cw_in, D, NCV, NCV, (bf16*)(ws + WS_WCIN), I.norm_g + 1 * D, 0, I_CI)
        TR(I.cw_out, D, D, D, (bf16*)(ws + WS_WCOUT), nullptr, 0, I_SQ)
        TR(I.nw_in, D, NNS, NNSP, (bf16*)(ws + WS_WNIN), I.norm_g + 5 * D, 0, I_NI)
        TR(I.nw_out, D, D, D, (bf16*)(ws + WS_WNOUT), nullptr, 0, I_SQ)
        TR(I.cmp_w1 + (size_t)0 * 4096 * 128, 4096, 128, 128, (bf16*)(ws + WS_W1T) + (size_t)0 * 128 * 4096, nullptr, 0, I_W1)
        TR(I.cmp_w1 + (size_t)1 * 4096 * 128, 4096, 128, 128, (bf16*)(ws + WS_W1T) + (size_t)1 * 128 * 4096, nullptr, 0, I_W1)
        TR(I.cmp_w2 + (size_t)0 * 128 * 64, 128, 64, 64, (bf16*)(ws + WS_W2T) + (size_t)0 * 64 * 128, nullptr, 0, I_W2)
        TR(I.cmp_w2 + (size_t)1 * 128 * 64, 128, 64, 64, (bf16*)(ws + WS_W2T) + (size_t)1 * 64 * 128, nullptr, 0, I_W2)
    }
#undef TR
    bf16* XB0 = (bf16*)(ws + WS_XB); float* SS0 = (float*)(ws + WS_SS);
    for (int m = gw; m < MT; m += NGW) {
        const float* src = m < MP ? I.x_prompt + (size_t)m * D : I.x_sample + (size_t)(m - MP) * D;
        const GAS f32x4* xr = (const GAS f32x4*)src + lane;
        GAS v2u* o8 = (GAS v2u*)(XB0 + (size_t)m * D) + lane; float s = 0.f;
#pragma unroll
        for (int j = 0; j < 4; ++j) { const f32x4 v = __builtin_nontemporal_load(xr + 64 * j); s += (v[0] * v[0] + v[1] * v[1]) + (v[2] * v[2] + v[3] * v[3]); v2u w; w.x = pk2(v[0], v[1]); w.y = pk2(v[2], v[3]); o8[64 * j] = w; }
        s = wave_sum(s);
        if (lane < 16) SS0[(size_t)m * 16 + lane] = lane == 0 ? s : 0.f;
        if (m >= MP && lane < 32) ((float*)(ws + WS_SSS))[(size_t)(m - MP) * 32 + lane] = lane == 0 ? s : 0.f;
    }
    bf16* PB = (bf16*)(ws + WS_PB);
    for (int r = gw; r < 2 * MT; r += NGW) { const int l = r / MT, m = r % MT;
        const float* src = m < MP ? I.p_prompt + ((size_t)l * MP + m) * PLE : I.p_sample + ((size_t)l * MS + (m - MP)) * PLE;
        const f32x4 v = __builtin_nontemporal_load((const GAS f32x4*)src + lane); v2u w; w.x = pk2(v[0], v[1]); w.y = pk2(v[2], v[3]); ((GAS v2u*)(PB + (size_t)r * PLE))[lane] = w; }
    float* ROPE = (float*)(ws + WS_ROPE);
    for (int i = gw * 64 + lane; i < 8196 * 32; i += NGW * 64) { const int pos = i >> 5, d = i & 31;
        const float inv = (float)exp2(-(double)d * (13.287712379549449 / 32.0));
        const float ang = (float)pos * inv; const double a = (double)ang, k = rint(a * 0.15915494309189535), rr = a - k * 6.283185307179586;
        float s, c; sincos_d(rr, s, c); ROPE[(size_t)pos * 64 + d] = c; ROPE[(size_t)pos * 64 + 32 + d] = s; }
}

__device__ __forceinline__ void conv_post(const In& I, float* out, unsigned char* ws, int vcu, int G, int wave, int lane) {
    const bf16* CV = (const bf16*)(ws + WS_CV); bf16* AC = (bf16*)(ws + WS_AC);
    const int gw = vcu * NWAVES + wave, NGW = G * NWAVES;
    constexpr int RS = 8, NSTRIP_P = MP / RS, NITEM = (NSTRIP_P + SB) * 2;
    for (int it = gw; it < NITEM; it += NGW) {
        const int half = it & 1, st = it >> 1, ch = half * 512 + lane * 8;
        const bool samp = st >= NSTRIP_P; const int row0 = samp ? MP + (st - NSTRIP_P) * 4 : st * RS, nrow = samp ? 4 : RS;
        const bool halo = !samp && (row0 & (SEQ - 1)) != 0;
        v4u cw[RS + 2], vw[RS + 2], bw[RS];
#pragma unroll
        for (int i = 0; i < RS + 2; ++i) { const int r = row0 - 2 + i; const bool ok = (i >= 2) ? (i - 2 < nrow) : halo; cw[i] = (v4u){0u, 0u, 0u, 0u}; vw[i] = cw[i];
            if (ok) { cw[i] = __builtin_nontemporal_load((const v4u*)(CV + (size_t)r * NCV + D + ch)); vw[i] = __builtin_nontemporal_load((const v4u*)(CV + (size_t)r * NCV + 2 * D + ch)); } }
#pragma unroll
        for (int i = 0; i < RS; ++i) { bw[i] = (v4u){0u, 0u, 0u, 0u}; if (i < nrow) bw[i] = __builtin_nontemporal_load((const v4u*)(CV + (size_t)(row0 + i) * NCV + ch)); }
        float w0[8], w1[8], w2[8], um2[8], um1[8];
#pragma unroll
        for (int e = 0; e < 8; ++e) { w0[e] = I.cw[ch + e]; w1[e] = I.cw[D + ch + e]; w2[e] = I.cw[2 * D + ch + e]; }
        if (samp) { const int bs = st - NSTRIP_P;
#pragma unroll
            for (int e = 0; e < 8; ++e) { um2[e] = I.state_conv[((size_t)bs * 2 + 0) * D + ch + e]; um1[e] = I.state_conv[((size_t)bs * 2 + 1) * D + ch + e]; }
        } else {
            const unsigned c2[4] = {cw[0].x, cw[0].y, cw[0].z, cw[0].w}, v2[4] = {vw[0].x, vw[0].y, vw[0].z, vw[0].w}, c1[4] = {cw[1].x, cw[1].y, cw[1].z, cw[1].w}, v1[4] = {vw[1].x, vw[1].y, vw[1].z, vw[1].w};
#pragma unroll
            for (int e = 0; e < 4; ++e) { um2[2 * e] = bflo(c2[e]) * bflo(v2[e]); um2[2 * e + 1] = bfhi(c2[e]) * bfhi(v2[e]); um1[2 * e] = bflo(c1[e]) * bflo(v1[e]); um1[2 * e + 1] = bfhi(c1[e]) * bfhi(v1[e]); } }
#pragma unroll
        for (int i = 0; i < RS; ++i) if (i < nrow) { const int row = row0 + i; float u[8], o[8];
            const unsigned cc[4] = {cw[i + 2].x, cw[i + 2].y, cw[i + 2].z, cw[i + 2].w}, vv[4] = {vw[i + 2].x, vw[i + 2].y, vw[i + 2].z, vw[i + 2].w}, bb[4] = {bw[i].x, bw[i].y, bw[i].z, bw[i].w};
#pragma unroll
            for (int e = 0; e < 4; ++e) { u[2 * e] = bflo(cc[e]) * bflo(vv[e]); u[2 * e + 1] = bfhi(cc[e]) * bfhi(vv[e]); }
#pragma unroll
            for (int e = 0; e < 8; ++e) { const float bv = (e & 1) ? bfhi(bb[e >> 1]) : bflo(bb[e >> 1]); o[e] = bv * (w0[e] * um2[e] + w1[e] * um1[e] + w2[e] * u[e]); um2[e] = um1[e]; um1[e] = u[e]; }
            st_bf16x8(AC + (size_t)row * D + ch, o);
            float* so = nullptr;
            if (!samp) { const int t = row & (SEQ - 1); if (t >= SEQ - 2) so = out + O_CONVP + ((size_t)(row >> 13) * 2 + (t - (SEQ - 2))) * D + ch; }
            else if (i >= 2) so = out + O_CONVS + ((size_t)(st - NSTRIP_P) * 2 + (i - 2)) * D + ch;
            if (so) { *(f32x4*)so = (f32x4){u[0], u[1], u[2], u[3]}; *(f32x4*)(so + 4) = (f32x4){u[4], u[5], u[6], u[7]}; } }
    }
}

__device__ __forceinline__ void nsa_post(const In& I, float* out, unsigned char* ws, int vcu, int G, int wave, int lane) {
    const bf16* RAW = (const bf16*)(ws + WS_H); const float* ROPE = (const float*)(ws + WS_ROPE);
    bf16* QN = (bf16*)(ws + WS_QN); bf16* QR = (bf16*)(ws + WS_QR); bf16* KS = (bf16*)(ws + WS_KS); bf16* VS = (bf16*)(ws + WS_VS); bf16* KW = (bf16*)(ws + WS_KW); bf16* VW = (bf16*)(ws + WS_VW);
    float* GATES = (float*)(ws + WS_GATES);
    const int gw = vcu * NWAVES + wave, NGW = G * NWAVES, qd = lane >> 2, p = lane & 3;
    for (int row = gw; row < MT; row += NGW) {
        const bool samp = row >= MP; const int sr = row - MP; const int pos = samp ? PAST + (sr & 3) : (row & (SEQ - 1));
        float cs[8], sn[8];
        { const f32x4 c0 = *(const f32x4*)(ROPE + (size_t)pos * 64 + 8 * p), c1 = *(const f32x4*)(ROPE + (size_t)pos * 64 + 8 * p + 4), s0 = *(const f32x4*)(ROPE + (size_t)pos * 64 + 32 + 8 * p), s1 = *(const f32x4*)(ROPE + (size_t)pos * 64 + 36 + 8 * p);
#pragma unroll
          for (int e = 0; e < 4; ++e) { cs[e] = c0[e]; cs[4 + e] = c1[e]; sn[e] = s0[e]; sn[4 + e] = s1[e]; } }
#pragma unroll
        for (int pass = 0; pass < 3; ++pass) { const int sg = qd + 16 * pass;
            if (sg < 40) {
                float x1[8], x2[8];
                ld_bf16x8_nt(RAW + (size_t)row * NNSP + 64 * sg + 8 * p, x1); ld_bf16x8_nt(RAW + (size_t)row * NNSP + 64 * sg + 32 + 8 * p, x2);
                const int typ = sg < 16 ? 0 : 1 + ((sg - 16) >> 2), g4 = sg & 3;
                const bool nrm = (typ == 0 || typ == 3 || typ == 5);
                if (nrm) { const int gi = typ == 0 ? 0 : (typ == 3 ? 2 : 3); float ssq = 0.f;
#pragma unroll
                    for (int e = 0; e < 8; ++e) ssq += x1[e] * x1[e] + x2[e] * x2[e];
                    ssq += __shfl_xor(ssq, 1); ssq += __shfl_xor(ssq, 2);
                    const float rs = __builtin_amdgcn_rsqf(ssq * (1.f / 64.f) + RMS_EPS);
#pragma unroll
                    for (int e = 0; e < 8; ++e) { x1[e] *= rs * I.qk_g[gi * 64 + 8 * p + e]; x2[e] *= rs * I.qk_g[gi * 64 + 32 + 8 * p + e]; } }
                float y1[8], y2[8];
#pragma unroll
                for (int e = 0; e < 8; ++e) { y1[e] = x1[e] * cs[e] - x2[e] * sn[e]; y2[e] = x2[e] * cs[e] + x1[e] * sn[e]; }
                if (typ == 0) { float a[8], b[8];
#pragma unroll
                    for (int e = 0; e < 8; ++e) { a[e] = x1[e] * QSCALE; b[e] = x2[e] * QSCALE; }
                    st_bf16x8(QN + (size_t)row * D + 64 * sg + 8 * p, a); st_bf16x8(QN + (size_t)row * D + 64 * sg + 32 + 8 * p, b);
#pragma unroll
                    for (int e = 0; e < 8; ++e) { a[e] = y1[e] * QSCALE; b[e] = y2[e] * QSCALE; }
                    st_bf16x8(QR + (size_t)row * D + 64 * sg + 8 * p, a); st_bf16x8(QR + (size_t)row * D + 64 * sg + 32 + 8 * p, b);
                } else {
                    const bool rope = (typ == 3 || typ == 5);
                    float o1[8], o2[8];
#pragma unroll
                    for (int e = 0; e < 8; ++e) { o1[e] = rope ? y1[e] : x1[e]; o2[e] = rope ? y2[e] : x2[e]; }
                    float* fo = nullptr; bf16* bo = nullptr; const size_t co = (size_t)g4 * 64 + 8 * p;
                    if (typ <= 4) { const size_t base = samp ? (typ == 1 ? O_KCS : typ == 2 ? O_VCS : typ == 3 ? O_KSS : O_VSS) + (size_t)sr * KVW : (typ == 1 ? O_KCP : typ == 2 ? O_VCP : typ == 3 ? O_KSP : O_VSP) + (size_t)row * KVW;
                        fo = out + base + co; if (typ == 3) bo = KS + (size_t)row * KVW + co; if (typ == 4) bo = VS + (size_t)row * KVW + co;
                    } else { bo = (typ == 5 ? KW : VW) + (size_t)row * KVW + co;
                        if (samp) fo = out + (typ == 5 ? O_KWS : O_VWS) + ((size_t)(sr >> 2) * 512 + 508 + (sr & 3)) * KVW + co;
                        else { const int t = row & (SEQ - 1); if (t >= SEQ - WIN) fo = out + (typ == 5 ? O_KWP : O_VWP) + ((size_t)(row >> 13) * 512 + (t - (SEQ - WIN))) * KVW + co; } }
                    if (fo) { const f32x4 a0 = (f32x4){o1[0], o1[1], o1[2], o1[3]}, a1 = (f32x4){o1[4], o1[5], o1[6], o1[7]}, a2 = (f32x4){o2[0], o2[1], o2[2], o2[3]}, a3 = (f32x4){o2[4], o2[5], o2[6], o2[7]};
                        if (typ <= 2 && !samp) { *(f32x4*)fo = a0; *(f32x4*)(fo + 4) = a1; *(f32x4*)(fo + 32) = a2; *(f32x4*)(fo + 36) = a3; }
                        else { __builtin_nontemporal_store(a0, (f32x4*)fo); __builtin_nontemporal_store(a1, (f32x4*)(fo + 4)); __builtin_nontemporal_store(a2, (f32x4*)(fo + 32)); __builtin_nontemporal_store(a3, (f32x4*)(fo + 36)); } }
                    if (bo) { st_bf16x8(bo, o1); st_bf16x8(bo + 32, o2); }
                }
            }
        }
        if (lane < 48) { const unsigned short rv = RAW[(size_t)row * NNSP + 2560 + lane]; GATES[(size_t)row * 48 + lane] = sigmoidf_(__uint_as_float((unsigned)rv << 16)); }
    }
    { const size_t n4 = (size_t)SB * 508 * 64; const size_t gt = (size_t)(vcu * NWAVES + wave) * 64 + lane, NT = (size_t)NGW * 64;
      for (size_t i = gt; i < 2 * n4; i += NT) { const int kv = i >= n4; const size_t j = kv ? i - n4 : i; const size_t bs = j / (508 * 64), rem = j % (508 * 64);
          const f32x4 v = __builtin_nontemporal_load((const GAS f32x4*)(kv ? I.cv_win : I.ck_win) + bs * 512 * 64 + 4 * 64 + rem);
          __builtin_nontemporal_store(v, (GAS f32x4*)(out + (kv ? O_VWS : O_KWS)) + bs * 512 * 64 + rem); } }
}

__device__ __forceinline__ void glds16(const void* gsrc, unsigned lds_dst) { unsigned keep;
    asm volatile("s_mov_b32 %0, m0\n\ts_mov_b32 m0, %2\n\ts_nop 0\n\tglobal_load_lds_dwordx4 %1, off\n\ts_mov_b32 m0, %0" : "=&s"(keep) : "v"(gsrc), "s"(lds_dst) : "memory"); }
__device__ __forceinline__ unsigned lds_addr(const LAS unsigned char* p) { return (unsigned)(uintptr_t)p; }
__device__ __forceinline__ void glds16_nt(const void* gsrc, unsigned lds_dst) { unsigned keep;
    asm volatile("s_mov_b32 %0, m0\n\ts_mov_b32 m0, %2\n\ts_nop 0\n\tglobal_load_lds_dwordx4 %1, off nt\n\ts_mov_b32 m0, %0" : "=&s"(keep) : "v"(gsrc), "s"(lds_dst) : "memory"); }

constexpr int CMP_NA = 5, CMP_NB = 3, CMP_BOFF = CMP_NA * 16384, CMP_RED_OFF = LDSCTL_OFF + 1024;
static_assert(CMP_BOFF + CMP_NB * 16384 <= RING_BYTES, "compress LDS");
__device__ __forceinline__ void cmp_bias_partials(const In& I, unsigned char* ws, int vcu, int G, int wave, int lane) {
    float* PART = (float*)(ws + WS_CPART); const int gw = vcu * NWAVES + wave, NGW = G * NWAVES;
    for (int it = gw; it < 128; it += NGW) { const int kv = it >> 6, j = it & 63; float a0 = 0.f, a1 = 0.f;
        const float* pp = I.cmp_pos + ((size_t)kv * 64 + j) * 64; const float* wp = I.cmp_w1 + ((size_t)kv * 4096 + 64 * j) * 128;
#pragma unroll 8
        for (int d = 0; d < 64; ++d) { const float p = pp[d]; a0 += p * wp[d * 128 + lane]; a1 += p * wp[d * 128 + 64 + lane]; }
        PART[(size_t)it * 128 + lane] = a0; PART[(size_t)it * 128 + 64 + lane] = a1; }
}
__device__ __forceinline__ void cmp_bias_reduce(unsigned char* ws, int vcu, int tid) {
    if (vcu != 0 || tid >= 256) return;
    const float* PART = (const float*)(ws + WS_CPART); float* BIAS = (float*)(ws + WS_CBIAS); const int kv = tid >> 7, n = tid & 127; float a = 0.f;
    for (int j = 0; j < 64; ++j) a += PART[((size_t)kv * 64 + j) * 128 + n];
    BIAS[tid] = a;
}
struct CmpSrc { const float* kbase; const float* vbase; const int* page_table; int seq0, nseq, cpu; };
__device__ __forceinline__ const float* cmp_chunk_base(const CmpSrc& S, int kv, int cid) {
    const int sq = cid >> 7, nb = cid & 127; const float* base = kv ? S.vbase : S.kbase;
    if (S.page_table) { const int pg = S.page_table[sq * NPAGE + (nb >> 1)]; return base + ((size_t)pg * 128 + (nb & 1) * 64) * KVW; }
    return base + ((size_t)sq * SEQ + nb * 64) * KVW;
}
__device__ __forceinline__ void compress_phase(const In& I, unsigned char* ws, LAS unsigned char* lds, const CmpSrc& S, int vcu, int G) {
    int tid_ = threadIdx.x; asm volatile("" : "+v"(tid_));
    const int tid = tid_, wave = __builtin_amdgcn_readfirstlane(tid >> 6), lane = tid & 63, fr = lane & 15, fq = lane >> 4, wm = wave >> 2, wn = wave & 3;
    const int cpu = S.cpu, upk = S.nseq * 128 / cpu, nunits = 2 * upk;
    int nmine = 0; for (int u = vcu; u < nunits; u += G) ++nmine;
    if (nmine == 0) return;
    const int total = nmine * 64;
    const bf16* W1T = (const bf16*)(ws + WS_W1T); const bf16* W2T = (const bf16*)(ws + WS_W2T);
    LAS float* BIAS = (LAS float*)(lds + CMP_RED_OFF + 1024);
    if (tid < 256) { const float* PART = (const float*)(ws + WS_CPART); const int kv = tid >> 7, n = tid & 127; float a = 0.f;
#pragma unroll 8
        for (int j = 0; j < 64; ++j) a += PART[((size_t)kv * 64 + j) * 128 + n];
        BIAS[tid] = a; }
    asm volatile("s_waitcnt vmcnt(0) lgkmcnt(0)" ::: "memory"); __builtin_amdgcn_s_barrier(); asm volatile("" ::: "memory");
    unsigned aoffs[2];
#pragma unroll
    for (int i = 0; i < 2; ++i) { const int c = 2 * wave + i, r = 4 * c + (lane >> 4); aoffs[i] = (unsigned)((lane >> 4) * 256 + (((lane & 15) ^ (r & 15)) * 16)); }
    unsigned boffs[2];
#pragma unroll
    for (int i = 0; i < 2; ++i) { int R, C; pg8::stage_rc(tid * 16 + i * 8192, R, C); boffs[i] = (unsigned)(R * 4096 + C) * 2u; }
#define CMP_ISSUE_A(gs_) do { const int ui_ = (gs_) >> 6, j_ = (gs_) & 63, u_ = vcu + ui_ * G, kv_ = u_ >= upk ? 1 : 0, ul_ = u_ - kv_ * upk; \
        LAS unsigned char* st_ = lds + ((gs_) % CMP_NA) * 16384; \
        if (j_ == 0) { cb0 = cmp_chunk_base(S, kv_, ul_ * cpu + (2 * wave < cpu ? 2 * wave : 0)); cb1 = cmp_chunk_base(S, kv_, ul_ * cpu + (2 * wave + 1 < cpu ? 2 * wave + 1 : 0)); }     \
        if (S.page_table) { glds16_nt((const char*)cb0 + (size_t)j_ * 1024 + aoffs[0], lds_addr(st_ + (2 * wave) * 1024)); glds16_nt((const char*)cb1 + (size_t)j_ * 1024 + aoffs[1], lds_addr(st_ + (2 * wave + 1) * 1024)); } \
        else { glds16((const char*)cb0 + (size_t)j_ * 1024 + aoffs[0], lds_addr(st_ + (2 * wave) * 1024)); glds16((const char*)cb1 + (size_t)j_ * 1024 + aoffs[1], lds_addr(st_ + (2 * wave + 1) * 1024)); } } while (0)
#define CMP_ISSUE_B(gs_) do { const int ui_ = (gs_) >> 6, j_ = (gs_) & 63, u_ = vcu + ui_ * G, kv_ = u_ >= upk ? 1 : 0; \
        LAS unsigned char* st_ = lds + CMP_BOFF + ((gs_) % CMP_NB) * 16384; const char* wb_ = (const char*)(W1T + (size_t)kv_ * 128 * 4096) + j_ * 128; \
        _Pragma("unroll") for (int i_ = 0; i_ < 2; ++i_) glds16(wb_ + boffs[i_], lds_addr(st_ + wave * 1024 + i_ * 8192)); } while (0)
    f32x4 acc[2][2];
#pragma unroll
    for (int a = 0; a < 2; ++a)
#pragma unroll
        for (int b = 0; b < 2; ++b) acc[a][b] = (f32x4){0.f, 0.f, 0.f, 0.f};
    const float* cb0 = nullptr; const float* cb1 = nullptr;
    CMP_ISSUE_A(0); CMP_ISSUE_A(1); CMP_ISSUE_B(0); CMP_ISSUE_A(2); CMP_ISSUE_B(1); CMP_ISSUE_A(3);
    for (int gs = 0; gs < total; ++gs) {
        if (gs + 3 < total) asm volatile("s_waitcnt vmcnt(4)" ::: "memory"); else if (gs + 1 < total) asm volatile("s_waitcnt vmcnt(2)" ::: "memory"); else asm volatile("s_waitcnt vmcnt(0)" ::: "memory");
        __builtin_amdgcn_s_barrier(); asm volatile("" ::: "memory");
        if (gs + 4 < total) CMP_ISSUE_A(gs + 4);
        if (gs + 2 < total) CMP_ISSUE_B(gs + 2);
        const LAS unsigned char* st = lds + (gs % CMP_NA) * 16384; const LAS unsigned char* stb = lds + CMP_BOFF + (gs % CMP_NB) * 16384;
#pragma unroll
        for (int ks = 0; ks < 2; ++ks) {
            bf16x8 xa[2], wb[2];
#pragma unroll
            for (int rb = 0; rb < 2; ++rb) { const int row = 32 * wm + 16 * rb + fr, ch = 8 * ks + 2 * fq;
                const f32x4 lo = *(const LAS f32x4*)(st + row * 256 + ((ch ^ (row & 15)) * 16)), hi = *(const LAS f32x4*)(st + row * 256 + (((ch + 1) ^ (row & 15)) * 16));
                v4u w; w.x = pk2(lo[0], lo[1]); w.y = pk2(lo[2], lo[3]); w.z = pk2(hi[0], hi[1]); w.w = pk2(hi[2], hi[3]); xa[rb] = __builtin_bit_cast(bf16x8, w); }
#pragma unroll
            for (int cb = 0; cb < 2; ++cb) wb[cb] = *(const LAS bf16x8*)(stb + pg8::lds_byte(32 * wn + 16 * cb + fr, 32 * ks + 8 * fq));
#pragma unroll
            for (int cb = 0; cb < 2; ++cb)
#pragma unroll
                for (int rb = 0; rb < 2; ++rb) acc[cb][rb] = __builtin_amdgcn_mfma_f32_16x16x32_bf16(wb[cb], xa[rb], acc[cb][rb], 0, 0, 0);
        }
        if ((gs & 63) == 63) {
            const int ui = gs >> 6, u = vcu + ui * G, kv = u >= upk ? 1 : 0, ul = u - kv * upk;
            LAS unsigned char* hid = lds + CMP_BOFF + (gs % CMP_NB) * 16384; LAS float* red = (LAS float*)(lds + CMP_RED_OFF);
            asm volatile("s_waitcnt lgkmcnt(0)" ::: "memory"); __builtin_amdgcn_s_barrier(); asm volatile("" ::: "memory");
#pragma unroll
            for (int cb = 0; cb < 2; ++cb) { const int n0 = 32 * wn + 16 * cb + 4 * fq; const f32x4 bv = *(const LAS f32x4*)(BIAS + kv * 128 + n0);
#pragma unroll
                for (int rb = 0; rb < 2; ++rb) { const int row = 32 * wm + 16 * rb + fr; float h[4];
#pragma unroll
                    for (int e = 0; e < 4; ++e) { const float x = acc[cb][rb][e] + bv[e]; const float t = 0.7978845608028654f * (x + 0.044715f * x * x * x); h[e] = x * sigmoidf_(2.f * t); acc[cb][rb][e] = 0.f; }
                    v2u w; w.x = pk2(h[0], h[1]); w.y = pk2(h[2], h[3]);
                    *(LAS v2u*)(hid + row * 256 + (((n0 >> 3) ^ (row & 15)) * 16) + (n0 & 7) * 2) = w; } }
            asm volatile("s_waitcnt lgkmcnt(0)" ::: "memory"); __builtin_amdgcn_s_barrier(); asm volatile("" ::: "memory");
            const int rblk = wave >> 1, oh = wave & 1;
            f32x4 o2[2] = {(f32x4){0.f, 0.f, 0.f, 0.f}, (f32x4){0.f, 0.f, 0.f, 0.f}};
#pragma unroll
            for (int ks = 0; ks < 4; ++ks) { const int row = 16 * rblk + fr, ch = 4 * ks + fq;
                const bf16x8 hb = *(const LAS bf16x8*)(hid + row * 256 + ((ch ^ (row & 15)) * 16));
#pragma unroll
                for (int ob = 0; ob < 2; ++ob) { const bf16x8 wa = *(const bf16x8*)(W2T + ((size_t)kv * 64 + 32 * oh + 16 * ob + fr) * 128 + 32 * ks + 8 * fq);
                    o2[ob] = __builtin_amdgcn_mfma_f32_16x16x32_bf16(wa, hb, o2[ob], 0, 0, 0); } }
            float ssq = 0.f;
#pragma unroll
            for (int ob = 0; ob < 2; ++ob)
#pragma unroll
                for (int e = 0; e < 4; ++e) ssq += o2[ob][e] * o2[ob][e];
            ssq += __shfl_xor(ssq, 16); ssq += __shfl_xor(ssq, 32);
            if (fq == 0) red[(16 * rblk + fr) * 2 + oh] = ssq;
            asm volatile("s_waitcnt lgkmcnt(0)" ::: "memory"); __builtin_amdgcn_s_barrier(); asm volatile("" ::: "memory");
            const int trow = 16 * rblk + fr; const float tot = red[trow * 2] + red[trow * 2 + 1];
            const float rs = kv ? 1.f : __builtin_amdgcn_rsqf(tot * (1.f / 64.f) + RMS_EPS);
            const bool rvalid = (trow >> 2) < cpu; const int cid = ul * cpu + (rvalid ? (trow >> 2) : 0), g = trow & 3, sq = S.seq0 + (cid >> 7), nb = cid & 127;
            bf16* dst = (bf16*)(ws + (kv ? WS_VC : WS_KC)) + (((size_t)sq * 4 + g) * 128 + nb) * 64;
#pragma unroll
            for (int ob = 0; ob < 2; ++ob) { const int o0 = 32 * oh + 16 * ob + 4 * fq; float y[4];
#pragma unroll
                for (int e = 0; e < 4; ++e) y[e] = o2[ob][e] * rs * (kv ? 1.f : I.qk_g[64 + o0 + e]);
                v2u w; w.x = pk2(y[0], y[1]); w.y = pk2(y[2], y[3]); if (rvalid) *(v2u*)(dst + o0) = w; }
        }
    }
    asm volatile("s_waitcnt vmcnt(0) lgkmcnt(0)" ::: "memory"); __builtin_amdgcn_s_barrier(); asm volatile("" ::: "memory");
}

constexpr int AT_IMP = 32768  , AT_OUTS = 65536, AT_SELM = LDSCTL_OFF + 1024;
constexpr int SAT_IMP = LDSCTL_OFF + 1024, SAT_SELM = SAT_IMP + 4 * 132 * 4;
static_assert(SAT_SELM + 4 * 8 * 4 <= LDS_BYTES && AT_SELM + 64 * 16 <= LDS_BYTES && AT_OUTS + 65536 <= RING_BYTES, "attention LDS");
__device__ __forceinline__ s16x4 tr16(const LAS unsigned char* p) { typedef short v4s __attribute__((ext_vector_type(4))); return __builtin_bit_cast(s16x4, __builtin_amdgcn_ds_read_tr16_b64_v4i16((LAS v4s*)p)); }
__device__ __forceinline__ unsigned dpp_max_u32(unsigned v) {
    v = max(v, (unsigned)__builtin_amdgcn_update_dpp(0, (int)v, 0xB1, 0xF, 0xF, true));
    v = max(v, (unsigned)__builtin_amdgcn_update_dpp(0, (int)v, 0x4E, 0xF, 0xF, true));
    v = max(v, (unsigned)__builtin_amdgcn_update_dpp(0, (int)v, 0x141, 0xF, 0xF, true));
    v = max(v, (unsigned)__builtin_amdgcn_update_dpp(0, (int)v, 0x140, 0xF, 0xF, true));
    const unsigned a = __builtin_amdgcn_readlane((int)v, 0), b = __builtin_amdgcn_readlane((int)v, 16), c = __builtin_amdgcn_readlane((int)v, 32), d = __builtin_amdgcn_readlane((int)v, 48);
    return max(max(a, b), max(c, d));
}
__device__ __forceinline__ void stage_block_dma(LAS unsigned char* dst, const bf16* src_row0, int pitch_bytes, int wave, int lane) {
    const int row = 8 * wave + (lane >> 3), chunk = (lane & 7) ^ (lane >> 3);
    glds16((const char*)src_row0 + (size_t)row * pitch_bytes + chunk * 16, lds_addr(dst + wave * 1024));
}
__device__ __forceinline__ void kfrags(bf16x8 (&kf)[4][2], const LAS unsigned char* kb, int fr, int fq) {
#pragma unroll
    for (int k = 0; k < 4; ++k)
#pragma unroll
        for (int ks = 0; ks < 2; ++ks) kf[k][ks] = *(const LAS bf16x8*)(kb + (16 * k + fr) * 128 + (((4 * ks + fq) ^ (fr & 7)) * 16));
}
__device__ __forceinline__ bf16x8 pack_p(const f32x4& a, const f32x4& b) { v4u w; w.x = pk2(a[0], a[1]); w.y = pk2(a[2], a[3]); w.z = pk2(b[0], b[1]); w.w = pk2(b[2], b[3]); return __builtin_bit_cast(bf16x8, w); }
template <bool do0, bool do1>
__device__ __forceinline__ void pv_block(const LAS unsigned char* vb, const bf16x8 (&p)[2][2], f32x4 (&o)[2][4], int fr, int fq) {
    const int q4 = fr >> 2, pp = fr & 3, kk = 4 * (fq & 1) + q4;
    const LAS unsigned char* vrow = vb + (4 * fq + q4) * 128 + (pp & 1) * 8;
#pragma unroll
    for (int db = 0; db < 4; ++db) { const int xo = (((2 * db + (pp >> 1)) ^ kk) * 16);
#pragma unroll
        for (int st = 0; st < 2; ++st) {
            const s16x4 lo4 = tr16(vrow + (32 * st) * 128 + xo), hi4 = tr16(vrow + (32 * st + 16) * 128 + xo);
            const bf16x8 vf = (bf16x8){lo4[0], lo4[1], lo4[2], lo4[3], hi4[0], hi4[1], hi4[2], hi4[3]};
            if (do0) o[0][db] = __builtin_amdgcn_mfma_f32_16x16x32_bf16(vf, p[0][st], o[0][db], 0, 0, 0);
            if (do1) o[1][db] = __builtin_amdgcn_mfma_f32_16x16x32_bf16(vf, p[1][st], o[1][db], 0, 0, 0); } }
}
template <bool EDGE, bool do0, bool do1>
__device__ __forceinline__ void attn_block_t(const LAS unsigned char* kb, const LAS unsigned char* vb, const bf16x8 (&q)[2][2], const float (&bias)[2], const int (&lo)[2], const int (&hi)[2],
                                           f32x4 (&o)[2][4], float (&l)[2], int fr, int fq) {
    bf16x8 kf[4][2]; kfrags(kf, kb, fr, fq);
    f32x4 sc[2][4];
#pragma unroll
    for (int s = 0; s < 2; ++s) if (s ? do1 : do0) {
#pragma unroll
        for (int k = 0; k < 4; ++k) sc[s][k] = __builtin_amdgcn_mfma_f32_16x16x32_bf16(kf[k][0], q[s][0], (f32x4){bias[s], bias[s], bias[s], bias[s]}, 0, 0, 0); }
#pragma unroll
    for (int s = 0; s < 2; ++s) if (s ? do1 : do0) {
#pragma unroll
        for (int k = 0; k < 4; ++k) sc[s][k] = __builtin_amdgcn_mfma_f32_16x16x32_bf16(kf[k][1], q[s][1], sc[s][k], 0, 0, 0); }
    __builtin_amdgcn_sched_barrier(0);
    bf16x8 vf[4][2];
    { const int q4 = fr >> 2, pp = fr & 3, kk = 4 * (fq & 1) + q4; const LAS unsigned char* vrow = vb + (4 * fq + q4) * 128 + (pp & 1) * 8;
#pragma unroll
      for (int db = 0; db < 4; ++db) { const int xo = (((2 * db + (pp >> 1)) ^ kk) * 16);
#pragma unroll
          for (int st = 0; st < 2; ++st) { const s16x4 lo4 = tr16(vrow + (32 * st) * 128 + xo), hi4 = tr16(vrow + (32 * st + 16) * 128 + xo);
              vf[db][st] = (bf16x8){lo4[0], lo4[1], lo4[2], lo4[3], hi4[0], hi4[1], hi4[2], hi4[3]}; } } }
    __builtin_amdgcn_sched_barrier(0);
    bf16x8 p[2][2];
#pragma unroll
    for (int s = 0; s < 2; ++s) if (s ? do1 : do0) { float ls = 0.f;
#pragma unroll
        for (int k = 0; k < 4; ++k)
#pragma unroll
            for (int e = 0; e < 4; ++e) { float v = sc[s][k][e]; if (EDGE) { const int key = 16 * k + 4 * fq + e; if (key < lo[s] || key > hi[s]) v = -INFINITY; } v = fast_exp2(v); sc[s][k][e] = v; ls += v; }
        l[s] += ls; p[s][0] = pack_p(sc[s][0], sc[s][1]); p[s][1] = pack_p(sc[s][2], sc[s][3]); }
    __builtin_amdgcn_sched_barrier(0);
#pragma unroll
    for (int st = 0; st < 2; ++st)
#pragma unroll
        for (int db = 0; db < 4; ++db) {
            if (do0) o[0][db] = __builtin_amdgcn_mfma_f32_16x16x32_bf16(vf[db][st], p[0][st], o[0][db], 0, 0, 0);
            if (do1) o[1][db] = __builtin_amdgcn_mfma_f32_16x16x32_bf16(vf[db][st], p[1][st], o[1][db], 0, 0, 0); }
}
template <bool EDGE>
__device__ __forceinline__ void attn_block(const LAS unsigned char* kb, const LAS unsigned char* vb, bool do0, bool do1, const bf16x8 (&q)[2][2], const float (&bias)[2], const int (&lo)[2], const int (&hi)[2],
                                           f32x4 (&o)[2][4], float (&l)[2], int fr, int fq) {
    if (do0 && do1) attn_block_t<EDGE, true, true>(kb, vb, q, bias, lo, hi, o, l, fr, fq);
    else if (do0) attn_block_t<EDGE, true, false>(kb, vb, q, bias, lo, hi, o, l, fr, fq);
    else attn_block_t<EDGE, false, true>(kb, vb, q, bias, lo, hi, o, l, fr, fq);
}

__device__ __forceinline__ void attn_prompt_unit(unsigned char* ws, LAS unsigned char* lds, int b, int g, int qb, int wave, int lane_) {
    int lane = lane_; asm volatile("" : "+v"(lane));
    const int fr = lane & 15, fq = lane >> 4, h = fr & 3, tq = fr >> 2;
    const bf16* QN = (const bf16*)(ws + WS_QN); const bf16* QR = (const bf16*)(ws + WS_QR); const float* GATES = (const float*)(ws + WS_GATES); bf16* O = (bf16*)(ws + WS_AC);
    LAS float* IMP = (LAS float*)(lds + AT_IMP); LAS unsigned* SELM = (LAS unsigned*)(lds + AT_SELM);
    const size_t seq0 = (size_t)b * SEQ; const int hc = (g * 4 + h) * 64;
    int itok[2]; size_t row[2];
#pragma unroll
    for (int s = 0; s < 2; ++s) { itok[s] = 8 * wave + 4 * s + tq; row[s] = seq0 + 64 * qb + itok[s]; }
    f32x4 out[2][4];
    {
        const int nblk = (qb + 64) >> 6;
        const bf16* KC = (const bf16*)(ws + WS_KC) + ((size_t)b * 4 + g) * 128 * 64; const bf16* VC = (const bf16*)(ws + WS_VC) + ((size_t)b * 4 + g) * 128 * 64;
        for (int i = 0; i < nblk; ++i) { stage_block_dma(lds + i * 16384, KC + (size_t)i * 64 * 64, 128, wave, lane); stage_block_dma(lds + i * 16384 + 8192, VC + (size_t)i * 64 * 64, 128, wave, lane); }
        asm volatile("s_waitcnt vmcnt(0)" ::: "memory"); __builtin_amdgcn_s_barrier(); asm volatile("" ::: "memory");
#pragma unroll
        for (int s = 0; s < 2; ++s) {
            bf16x8 q[2];
#pragma unroll
            for (int ks = 0; ks < 2; ++ks) q[ks] = *(const bf16x8*)(QN + row[s] * D + hc + 32 * ks + 8 * fq);
            const int nv = qb + (itok[s] == 63 ? 1 : 0);
            f32x4 sc[2][4]; float ls = 0.f;
#pragma unroll
            for (int i = 0; i < 2; ++i) {
                if (i < nblk) { bf16x8 kf[4][2]; kfrags(kf, lds + i * 16384, fr, fq);
#pragma unroll
                    for (int k = 0; k < 4; ++k) { sc[i][k] = (f32x4){0.f, 0.f, 0.f, 0.f};
#pragma unroll
                        for (int ks = 0; ks < 2; ++ks) sc[i][k] = __builtin_amdgcn_mfma_f32_16x16x32_bf16(kf[k][ks], q[ks], sc[i][k], 0, 0, 0);
#pragma unroll
                        for (int e = 0; e < 4; ++e) { const int key = 64 * i + 16 * k + 4 * fq + e; const float v = key < nv ? fast_exp2(sc[i][k][e]) : 0.f; sc[i][k][e] = v; ls += v; } }
                } else {
#pragma unroll
                    for (int k = 0; k < 4; ++k) sc[i][k] = (f32x4){0.f, 0.f, 0.f, 0.f}; } }
            ls += __shfl_xor(ls, 16); ls += __shfl_xor(ls, 32);
            const float inv = ls > 0.f ? 1.f / ls : 0.f;
            f32x4 oc[2][4];
#pragma unroll
            for (int d = 0; d < 4; ++d) { oc[0][d] = (f32x4){0.f, 0.f, 0.f, 0.f}; oc[1][d] = oc[0][d]; }
#pragma unroll
            for (int i = 0; i < 2; ++i) if (i < nblk) {
#pragma unroll
                for (int k = 0; k < 4; ++k) { f32x4 pn = sc[i][k] * inv;
#pragma unroll
                    for (int e = 0; e < 4; ++e) { float t = pn[e]; t += __shfl_xor(t, 1); t += __shfl_xor(t, 2); pn[e] = t; }
                    if (h == 0) *(LAS f32x4*)(IMP + itok[s] * 128 + 64 * i + 16 * k + 4 * fq) = pn; }
                bf16x8 p[2][2]; p[0][0] = pack_p(sc[i][0], sc[i][1]); p[0][1] = pack_p(sc[i][2], sc[i][3]); p[1][0] = p[0][0]; p[1][1] = p[0][1];
                pv_block<true, false>(lds + i * 16384 + 8192, p, oc, fr, fq); }
            const float gc = GATES[row[s] * 48 + (g * 4 + h) * 3 + 0] * inv;
#pragma unroll
            for (int d = 0; d < 4; ++d)
#pragma unroll
                for (int e = 0; e < 4; ++e) out[s][d][e] = oc[0][d][e] * gc;
        }
    }
    asm volatile("; MARK_TOPK");
    unsigned long long un_lo[2] = {0ull, 0ull}, un_hi[2] = {0ull, 0ull};
    asm volatile("s_waitcnt lgkmcnt(0)" ::: "memory");
#pragma unroll
    for (int pass = 0; pass < 2; ++pass) { const int c = lane & 15, tok = 8 * wave + 4 * pass + (lane >> 4);
        unsigned w0, w1 = 0u, w2 = 0u, w3 = 0u;
        if (qb <= 15) w0 = (2u << qb) - 1u;
        else {
            unsigned key[8];
#pragma unroll
            for (int j = 0; j < 8; ++j) { const int n = c + 16 * j; const float v = IMP[tok * 128 + n]; key[j] = (n >= 1 && n <= qb - 2) ? ((__float_as_uint(v) & ~127u) | (unsigned)(127 - n)) : 0u; }
            unsigned thr = 0xFFFFFFFFu;
#pragma unroll 1
            for (int r = 0; r < 13; ++r) { unsigned m = 0u;
#pragma unroll
                for (int j = 0; j < 8; ++j) m = max(m, key[j] < thr ? key[j] : 0u);
                m = max(m, (unsigned)__builtin_amdgcn_update_dpp(0, (int)m, 0xB1, 0xF, 0xF, true)); m = max(m, (unsigned)__builtin_amdgcn_update_dpp(0, (int)m, 0x4E, 0xF, 0xF, true));
                m = max(m, (unsigned)__builtin_amdgcn_update_dpp(0, (int)m, 0x141, 0xF, 0xF, true)); m = max(m, (unsigned)__builtin_amdgcn_update_dpp(0, (int)m, 0x140, 0xF, 0xF, true));
                thr = m; }
            unsigned b[4] = {0u, 0u, 0u, 0u};
#pragma unroll
            for (int j = 0; j < 8; ++j) b[j >> 1] |= (key[j] >= thr ? 1u : 0u) << (c + 16 * (j & 1));
#pragma unroll
            for (int w = 0; w < 4; ++w) { unsigned x = b[w];
                x |= (unsigned)__builtin_amdgcn_update_dpp(0, (int)x, 0xB1, 0xF, 0xF, true); x |= (unsigned)__builtin_amdgcn_update_dpp(0, (int)x, 0x4E, 0xF, 0xF, true);
                x |= (unsigned)__builtin_amdgcn_update_dpp(0, (int)x, 0x141, 0xF, 0xF, true); x |= (unsigned)__builtin_amdgcn_update_dpp(0, (int)x, 0x140, 0xF, 0xF, true); b[w] = x; }
            const unsigned long long flo = 1ull | (qb - 1 < 64 ? 1ull << (qb - 1) : 0ull) | (qb < 64 ? 1ull << qb : 0ull), fhi = (qb - 1 >= 64 ? 1ull << (qb - 65) : 0ull) | (qb >= 64 ? 1ull << (qb - 64) : 0ull);
            w0 = b[0] | (unsigned)flo; w1 = b[1] | (unsigned)(flo >> 32); w2 = b[2] | (unsigned)fhi; w3 = b[3] | (unsigned)(fhi >> 32);
        }
        if (c == 0) { SELM[tok * 4 + 0] = w0; SELM[tok * 4 + 1] = w1; SELM[tok * 4 + 2] = w2; SELM[tok * 4 + 3] = w3; }
        const unsigned u0 = __builtin_amdgcn_readlane((int)w0, 0) | __builtin_amdgcn_readlane((int)w0, 16) | __builtin_amdgcn_readlane((int)w0, 32) | __builtin_amdgcn_readlane((int)w0, 48);
        const unsigned u1 = __builtin_amdgcn_readlane((int)w1, 0) | __builtin_amdgcn_readlane((int)w1, 16) | __builtin_amdgcn_readlane((int)w1, 32) | __builtin_amdgcn_readlane((int)w1, 48);
        const unsigned u2 = __builtin_amdgcn_readlane((int)w2, 0) | __builtin_amdgcn_readlane((int)w2, 16) | __builtin_amdgcn_readlane((int)w2, 32) | __builtin_amdgcn_readlane((int)w2, 48);
        const unsigned u3 = __builtin_amdgcn_readlane((int)w3, 0) | __builtin_amdgcn_readlane((int)w3, 16) | __builtin_amdgcn_readlane((int)w3, 32) | __builtin_amdgcn_readlane((int)w3, 48);
        un_lo[pass] = (unsigned long long)u0 | ((unsigned long long)u1 << 32); un_hi[pass] = (unsigned long long)u2 | ((unsigned long long)u3 << 32);
    }
    asm volatile("s_waitcnt lgkmcnt(0)" ::: "memory");
    bf16x8 qr[2][2];
#pragma unroll
    for (int s = 0; s < 2; ++s)
#pragma unroll
        for (int ks = 0; ks < 2; ++ks) qr[s][ks] = *(const bf16x8*)(QR + row[s] * D + hc + 32 * ks + 8 * fq);
    float gsel[2], gwin[2];
#pragma unroll
    for (int s = 0; s < 2; ++s) { gsel[s] = GATES[row[s] * 48 + (g * 4 + h) * 3 + 1]; gwin[s] = GATES[row[s] * 48 + (g * 4 + h) * 3 + 2]; }
    asm volatile("; MARK_SEL");
    {
        const bf16* KS = (const bf16*)(ws + WS_KS) + seq0 * KVW + g * 64; const bf16* VS = (const bf16*)(ws + WS_VS) + seq0 * KVW + g * 64;
        const bf16* KW = (const bf16*)(ws + WS_KW) + seq0 * KVW + g * 64; const bf16* VW = (const bf16*)(ws + WS_VW) + seq0 * KVW + g * 64;
        const int nsel = qb + 1, n0w = qb >= 8 ? qb - 8 : 0, nit = nsel + (qb - n0w + 1);
#define AT_ISSUE(it_) do { const int it__ = (it_); const bool w__ = it__ >= nsel; const int n__ = w__ ? n0w + (it__ - nsel) : it__; LAS unsigned char* st__ = lds + (it__ & 7) * 16384; \
            stage_block_dma(st__, (w__ ? KW : KS) + (size_t)n__ * 64 * KVW, KVW * 2, wave, lane); stage_block_dma(st__ + 8192, (w__ ? VW : VS) + (size_t)n__ * 64 * KVW, KVW * 2, wave, lane); } while (0)
#define AT_FOLD(gt_) do { _Pragma("unroll") for (int s = 0; s < 2; ++s) { float ls = la[s]; ls += __shfl_xor(ls, 16); ls += __shfl_xor(ls, 32); const float gs = gt_[s] * (ls > 0.f ? 1.f / ls : 0.f); la[s] = 0.f; \
            _Pragma("unroll") for (int d = 0; d < 4; ++d) { out[s][d] += oa[s][d] * gs; oa[s][d] = (f32x4){0.f, 0.f, 0.f, 0.f}; } } } while (0)
        f32x4 oa[2][4]; float la[2] = {0.f, 0.f};
#pragma unroll
        for (int s = 0; s < 2; ++s)
#pragma unroll
            for (int d = 0; d < 4; ++d) oa[s][d] = (f32x4){0.f, 0.f, 0.f, 0.f};
        asm volatile("" : "+v"(qr[0][0]), "+v"(qr[0][1]), "+v"(qr[1][0]), "+v"(qr[1][1]), "+v"(gsel[0]), "+v"(gsel[1]), "+v"(gwin[0]), "+v"(gwin[1]));
        asm volatile("s_waitcnt vmcnt(0)" ::: "memory"); __builtin_amdgcn_s_barrier(); asm volatile("" ::: "memory");
        AT_ISSUE(0); AT_ISSUE(1); if (nit > 2) AT_ISSUE(2); if (nit > 3) AT_ISSUE(3);
        const int fr0_ = fr, fq0_ = fq;
#define AT_STEP(it_) do { if (((it_) & 3) == 0) { asm volatile("s_waitcnt vmcnt(0)" ::: "memory"); __builtin_amdgcn_s_barrier(); asm volatile("" ::: "memory"); \
            _Pragma("unroll") for (int j = 4; j < 8; ++j) if ((it_) + j < nit) AT_ISSUE((it_) + j); } } while (0)
#pragma unroll 1
        for (int it = 0; it < nsel; ++it) {
            AT_STEP(it);
            int fr = fr0_, fq = fq0_; asm volatile("" : "+v"(fr), "+v"(fq));
            const LAS unsigned char* st = lds + (it & 7) * 16384; const int n = it;
            const bool do0 = ((n < 64 ? un_lo[0] >> n : un_hi[0] >> (n - 64)) & 1ull) != 0ull, do1 = ((n < 64 ? un_lo[1] >> n : un_hi[1] >> (n - 64)) & 1ull) != 0ull;
            if (do0 || do1) { float bias[2]; const int lo[2] = {0, 0}, hi[2] = {itok[0], itok[1]};
#pragma unroll
                for (int s = 0; s < 2; ++s) { const unsigned wd = SELM[itok[s] * 4 + (n >> 5)]; bias[s] = ((wd >> (n & 31)) & 1u) ? 0.f : -INFINITY; }
                if (n == qb) attn_block<true>(st, st + 8192, do0, do1, qr, bias, lo, hi, oa, la, fr, fq);
                else attn_block<false>(st, st + 8192, do0, do1, qr, bias, lo, hi, oa, la, fr, fq); }
        }
        AT_FOLD(gsel);
#pragma unroll 1
        for (int it = nsel; it < nit; ++it) {
            AT_STEP(it);
            int fr = fr0_, fq = fq0_; asm volatile("" : "+v"(fr), "+v"(fq));
            const LAS unsigned char* st = lds + (it & 7) * 16384; const int n = n0w + (it - nsel); const float bias[2] = {0.f, 0.f};
            if (n == qb || n == qb - 8) { int lo[2], hi[2];
#pragma unroll
                for (int s = 0; s < 2; ++s) { lo[s] = (n == qb - 8) ? itok[s] + 1 : 0; hi[s] = (n == qb) ? itok[s] : 63; }
                attn_block<true>(st, st + 8192, true, true, qr, bias, lo, hi, oa, la, fr, fq);
            } else { const int lo[2] = {0, 0}, hi[2] = {63, 63}; attn_block<false>(st, st + 8192, true, true, qr, bias, lo, hi, oa, la, fr, fq); }
        }
#undef AT_STEP
#pragma unroll
        for (int s = 0; s < 2; ++s) { float ls = la[s]; ls += __shfl_xor(ls, 16); ls += __shfl_xor(ls, 32); const float gw = gwin[s] * (ls > 0.f ? 1.f / ls : 0.f);
#pragma unroll
            for (int d = 0; d < 4; ++d) { float y[4];
#pragma unroll
                for (int e = 0; e < 4; ++e) y[e] = out[s][d][e] + oa[s][d][e] * gw;
                v2u w; w.x = pk2(y[0], y[1]); w.y = pk2(y[2], y[3]); *(v2u*)(O + row[s] * D + hc + 16 * d + 4 * fq) = w; } }
#undef AT_ISSUE
#undef AT_FOLD
    }
    asm volatile("s_waitcnt lgkmcnt(0)" ::: "memory"); __builtin_amdgcn_s_barrier(); asm volatile("" ::: "memory");
}

__device__ __forceinline__ void stage_f32_rows(LAS unsigned char* dst, const float* src_row0  , int lane) {
#pragma unroll
    for (int half = 0; half < 2; ++half) { f32x4 v[8];
#pragma unroll
        for (int k = 0; k < 8; ++k) { const int r = 32 * half + 4 * k + (lane >> 4); v[k] = __builtin_nontemporal_load((const f32x4*)(src_row0 + (size_t)r * KVW + 4 * (lane & 15))); }
#pragma unroll
        for (int k = 0; k < 8; ++k) { const int r = 32 * half + 4 * k + (lane >> 4), c16 = (lane & 15) >> 1; v2u w; w.x = pk2(v[k][0], v[k][1]); w.y = pk2(v[k][2], v[k][3]);
            *(LAS v2u*)(dst + r * 128 + ((c16 ^ (r & 7)) * 16) + (lane & 1) * 8) = w; } }
}
__device__ __forceinline__ void stage_bf16_rows(LAS unsigned char* dst, const bf16* src_row0, int pitch, int nvalid, int lane) {
#pragma unroll
    for (int k = 0; k < 8; ++k) { const int r = 8 * k + (lane >> 3), c = lane & 7; v4u w = (v4u){0u, 0u, 0u, 0u};
        if (r < nvalid) w = *(const v4u*)(src_row0 + (size_t)r * pitch + 8 * c);
        *(LAS v4u*)(dst + r * 128 + ((c ^ (r & 7)) * 16)) = w; }
}
__device__ __forceinline__ void attn_sample_unit(const In& I, unsigned char* ws, LAS unsigned char* lds, int bs, int g, int half, int wave, int lane_) {
    int lane = lane_; asm volatile("" : "+v"(lane));
    const int fr = lane & 15, fq = lane >> 4, h = fr & 3, tq = fr >> 2;
    const bf16* QN = (const bf16*)(ws + WS_QN); const bf16* QR = (const bf16*)(ws + WS_QR); const float* GATES = (const float*)(ws + WS_GATES); bf16* O = (bf16*)(ws + WS_AC);
    LAS float* IMP = (LAS float*)(lds + SAT_IMP); LAS unsigned* SELM = (LAS unsigned*)(lds + SAT_SELM);
    LAS unsigned char* my = lds + wave * 16384;
    const size_t row = (size_t)MP + 4 * bs + tq; const int hc = (g * 4 + h) * 64; const bool mine = (tq >> 1) == half; const float rowbias = mine ? 0.f : -INFINITY;
    f32x4 acc[2][4]; float lsum[2] = {0.f, 0.f};
    f32x4 oc[2][4]; float lc = 0.f;
#pragma unroll
    for (int d = 0; d < 4; ++d) { acc[0][d] = (f32x4){0.f, 0.f, 0.f, 0.f}; acc[1][d] = acc[0][d]; oc[0][d] = acc[0][d]; oc[1][d] = acc[0][d]; }
    if (wave == 0) {
        const bf16* KC = (const bf16*)(ws + WS_KC) + ((size_t)(2 + bs) * 4 + g) * 128 * 64; const bf16* VC = (const bf16*)(ws + WS_VC) + ((size_t)(2 + bs) * 4 + g) * 128 * 64;
        bf16x8 q[2];
#pragma unroll
        for (int ks = 0; ks < 2; ++ks) q[ks] = *(const bf16x8*)(QN + row * D + hc + 32 * ks + 8 * fq);
        f32x4 sc[2][4];
#pragma unroll 1
        for (int i = 0; i < 2; ++i) {
            stage_bf16_rows(my, KC + (size_t)i * 64 * 64, 64, 64, lane); stage_bf16_rows(my + 8192, VC + (size_t)i * 64 * 64, 64, 64, lane);
            asm volatile("s_waitcnt lgkmcnt(0)" ::: "memory");
            bf16x8 kf[4][2]; kfrags(kf, my, fr, fq);
            f32x4 t[4];
#pragma unroll
            for (int k = 0; k < 4; ++k) { t[k] = (f32x4){0.f, 0.f, 0.f, 0.f};
#pragma unroll
                for (int ks = 0; ks < 2; ++ks) t[k] = __builtin_amdgcn_mfma_f32_16x16x32_bf16(kf[k][ks], q[ks], t[k], 0, 0, 0);
#pragma unroll
                for (int e = 0; e < 4; ++e) { t[k][e] = fast_exp2(t[k][e]); lc += t[k][e]; } }
            bf16x8 p[2][2]; p[0][0] = pack_p(t[0], t[1]); p[0][1] = pack_p(t[2], t[3]); p[1][0] = p[0][0]; p[1][1] = p[0][1];
            pv_block<true, false>(my + 8192, p, oc, fr, fq);
            asm volatile("s_waitcnt lgkmcnt(0)" ::: "memory");
#pragma unroll
            for (int k = 0; k < 4; ++k) { if (i == 0) sc[0][k] = t[k]; else sc[1][k] = t[k]; }
        }
        lc += __shfl_xor(lc, 16); lc += __shfl_xor(lc, 32);
        const float inv = 1.f / lc;
#pragma unroll
        for (int i = 0; i < 2; ++i)
#pragma unroll
            for (int k = 0; k < 4; ++k) { f32x4 pn = sc[i][k] * inv;
#pragma unroll
                for (int e = 0; e < 4; ++e) { float t = pn[e]; t += __shfl_xor(t, 1); t += __shfl_xor(t, 2); pn[e] = t; }
                if (h == 0) *(LAS f32x4*)(IMP + tq * 132 + 64 * i + 16 * k + 4 * fq) = pn; }
    }
    asm volatile("s_waitcnt lgkmcnt(0)" ::: "memory"); __builtin_amdgcn_s_barrier(); asm volatile("" ::: "memory");
    if (wave < 4) {
        const float v0 = IMP[wave * 132 + lane], v1 = IMP[wave * 132 + 64 + lane];
        unsigned u0 = (lane >= 1) ? __float_as_uint(v0) : 0u, u1 = (lane + 64 <= 126) ? __float_as_uint(v1) : 0u;
        unsigned long long mlo = 1ull, mhi = 1ull << 63;
#pragma unroll 1
        for (int r = 0; r < 13; ++r) { const unsigned m = dpp_max_u32(max(u0, u1));
            const unsigned long long b0 = __ballot(u0 == m);
            if (b0) { const int idx = __builtin_ctzll(b0); mlo |= 1ull << idx; if (lane == idx) u0 = 0u; }
            else { const unsigned long long b1 = __ballot(u1 == m); const int idx = __builtin_ctzll(b1); mhi |= 1ull << idx; if (lane == idx) u1 = 0u; } }
        if (lane == 0) { SELM[wave * 8 + 0] = (unsigned)mlo; SELM[wave * 8 + 1] = (unsigned)(mlo >> 32); SELM[wave * 8 + 2] = (unsigned)mhi; SELM[wave * 8 + 3] = (unsigned)(mhi >> 32); }
    }
    asm volatile("s_waitcnt lgkmcnt(0)" ::: "memory"); __builtin_amdgcn_s_barrier(); asm volatile("" ::: "memory");
    unsigned selw[4];
#pragma unroll
    for (int w = 0; w < 4; ++w) selw[w] = SELM[tq * 8 + w];
    unsigned long long un_lo = 0ull, un_hi = 0ull;
#pragma unroll
    for (int t = 2 * half; t < 2 * half + 2; ++t) { un_lo |= (unsigned long long)SELM[t * 8 + 0] | ((unsigned long long)SELM[t * 8 + 1] << 32); un_hi |= (unsigned long long)SELM[t * 8 + 2] | ((unsigned long long)SELM[t * 8 + 3] << 32); }
    un_lo = ((unsigned long long)__builtin_amdgcn_readfirstlane((unsigned)(un_lo >> 32)) << 32) | (unsigned)__builtin_amdgcn_readfirstlane((unsigned)un_lo);
    un_hi = ((unsigned long long)__builtin_amdgcn_readfirstlane((unsigned)(un_hi >> 32)) << 32) | (unsigned)__builtin_amdgcn_readfirstlane((unsigned)un_hi);
    bf16x8 qr[2][2];
#pragma unroll
    for (int ks = 0; ks < 2; ++ks) { qr[0][ks] = *(const bf16x8*)(QR + row * D + hc + 32 * ks + 8 * fq); qr[1][ks] = qr[0][ks]; }
    int cnt = 0;
    { const int* pt = I.page_table + bs * NPAGE;
#pragma unroll 1
      for (int n = 0; n < 128; ++n) { const bool on = ((n < 64 ? un_lo >> n : un_hi >> (n - 64)) & 1ull) != 0ull; if (!on) continue;
          if ((cnt++ & 7) != wave) continue;
          const int pg = pt[n >> 1]; const size_t ro = ((size_t)pg * 128 + (n & 1) * 64) * KVW + g * 64;
          stage_f32_rows(my, I.ck_sel + ro, lane); stage_f32_rows(my + 8192, I.cv_sel + ro, lane);
          asm volatile("s_waitcnt lgkmcnt(0)" ::: "memory");
          const int wi = n >> 5; const unsigned wd = wi == 0 ? selw[0] : (wi == 1 ? selw[1] : (wi == 2 ? selw[2] : selw[3]));
          const float bias[2] = {((wd >> (n & 31)) & 1u) ? rowbias : -INFINITY, 0.f}; const int lo[2] = {0, 0}, hi[2] = {63, 63};
          attn_block<false>(my, my + 8192, true, false, qr, bias, lo, hi, acc, lsum, fr, fq);
          asm volatile("s_waitcnt lgkmcnt(0)" ::: "memory"); } }
#pragma unroll 1
    for (int wb = 0; wb < 8; ++wb) { if ((cnt++ & 7) != wave) continue;
        const size_t ro = ((size_t)bs * 512 + 64 * wb) * KVW + g * 64;
        stage_f32_rows(my, I.ck_win + ro, lane); stage_f32_rows(my + 8192, I.cv_win + ro, lane);
        asm volatile("s_waitcnt lgkmcnt(0)" ::: "memory");
        const float bias[2] = {0.f, rowbias}; const int lo[2] = {0, wb == 0 ? tq + 1 : 0}, hi[2] = {63, 63};
        attn_block<true>(my, my + 8192, false, true, qr, bias, lo, hi, acc, lsum, fr, fq);
        asm volatile("s_waitcnt lgkmcnt(0)" ::: "memory"); }
    if ((cnt++ & 7) == wave) {
        stage_bf16_rows(my, (const bf16*)(ws + WS_KS) + ((size_t)MP + 4 * bs) * KVW + g * 64, KVW, 4, lane); stage_bf16_rows(my + 8192, (const bf16*)(ws + WS_VS) + ((size_t)MP + 4 * bs) * KVW + g * 64, KVW, 4, lane);
        asm volatile("s_waitcnt lgkmcnt(0)" ::: "memory");
        const float bias[2] = {rowbias, 0.f}; const int lo[2] = {0, 0}, hi[2] = {tq, tq};
        attn_block<true>(my, my + 8192, true, false, qr, bias, lo, hi, acc, lsum, fr, fq);
        asm volatile("s_waitcnt lgkmcnt(0)" ::: "memory"); }
    if ((cnt++ & 7) == wave) {
        stage_bf16_rows(my, (const bf16*)(ws + WS_KW) + ((size_t)MP + 4 * bs) * KVW + g * 64, KVW, 4, lane); stage_bf16_rows(my + 8192, (const bf16*)(ws + WS_VW) + ((size_t)MP + 4 * bs) * KVW + g * 64, KVW, 4, lane);
        asm volatile("s_waitcnt lgkmcnt(0)" ::: "memory");
        const float bias[2] = {0.f, rowbias}; const int lo[2] = {0, 0}, hi[2] = {tq, tq};
        attn_block<true>(my, my + 8192, false, true, qr, bias, lo, hi, acc, lsum, fr, fq);
        asm volatile("s_waitcnt lgkmcnt(0)" ::: "memory"); }
    __builtin_amdgcn_s_barrier(); asm volatile("" ::: "memory");
    { LAS float* red = (LAS float*)lds + wave * (2 * 17 * 64);
#pragma unroll
      for (int br = 0; br < 2; ++br) {
#pragma unroll
          for (int d = 0; d < 4; ++d)
#pragma unroll
              for (int e = 0; e < 4; ++e) red[(br * 17 + 4 * d + e) * 64 + lane] = acc[br][d][e];
          red[(br * 17 + 16) * 64 + lane] = lsum[br]; } }
    asm volatile("s_waitcnt lgkmcnt(0)" ::: "memory"); __builtin_amdgcn_s_barrier(); asm volatile("" ::: "memory");
    if (wave == 0) {
        float outv[16];
        const float gc = GATES[row * 48 + (g * 4 + h) * 3 + 0] / lc;
#pragma unroll
        for (int d = 0; d < 4; ++d)
#pragma unroll
            for (int e = 0; e < 4; ++e) outv[4 * d + e] = oc[0][d][e] * gc;
#pragma unroll
        for (int br = 0; br < 2; ++br) { float ls = 0.f; float ob[16];
#pragma unroll
            for (int k = 0; k < 16; ++k) ob[k] = 0.f;
#pragma unroll 1
            for (int w = 0; w < 8; ++w) { const LAS float* red = (const LAS float*)lds + w * (2 * 17 * 64);
#pragma unroll
                for (int k = 0; k < 16; ++k) ob[k] += red[(br * 17 + k) * 64 + lane];
                ls += red[(br * 17 + 16) * 64 + lane]; }
            ls += __shfl_xor(ls, 16); ls += __shfl_xor(ls, 32);
            const float gb = GATES[row * 48 + (g * 4 + h) * 3 + 1 + br] * (ls > 0.f ? 1.f / ls : 0.f);
#pragma unroll
            for (int k = 0; k < 16; ++k) outv[k] += ob[k] * gb; }
#pragma unroll
        for (int d = 0; d < 4; ++d) { v2u w; w.x = pk2(outv[4 * d], outv[4 * d + 1]); w.y = pk2(outv[4 * d + 2], outv[4 * d + 3]); if (mine) *(v2u*)(O + row * D + hc + 16 * d + 4 * fq) = w; }
    }
    asm volatile("s_waitcnt lgkmcnt(0)" ::: "memory"); __builtin_amdgcn_s_barrier(); asm volatile("" ::: "memory");
}
__device__ __forceinline__ void attention_phase(const In& I, unsigned char* ws, LAS unsigned char* lds, int vcu, int G) {
    int tid_ = threadIdx.x; asm volatile("" : "+v"(tid_));
    const int wave = __builtin_amdgcn_readfirstlane(tid_ >> 6), lane = tid_ & 63;
#pragma unroll 1
    for (int k = vcu; k < 1024; k += G) { int bg = k & 7, qb = 127 - (k >> 3);
        if (G == 256) { const int i = k >> 8, j = vcu & 31; bg = vcu >> 5; qb = i == 0 ? 127 - j : (i == 1 ? 64 + j : (i == 2 ? 63 - j : j)); }
        asm volatile("; MARK_PROMPT_UNIT");
        attn_prompt_unit(ws, lds, bg >> 2, bg & 3, qb, wave, lane); }
#pragma unroll 1
#ifdef PROBE_TWICE_SAMPLE
    for (int rep = 0; rep < 2; ++rep)
#endif
    for (int k = vcu; k < 256; k += G) { asm volatile("; MARK_SAMPLE_UNIT"); attn_sample_unit(I, ws, lds, k >> 3, (k >> 1) & 3, k & 1, wave, lane); }
    asm volatile("; MARK_ATT_END");
}

#ifdef PROBE_TEAM_TICKS
#define PROBE_TB_T0 if (threadIdx.x == 0) ((volatile LAS unsigned*)(lds + MISC_OFF))[14] = (unsigned)__builtin_amdgcn_s_memrealtime();
#define PROBE_TB_T1 if (threadIdx.x == 0) ((volatile LAS unsigned*)(lds + MISC_OFF))[13] += (unsigned)__builtin_amdgcn_s_memrealtime() - ((volatile LAS unsigned*)(lds + MISC_OFF))[14];
#else
#define PROBE_TB_T0
#define PROBE_TB_T1
#endif
#ifdef PROBE_SK_TICKS
#define PROBE_SK_T0 if (threadIdx.x == 0) ((volatile LAS unsigned*)(lds + MISC_OFF))[14] = (unsigned)__builtin_amdgcn_s_memrealtime();
#define PROBE_SK_T1 __syncthreads(); if (threadIdx.x == 0) ((volatile LAS unsigned*)(lds + MISC_OFF))[13] += (unsigned)__builtin_amdgcn_s_memrealtime() - ((volatile LAS unsigned*)(lds + MISC_OFF))[14];
#else
#define PROBE_SK_T0
#define PROBE_SK_T1
#endif
#ifdef PROBE_SK2_TICKS
#define PROBE_SK2_T0 if (threadIdx.x == 0) ((volatile LAS unsigned*)(lds + MISC_OFF))[14] = (unsigned)__builtin_amdgcn_s_memrealtime();
#define PROBE_SK2_T1 __syncthreads(); if (threadIdx.x == 0) ((volatile LAS unsigned*)(lds + MISC_OFF))[13] += (unsigned)__builtin_amdgcn_s_memrealtime() - ((volatile LAS unsigned*)(lds + MISC_OFF))[14];
#else
#define PROBE_SK2_T0
#define PROBE_SK2_T1
#endif
#ifdef PROBE_GW
__device__ float g_w[256];
#define PROBE_BAR_T0 const unsigned pb0_ = (unsigned)__builtin_amdgcn_s_memrealtime();
#define PROBE_BAR_T1 if (pid == PROBE_PID && threadIdx.x == 0) __hip_atomic_store(&g_w[blockIdx.x & 255], (float)((unsigned)__builtin_amdgcn_s_memrealtime() - pb0_) * 0.01f, __ATOMIC_RELAXED, __HIP_MEMORY_SCOPE_AGENT);
#elif defined(PROBE_BAR_TICKS)
#define PROBE_BAR_T0 if (threadIdx.x == 0) ((volatile LAS unsigned*)(lds + MISC_OFF))[14] = (unsigned)__builtin_amdgcn_s_memrealtime();
#define PROBE_BAR_T1 if (threadIdx.x == 0) ((volatile LAS unsigned*)(lds + MISC_OFF))[13] += (unsigned)__builtin_amdgcn_s_memrealtime() - ((volatile LAS unsigned*)(lds + MISC_OFF))[14];
#else
#define PROBE_BAR_T0
#define PROBE_BAR_T1
#endif
#ifdef PROBE_EPI_TICKS
#define PROBE_END_SEAM SEAM();
#else
#define PROBE_END_SEAM
#endif
#ifdef PROBE_TWICE_ATT
#define PROBE_ATT SEAM(); attention_phase(I, ws, lds, vcu, G);
#else
#define PROBE_ATT
#endif
#ifndef NSA_MIXER_BODY
#define NSA_MIXER_BODY { CmpSrc cs{out + O_KCP, out + O_VCP, nullptr, 0, 2, 2}; compress_phase(I, ws, lds, cs, vcu, G); } SEAM(); \
    attention_phase(I, ws, lds, vcu, G); PROBE_ATT SEAM();
#endif

struct Args { const void* in[26]; float* out; unsigned char* ws; int ph_lo, ph_hi; };
__global__ void __launch_bounds__(NWAVES * 64, 2) fwd(Args args) {
    extern __shared__ __attribute__((aligned(16))) unsigned char lds_[];
    LAS unsigned char* lds = (LAS unsigned char*)lds_;
    const int tid = threadIdx.x, lane = tid & 63, wave = __builtin_amdgcn_readfirstlane(tid >> 6);
    const int G = gridDim.x; int vcu; { const int bx = blockIdx.x; vcu = (G % 8 == 0) ? (bx % 8) * (G / 8) + bx / 8 : bx; }
    unsigned char* ws = args.ws; float* out = args.out;
    gu32* ctl = (gu32*)(ws + WS_CTL);
    In I;
    I.x_prompt = (const float*)args.in[0]; I.x_sample = (const float*)args.in[1]; I.state_conv = (const float*)args.in[2]; I.ck_cmp = (const float*)args.in[3]; I.cv_cmp = (const float*)args.in[4];
    I.ck_sel = (const float*)args.in[5]; I.cv_sel = (const float*)args.in[6]; I.ck_win = (const float*)args.in[7]; I.cv_win = (const float*)args.in[8]; I.page_table = (const int*)args.in[9];
    I.p_prompt = (const float*)args.in[10]; I.p_sample = (const float*)args.in[11]; I.norm_g = (const float*)args.in[12]; I.w_gu = (const float*)args.in[13]; I.w_down = (const float*)args.in[14];
    I.w_proj = (const float*)args.in[15]; I.w_gate = (const float*)args.in[16]; I.cw_in = (const float*)args.in[17]; I.cw = (const float*)args.in[18]; I.cw_out = (const float*)args.in[19];
    I.nw_in = (const float*)args.in[20]; I.qk_g = (const float*)args.in[21]; I.cmp_pos = (const float*)args.in[22]; I.cmp_w1 = (const float*)args.in[23]; I.cmp_w2 = (const float*)args.in[24]; I.nw_out = (const float*)args.in[25];
    for (int u = tid; u < (LDS_BYTES - LDSCTL_OFF) / 4; u += NWAVES * 64) ((LAS unsigned*)(lds + LDSCTL_OFF))[u] = 0u;
    __syncthreads();
    (void)xcd_barrier_post((unsigned*)ctl + CW_BAR, (volatile LAS unsigned*)(lds + MISC_OFF) + 8);
    const int hi = args.ph_hi; int pid = 0;
    const bool team_ok = (G == 256);
    unsigned* const ctlw = (unsigned*)(ws + WS_CTL);
    if (team_ok && tid == 0) __hip_atomic_store(ctlw + CW_XCC + blockIdx.x, xb_xcc_id() + 1u, __ATOMIC_RELAXED, __HIP_MEMORY_SCOPE_AGENT);
    unsigned tep = 0u, sk_need = 0u, sk_pend = 0u; bool arrived = false;
#define SEAM() do { asm volatile("; SEAM_MARK %0" :: "i"(__LINE__)); ++pid; if (pid >= hi) return; if (sk_pend) { asm volatile("s_waitcnt vmcnt(0)" ::: "memory"); __syncthreads(); if (threadIdx.x == 0) (void)xb_add((unsigned*)(ws + WS_CTL) + CW_SKCNT, sk_pend); sk_pend = 0u; } XcdBarrier b_; b_.bar = (unsigned*)(ws + WS_CTL) + CW_BAR; b_.x = xb_xcc_id(); b_.st = (volatile LAS unsigned*)(lds + MISC_OFF) + 8; PROBE_BAR_T0 xcd_barrier(b_); PROBE_BAR_T1 } while (0)
#define SEAM_T() do { if (!team_ok) { SEAM(); } else { asm volatile("; SEAM_T_MARK %0" :: "i"(__LINE__)); ++pid; if (pid >= hi) return; \
      if (arrived) { PROBE_TB_T0 team_wait((unsigned*)(ws + WS_CTL), 4u * tep, sk_pend); PROBE_TB_T1 } \
      else { ++tep; PROBE_TB_T0 team_barrier((unsigned*)(ws + WS_CTL), 4u * tep, (volatile LAS unsigned*)(lds + MISC_OFF) + 12, sk_pend); PROBE_TB_T1 } sk_pend = 0u; arrived = false; } } while (0)
#define TEAM_ARRIVE() do { if (team_ok) { ++tep; team_arrive((unsigned*)(ws + WS_CTL), (volatile LAS unsigned*)(lds + MISC_OFF) + 12); arrived = true; } } while (0)


    bf16* const XB_0 = (bf16*)(ws + WS_XB); bf16* const XB_1 = (bf16*)(ws + WS_XB + SZ_XB);
    float* const SS_0 = (float*)(ws + WS_SS); float* const SS_1 = (float*)(ws + WS_SS + SZ_SS);
    bf16* const Hb = (bf16*)(ws + WS_H); bf16* const ACb = (bf16*)(ws + WS_AC);
    bf16* const PBb = (bf16*)(ws + WS_PB); bf16* const Pb = (bf16*)(ws + WS_P);

#ifdef PROBE_EPI_TICKS
    if (blockIdx.x == 0 && tid == 0) g_ticks_store = 0ull;
#endif
#ifdef PH_HI_OVERRIDE
    { const size_t gt = (size_t)(vcu * NWAVES + wave) * 64 + lane, NT = (size_t)G * NWAVES * 64;
      for (size_t i = DBG_FILL_FROM / 4 + gt; i < O_END / 4; i += NT) ((GAS f32x4*)out)[i] = (f32x4){0.f, 0.f, 0.f, 0.f}; }
#endif
    p0_prologue(I, out, ws, lds, vcu, G, wave, lane);
    cmp_bias_partials(I, ws, vcu, G, wave, lane);
#ifdef PROBE_TWICE_PRO
    SEAM(); p0_prologue(I, out, ws, lds, vcu, G, wave, lane);
#endif
    SEAM();
    if (team_ok && tid == 0) { const int t0 = (int)blockIdx.x & 63; unsigned x0 = xb_ld(ctlw + CW_XCC + t0), same = 1u;
        for (int m = 1; m < 4; ++m) same = (xb_ld(ctlw + CW_XCC + t0 + 64 * m) == x0) ? same : 2u;
        ((volatile LAS unsigned*)(lds + MISC_OFF))[12] = same; }
#define SK_REM(units_) ((units_) % G)
#define SK_FIRST(units_) ((SK_REM(units_) == 0 || (int)blockIdx.x >= SK_REM(units_)) ? (G - 1 - (int)blockIdx.x) : 0x3fffffff)
#define SK_STRIDE(units_) (SK_REM(units_) == 0 ? G : G - SK_REM(units_))
#define PH_PROJ(l) { const bf16* Wp = (const bf16*)(ws + WS_WPROJ + (size_t)(l) * SZ_WPROJ); int kk_ = PLE; asm volatile("" : "+s"(kk_)); \
      pg8::Gemm g{PBb + (size_t)(l) * MT * PLE, Wp, MP, D, kk_}; GOrder S; S.init(MP, D, G, (int)blockIdx.x); pg8::EpiRaw<false> E{Pb + (size_t)(l) * MT * D, D, nullptr}; \
      pg8::gemm_phase<pg8::EpiRaw<false>, GOrder, true, true>(lds, g, S, E); \
      SkRaw<false> SE{Pb + (size_t)(l) * MT * D, D, nullptr}; skinny_phase<0, 4>(lds, PBb + ((size_t)(l) * MT + MP) * PLE, Wp, PLE, D / 64, SE, SK_FIRST(256), SK_STRIDE(256), nullptr, 0u, sk_pend); }
    PH_PROJ(0)
    PH_PROJ(1)
    { CmpSrc cs{I.ck_cmp, I.cv_cmp, I.page_table, 2, 32, 16}; compress_phase(I, ws, lds, cs, vcu, G); }
    ++pid;

#define XBP(c) ((bf16*)(ws + WS_XB + (size_t)(c) * SZ_XB))
#define SSP(c) ((float*)(ws + WS_SS + (size_t)(c) * SZ_SS))
#define SSSP(c) ((float*)(ws + WS_SSS + (size_t)(c) * SZ_SSS))
#define PH_GU(l, s, c, ARR) { const bf16* Wgu = (const bf16*)(ws + WS_WGU + (size_t)((l) * 2 + (s)) * SZ_WGU); \
      pg8::Gemm g{XBP(c), Wgu, MP, NGU, D}; GOrder S; S.init(MP, NGU, G, (int)blockIdx.x); pg8::EpiSwiglu E{Hb, SSP(c)}; \
      pg8::gemm_phase<pg8::EpiSwiglu, GOrder, true, true>(lds, g, S, E); if (ARR) TEAM_ARRIVE(); \
      PROBE_SK_T0 SkSwiglu SE{Hb, SSSP(c)}; skinny_phase<1, 4>(lds, XBP(c) + (size_t)MP * D, Wgu, D, FF / 32, SE, SK_FIRST(64 * (NGU / 256)), SK_STRIDE(64 * (NGU / 256)), ctlw, sk_need, sk_pend); sk_need += 4u * (FF / 32); PROBE_SK_T1 }
#define PH_RESID(Asrc, K_, Wt, scale, c, SKS, ARR, LOW) { pg8::Gemm g{(Asrc), (const bf16*)(Wt), MP, D, (K_)}; GOrder S; S.init(MP, D, G, (int)blockIdx.x); \
      pg8::EpiResid<false, false> E{XBP(c), nullptr, XBP((c) ^ 1), SSP((c) ^ 1), (scale), nullptr, nullptr}; \
      pg8::gemm_phase<pg8::EpiResid<false, false>, GOrder, true, true>(lds, g, S, E); if (ARR) TEAM_ARRIVE(); \
      if (SKS) { PROBE_SK2_T0 SkResid<false> SE{XBP(c), nullptr, XBP((c) ^ 1), SSSP((c) ^ 1), (scale), nullptr, nullptr, 0};   \
      skinny_phase<0, 2>(lds, (Asrc) + (size_t)MP * (K_), (const bf16*)(Wt), (K_), D / 32, SE, ((LOW) && team_ok) ? ((int)blockIdx.x < 128 ? (int)blockIdx.x : 0x3fffffff) : SK_FIRST(256), SK_STRIDE(256), ctlw, sk_need, sk_pend); sk_need += 4u * (D / 32); PROBE_SK2_T1 } }
#define PH_RAW(Wt, N_, NCU_, c, Ob) { pg8::Gemm g{XBP(c), (const bf16*)(Wt), MP, (N_), D}; GOrder S; S.init(MP, (N_), G, (int)blockIdx.x); pg8::EpiRaw<true> E{(Ob), (N_), SSP(c)}; \
      pg8::gemm_phase<pg8::EpiRaw<true>, GOrder, true, true>(lds, g, S, E); \
      SkRaw<true> SE{(Ob), (N_), SSSP(c)}; skinny_phase<0, 4>(lds, XBP(c) + (size_t)MP * D, (const bf16*)(Wt), D, (NCU_), SE, SK_FIRST(64 * ((N_) / 256)), SK_STRIDE(64 * ((N_) / 256)), ctlw, sk_need, sk_pend); sk_need += 4u * (NCU_); }
#define PH_GATE(l, c, FIN, ARR) { const bf16* Wg = (const bf16*)(ws + WS_WGATE + (size_t)(l) * SZ_WSQ); const bf16* Pl = Pb + (size_t)(l) * MT * D; \
      pg8::Gemm g{XBP(c), Wg, MP, D, D}; GOrder S; S.init(MP, D, G, (int)blockIdx.x); pg8::EpiResid<true, FIN> E{XBP(c), out, XBP((c) ^ 1), SSP((c) ^ 1), 1.0f, SSP(c), Pl}; \
      pg8::gemm_phase<pg8::EpiResid<true, FIN>, GOrder, true, true>(lds, g, S, E); if (ARR) TEAM_ARRIVE(); \
      SkResid<true> SE{XBP(c), out, XBP((c) ^ 1), SSSP((c) ^ 1), 1.0f, SSSP(c), Pl, FIN};   \
      skinny_phase<0, 2>(lds, XBP(c) + (size_t)MP * D, Wg, D, D / 32, SE, SK_FIRST(256), SK_STRIDE(256), ctlw, sk_need, sk_pend); sk_need += 4u * (D / 32); }

    PH_GU(0, 0, 0, 1) SEAM_T();
    PH_RESID(Hb, FF, ws + WS_WDN + 0 * SZ_WDN, 0.5f, 0, 1, 1, 0) SEAM_T();
    PH_RAW(ws + WS_WCIN, NCV, NCV / 64, 1, (bf16*)(ws + WS_CV)) SEAM();
    conv_post(I, out, ws, vcu, G, wave, lane); SEAM();
#ifdef PROBE_TWICE_POST
    conv_post(I, out, ws, vcu, G, wave, lane); SEAM();
#endif
    PH_RESID(ACb, D, ws + WS_WCOUT, 1.0f, 1, 1, 1, 0) SEAM_T();
    PH_GU(0, 1, 0, 1) SEAM_T();
    PH_RESID(Hb, FF, ws + WS_WDN + 1 * SZ_WDN, 0.5f, 0, 1, 1, 0) SEAM_T();
    PH_GATE(0, 1, false, 1) SEAM_T();
    PH_GU(1, 0, 0, 1) SEAM_T();
    PH_RESID(Hb, FF, ws + WS_WDN + 2 * SZ_WDN, 0.5f, 0, 1, 1, 0) SEAM_T();
    PH_RAW(ws + WS_WNIN, NNSP, (NNS + 63) / 64, 1, Hb) SEAM();
    nsa_post(I, out, ws, vcu, G, wave, lane); SEAM();
#ifdef PROBE_TWICE_POST
    nsa_post(I, out, ws, vcu, G, wave, lane); SEAM();
#endif
    NSA_MIXER_BODY
    PH_RESID(ACb, D, ws + WS_WNOUT, 1.0f, 1, 1, 1, 0) SEAM_T();
    PH_GU(1, 1, 0, 1) SEAM_T();
    PH_RESID(Hb, FF, ws + WS_WDN + 3 * SZ_WDN, 0.5f, 0, 1, 1, 1) SEAM_T();
    PH_GATE(1, 1, true, 0)
#ifdef PROBE_EPI_TICKS
    if ((PROBE_COND) && tid == 0) atomicAdd(g_probe_ticks, (unsigned long long)((volatile LAS unsigned*)(lds + MISC_OFF))[13]);
#endif
    PROBE_END_SEAM
#ifdef PROBE_EPI_TICKS
#ifdef PROBE_GW
    { float us = 0.f; { PROBE_STAT }
#else
    { const float us = (float)__hip_atomic_load(&g_ticks_store, __ATOMIC_RELAXED, __HIP_MEMORY_SCOPE_AGENT) * 0.01f * PROBE_MUL;
#endif
      const float sc = 1.f + sqrtf(us * 1e-6f);
      const size_t gt = (size_t)(vcu * NWAVES + wave) * 64 + lane, NT = (size_t)G * NWAVES * 64;
      for (size_t i = O_CONVS / 4 + gt; i < O_KCP / 4; i += NT) ((GAS f32x4*)out)[i] *= sc; }
#endif
#ifdef DBG_SCALE_FROM
    { const size_t gt = (size_t)(vcu * NWAVES + wave) * 64 + lane, NT = (size_t)G * NWAVES * 64;
      for (size_t i = (DBG_SCALE_FROM) / 4 + gt; i < (DBG_SCALE_TO) / 4; i += NT) ((GAS f32x4*)out)[i] *= 1.2f; }
#endif
#undef SEAM
}

#ifdef PH_HI_OVERRIDE
#define PH_HI PH_HI_OVERRIDE
#endif
#ifndef PH_HI
#define PH_HI 1000
#endif
extern "C" void kernel_launch(void* const* d_in, const int* in_sizes, int n_in, void* d_out, int out_size, void* d_ws, size_t ws_size, hipStream_t stream) {
    static int grid = 0;
    if (grid == 0) {
        if (n_in != 26 || out_size != (int)O_END || ws_size < WS_END) { fprintf(stderr, "kernel_launch: unexpected sizes n_in %d out %d ws %zu (need %zu)\n", n_in, out_size, ws_size, (size_t)WS_END); grid = -1; return; }
        int dev = 0, cus = 0, per_cu = 0;
        if (hipGetDevice(&dev) != hipSuccess || hipDeviceGetAttribute(&cus, hipDeviceAttributeMultiprocessorCount, dev) != hipSuccess) { grid = -1; return; }
        if (hipFuncSetAttribute((const void*)fwd, hipFuncAttributeMaxDynamicSharedMemorySize, LDS_BYTES) != hipSuccess) { fprintf(stderr, "kernel_launch: hipFuncSetAttribute failed\n"); grid = -1; return; }
        if (hipOccupancyMaxActiveBlocksPerMultiprocessor(&per_cu, (const void*)fwd, NWAVES * 64, LDS_BYTES) != hipSuccess || per_cu < 1) { fprintf(stderr, "kernel_launch: occupancy query says %d\n", per_cu); (void)hipGetLastError(); grid = -1; return; }
        grid = cus;
    }
    if (grid < 0) return;
    (void)hipMemsetAsync((char*)d_ws + WS_CTL, 0, CTL_ZERO_BYTES, stream);
    Args a{};
    for (int i = 0; i < 26; ++i) a.in[i] = d_in[i];
    a.out = (float*)d_out; a.ws = (unsigned char*)d_ws; a.ph_lo = 0; a.ph_hi = PH_HI;
    hipLaunchKernelGGL(fwd, dim3(grid), dim3(NWAVES * 64), LDS_BYTES, stream, a);
}
```

```cpp
#define NSA_KERNEL_ONE_LAUNCH 1
#include <hip/hip_runtime.h>
#include <cstdio>
#include <cstdint>

#define GAS __attribute__((address_space(1)))
#define LAS __attribute__((address_space(3)))
typedef unsigned short bf16;
typedef unsigned v4u __attribute__((ext_vector_type(4)));
typedef unsigned v2u __attribute__((ext_vector_type(2)));
typedef float v2f __attribute__((ext_vector_type(2)));
typedef float f32x4 __attribute__((ext_vector_type(4)));
typedef float f32x2 __attribute__((ext_vector_type(2)));
typedef short bf16x8 __attribute__((ext_vector_type(8)));
typedef short s16x4 __attribute__((ext_vector_type(4)));
typedef GAS unsigned gu32;

constexpr int D = 1024, MP = 16384, MS = 128, MT = MP + MS, FF = 2816, NGU = 2 * FF, NCV = 3072, NNS = 2608, NNSP = 2816, PLE = 256;
constexpr int SEQ = 8192, SB = 32, ST = 4, PAST = 8192, NPAGE = 64, HD = 64, KVW = 256, WIN = 512, NBT = 34  ;
constexpr float RMS_EPS = 1e-6f;
constexpr float QSCALE = 0.125f * 1.4426950408889634f;

constexpr size_t O_Y = 0, O_YS = O_Y + (size_t)MP * D, O_CONVP = O_YS + (size_t)MS * D, O_CONVS = O_CONVP + 2 * 2 * D, O_KCP = O_CONVS + 32 * 2 * D;
constexpr size_t SZ_P = (size_t)MP * KVW, SZ_WP = 2 * 512 * KVW, SZ_S = (size_t)MS * KVW, SZ_WS = 32 * 512 * KVW;
constexpr size_t O_VCP = O_KCP + SZ_P, O_KSP = O_VCP + SZ_P, O_VSP = O_KSP + SZ_P, O_KWP = O_VSP + SZ_P, O_VWP = O_KWP + SZ_WP;
constexpr size_t O_KCS = O_VWP + SZ_WP, O_VCS = O_KCS + SZ_S, O_KSS = O_VCS + SZ_S, O_VSS = O_KSS + SZ_S, O_KWS = O_VSS + SZ_S, O_VWS = O_KWS + SZ_WS, O_END = O_VWS + SZ_WS;
static_assert(O_END == 42799104, "d_out size");

constexpr size_t MiB = 1u << 20;
constexpr size_t WS_CTL = 0, CTL_ZERO_BYTES = 1 * MiB;
constexpr size_t WS_WGU = 2 * MiB;
constexpr size_t SZ_WGU = (size_t)NGU * D * 2;
constexpr size_t WS_WDN = WS_WGU + 4 * SZ_WGU;
constexpr size_t SZ_WDN = (size_t)D * FF * 2;
constexpr size_t WS_WGATE = WS_WDN + 4 * SZ_WDN;
constexpr size_t SZ_WSQ = (size_t)D * D * 2;
constexpr size_t WS_WPROJ = WS_WGATE + 2 * SZ_WSQ;
constexpr size_t SZ_WPROJ = (size_t)D * PLE * 2;
constexpr size_t WS_WCIN = WS_WPROJ + 2 * SZ_WPROJ;
constexpr size_t WS_WCOUT = WS_WCIN + (size_t)NCV * D * 2;
constexpr size_t WS_WNIN = WS_WCOUT + SZ_WSQ;
constexpr size_t WS_WNOUT = WS_WNIN + (size_t)NNSP * D * 2;
constexpr size_t WS_W1T = WS_WNOUT + SZ_WSQ;
constexpr size_t WS_W2T = WS_W1T + 2 * (size_t)128 * 4096 * 2;
constexpr size_t WS_ROPE = WS_W2T + 2 * 64 * 128 * 2;
constexpr size_t WS_SS = (WS_ROPE + (size_t)8196 * 64 * 4 + MiB - 1) / MiB * MiB;
constexpr size_t SZ_SS = (size_t)MT * 16 * 4;
constexpr size_t WS_XB = (WS_SS + 2 * SZ_SS + MiB - 1) / MiB * MiB;
constexpr size_t SZ_XB = (size_t)MT * D * 2;
constexpr size_t WS_H = (WS_XB + 2 * SZ_XB + MiB - 1) / MiB * MiB;
constexpr size_t WS_AC = (WS_H + (size_t)MT * NCV * 2 + MiB - 1) / MiB * MiB;
constexpr size_t WS_PB = (WS_AC + SZ_XB + MiB - 1) / MiB * MiB;
constexpr size_t WS_P = (WS_PB + 2 * (size_t)MT * PLE * 2 + MiB - 1) / MiB * MiB;
constexpr size_t WS_QN = (WS_P + 2 * SZ_XB + MiB - 1) / MiB * MiB;
constexpr size_t WS_QR = (WS_QN + SZ_XB + MiB - 1) / MiB * MiB;
constexpr size_t SZ_KV = (size_t)MT * KVW * 2;
constexpr size_t WS_KS = (WS_QR + SZ_XB + MiB - 1) / MiB * MiB;
constexpr size_t WS_VS = WS_KS + SZ_KV, WS_KW = WS_VS + SZ_KV, WS_VW = WS_KW + SZ_KV;
constexpr size_t WS_GATES = (WS_VW + SZ_KV + MiB - 1) / MiB * MiB;
constexpr size_t WS_KC = (WS_GATES + (size_t)MT * 48 * 4 + MiB - 1) / MiB * MiB;
constexpr size_t SZ_KC = (size_t)NBT * 4 * 128 * 64 * 2;
constexpr size_t WS_VC = (WS_KC + SZ_KC + MiB - 1) / MiB * MiB;
constexpr size_t WS_CPART = (WS_VC + SZ_KC + MiB - 1) / MiB * MiB;
constexpr size_t WS_CBIAS = WS_CPART + 2 * 64 * 128 * 4;
constexpr size_t WS_SSS = WS_CPART + 256 * 1024, SZ_SSS = (size_t)MS * 32 * 4;
constexpr size_t WS_END = WS_CPART + MiB;
constexpr size_t WS_CV = WS_QN;
static_assert(WS_CV + (size_t)MT * NCV * 2 <= WS_GATES, "CV alias");

constexpr int CW_TMO = 0, CW_CODE = 1, CW_BAR = 4096;
constexpr int CW_TEAM = 8192  , CW_XCC = 12288  , CW_SKCNT = 12800  ;

constexpr int RING_BYTES = 131072, LDSCTL_OFF = 147456  , MISC_OFF = LDSCTL_OFF + 320, LDS_BYTES = 163840  ;
constexpr int NWAVES = 8;

#define RLX_AGENT __ATOMIC_RELAXED, __HIP_MEMORY_SCOPE_AGENT
#define LDS_WAIT() asm volatile("s_waitcnt lgkmcnt(0)" ::: "memory")
#define VM_WAIT() asm volatile("s_waitcnt vmcnt(0)" ::: "memory")

typedef float f2v __attribute__((ext_vector_type(2)));
typedef __bf16 b2v __attribute__((ext_vector_type(2)));
__device__ __forceinline__ unsigned pk2(float lo, float hi) { f2v v = {lo, hi}; b2v b = __builtin_convertvector(v, b2v); return __builtin_bit_cast(unsigned, b); }
__device__ __forceinline__ float bflo(unsigned u) { return __uint_as_float(u << 16); }
__device__ __forceinline__ float bfhi(unsigned u) { return __uint_as_float(u & 0xffff0000u); }
__device__ __forceinline__ float fast_exp2(float x) { return __builtin_amdgcn_exp2f(x); }
__device__ __forceinline__ float sigmoidf_(float x) { return __builtin_amdgcn_rcpf(1.f + fast_exp2(-1.4426950408889634f * x)); }

#ifdef PROBE_EPI_TICKS
#ifndef PROBE_COND
#define PROBE_COND (blockIdx.x == 0)
#endif
#ifndef PROBE_MUL
#define PROBE_MUL 1.0f
#endif
#ifndef PROBE_BLOCK
#define PROBE_BLOCK 0
#endif
#define PROBE_THREAD 0
__device__ unsigned long long g_ticks_store;
#define g_probe_ticks (&g_ticks_store)
#endif
namespace pg8 {
#define PG8_LAS __attribute__((address_space(3)))
typedef unsigned short bf16_t;
typedef short bf16x8 __attribute__((ext_vector_type(8)));
typedef float f32x4 __attribute__((ext_vector_type(4)));
typedef unsigned u32x4 __attribute__((ext_vector_type(4)));
constexpr int BM = 256, BK = 64, HALF = 128, HTB = HALF * BK * 2  , STAGE_BYTES = 8 * HTB, NXCD = 8, WGM = 8;

__host__ __device__ __forceinline__ int lds_byte(int r, int c) { const int st = (r >> 4) * 2 + (c >> 5), rr = r & 15, cc = c & 31, ob = rr * 64 + cc * 2; return st * 1024 + (ob ^ (((ob >> 9) & 1) << 5)); }
__host__ __device__ __forceinline__ void stage_rc(int b, int& R, int& C) { const int st = b / 1024, sb = b % 1024, swz = sb ^ (((sb >> 9) & 1) << 5); R = (st >> 1) * 16 + swz / 64; C = (st & 1) * 32 + (swz % 64) / 2; }
__host__ __device__ __forceinline__ int perm32(int rho) { const int n = rho >> 4, i = rho & 15; return 8 * (i >> 2) + 4 * n + (i & 3); }

struct Unit { int pm, pn; };
struct Gemm { const bf16_t* A; const bf16_t* Bt; int M, N, K; };

struct StaticOrder {
    int nM, nN, nwg, G, c;
    __host__ __device__ void init(int M, int N, int G_, int c_) { nM = M / BM; nN = N / BM; nwg = nM * nN; G = G_; c = c_; }
    __host__ __device__ bool next(int i, Unit& u) const {
        const long L = (long)i * G + c; if (L >= nwg) return false;
        int wgid = (int)L; { const int q = nwg / NXCD, r = nwg % NXCD, xcd = wgid % NXCD, off = wgid / NXCD; wgid = (xcd < r ? xcd * (q + 1) : r * (q + 1) + (xcd - r) * q) + off; }
        const int nig = WGM * nN, gid = wgid / nig, fm = gid * WGM, gsz = (nM - fm) < WGM ? (nM - fm) : WGM;
        u.pm = fm + ((wgid % nig) % gsz); u.pn = (wgid % nig) / gsz; return true;
    }
    __device__ __forceinline__ void a_ready(const Unit&) const {}
    __device__ __forceinline__ void done(const Unit&) const {}
};
template <class Epi, class Sched, bool ALIGN_EPI = false, bool SP2 = false>
__device__ __forceinline__ void gemm_phase(PG8_LAS unsigned char* lds, const Gemm g, const Sched& S, const Epi& E) {
    int tid_ = threadIdx.x; asm volatile("" : "+v"(tid_));
    const int tid = tid_, wid = __builtin_amdgcn_readfirstlane(tid >> 6), lane = tid & 63, wr = wid >> 2, wc = wid & 3, fr = lane & 15, fq = lane >> 4;
    const int K = g.K, nt = K / BK;
    unsigned voffA[2], voffB[2];
#pragma unroll
    for (int i = 0; i < 2; ++i) { int R, C; stage_rc(tid * 16 + i * 8192, R, C); const int Rb = Epi::PERM ? ((R & ~31) + perm32(R & 31)) : R;
        voffA[i] = (unsigned)(R * K + C) * 2u; voffB[i] = (unsigned)(Rb * K + C) * 2u; }
    const size_t kstep = (size_t)(BK * 2);
    const size_t hstep = (size_t)HALF * K * 2;
    const size_t tstep = 2 * hstep;
    const unsigned ldsw = (unsigned)wid * 1024u;
    const int aoff = lds_byte(wr * 64 + fr, fq * 8), boff = lds_byte(wc * 32 + fr, fq * 8);
#define PG8_SA(b, h) (((b) * 2 + (h)) * HTB)
#define PG8_SB(b, h) ((4 + (b) * 2 + (h)) * HTB)
#define PG8_STAGE(bufoff, gbase, voff) do { _Pragma("unroll") for (int _i = 0; _i < 2; ++_i) \
        __builtin_amdgcn_global_load_lds((const unsigned*)((const char*)(gbase) + (voff)[_i]), (PG8_LAS unsigned*)(lds + (bufoff) + ldsw + _i * 8192), 16, 0, 0); } while (0)
#define PG8_LDA(dst, b, h) do { _Pragma("unroll") for (int m = 0; m < 4; ++m) _Pragma("unroll") for (int k = 0; k < 2; ++k) dst[m][k] = *(const PG8_LAS bf16x8*)(lds + PG8_SA(b, h) + aoff + m * 2048 + k * 1024); } while (0)
#define PG8_LDB(dst, b, h) do { _Pragma("unroll") for (int n = 0; n < 2; ++n) _Pragma("unroll") for (int k = 0; k < 2; ++k) dst[n][k] = *(const PG8_LAS bf16x8*)(lds + PG8_SB(b, h) + boff + n * 2048 + k * 1024); } while (0)
#define PG8_MMA(ai, bj, At, Bt) do { __builtin_amdgcn_s_setprio(1); _Pragma("unroll") for (int m = 0; m < 4; ++m) _Pragma("unroll") for (int n = 0; n < 2; ++n) _Pragma("unroll") for (int k = 0; k < 2; ++k) \
        acc[ai][bj][m][n] = __builtin_amdgcn_mfma_f32_16x16x32_bf16(Bt[n][k], At[m][k], acc[ai][bj][m][n], 0, 0, 0); __builtin_amdgcn_s_setprio(0); } while (0)
#define PG8_WAIT_V(n) asm volatile("s_waitcnt vmcnt(" #n ")" ::: "memory")
#define PG8_WAIT_L(n) asm volatile("s_waitcnt lgkmcnt(" #n ")" ::: "memory")
#define PG8_BAR __builtin_amdgcn_s_barrier()
#define PG8_SCHED __builtin_amdgcn_sched_barrier(0)
    Unit cur, nxt; int ui = 0;
    if (!S.next(0, cur)) return;
    f32x4 acc[2][2][4][2];
#pragma unroll
    for (int a = 0; a < 2; ++a)
#pragma unroll
        for (int b = 0; b < 2; ++b)
#pragma unroll
            for (int m = 0; m < 4; ++m)
#pragma unroll
                for (int n = 0; n < 2; ++n) acc[a][b][m][n] = (f32x4){0.f, 0.f, 0.f, 0.f};
    bf16x8 At[4][2], B0[2][2], B1[2][2];
    const char* cA = (const char*)g.A + (size_t)cur.pm * tstep; const char* cB = (const char*)g.Bt + (size_t)cur.pn * tstep;
    S.a_ready(cur);
    if constexpr (SP2) {
        PG8_STAGE(PG8_SB(0, 0), cB, voffB); PG8_STAGE(PG8_SB(0, 1), cB + hstep, voffB); PG8_STAGE(PG8_SA(0, 0), cA, voffA); PG8_STAGE(PG8_SA(0, 1), cA + hstep, voffA);
        if (wr == 1) PG8_BAR;
        PG8_WAIT_V(2); PG8_BAR;
        PG8_STAGE(PG8_SB(1, 0), cB + kstep, voffB); PG8_STAGE(PG8_SA(1, 0), cA + kstep, voffA); PG8_STAGE(PG8_SB(1, 1), cB + hstep + kstep, voffB);
        PG8_WAIT_V(6); PG8_BAR;
    } else {
        PG8_STAGE(PG8_SB(0, 0), cB, voffB); PG8_STAGE(PG8_SA(0, 0), cA, voffA); PG8_STAGE(PG8_SB(0, 1), cB + hstep, voffB); PG8_STAGE(PG8_SA(0, 1), cA + hstep, voffA);
        if (wr == 1) PG8_BAR;
        PG8_WAIT_V(4); PG8_BAR;
        PG8_STAGE(PG8_SB(1, 0), cB + kstep, voffB); PG8_STAGE(PG8_SA(1, 0), cA + kstep, voffA); PG8_STAGE(PG8_SB(1, 1), cB + hstep + kstep, voffB);
        PG8_WAIT_V(6); PG8_BAR;
    }
    for (;;) {
        const bool has_next = S.next(ui + 1, nxt);
        const char* nA = has_next ? (const char*)g.A + (size_t)nxt.pm * tstep : cA; const char* nB = has_next ? (const char*)g.Bt + (size_t)nxt.pn * tstep : cB;
        for (int t = 0; t < nt; t += 2) {
            const bool last = (t == nt - 2);
            const char* a1 = cA + (size_t)(t + 1) * kstep;
            const char* a2 = last ? nA : cA + (size_t)(t + 2) * kstep; const char* b2 = last ? nB : cB + (size_t)(t + 2) * kstep;
            const char* a3 = a2 + kstep; const char* b3 = b2 + kstep;
            if (last && has_next) S.a_ready(nxt);
            if constexpr (SP2) {
            PG8_LDB(B0, 0, 0); PG8_LDB(B1, 0, 1); PG8_SCHED; PG8_LDA(At, 0, 0); PG8_STAGE(PG8_SA(1, 1), a1 + hstep, voffA);
            PG8_WAIT_V(8); PG8_WAIT_L(0); PG8_BAR; PG8_MMA(0, 0, At, B0); PG8_MMA(0, 1, At, B1); PG8_BAR; PG8_SCHED;
            PG8_LDA(At, 0, 1); PG8_STAGE(PG8_SB(0, 0), b2, voffB); PG8_STAGE(PG8_SB(0, 1), b2 + hstep, voffB); PG8_STAGE(PG8_SA(0, 0), a2, voffA);
            PG8_WAIT_V(8); PG8_WAIT_L(0); PG8_BAR; PG8_MMA(1, 0, At, B0); PG8_MMA(1, 1, At, B1); PG8_BAR; PG8_SCHED;
            PG8_LDB(B0, 1, 0); PG8_LDB(B1, 1, 1); PG8_SCHED; PG8_LDA(At, 1, 0); PG8_STAGE(PG8_SA(0, 1), a2 + hstep, voffA);
            PG8_WAIT_V(8); PG8_WAIT_L(0); PG8_BAR; PG8_MMA(0, 0, At, B0); PG8_MMA(0, 1, At, B1); PG8_BAR; PG8_SCHED;
            PG8_LDA(At, 1, 1); PG8_STAGE(PG8_SB(1, 0), b3, voffB); PG8_STAGE(PG8_SB(1, 1), b3 + hstep, voffB); PG8_STAGE(PG8_SA(1, 0), a3, voffA);
            PG8_WAIT_V(8); PG8_WAIT_L(0); PG8_BAR; PG8_MMA(1, 0, At, B0); PG8_MMA(1, 1, At, B1); PG8_BAR; PG8_SCHED;
            } else {
            PG8_LDB(B0, 0, 0); PG8_SCHED; PG8_LDA(At, 0, 0); PG8_STAGE(PG8_SA(1, 1), a1 + hstep, voffA);
            PG8_WAIT_L(8); PG8_BAR; PG8_WAIT_L(0); PG8_MMA(0, 0, At, B0); PG8_BAR; PG8_SCHED;
            PG8_LDB(B1, 0, 1); PG8_STAGE(PG8_SB(0, 0), b2, voffB);
            PG8_BAR; PG8_WAIT_L(0); PG8_MMA(0, 1, At, B1); PG8_BAR;
            PG8_LDA(At, 0, 1); PG8_STAGE(PG8_SA(0, 0), a2, voffA);
            PG8_BAR; PG8_WAIT_L(0); PG8_MMA(1, 0, At, B0); PG8_BAR; PG8_SCHED;
            PG8_STAGE(PG8_SB(0, 1), b2 + hstep, voffB);
            PG8_WAIT_V(6); PG8_BAR; PG8_MMA(1, 1, At, B1); PG8_BAR;
            PG8_LDB(B0, 1, 0); PG8_SCHED; PG8_LDA(At, 1, 0); PG8_STAGE(PG8_SA(0, 1), a2 + hstep, voffA);
            PG8_WAIT_L(8); PG8_BAR; PG8_WAIT_L(0); PG8_MMA(0, 0, At, B0); PG8_BAR; PG8_SCHED;
            PG8_LDB(B1, 1, 1); PG8_STAGE(PG8_SB(1, 0), b3, voffB);
            PG8_BAR; PG8_WAIT_L(0); PG8_MMA(0, 1, At, B1); PG8_BAR;
            PG8_LDA(At, 1, 1); PG8_STAGE(PG8_SA(1, 0), a3, voffA);
            PG8_BAR; PG8_WAIT_L(0); PG8_MMA(1, 0, At, B0); PG8_BAR; PG8_SCHED;
            PG8_STAGE(PG8_SB(1, 1), b3 + hstep, voffB);
            PG8_WAIT_V(6); PG8_BAR; PG8_MMA(1, 1, At, B1); PG8_BAR;
            }
        }
        if constexpr (ALIGN_EPI) { if (wr == 0) PG8_BAR; }
#ifdef PROBE_GEMM_EPI_TICKS
        const unsigned long long pt0_ = __builtin_amdgcn_s_memrealtime();
#endif
        if constexpr (!Epi::AFTER_DRAIN) { E(acc, cur, wr, wc, fr, fq); S.done(cur); }
#ifdef PROBE_GEMM_EPI_TICKS
        if (blockIdx.x == PROBE_BLOCK && threadIdx.x == PROBE_THREAD && PROBE_EPI_TICKS) atomicAdd(g_probe_ticks, (unsigned long long)(__builtin_amdgcn_s_memrealtime() - pt0_));
#endif
        if (!has_next) break;
#pragma unroll
        for (int a = 0; a < 2; ++a)
#pragma unroll
            for (int b = 0; b < 2; ++b)
#pragma unroll
                for (int m = 0; m < 4; ++m)
#pragma unroll
                    for (int n = 0; n < 2; ++n) acc[a][b][m][n] = (f32x4){0.f, 0.f, 0.f, 0.f};
        cur = nxt; cA = nA; cB = nB; ++ui;
        if constexpr (ALIGN_EPI) { if (wr == 1) PG8_BAR; }
    }
    PG8_WAIT_V(0);
    if constexpr (!ALIGN_EPI) { if (wr == 0) PG8_BAR; }
    PG8_BAR;
    if constexpr (Epi::AFTER_DRAIN) { E.fused(acc, cur, wr, wc, fr, fq, lds, wid, lane); S.done(cur); }
#undef PG8_SA
#undef PG8_SB
#undef PG8_STAGE
#undef PG8_LDA
#undef PG8_LDB
#undef PG8_MMA
#undef PG8_WAIT_V
#undef PG8_WAIT_L
#undef PG8_BAR
#undef PG8_SCHED
}

__device__ __forceinline__ void rstd8(const float* ss, int row0, int fq, float (&r)[8]) {
    f32x4 v[8];
#pragma unroll
    for (int i = 0; i < 8; ++i) v[i] = *(const f32x4*)(ss + (size_t)(row0 + (i >> 2) * HALF + (i & 3) * 16) * 16 + 4 * fq);
#pragma unroll
    for (int i = 0; i < 8; ++i) { float s = (v[i][0] + v[i][1]) + (v[i][2] + v[i][3]); s += __shfl_xor(s, 16); s += __shfl_xor(s, 32); r[i] = __builtin_amdgcn_rsqf(s * (1.f / 1024.f) + 1e-6f); }
#pragma unroll
    for (int i = 0; i < 8; ++i) asm volatile("" : "+v"(r[i]));
}
template <bool NORM> struct EpiRaw {
    static constexpr bool PERM = true, AFTER_DRAIN = false;
    bf16_t* O; int ldc; const float* ss;
    __device__ __forceinline__ void operator()(const f32x4 (&acc)[2][2][4][2], const Unit& u, int wr, int wc, int fr, int fq) const {
        const int row0 = u.pm * BM + wr * 64 + fr, col0 = u.pn * BM + wc * 32 + 8 * fq;
        float rr[8];
        if (NORM) rstd8(ss, row0, fq, rr);
#pragma unroll
        for (int ai = 0; ai < 2; ++ai)
#pragma unroll
            for (int m = 0; m < 4; ++m) { const int row = row0 + ai * HALF + m * 16; const float r = NORM ? rr[ai * 4 + m] : 1.f;
                bf16_t* rowp = O + (size_t)row * ldc + col0;
#pragma unroll
                for (int bj = 0; bj < 2; ++bj) { const f32x4 v0 = acc[ai][bj][m][0] * r, v1 = acc[ai][bj][m][1] * r;
                    u32x4 w; w.x = pk2(v0[0], v0[1]); w.y = pk2(v0[2], v0[3]); w.z = pk2(v1[0], v1[1]); w.w = pk2(v1[2], v1[3]);
                    if (NORM) *(u32x4*)(rowp + bj * HALF) = w; else __builtin_nontemporal_store(w, (u32x4*)(rowp + bj * HALF)); } }
    }
};
struct EpiSwiglu {
    static constexpr bool PERM = true, AFTER_DRAIN = false;
    bf16_t* H; const float* ss;
    __device__ __forceinline__ void operator()(const f32x4 (&acc)[2][2][4][2], const Unit& u, int wr, int wc, int fr, int fq) const {
        const int row0 = u.pm * BM + wr * 64 + fr, col0 = u.pn * HALF + wc * 32 + 8 * fq;
        float rr[8]; rstd8(ss, row0, fq, rr);
#pragma unroll
        for (int ai = 0; ai < 2; ++ai)
#pragma unroll
            for (int m = 0; m < 4; ++m) { const int row = row0 + ai * HALF + m * 16; const float r = rr[ai * 4 + m];
                float h[8];
#pragma unroll
                for (int n = 0; n < 2; ++n)
#pragma unroll
                    for (int e = 0; e < 4; ++e) { const float g = acc[ai][0][m][n][e] * r, uu = acc[ai][1][m][n][e] * r; h[4 * n + e] = g * sigmoidf_(g) * uu; }
                u32x4 w; w.x = pk2(h[0], h[1]); w.y = pk2(h[2], h[3]); w.z = pk2(h[4], h[5]); w.w = pk2(h[6], h[7]);
                *(u32x4*)(H + (size_t)row * FF + col0) = w; }
    }
};
template <bool GATE, bool FINAL> struct EpiResid {
    static constexpr bool PERM = true, AFTER_DRAIN = false;
    const bf16_t* XBi; float* Y; bf16_t* XBo; float* SSo; float scale; const float* ss_in; const bf16_t* P;
    __device__ __forceinline__ void operator()(const f32x4 (&acc)[2][2][4][2], const Unit& u, int wr, int wc, int fr, int fq) const {
        const int row0 = u.pm * BM + wr * 64 + fr, col0 = u.pn * BM + wc * 32 + 8 * fq;
        float rr[8];
        if (GATE) rstd8(ss_in, row0, fq, rr);
        constexpr int RB = GATE ? 2 : 4;
#pragma unroll
        for (int g8 = 0; g8 < 8; g8 += RB) {
            u32x4 xw[RB][2], pw[RB][2];
#pragma unroll
            for (int mi = 0; mi < RB; ++mi)
#pragma unroll
                for (int bj = 0; bj < 2; ++bj) { const int i = g8 + mi; const size_t off = (size_t)(row0 + (i >> 2) * HALF + (i & 3) * 16) * D + col0 + bj * HALF; xw[mi][bj] = GATE ? *(const u32x4*)(XBi + off) : __builtin_nontemporal_load((const u32x4*)(XBi + off)); if (GATE) pw[mi][bj] = __builtin_nontemporal_load((const u32x4*)(P + off)); }
#pragma unroll
            for (int mi = 0; mi < RB; ++mi)
#pragma unroll
                for (int bj = 0; bj < 2; ++bj) { asm volatile("" : "+v"(xw[mi][bj])); if (GATE) asm volatile("" : "+v"(pw[mi][bj])); }
#pragma unroll
            for (int mi = 0; mi < RB; ++mi) { const int i = g8 + mi, ai = i >> 2, m = i & 3; const int row = row0 + ai * HALF + m * 16; const float r = GATE ? rr[i] : 0.f;
                float sq = 0.f;
#pragma unroll
                for (int bj = 0; bj < 2; ++bj) { const size_t off = (size_t)row * D + col0 + bj * HALF; const u32x4 xv = xw[mi][bj];
                    f32x4 x0 = (f32x4){bflo(xv.x), bfhi(xv.x), bflo(xv.y), bfhi(xv.y)}, x1 = (f32x4){bflo(xv.z), bfhi(xv.z), bflo(xv.w), bfhi(xv.w)}; const f32x4 a0 = acc[ai][bj][m][0], a1 = acc[ai][bj][m][1];
                    if (GATE) { const u32x4 pv = pw[mi][bj];
                        x0[0] += sigmoidf_(a0[0] * r) * bflo(pv.x); x0[1] += sigmoidf_(a0[1] * r) * bfhi(pv.x); x0[2] += sigmoidf_(a0[2] * r) * bflo(pv.y); x0[3] += sigmoidf_(a0[3] * r) * bfhi(pv.y);
                        x1[0] += sigmoidf_(a1[0] * r) * bflo(pv.z); x1[1] += sigmoidf_(a1[1] * r) * bfhi(pv.z); x1[2] += sigmoidf_(a1[2] * r) * bflo(pv.w); x1[3] += sigmoidf_(a1[3] * r) * bfhi(pv.w);
                    } else { x0 += a0 * scale; x1 += a1 * scale; }
                    if (FINAL) { __builtin_nontemporal_store(x0, (f32x4*)(Y + off)); __builtin_nontemporal_store(x1, (f32x4*)(Y + off + 4)); }
                    else { u32x4 w; w.x = pk2(x0[0], x0[1]); w.y = pk2(x0[2], x0[3]); w.z = pk2(x1[0], x1[1]); w.w = pk2(x1[2], x1[3]);
                        *(u32x4*)(XBo + off) = w;
                        sq += (x0[0] * x0[0] + x0[1] * x0[1]) + (x0[2] * x0[2] + x0[3] * x0[3]) + (x1[0] * x1[0] + x1[1] * x1[1]) + (x1[2] * x1[2] + x1[3] * x1[3]); } }
                if (!FINAL) { sq += __shfl_xor(sq, 16); sq += __shfl_xor(sq, 32); if (fq == 0) SSo[(size_t)row * 16 + u.pn * 4 + wc] = sq; } }
        }
    }
};
}
typedef pg8::StaticOrder GOrder;

#define XB_TMO      128
#define XB_XCNT(j)  (256  + 64 * (j))
#define XB_XSUB(j)  (1280 + 64 * (j))
#define XB_XGEN(j)  (2304 + 64 * (j))
#define XB_TOP      3328
#define XB_TOPGEN   3392
#define XCD_BAR_WORDS 3456
#define XB_SPIN_CAP (1u << 18)

__device__ __forceinline__ unsigned xb_ld(unsigned* p)              { return __hip_atomic_load(p, __ATOMIC_RELAXED, __HIP_MEMORY_SCOPE_AGENT); }
__device__ __forceinline__ unsigned xb_add(unsigned* p, unsigned v) { return __hip_atomic_fetch_add(p, v, __ATOMIC_RELAXED, __HIP_MEMORY_SCOPE_AGENT); }
__device__ __forceinline__ unsigned xb_xcc_id() { return (unsigned)__builtin_amdgcn_s_getreg((3 << 11) | 20) & 0xFu; }
#define XB_SPIN(cond, bar) do { unsigned _sp = 0; while (cond) { __builtin_amdgcn_s_sleep(1); \
    if ((++_sp & 255u) == 0u) { if (xb_ld(&(bar)[XB_TMO])) break; if (_sp > XB_SPIN_CAP) { atomicAdd(&(bar)[XB_TMO], 1u); break; } } } } while (0)

struct XcdBarrier {
    unsigned* bar; unsigned x;
    volatile LAS unsigned* st;
};

__device__ __forceinline__ XcdBarrier xcd_barrier_post(unsigned* bar, volatile LAS unsigned* st) {
    XcdBarrier b; b.bar = bar; b.x = xb_xcc_id(); b.st = st;
    if (threadIdx.x == 0) (void)xb_add(&bar[XB_XCNT(b.x)], 1u);
    return b;
}
__device__ __forceinline__ void xcd_barrier_complete(unsigned* bar, unsigned x, unsigned& nloc, unsigned& nx) {
    const unsigned G = gridDim.x * gridDim.y * gridDim.z;
    unsigned sum, cnt, mine, sp = 0u;
    for (;;) {
        sum = 0u; cnt = 0u; mine = 0u;
#pragma unroll
        for (unsigned j = 0; j < 16; ++j) { const unsigned c = xb_ld(&bar[XB_XCNT(j)]); sum += c; cnt += (c > 0u) ? 1u : 0u; mine = (j == x) ? c : mine; }
        if (sum == G) break;
        __builtin_amdgcn_s_sleep(1);
        if ((++sp & 255u) == 0u) { if (xb_ld(&bar[XB_TMO])) break; if (sp > XB_SPIN_CAP) { atomicAdd(&bar[XB_TMO], 1u); break; } }
    }
    nloc = mine > 0u ? mine : 1u; nx = cnt > 0u ? cnt : 1u;
}

__device__ __forceinline__ void xcd_barrier(const XcdBarrier& b) {
    asm volatile("s_waitcnt vmcnt(0)" ::: "memory");
    __syncthreads();
    if (threadIdx.x == 0) {
        unsigned* bar = b.bar;
        __builtin_amdgcn_s_waitcnt(0);
        unsigned nloc = b.st[0], nx = b.st[1];
        if (nloc == 0u) { xcd_barrier_complete(bar, b.x, nloc, nx); b.st[0] = nloc; b.st[1] = nx; }
        const unsigned old = xb_add(&bar[XB_XSUB(b.x)], 1u);
        const unsigned gen = old / nloc;
        if (old + 1u == (gen + 1u) * nloc) {
            __builtin_amdgcn_fence(__ATOMIC_RELEASE, "agent");
            asm volatile("s_waitcnt vmcnt(0)" ::: "memory");
            const unsigned og = xb_add(&bar[XB_TOP], 1u);
            const unsigned tg = og / nx;
            if (og + 1u == (tg + 1u) * nx) xb_add(&bar[XB_TOPGEN], 1u);
            else XB_SPIN(xb_ld(&bar[XB_TOPGEN]) == tg, bar);
            __builtin_amdgcn_fence(__ATOMIC_ACQUIRE, "agent");
            xb_add(&bar[XB_XGEN(b.x)], 1u);
            asm volatile("s_waitcnt vmcnt(0)" ::: "memory");
        } else {
            XB_SPIN(xb_ld(&bar[XB_XGEN(b.x)]) == gen, bar);
            __builtin_amdgcn_fence(__ATOMIC_ACQUIRE, "agent");
            asm volatile("s_waitcnt vmcnt(0)" ::: "memory");
        }
    }
    __syncthreads();
}

__device__ __forceinline__ void team_barrier(unsigned* ctlw, unsigned target, volatile LAS unsigned* same, unsigned pend) {
    asm volatile("s_waitcnt vmcnt(0)" ::: "memory");
    __syncthreads();
    if (threadIdx.x == 0) {
        const int bx = blockIdx.x; unsigned* tb = ctlw + CW_TEAM + 64 * ((bx & 7) * 8 + ((bx >> 3) & 7));
        __builtin_amdgcn_s_waitcnt(0);
        if (*same != 1u) { __builtin_amdgcn_fence(__ATOMIC_RELEASE, "agent"); asm volatile("s_waitcnt vmcnt(0)" ::: "memory"); }
        if (pend) (void)xb_add(ctlw + CW_SKCNT, pend);
        (void)xb_add(tb, 1u);
        XB_SPIN(xb_ld(tb) < target, ctlw + CW_BAR);
        __builtin_amdgcn_fence(__ATOMIC_ACQUIRE, "agent");
        asm volatile("s_waitcnt vmcnt(0)" ::: "memory");
    }
    __syncthreads();
}

__device__ __forceinline__ void team_arrive(unsigned* ctlw, volatile LAS unsigned* same) {
    asm volatile("s_waitcnt vmcnt(0)" ::: "memory");
    __syncthreads();
    if (threadIdx.x == 0) {
        const int bx = blockIdx.x; unsigned* tb = ctlw + CW_TEAM + 64 * ((bx & 7) * 8 + ((bx >> 3) & 7));
        __builtin_amdgcn_s_waitcnt(0);
        if (*same != 1u) { __builtin_amdgcn_fence(__ATOMIC_RELEASE, "agent"); asm volatile("s_waitcnt vmcnt(0)" ::: "memory"); }
        (void)xb_add(tb, 1u);
    }
}
__device__ __forceinline__ void team_wait(unsigned* ctlw, unsigned target, unsigned pend) {
    if (pend) { asm volatile("s_waitcnt vmcnt(0)" ::: "memory"); __syncthreads(); }
    if (threadIdx.x == 0) {
        const int bx = blockIdx.x; unsigned* tb = ctlw + CW_TEAM + 64 * ((bx & 7) * 8 + ((bx >> 3) & 7));
        if (pend) (void)xb_add(ctlw + CW_SKCNT, pend);
        XB_SPIN(xb_ld(tb) < target, ctlw + CW_BAR);
        __builtin_amdgcn_fence(__ATOMIC_ACQUIRE, "agent");
        asm volatile("s_waitcnt vmcnt(0)" ::: "memory");
    }
    __syncthreads();
}

__device__ __forceinline__ float wave_sum(float v) {
#pragma unroll
    for (int o = 1; o < 64; o <<= 1) v += __shfl_xor(v, o);
    return v;
}
__device__ __forceinline__ void st_bf16x8(bf16* p, const float* v) { v4u w; w.x = pk2(v[0], v[1]); w.y = pk2(v[2], v[3]); w.z = pk2(v[4], v[5]); w.w = pk2(v[6], v[7]); *(v4u*)p = w; }
__device__ __forceinline__ void ld_bf16x8_nt(const bf16* p, float* v) { const v4u w = __builtin_nontemporal_load((const v4u*)p); v[0] = bflo(w.x); v[1] = bfhi(w.x); v[2] = bflo(w.y); v[3] = bfhi(w.y); v[4] = bflo(w.z); v[5] = bfhi(w.z); v[6] = bflo(w.w); v[7] = bfhi(w.w); }
__device__ __forceinline__ void ld_bf16x8(const bf16* p, float* v) { const v4u w = *(const v4u*)p; v[0] = bflo(w.x); v[1] = bfhi(w.x); v[2] = bflo(w.y); v[3] = bfhi(w.y); v[4] = bflo(w.z); v[5] = bfhi(w.z); v[6] = bflo(w.w); v[7] = bfhi(w.w); }

template <int MODE, int NB> __device__ __forceinline__ int sk_brow(int cu, int j) {
    if (MODE == 0) return cu * (16 * NB) + j;
    const int T = cu >> 2, q = cu & 3; return T * 256 + q * 32 + (j & 31) + ((j >> 5) ? 128 : 0);
}
#ifdef PROBE_SKW_TICKS
#define PROBE_SKW_T0 if (threadIdx.x == 0) ((volatile LAS unsigned*)(lds + MISC_OFF))[14] = (unsigned)__builtin_amdgcn_s_memrealtime();
#define PROBE_SKW_T1 if (threadIdx.x == 0) ((volatile LAS unsigned*)(lds + MISC_OFF))[13] += (unsigned)__builtin_amdgcn_s_memrealtime() - ((volatile LAS unsigned*)(lds + MISC_OFF))[14];
#else
#define PROBE_SKW_T0
#define PROBE_SKW_T1
#endif
template <int MODE, int NB, class Epi>
__device__ __forceinline__ void skinny_phase(LAS unsigned char* lds, const bf16* A, const bf16* Bt, int K, int ncu, const Epi& E, int first, int stride, unsigned* ctlw, unsigned need, unsigned& pend, int lim = 0x7fffffff) {
    int tid_ = threadIdx.x; asm volatile("" : "+v"(tid_));
    const int tid = tid_, wave = __builtin_amdgcn_readfirstlane(tid >> 6), lane = tid & 63, fr = lane & 15, fq = lane >> 4;
    constexpr int NC = 16 * NB;
    LAS float* part = (LAS float*)lds;
    LAS float* tile = (LAS float*)(lds + 65536);
    const int kw = K >> 3, k0 = wave * kw, nst = kw >> 5;
    lim = lim < 4 * ncu ? lim : 4 * ncu;
    const bool mine = first < lim;
    if (ctlw != nullptr && mine && need > 0u) {
        PROBE_SKW_T0
        if (threadIdx.x == 0) { XB_SPIN(xb_ld(ctlw + CW_SKCNT) < need, ctlw + CW_BAR); __builtin_amdgcn_fence(__ATOMIC_ACQUIRE, "agent"); asm volatile("s_waitcnt vmcnt(0)" ::: "memory"); }
        PROBE_SKW_T1
        __syncthreads();
    }
    unsigned ndone = 0u;
    for (int un = first; un < lim; un += stride) {
        const int rb = un & 3, cu = un >> 2; ++ndone;
        typename Epi::Pre pre = E.pre(rb, cu, tid);
        f32x4 acc[2][NB];
#pragma unroll
        for (int i = 0; i < 2; ++i)
#pragma unroll
            for (int c = 0; c < NB; ++c) acc[i][c] = (f32x4){0.f, 0.f, 0.f, 0.f};
        const bf16* ap = A + (size_t)(rb * 32 + fr) * K + k0 + 8 * fq;
        const bf16* bp[NB];
#pragma unroll
        for (int c = 0; c < NB; ++c) bp[c] = Bt + (size_t)sk_brow<MODE, NB>(cu, 16 * c + fr) * K + k0 + 8 * fq;
        constexpr int SKB = NB == 4 ? 6 : 11;
#pragma unroll 1
        for (int s0 = 0; s0 < nst; s0 += SKB) {
            bf16x8 a0[SKB], a1[SKB], b[SKB][NB];
#pragma unroll
            for (int j = 0; j < SKB; ++j) if (s0 + j < nst) { const int s = s0 + j;
                a0[j] = *(const bf16x8*)(ap + 32 * s); a1[j] = *(const bf16x8*)(ap + (size_t)16 * K + 32 * s);
#pragma unroll
                for (int c = 0; c < NB; ++c) b[j][c] = *(const bf16x8*)(bp[c] + 32 * s); }
#pragma unroll
            for (int j = 0; j < SKB; ++j) if (s0 + j < nst) {
#pragma unroll
                for (int c = 0; c < NB; ++c) { acc[0][c] = __builtin_amdgcn_mfma_f32_16x16x32_bf16(a0[j], b[j][c], acc[0][c], 0, 0, 0); acc[1][c] = __builtin_amdgcn_mfma_f32_16x16x32_bf16(a1[j], b[j][c], acc[1][c], 0, 0, 0); } }
        }
#pragma unroll
        for (int i = 0; i < 2; ++i)
#pragma unroll
            for (int c = 0; c < NB; ++c)
#pragma unroll
                for (int r = 0; r < 4; ++r) part[wave * (32 * NC) + (i * 16 + 4 * fq + r) * NC + c * 16 + fr] = acc[i][c][r];
        __syncthreads();
        if (tid < 8 * NC) { const int row = tid / (NC / 4), cg = tid % (NC / 4); f32x4 s = (f32x4){0.f, 0.f, 0.f, 0.f};
#pragma unroll
          for (int w = 0; w < 8; ++w) s += *(const LAS f32x4*)(part + w * (32 * NC) + row * NC + 4 * cg);
          *(LAS f32x4*)(tile + row * NC + 4 * cg) = s; }
        __syncthreads();
        E(tile, rb, cu, tid, pre);
        __syncthreads();
    }
    if (ctlw != nullptr) pend += ndone;
}
__device__ __forceinline__ void st_wt8(void* p, v2u w) { __hip_atomic_store((unsigned long long*)p, (unsigned long long)w.x | ((unsigned long long)w.y << 32), __ATOMIC_RELAXED, __HIP_MEMORY_SCOPE_AGENT); }
__device__ __forceinline__ void st_wt4(float* p, float v) { __hip_atomic_store(p, v, __ATOMIC_RELAXED, __HIP_MEMORY_SCOPE_AGENT); }
__device__ __forceinline__ float sk_ss_load(const float* sss, int srow, int cg) { const v2f v = *(const v2f*)(sss + (size_t)srow * 32 + 2 * cg); return v.x + v.y; }
__device__ __forceinline__ float sk_rstd_finish(float s) {
    s += __shfl_xor(s, 1); s += __shfl_xor(s, 2); s += __shfl_xor(s, 4); s += __shfl_xor(s, 8);
    return __builtin_amdgcn_rsqf(s * (1.f / 1024.f) + 1e-6f);
}
template <bool NORM> struct SkRaw { bf16* O; int ldc; const float* sss;
    struct Pre { float s; };
    __device__ __forceinline__ Pre pre(int rb, int cu, int tid) const { Pre p; p.s = NORM ? sk_ss_load(sss, rb * 32 + (tid >> 4), tid & 15) : 0.f; return p; }
    __device__ __forceinline__ void operator()(const LAS float* tile, int rb, int cu, int tid, const Pre& p) const {
        const int row = tid >> 4, cg = tid & 15, grow = MP + rb * 32 + row; const float r = NORM ? sk_rstd_finish(p.s) : 1.f;
        const f32x4 v = *(const LAS f32x4*)(tile + row * 64 + 4 * cg) * r; const int col = cu * 64 + 4 * cg;
        if (col < ldc) { v2u w; w.x = pk2(v[0], v[1]); w.y = pk2(v[2], v[3]); st_wt8(O + (size_t)grow * ldc + col, w); }
    } };
struct SkSwiglu { bf16* H; const float* sss;
    struct Pre { float s; };
    __device__ __forceinline__ Pre pre(int rb, int cu, int tid) const { Pre p; p.s = sk_ss_load(sss, rb * 32 + (tid >> 4), tid & 15); return p; }
    __device__ __forceinline__ void operator()(const LAS float* tile, int rb, int cu, int tid, const Pre& p) const {
        const int row = tid >> 4, cg = tid & 15, grow = MP + rb * 32 + row; const float r = sk_rstd_finish(p.s);
        if (cg < 8) { const f32x4 g = *(const LAS f32x4*)(tile + row * 64 + 4 * cg) * r, u = *(const LAS f32x4*)(tile + row * 64 + 32 + 4 * cg) * r;
            float h[4];
#pragma unroll
            for (int e = 0; e < 4; ++e) h[e] = g[e] * sigmoidf_(g[e]) * u[e];
            v2u w; w.x = pk2(h[0], h[1]); w.y = pk2(h[2], h[3]); st_wt8(H + (size_t)grow * FF + cu * 32 + 4 * cg, w); }
    } };
template <bool GATE> struct SkResid { const bf16* XBi; float* Y; bf16* XBo; float* SSSo; float scale; const float* sss_in; const bf16* P; int fin;
    struct Pre { v2u xw, pw; float s; };
    __device__ __forceinline__ Pre pre(int rb, int cu, int tid) const { Pre p; const int t = tid & 255, row = t >> 3, cg = t & 7; const size_t off = (size_t)(MP + rb * 32 + row) * D + cu * 32 + 4 * cg;
        p.xw = *(const v2u*)(XBi + off); p.pw = p.xw; p.s = 0.f;
        if (GATE) { p.pw = *(const v2u*)(P + off); const f32x4 v = *(const f32x4*)(sss_in + (size_t)(rb * 32 + row) * 32 + 4 * cg); p.s = (v[0] + v[1]) + (v[2] + v[3]); }
        return p; }
    __device__ __forceinline__ void operator()(const LAS float* tile, int rb, int cu, int tid, const Pre& p) const {
        const int t = tid & 255, row = t >> 3, cg = t & 7, srow = rb * 32 + row; float r = 0.f;
        if (GATE) { float s = p.s; s += __shfl_xor(s, 1); s += __shfl_xor(s, 2); s += __shfl_xor(s, 4); r = __builtin_amdgcn_rsqf(s * (1.f / 1024.f) + 1e-6f); }
        const f32x4 a = *(const LAS f32x4*)(tile + row * 32 + 4 * cg); const size_t off = (size_t)(MP + srow) * D + cu * 32 + 4 * cg;
        f32x4 x = (f32x4){bflo(p.xw.x), bfhi(p.xw.x), bflo(p.xw.y), bfhi(p.xw.y)};
        if (GATE) { x[0] += sigmoidf_(a[0] * r) * bflo(p.pw.x); x[1] += sigmoidf_(a[1] * r) * bfhi(p.pw.x); x[2] += sigmoidf_(a[2] * r) * bflo(p.pw.y); x[3] += sigmoidf_(a[3] * r) * bfhi(p.pw.y);
        } else x += a * scale;
        float sq = (x[0] * x[0] + x[1] * x[1]) + (x[2] * x[2] + x[3] * x[3]);
        sq += __shfl_xor(sq, 1); sq += __shfl_xor(sq, 2); sq += __shfl_xor(sq, 4);
        if (tid < 256) {
            if (fin) *(f32x4*)(Y + off) = x;
            else { v2u w; w.x = pk2(x[0], x[1]); w.y = pk2(x[2], x[3]); st_wt8(XBo + off, w); if (cg == 0) st_wt4(SSSo + (size_t)srow * 32 + cu, sq); } }
    } };

__device__ __forceinline__ void transpose_item(const float* W, int K, int N, int Nd, bf16* WT, const float* gain, int mode, LAS float* scr, int item, int lane) {
    const int nblk = Nd / 64, kb = item / nblk, nb = item % nblk, k0 = 64 * kb, n0 = 64 * nb;
    const int n4 = 4 * (lane & 15), n = n0 + n4;
    f32x4 v[16];
#pragma unroll
    for (int i = 0; i < 16; ++i) { const int kk = 4 * i + (lane >> 4); v[i] = (f32x4){0.f, 0.f, 0.f, 0.f}; if (n < N) v[i] = __builtin_nontemporal_load((const f32x4*)(W + (size_t)(k0 + kk) * N + n)); }
    if (gain) {
#pragma unroll
        for (int i = 0; i < 16; ++i) v[i] *= gain[k0 + 4 * i + (lane >> 4)]; }
#pragma unroll
    for (int i = 0; i < 16; ++i) { const int kk = 4 * i + (lane >> 4); scr[kk * 65 + n4] = v[i][0]; scr[kk * 65 + n4 + 1] = v[i][1]; scr[kk * 65 + n4 + 2] = v[i][2]; scr[kk * 65 + n4 + 3] = v[i][3]; }
    LDS_WAIT(); asm volatile("" ::: "memory");
    const int c = lane & 7;
#pragma unroll
    for (int j = 0; j < 8; ++j) { const int nl = (lane >> 3) + 8 * j, nn = n0 + nl; const LAS float* s = scr + (8 * c) * 65 + nl;
        int drow = nn; if (mode == 1) { const int jj = nn < FF ? nn : nn - FF; drow = (jj >> 7) * 256 + (jj & 127) + (nn < FF ? 0 : 128); }
        v4u o; o.x = pk2(s[0 * 65], s[1 * 65]); o.y = pk2(s[2 * 65], s[3 * 65]); o.z = pk2(s[4 * 65], s[5 * 65]); o.w = pk2(s[6 * 65], s[7 * 65]);
        *(GAS v4u*)(WT + (size_t)drow * K + k0 + 8 * c) = o; }
    LDS_WAIT(); asm volatile("" ::: "memory");
}
struct In {
    const float *x_prompt, *x_sample, *state_conv, *ck_cmp, *cv_cmp, *ck_sel, *cv_sel, *ck_win, *cv_win; const int* page_table; const float *p_prompt, *p_sample, *norm_g, *w_gu, *w_down,
        *w_proj, *w_gate, *cw_in, *cw, *cw_out, *nw_in, *qk_g, *cmp_pos, *cmp_w1, *cmp_w2, *nw_out;
};
__device__ __forceinline__ void sincos_d(double r, float& s, float& c) {
    const double r2 = r * r;
    double sp = 1.0, cp = 1.0;
#pragma unroll
    for (int k = 12; k >= 1; --k) { sp = 1.0 - sp * r2 / (double)((2 * k) * (2 * k + 1)); cp = 1.0 - cp * r2 / (double)((2 * k - 1) * (2 * k)); }
    s = (float)(r * sp); c = (float)cp;
}
__device__ __forceinline__ void p0_prologue(const In& I, float* out, unsigned char* ws, LAS unsigned char* lds, int vcu, int G, int wave, int lane) {
    LAS float* scr = (LAS float*)(lds + wave * 17408);
    const int gw = vcu * NWAVES + wave, NGW = G * NWAVES;
    constexpr int I_GU = (D / 64) * (NGU / 64), I_DN = (FF / 64) * (D / 64), I_SQ = (D / 64) * (D / 64), I_PR = (PLE / 64) * (D / 64), I_CI = (D / 64) * (NCV / 64), I_NI = (D / 64) * (NNSP / 64),
                  I_W1 = (4096 / 64) * (128 / 64), I_W2 = (128 / 64) * (64 / 64);
    constexpr int NITEMS = 4 * I_GU + 4 * I_DN + 2 * I_SQ + 2 * I_PR + I_CI + I_SQ + I_NI + I_SQ + 2 * I_W1 + 2 * I_W2;
#define TR(W_, K_, N_, ND_, WT_, G_, MODE_, NI_) if (r < (NI_)) { transpose_item(W_, K_, N_, ND_, WT_, G_, MODE_, scr, r, lane); continue; } r -= (NI_);
    for (int it = gw; it < NITEMS; it += NGW) {
        int r = it;
        TR(I.w_gu + (size_t)0 * D * NGU, D, NGU, NGU, (bf16*)(ws + WS_WGU + 0 * SZ_WGU), I.norm_g + 0 * D, 1, I_GU)
        TR(I.w_gu + (size_t)1 * D * NGU, D, NGU, NGU, (bf16*)(ws + WS_WGU + 1 * SZ_WGU), I.norm_g + 2 * D, 1, I_GU)
        TR(I.w_gu + (size_t)2 * D * NGU, D, NGU, NGU, (bf16*)(ws + WS_WGU + 2 * SZ_WGU), I.norm_g + 4 * D, 1, I_GU)
        TR(I.w_gu + (size_t)3 * D * NGU, D, NGU, NGU, (bf16*)(ws + WS_WGU + 3 * SZ_WGU), I.norm_g + 6 * D, 1, I_GU)
        TR(I.w_down + (size_t)0 * FF * D, FF, D, D, (bf16*)(ws + WS_WDN + 0 * SZ_WDN), nullptr, 0, I_DN)
        TR(I.w_down + (size_t)1 * FF * D, FF, D, D, (bf16*)(ws + WS_WDN + 1 * SZ_WDN), nullptr, 0, I_DN)
        TR(I.w_down + (size_t)2 * FF * D, FF, D, D, (bf16*)(ws + WS_WDN + 2 * SZ_WDN), nullptr, 0, I_DN)
        TR(I.w_down + (size_t)3 * FF * D, FF, D, D, (bf16*)(ws + WS_WDN + 3 * SZ_WDN), nullptr, 0, I_DN)
        TR(I.w_gate + (size_t)0 * D * D, D, D, D, (bf16*)(ws + WS_WGATE + 0 * SZ_WSQ), I.norm_g + 3 * D, 0, I_SQ)
        TR(I.w_gate + (size_t)1 * D * D, D, D, D, (bf16*)(ws + WS_WGATE + 1 * SZ_WSQ), I.norm_g + 7 * D, 0, I_SQ)
        TR(I.w_proj + (size_t)0 * PLE * D, PLE, D, D, (bf16*)(ws + WS_WPROJ + 0 * SZ_WPROJ), nullptr, 0, I_PR)
        TR(I.w_proj + (size_t)1 * PLE * D, PLE, D, D, (bf16*)(ws + WS_WPROJ + 1 * SZ_WPROJ), nullptr, 0, I_PR)
        TR(I.cw_in, D, NCV, NCV, (bf16*)(ws + WS_WCIN), I.norm_g + 1 * D, 0, I_CI)
        TR(I.cw_out, D, D, D, (bf16*)(ws + WS_WCOUT), nullptr, 0, I_SQ)
        TR(I.nw_in, D, NNS, NNSP, (bf16*)(ws + WS_WNIN), I.norm_g + 5 * D, 0, I_NI)
        TR(I.nw_out, D, D, D, (bf16*)(ws + WS_WNOUT), nullptr, 0, I_SQ)
        TR(I.cmp_w1 + (size_t)0 * 4096 * 128, 4096, 128, 128, (bf16*)(ws + WS_W1T) + (size_t)0 * 128 * 4096, nullptr, 0, I_W1)
        TR(I.cmp_w1 + (size_t)1 * 4096 * 128, 4096, 128, 128, (bf16*)(ws + WS_W1T) + (size_t)1 * 128 * 4096, nullptr, 0, I_W1)
        TR(I.cmp_w2 + (size_t)0 * 128 * 64, 128, 64, 64, (bf16*)(ws + WS_W2T) + (size_t)0 * 64 * 128, nullptr, 0, I_W2)
        TR(I.cmp_w2 + (size_t)1 * 128 * 64, 128, 64, 64, (bf16*)(ws + WS_W2T) + (size_t)1 * 64 * 128, nullptr, 0, I_W2)
    }
#undef TR
    bf16* XB0 = (bf16*)(ws + WS_XB); float* SS0 = (float*)(ws + WS_SS);
    for (int m = gw; m < MT; m += NGW) {
        const float* src = m < MP ? I.x_prompt + (size_t)m * D : I.x_sample + (size_t)(m - MP) * D;
        const GAS f32x4* xr = (const GAS f32x4*)src + lane;
        GAS v2u* o8 = (GAS v2u*)(XB0 + (size_t)m * D) + lane; float s = 0.f;
#pragma unroll
        for (int j = 0; j < 4; ++j) { const f32x4 v = __builtin_nontemporal_load(xr + 64 * j); s += (v[0] * v[0] + v[1] * v[1]) + (v[2] * v[2] + v[3] * v[3]); v2u w; w.x = pk2(v[0], v[1]); w.y = pk2(v[2], v[3]); o8[64 * j] = w; }
        s = wave_sum(s);
        if (lane < 16) SS0[(size_t)m * 16 + lane] = lane == 0 ? s : 0.f;
        if (m >= MP && lane < 32) ((float*)(ws + WS_SSS))[(size_t)(m - MP) * 32 + lane] = lane == 0 ? s : 0.f;
    }
    bf16* PB = (bf16*)(ws + WS_PB);
    for (int r = gw; r < 2 * MT; r += NGW) { const int l = r / MT, m = r % MT;
        const float* src = m < MP ? I.p_prompt + ((size_t)l * MP + m) * PLE : I.p_sample + ((size_t)l * MS + (m - MP)) * PLE;
        const f32x4 v = __builtin_nontemporal_load((const GAS f32x4*)src + lane); v2u w; w.x = pk2(v[0], v[1]); w.y = pk2(v[2], v[3]); ((GAS v2u*)(PB + (size_t)r * PLE))[lane] = w; }
    float* ROPE = (float*)(ws + WS_ROPE);
    for (int i = gw * 64 + lane; i < 8196 * 32; i += NGW * 64) { const int pos = i >> 5, d = i & 31;
        const float inv = (float)exp2(-(double)d * (13.287712379549449 / 32.0));
        const float ang = (float)pos * inv; const double a = (double)ang, k = rint(a * 0.15915494309189535), rr = a - k * 6.283185307179586;
        float s, c; sincos_d(rr, s, c); ROPE[(size_t)pos * 64 + d] = c; ROPE[(size_t)pos * 64 + 32 + d] = s; }
}

__device__ __forceinline__ void conv_post(const In& I, float* out, unsigned char* ws, int vcu, int G, int wave, int lane) {
    const bf16* CV = (const bf16*)(ws + WS_CV); bf16* AC = (bf16*)(ws + WS_AC);
    const int gw = vcu * NWAVES + wave, NGW = G * NWAVES;
    constexpr int RS = 8, NSTRIP_P = MP / RS, NITEM = (NSTRIP_P + SB) * 2;
    for (int it = gw; it < NITEM; it += NGW) {
        const int half = it & 1, st = it >> 1, ch = half * 512 + lane * 8;
        const bool samp = st >= NSTRIP_P; const int row0 = samp ? MP + (st - NSTRIP_P) * 4 : st * RS, nrow = samp ? 4 : RS;
        const bool halo = !samp && (row0 & (SEQ - 1)) != 0;
        v4u cw[RS + 2], vw[RS + 2], bw[RS];
#pragma unroll
        for (int i = 0; i < RS + 2; ++i) { const int r = row0 - 2 + i; const bool ok = (i >= 2) ? (i - 2 < nrow) : halo; cw[i] = (v4u){0u, 0u, 0u, 0u}; vw[i] = cw[i];
            if (ok) { cw[i] = __builtin_nontemporal_load((const v4u*)(CV + (size_t)r * NCV + D + ch)); vw[i] = __builtin_nontemporal_load((const v4u*)(CV + (size_t)r * NCV + 2 * D + ch)); } }
#pragma unroll
        for (int i = 0; i < RS; ++i) { bw[i] = (v4u){0u, 0u, 0u, 0u}; if (i < nrow) bw[i] = __builtin_nontemporal_load((const v4u*)(CV + (size_t)(row0 + i) * NCV + ch)); }
        float w0[8], w1[8], w2[8], um2[8], um1[8];
#pragma unroll
        for (int e = 0; e < 8; ++e) { w0[e] = I.cw[ch + e]; w1[e] = I.cw[D + ch + e]; w2[e] = I.cw[2 * D + ch + e]; }
        if (samp) { const int bs = st - NSTRIP_P;
#pragma unroll
            for (int e = 0; e < 8; ++e) { um2[e] = I.state_conv[((size_t)bs * 2 + 0) * D + ch + e]; um1[e] = I.state_conv[((size_t)bs * 2 + 1) * D + ch + e]; }
        } else {
            const unsigned c2[4] = {cw[0].x, cw[0].y, cw[0].z, cw[0].w}, v2[4] = {vw[0].x, vw[0].y, vw[0].z, vw[0].w}, c1[4] = {cw[1].x, cw[1].y, cw[1].z, cw[1].w}, v1[4] = {vw[1].x, vw[1].y, vw[1].z, vw[1].w};
#pragma unroll
            for (int e = 0; e < 4; ++e) { um2[2 * e] = bflo(c2[e]) * bflo(v2[e]); um2[2 * e + 1] = bfhi(c2[e]) * bfhi(v2[e]); um1[2 * e] = bflo(c1[e]) * bflo(v1[e]); um1[2 * e + 1] = bfhi(c1[e]) * bfhi(v1[e]); } }
#pragma unroll
        for (int i = 0; i < RS; ++i) if (i < nrow) { const int row = row0 + i; float u[8], o[8];
            const unsigned cc[4] = {cw[i + 2].x, cw[i + 2].y, cw[i + 2].z, cw[i + 2].w}, vv[4] = {vw[i + 2].x, vw[i + 2].y, vw[i + 2].z, vw[i + 2].w}, bb[4] = {bw[i].x, bw[i].y, bw[i].z, bw[i].w};
#pragma unroll
            for (int e = 0; e < 4; ++e) { u[2 * e] = bflo(cc[e]) * bflo(vv[e]); u[2 * e + 1] = bfhi(cc[e]) * bfhi(vv[e]); }
#pragma unroll
            for (int e = 0; e < 8; ++e) { const float bv = (e & 1) ? bfhi(bb[e >> 1]) : bflo(bb[e >> 1]); o[e] = bv * (w0[e] * um2[e] + w1[e] * um1[e] + w2[e] * u[e]); um2[e] = um1[e]; um1[e] = u[e]; }
            st_bf16x8(AC + (size_t)row * D + ch, o);
            float* so = nullptr;
            if (!samp) { const int t = row & (SEQ - 1); if (t >= SEQ - 2) so = out + O_CONVP + ((size_t)(row >> 13) * 2 + (t - (SEQ - 2))) * D + ch; }
            else if (i >= 2) so = out + O_CONVS + ((size_t)(st - NSTRIP_P) * 2 + (i - 2)) * D + ch;
            if (so) { *(f32x4*)so = (f32x4){u[0], u[1], u[2], u[3]}; *(f32x4*)(so + 4) = (f32x4){u[4], u[5], u[6], u[7]}; } }
    }
}

__device__ __forceinline__ void nsa_post(const In& I, float* out, unsigned char* ws, int vcu, int G, int wave, int lane) {
    const bf16* RAW = (const bf16*)(ws + WS_H); const float* ROPE = (const float*)(ws + WS_ROPE);
    bf16* QN = (bf16*)(ws + WS_QN); bf16* QR = (bf16*)(ws + WS_QR); bf16* KS = (bf16*)(ws + WS_KS); bf16* VS = (bf16*)(ws + WS_VS); bf16* KW = (bf16*)(ws + WS_KW); bf16* VW = (bf16*)(ws + WS_VW);
    float* GATES = (float*)(ws + WS_GATES);
    const int gw = vcu * NWAVES + wave, NGW = G * NWAVES, qd = lane >> 2, p = lane & 3;
    for (int row = gw; row < MT; row += NGW) {
        const bool samp = row >= MP; const int sr = row - MP; const int pos = samp ? PAST + (sr & 3) : (row & (SEQ - 1));
        float cs[8], sn[8];
        { const f32x4 c0 = *(const f32x4*)(ROPE + (size_t)pos * 64 + 8 * p), c1 = *(const f32x4*)(ROPE + (size_t)pos * 64 + 8 * p + 4), s0 = *(const f32x4*)(ROPE + (size_t)pos * 64 + 32 + 8 * p), s1 = *(const f32x4*)(ROPE + (size_t)pos * 64 + 36 + 8 * p);
#pragma unroll
          for (int e = 0; e < 4; ++e) { cs[e] = c0[e]; cs[4 + e] = c1[e]; sn[e] = s0[e]; sn[4 + e] = s1[e]; } }
#pragma unroll
        for (int pass = 0; pass < 3; ++pass) { const int sg = qd + 16 * pass;
            if (sg < 40) {
                float x1[8], x2[8];
                ld_bf16x8_nt(RAW + (size_t)row * NNSP + 64 * sg + 8 * p, x1); ld_bf16x8_nt(RAW + (size_t)row * NNSP + 64 * sg + 32 + 8 * p, x2);
                const int typ = sg < 16 ? 0 : 1 + ((sg - 16) >> 2), g4 = sg & 3;
                const bool nrm = (typ == 0 || typ == 3 || typ == 5);
                if (nrm) { const int gi = typ == 0 ? 0 : (typ == 3 ? 2 : 3); float ssq = 0.f;
#pragma unroll
                    for (int e = 0; e < 8; ++e) ssq += x1[e] * x1[e] + x2[e] * x2[e];
                    ssq += __shfl_xor(ssq, 1); ssq += __shfl_xor(ssq, 2);
                    const float rs = __builtin_amdgcn_rsqf(ssq * (1.f / 64.f) + RMS_EPS);
#pragma unroll
                    for (int e = 0; e < 8; ++e) { x1[e] *= rs * I.qk_g[gi * 64 + 8 * p + e]; x2[e] *= rs * I.qk_g[gi * 64 + 32 + 8 * p + e]; } }
                float y1[8], y2[8];
#pragma unroll
                for (int e = 0; e < 8; ++e) { y1[e] = x1[e] * cs[e] - x2[e] * sn[e]; y2[e] = x2[e] * cs[e] + x1[e] * sn[e]; }
                if (typ == 0) { float a[8], b[8];
#pragma unroll
                    for (int e = 0; e < 8; ++e) { a[e] = x1[e] * QSCALE; b[e] = x2[e] * QSCALE; }
                    st_bf16x8(QN + (size_t)row * D + 64 * sg + 8 * p, a); st_bf16x8(QN + (size_t)row * D + 64 * sg + 32 + 8 * p, b);
#pragma unroll
                    for (int e = 0; e < 8; ++e) { a[e] = y1[e] * QSCALE; b[e] = y2[e] * QSCALE; }
                    st_bf16x8(QR + (size_t)row * D + 64 * sg + 8 * p, a); st_bf16x8(QR + (size_t)row * D + 64 * sg + 32 + 8 * p, b);
                } else {
                    const bool rope = (typ == 3 || typ == 5);
                    float o1[8], o2[8];
#pragma unroll
                    for (int e = 0; e < 8; ++e) { o1[e] = rope ? y1[e] : x1[e]; o2[e] = rope ? y2[e] : x2[e]; }
                    float* fo = nullptr; bf16* bo = nullptr; const size_t co = (size_t)g4 * 64 + 8 * p;
                    if (typ <= 4) { const size_t base = samp ? (typ == 1 ? O_KCS : typ == 2 ? O_VCS : typ == 3 ? O_KSS : O_VSS) + (size_t)sr * KVW : (typ == 1 ? O_KCP : typ == 2 ? O_VCP : typ == 3 ? O_KSP : O_VSP) + (size_t)row * KVW;
                        fo = out + base + co; if (typ == 3) bo = KS + (size_t)row * KVW + co; if (typ == 4) bo = VS + (size_t)row * KVW + co;
                    } else { bo = (typ == 5 ? KW : VW) + (size_t)row * KVW + co;
                        if (samp) fo = out + (typ == 5 ? O_KWS : O_VWS) + ((size_t)(sr >> 2) * 512 + 508 + (sr & 3)) * KVW + co;
                        else { const int t = row & (SEQ - 1); if (t >= SEQ - WIN) fo = out + (typ == 5 ? O_KWP : O_VWP) + ((size_t)(row >> 13) * 512 + (t - (SEQ - WIN))) * KVW + co; } }
                    if (fo) { const f32x4 a0 = (f32x4){o1[0], o1[1], o1[2], o1[3]}, a1 = (f32x4){o1[4], o1[5], o1[6], o1[7]}, a2 = (f32x4){o2[0], o2[1], o2[2], o2[3]}, a3 = (f32x4){o2[4], o2[5], o2[6], o2[7]};
                        if (typ <= 2 && !samp) { *(f32x4*)fo = a0; *(f32x4*)(fo + 4) = a1; *(f32x4*)(fo + 32) = a2; *(f32x4*)(fo + 36) = a3; }
                        else { __builtin_nontemporal_store(a0, (f32x4*)fo); __builtin_nontemporal_store(a1, (f32x4*)(fo + 4)); __builtin_nontemporal_store(a2, (f32x4*)(fo + 32)); __builtin_nontemporal_store(a3, (f32x4*)(fo + 36)); } }
                    if (bo) { st_bf16x8(bo, o1); st_bf16x8(bo + 32, o2); }
                }
            }
        }
        if (lane < 48) { const unsigned short rv = RAW[(size_t)row * NNSP + 2560 + lane]; GATES[(size_t)row * 48 + lane] = sigmoidf_(__uint_as_float((unsigned)rv << 16)); }
    }
    { const size_t n4 = (size_t)SB * 508 * 64; const size_t gt = (size_t)(vcu * NWAVES + wave) * 64 + lane, NT = (size_t)NGW * 64;
      for (size_t i = gt; i < 2 * n4; i += NT) { const int kv = i >= n4; const size_t j = kv ? i - n4 : i; const size_t bs = j / (508 * 64), rem = j % (508 * 64);
          const f32x4 v = __builtin_nontemporal_load((const GAS f32x4*)(kv ? I.cv_win : I.ck_win) + bs * 512 * 64 + 4 * 64 + rem);
          __builtin_nontemporal_store(v, (GAS f32x4*)(out + (kv ? O_VWS : O_KWS)) + bs * 512 * 64 + rem); } }
}

__device__ __forceinline__ void glds16(const void* gsrc, unsigned lds_dst) { unsigned keep;
    asm volatile("s_mov_b32 %0, m0\n\ts_mov_b32 m0, %2\n\ts_nop 0\n\tglobal_load_lds_dwordx4 %1, off\n\ts_mov_b32 m0, %0" : "=&s"(keep) : "v"(gsrc), "s"(lds_dst) : "memory"); }
__device__ __forceinline__ unsigned lds_addr(const LAS unsigned char* p) { return (unsigned)(uintptr_t)p; }
__device__ __forceinline__ void glds16_nt(const void* gsrc, unsigned lds_dst) { unsigned keep;
    asm volatile("s_mov_b32 %0, m0\n\ts_mov_b32 m0, %2\n\ts_nop 0\n\tglobal_load_lds_dwordx4 %1, off nt\n\ts_mov_b32 m0, %0" : "=&s"(keep) : "v"(gsrc), "s"(lds_dst) : "memory"); }

constexpr int CMP_NA = 5, CMP_NB = 3, CMP_BOFF = CMP_NA * 16384, CMP_RED_OFF = LDSCTL_OFF + 1024;
static_assert(CMP_BOFF + CMP_NB * 16384 <= RING_BYTES, "compress LDS");
__device__ __forceinline__ void cmp_bias_partials(const In& I, unsigned char* ws, int vcu, int G, int wave, int lane) {
    float* PART = (float*)(ws + WS_CPART); const int gw = vcu * NWAVES + wave, NGW = G * NWAVES;
    for (int it = gw; it < 128; it += NGW) { const int kv = it >> 6, j = it & 63; float a0 = 0.f, a1 = 0.f;
        const float* pp = I.cmp_pos + ((size_t)kv * 64 + j) * 64; const float* wp = I.cmp_w1 + ((size_t)kv * 4096 + 64 * j) * 128;
#pragma unroll 8
        for (int d = 0; d < 64; ++d) { const float p = pp[d]; a0 += p * wp[d * 128 + lane]; a1 += p * wp[d * 128 + 64 + lane]; }
        PART[(size_t)it * 128 + lane] = a0; PART[(size_t)it * 128 + 64 + lane] = a1; }
}
__device__ __forceinline__ void cmp_bias_reduce(unsigned char* ws, int vcu, int tid) {
    if (vcu != 0 || tid >= 256) return;
    const float* PART = (const float*)(ws + WS_CPART); float* BIAS = (float*)(ws + WS_CBIAS); const int kv = tid >> 7, n = tid & 127; float a = 0.f;
    for (int j = 0; j < 64; ++j) a += PART[((size_t)kv * 64 + j) * 128 + n];
    BIAS[tid] = a;
}
struct CmpSrc { const float* kbase; const float* vbase; const int* page_table; int seq0, nseq, cpu; };
__device__ __forceinline__ const float* cmp_chunk_base(const CmpSrc& S, int kv, int cid) {
    const int sq = cid >> 7, nb = cid & 127; const float* base = kv ? S.vbase : S.kbase;
    if (S.page_table) { const int pg = S.page_table[sq * NPAGE + (nb >> 1)]; return base + ((size_t)pg * 128 + (nb & 1) * 64) * KVW; }
    return base + ((size_t)sq * SEQ + nb * 64) * KVW;
}
__device__ __forceinline__ void compress_phase(const In& I, unsigned char* ws, LAS unsigned char* lds, const CmpSrc& S, int vcu, int G) {
    int tid_ = threadIdx.x; asm volatile("" : "+v"(tid_));
    const int tid = tid_, wave = __builtin_amdgcn_readfirstlane(tid >> 6), lane = tid & 63, fr = lane & 15, fq = lane >> 4, wm = wave >> 2, wn = wave & 3;
    const int cpu = S.cpu, upk = S.nseq * 128 / cpu, nunits = 2 * upk;
    int nmine = 0; for (int u = vcu; u < nunits; u += G) ++nmine;
    if (nmine == 0) return;
    const int total = nmine * 64;
    const bf16* W1T = (const bf16*)(ws + WS_W1T); const bf16* W2T = (const bf16*)(ws + WS_W2T);
    LAS float* BIAS = (LAS float*)(lds + CMP_RED_OFF + 1024);
    if (tid < 256) { const float* PART = (const float*)(ws + WS_CPART); const int kv = tid >> 7, n = tid & 127; float a = 0.f;
#pragma unroll 8
        for (int j = 0; j < 64; ++j) a += PART[((size_t)kv * 64 + j) * 128 + n];
        BIAS[tid] = a; }
    asm volatile("s_waitcnt vmcnt(0) lgkmcnt(0)" ::: "memory"); __builtin_amdgcn_s_barrier(); asm volatile("" ::: "memory");
    unsigned aoffs[2];
#pragma unroll
    for (int i = 0; i < 2; ++i) { const int c = 2 * wave + i, r = 4 * c + (lane >> 4); aoffs[i] = (unsigned)((lane >> 4) * 256 + (((lane & 15) ^ (r & 15)) * 16)); }
    unsigned boffs[2];
#pragma unroll
    for (int i = 0; i < 2; ++i) { int R, C; pg8::stage_rc(tid * 16 + i * 8192, R, C); boffs[i] = (unsigned)(R * 4096 + C) * 2u; }
#define CMP_ISSUE_A(gs_) do { const int ui_ = (gs_) >> 6, j_ = (gs_) & 63, u_ = vcu + ui_ * G, kv_ = u_ >= upk ? 1 : 0, ul_ = u_ - kv_ * upk; \
        LAS unsigned char* st_ = lds + ((gs_) % CMP_NA) * 16384; \
        if (j_ == 0) { cb0 = cmp_chunk_base(S, kv_, ul_ * cpu + (2 * wave < cpu ? 2 * wave : 0)); cb1 = cmp_chunk_base(S, kv_, ul_ * cpu + (2 * wave + 1 < cpu ? 2 * wave + 1 : 0)); }     \
        if (S.page_table) { glds16_nt((const char*)cb0 + (size_t)j_ * 1024 + aoffs[0], lds_addr(st_ + (2 * wave) * 1024)); glds16_nt((const char*)cb1 + (size_t)j_ * 1024 + aoffs[1], lds_addr(st_ + (2 * wave + 1) * 1024)); } \
        else { glds16((const char*)cb0 + (size_t)j_ * 1024 + aoffs[0], lds_addr(st_ + (2 * wave) * 1024)); glds16((const char*)cb1 + (size_t)j_ * 1024 + aoffs[1], lds_addr(st_ + (2 * wave + 1) * 1024)); } } while (0)
#define CMP_ISSUE_B(gs_) do { const int ui_ = (gs_) >> 6, j_ = (gs_) & 63, u_ = vcu + ui_ * G, kv_ = u_ >= upk ? 1 : 0; \
        LAS unsigned char* st_ = lds + CMP_BOFF + ((gs_) % CMP_NB) * 16384; const char* wb_ = (const char*)(W1T + (size_t)kv_ * 128 * 4096) + j_ * 128; \
        _Pragma("unroll") for (int i_ = 0; i_ < 2; ++i_) glds16(wb_ + boffs[i_], lds_addr(st_ + wave * 1024 + i_ * 8192)); } while (0)
    f32x4 acc[2][2];
#pragma unroll
    for (int a = 0; a < 2; ++a)
#pragma unroll
        for (int b = 0; b < 2; ++b) acc[a][b] = (f32x4){0.f, 0.f, 0.f, 0.f};
    const float* cb0 = nullptr; const float* cb1 = nullptr;
    CMP_ISSUE_A(0); CMP_ISSUE_A(1); CMP_ISSUE_B(0); CMP_ISSUE_A(2); CMP_ISSUE_B(1); CMP_ISSUE_A(3);
    for (int gs = 0; gs < total; ++gs) {
        if (gs + 3 < total) asm volatile("s_waitcnt vmcnt(4)" ::: "memory"); else if (gs + 1 < total) asm volatile("s_waitcnt vmcnt(2)" ::: "memory"); else asm volatile("s_waitcnt vmcnt(0)" ::: "memory");
        __builtin_amdgcn_s_barrier(); asm volatile("" ::: "memory");
        if (gs + 4 < total) CMP_ISSUE_A(gs + 4);
        if (gs + 2 < total) CMP_ISSUE_B(gs + 2);
        const LAS unsigned char* st = lds + (gs % CMP_NA) * 16384; const LAS unsigned char* stb = lds + CMP_BOFF + (gs % CMP_NB) * 16384;
#pragma unroll
        for (int ks = 0; ks < 2; ++ks) {
            bf16x8 xa[2], wb[2];
#pragma unroll
            for (int rb = 0; rb < 2; ++rb) { const int row = 32 * wm + 16 * rb + fr, ch = 8 * ks + 2 * fq;
                const f32x4 lo = *(const LAS f32x4*)(st + row * 256 + ((ch ^ (row & 15)) * 16)), hi = *(const LAS f32x4*)(st + row * 256 + (((ch + 1) ^ (row & 15)) * 16));
                v4u w; w.x = pk2(lo[0], lo[1]); w.y = pk2(lo[2], lo[3]); w.z = pk2(hi[0], hi[1]); w.w = pk2(hi[2], hi[3]); xa[rb] = __builtin_bit_cast(bf16x8, w); }
#pragma unroll
            for (int cb = 0; cb < 2; ++cb) wb[cb] = *(const LAS bf16x8*)(stb + pg8::lds_byte(32 * wn + 16 * cb + fr, 32 * ks + 8 * fq));
#pragma unroll
            for (int cb = 0; cb < 2; ++cb)
#pragma unroll
                for (int rb = 0; rb < 2; ++rb) acc[cb][rb] = __builtin_amdgcn_mfma_f32_16x16x32_bf16(wb[cb], xa[rb], acc[cb][rb], 0, 0, 0);
        }
        if ((gs & 63) == 63) {
            const int ui = gs >> 6, u = vcu + ui * G, kv = u >= upk ? 1 : 0, ul = u - kv * upk;
            LAS unsigned char* hid = lds + CMP_BOFF + (gs % CMP_NB) * 16384; LAS float* red = (LAS float*)(lds + CMP_RED_OFF);
            asm volatile("s_waitcnt lgkmcnt(0)" ::: "memory"); __builtin_amdgcn_s_barrier(); asm volatile("" ::: "memory");
#pragma unroll
            for (int cb = 0; cb < 2; ++cb) { const int n0 = 32 * wn + 16 * cb + 4 * fq; const f32x4 bv = *(const LAS f32x4*)(BIAS + kv * 128 + n0);
#pragma unroll
                for (int rb = 0; rb < 2; ++rb) { const int row = 32 * wm + 16 * rb + fr; float h[4];
#pragma unroll
                    for (int e = 0; e < 4; ++e) { const float x = acc[cb][rb][e] + bv[e]; const float t = 0.7978845608028654f * (x + 0.044715f * x * x * x); h[e] = x * sigmoidf_(2.f * t); acc[cb][rb][e] = 0.f; }
                    v2u w; w.x = pk2(h[0], h[1]); w.y = pk2(h[2], h[3]);
                    *(LAS v2u*)(hid + row * 256 + (((n0 >> 3) ^ (row & 15)) * 16) + (n0 & 7) * 2) = w; } }
            asm volatile("s_waitcnt lgkmcnt(0)" ::: "memory"); __builtin_amdgcn_s_barrier(); asm volatile("" ::: "memory");
            const int rblk = wave >> 1, oh = wave & 1;
            f32x4 o2[2] = {(f32x4){0.f, 0.f, 0.f, 0.f}, (f32x4){0.f, 0.f, 0.f, 0.f}};
#pragma unroll
            for (int ks = 0; ks < 4; ++ks) { const int row = 16 * rblk + fr, ch = 4 * ks + fq;
                const bf16x8 hb = *(const LAS bf16x8*)(hid + row * 256 + ((ch ^ (row & 15)) * 16));
#pragma unroll
                for (int ob = 0; ob < 2; ++ob) { const bf16x8 wa = *(const bf16x8*)(W2T + ((size_t)kv * 64 + 32 * oh + 16 * ob + fr) * 128 + 32 * ks + 8 * fq);
                    o2[ob] = __builtin_amdgcn_mfma_f32_16x16x32_bf16(wa, hb, o2[ob], 0, 0, 0); } }
            float ssq = 0.f;
#pragma unroll
            for (int ob = 0; ob < 2; ++ob)
#pragma unroll
                for (int e = 0; e < 4; ++e) ssq += o2[ob][e] * o2[ob][e];
            ssq += __shfl_xor(ssq, 16); ssq += __shfl_xor(ssq, 32);
            if (fq == 0) red[(16 * rblk + fr) * 2 + oh] = ssq;
            asm volatile("s_waitcnt lgkmcnt(0)" ::: "memory"); __builtin_amdgcn_s_barrier(); asm volatile("" ::: "memory");
            const int trow = 16 * rblk + fr; const float tot = red[trow * 2] + red[trow * 2 + 1];
            const float rs = kv ? 1.f : __builtin_amdgcn_rsqf(tot * (1.f / 64.f) + RMS_EPS);
            const bool rvalid = (trow >> 2) < cpu; const int cid = ul * cpu + (rvalid ? (trow >> 2) : 0), g = trow & 3, sq = S.seq0 + (cid >> 7), nb = cid & 127;
            bf16* dst = (bf16*)(ws + (kv ? WS_VC : WS_KC)) + (((size_t)sq * 4 + g) * 128 + nb) * 64;
#pragma unroll
            for (int ob = 0; ob < 2; ++ob) { const int o0 = 32 * oh + 16 * ob + 4 * fq; float y[4];
#pragma unroll
                for (int e = 0; e < 4; ++e) y[e] = o2[ob][e] * rs * (kv ? 1.f : I.qk_g[64 + o0 + e]);
                v2u w; w.x = pk2(y[0], y[1]); w.y = pk2(y[2], y[3]); if (rvalid) *(v2u*)(dst + o0) = w; }
        }
    }
    asm volatile("s_waitcnt vmcnt(0) lgkmcnt(0)" ::: "memory"); __builtin_amdgcn_s_barrier(); asm volatile("" ::: "memory");
}

constexpr int AT_IMP = 32768  , AT_OUTS = 65536, AT_SELM = LDSCTL_OFF + 1024;
constexpr int SAT_IMP = LDSCTL_OFF + 1024, SAT_SELM = SAT_IMP + 4 * 132 * 4;
static_assert(SAT_SELM + 4 * 8 * 4 <= LDS_BYTES && AT_SELM + 64 * 16 <= LDS_BYTES && AT_OUTS + 65536 <= RING_BYTES, "attention LDS");
__device__ __forceinline__ s16x4 tr16(const LAS unsigned char* p) { typedef short v4s __attribute__((ext_vector_type(4))); return __builtin_bit_cast(s16x4, __builtin_amdgcn_ds_read_tr16_b64_v4i16((LAS v4s*)p)); }
__device__ __forceinline__ unsigned dpp_max_u32(unsigned v) {
    v = max(v, (unsigned)__builtin_amdgcn_update_dpp(0, (int)v, 0xB1, 0xF, 0xF, true));
    v = max(v, (unsigned)__builtin_amdgcn_update_dpp(0, (int)v, 0x4E, 0xF, 0xF, true));
    v = max(v, (unsigned)__builtin_amdgcn_update_dpp(0, (int)v, 0x141, 0xF, 0xF, true));
    v = max(v, (unsigned)__builtin_amdgcn_update_dpp(0, (int)v, 0x140, 0xF, 0xF, true));
    const unsigned a = __builtin_amdgcn_readlane((int)v, 0), b = __builtin_amdgcn_readlane((int)v, 16), c = __builtin_amdgcn_readlane((int)v, 32), d = __builtin_amdgcn_readlane((int)v, 48);
    return max(max(a, b), max(c, d));
}
__device__ __forceinline__ void stage_block_dma(LAS unsigned char* dst, const bf16* src_row0, int pitch_bytes, int wave, int lane) {
    const int row = 8 * wave + (lane >> 3), chunk = (lane & 7) ^ (lane >> 3);
    glds16((const char*)src_row0 + (size_t)row * pitch_bytes + chunk * 16, lds_addr(dst + wave * 1024));
}
__device__ __forceinline__ void kfrags(bf16x8 (&kf)[4][2], const LAS unsigned char* kb, int fr, int fq) {
#pragma unroll
    for (int k = 0; k < 4; ++k)
#pragma unroll
        for (int ks = 0; ks < 2; ++ks) kf[k][ks] = *(const LAS bf16x8*)(kb + (16 * k + fr) * 128 + (((4 * ks + fq) ^ (fr & 7)) * 16));
}
__device__ __forceinline__ bf16x8 pack_p(const f32x4& a, const f32x4& b) { v4u w; w.x = pk2(a[0], a[1]); w.y = pk2(a[2], a[3]); w.z = pk2(b[0], b[1]); w.w = pk2(b[2], b[3]); return __builtin_bit_cast(bf16x8, w); }
template <bool do0, bool do1>
__device__ __forceinline__ void pv_block(const LAS unsigned char* vb, const bf16x8 (&p)[2][2], f32x4 (&o)[2][4], int fr, int fq) {
    const int q4 = fr >> 2, pp = fr & 3, kk = 4 * (fq & 1) + q4;
    const LAS unsigned char* vrow = vb + (4 * fq + q4) * 128 + (pp & 1) * 8;
#pragma unroll
    for (int db = 0; db < 4; ++db) { const int xo = (((2 * db + (pp >> 1)) ^ kk) * 16);
#pragma unroll
        for (int st = 0; st < 2; ++st) {
            const s16x4 lo4 = tr16(vrow + (32 * st) * 128 + xo), hi4 = tr16(vrow + (32 * st + 16) * 128 + xo);
            const bf16x8 vf = (bf16x8){lo4[0], lo4[1], lo4[2], lo4[3], hi4[0], hi4[1], hi4[2], hi4[3]};
            if (do0) o[0][db] = __builtin_amdgcn_mfma_f32_16x16x32_bf16(vf, p[0][st], o[0][db], 0, 0, 0);
            if (do1) o[1][db] = __builtin_amdgcn_mfma_f32_16x16x32_bf16(vf, p[1][st], o[1][db], 0, 0, 0); } }
}
template <bool EDGE, bool do0, bool do1>
__device__ __forceinline__ void attn_block_t(const LAS unsigned char* kb, const LAS unsigned char* vb, const bf16x8 (&q)[2][2], const float (&bias)[2], const int (&lo)[2], const int (&hi)[2],
                                           f32x4 (&o)[2][4], float (&l)[2], int fr, int fq) {
    bf16x8 kf[4][2]; kfrags(kf, kb, fr, fq);
    f32x4 sc[2][4];
#pragma unroll
    for (int s = 0; s < 2; ++s) if (s ? do1 : do0) {
#pragma unroll
        for (int k = 0; k < 4; ++k) sc[s][k] = __builtin_amdgcn_mfma_f32_16x16x32_bf16(kf[k][0], q[s][0], (f32x4){bias[s], bias[s], bias[s], bias[s]}, 0, 0, 0); }
#pragma unroll
    for (int s = 0; s < 2; ++s) if (s ? do1 : do0) {
#pragma unroll
        for (int k = 0; k < 4; ++k) sc[s][k] = __builtin_amdgcn_mfma_f32_16x16x32_bf16(kf[k][1], q[s][1], sc[s][k], 0, 0, 0); }
    __builtin_amdgcn_sched_barrier(0);
    bf16x8 vf[4][2];
    { const int q4 = fr >> 2, pp = fr & 3, kk = 4 * (fq & 1) + q4; const LAS unsigned char* vrow = vb + (4 * fq + q4) * 128 + (pp & 1) * 8;
#pragma unroll
      for (int db = 0; db < 4; ++db) { const int xo = (((2 * db + (pp >> 1)) ^ kk) * 16);
#pragma unroll
          for (int st = 0; st < 2; ++st) { const s16x4 lo4 = tr16(vrow + (32 * st) * 128 + xo), hi4 = tr16(vrow + (32 * st + 16) * 128 + xo);
              vf[db][st] = (bf16x8){lo4[0], lo4[1], lo4[2], lo4[3], hi4[0], hi4[1], hi4[2], hi4[3]}; } } }
    __builtin_amdgcn_sched_barrier(0);
    bf16x8 p[2][2];
#pragma unroll
    for (int s = 0; s < 2; ++s) if (s ? do1 : do0) { float ls = 0.f;
#pragma unroll
        for (int k = 0; k < 4; ++k)
#pragma unroll
            for (int e = 0; e < 4; ++e) { float v = sc[s][k][e]; if (EDGE) { const int key = 16 * k + 4 * fq + e; if (key < lo[s] || key > hi[s]) v = -INFINITY; } v = fast_exp2(v); sc[s][k][e] = v; ls += v; }
        l[s] += ls; p[s][0] = pack_p(sc[s][0], sc[s][1]); p[s][1] = pack_p(sc[s][2], sc[s][3]); }
    __builtin_amdgcn_sched_barrier(0);
#pragma unroll
    for (int st = 0; st < 2; ++st)
#pragma unroll
        for (int db = 0; db < 4; ++db) {
            if (do0) o[0][db] = __builtin_amdgcn_mfma_f32_16x16x32_bf16(vf[db][st], p[0][st], o[0][db], 0, 0, 0);
            if (do1) o[1][db] = __builtin_amdgcn_mfma_f32_16x16x32_bf16(vf[db][st], p[1][st], o[1][db], 0, 0, 0); }
}
template <bool EDGE>
__device__ __forceinline__ void attn_block(const LAS unsigned char* kb, const LAS unsigned char* vb, bool do0, bool do1, const bf16x8 (&q)[2][2], const float (&bias)[2], const int (&lo)[2], const int (&hi)[2],
                                           f32x4 (&o)[2][4], float (&l)[2], int fr, int fq) {
    if (do0 && do1) attn_block_t<EDGE, true, true>(kb, vb, q, bias, lo, hi, o, l, fr, fq);
    else if (do0) attn_block_t<EDGE, true, false>(kb, vb, q, bias, lo, hi, o, l, fr, fq);
    else attn_block_t<EDGE, false, true>(kb, vb, q, bias, lo, hi, o, l, fr, fq);
}

__device__ __forceinline__ void attn_prompt_unit(unsigned char* ws, LAS unsigned char* lds, int b, int g, int qb, int wave, int lane_) {
    int lane = lane_; asm volatile("" : "+v"(lane));
    const int fr = lane & 15, fq = lane >> 4, h = fr & 3, tq = fr >> 2;
    const bf16* QN = (const bf16*)(ws + WS_QN); const bf16* QR = (const bf16*)(ws + WS_QR); const float* GATES = (const float*)(ws + WS_GATES); bf16* O = (bf16*)(ws + WS_AC);
    LAS float* IMP = (LAS float*)(lds + AT_IMP); LAS unsigned* SELM = (LAS unsigned*)(lds + AT_SELM);
    const size_t seq0 = (size_t)b * SEQ; const int hc = (g * 4 + h) * 64;
    int itok[2]; size_t row[2];
#pragma unroll
    for (int s = 0; s < 2; ++s) { itok[s] = 8 * wave + 4 * s + tq; row[s] = seq0 + 64 * qb + itok[s]; }
    f32x4 out[2][4];
    {
        const int nblk = (qb + 64) >> 6;
        const bf16* KC = (const bf16*)(ws + WS_KC) + ((size_t)b * 4 + g) * 128 * 64; const bf16* VC = (const bf16*)(ws + WS_VC) + ((size_t)b * 4 + g) * 128 * 64;
        for (int i = 0; i < nblk; ++i) { stage_block_dma(lds + i * 16384, KC + (size_t)i * 64 * 64, 128, wave, lane); stage_block_dma(lds + i * 16384 + 8192, VC + (size_t)i * 64 * 64, 128, wave, lane); }
        asm volatile("s_waitcnt vmcnt(0)" ::: "memory"); __builtin_amdgcn_s_barrier(); asm volatile("" ::: "memory");
#pragma unroll
        for (int s = 0; s < 2; ++s) {
            bf16x8 q[2];
#pragma unroll
            for (int ks = 0; ks < 2; ++ks) q[ks] = *(const bf16x8*)(QN + row[s] * D + hc + 32 * ks + 8 * fq);
            const int nv = qb + (itok[s] == 63 ? 1 : 0);
            f32x4 sc[2][4]; float ls = 0.f;
#pragma unroll
            for (int i = 0; i < 2; ++i) {
                if (i < nblk) { bf16x8 kf[4][2]; kfrags(kf, lds + i * 16384, fr, fq);
#pragma unroll
                    for (int k = 0; k < 4; ++k) { sc[i][k] = (f32x4){0.f, 0.f, 0.f, 0.f};
#pragma unroll
                        for (int ks = 0; ks < 2; ++ks) sc[i][k] = __builtin_amdgcn_mfma_f32_16x16x32_bf16(kf[k][ks], q[ks], sc[i][k], 0, 0, 0);
#pragma unroll
                        for (int e = 0; e < 4; ++e) { const int key = 64 * i + 16 * k + 4 * fq + e; const float v = key < nv ? fast_exp2(sc[i][k][e]) : 0.f; sc[i][k][e] = v; ls += v; } }
                } else {
#pragma unroll
                    for (int k = 0; k < 4; ++k) sc[i][k] = (f32x4){0.f, 0.f, 0.f, 0.f}; } }
            ls += __shfl_xor(ls, 16); ls += __shfl_xor(ls, 32);
            const float inv = ls > 0.f ? 1.f / ls : 0.f;
            f32x4 oc[2][4];
#pragma unroll
            for (int d = 0; d < 4; ++d) { oc[0][d] = (f32x4){0.f, 0.f, 0.f, 0.f}; oc[1][d] = oc[0][d]; }
#pragma unroll
            for (int i = 0; i < 2; ++i) if (i < nblk) {
#pragma unroll
                for (int k = 0; k < 4; ++k) { f32x4 pn = sc[i][k] * inv;
#pragma unroll
                    for (int e = 0; e < 4; ++e) { float t = pn[e]; t += __shfl_xor(t, 1); t += __shfl_xor(t, 2); pn[e] = t; }
                    if (h == 0) *(LAS f32x4*)(IMP + itok[s] * 128 + 64 * i + 16 * k + 4 * fq) = pn; }
                bf16x8 p[2][2]; p[0][0] = pack_p(sc[i][0], sc[i][1]); p[0][1] = pack_p(sc[i][2], sc[i][3]); p[1][0] = p[0][0]; p[1][1] = p[0][1];
                pv_block<true, false>(lds + i * 16384 + 8192, p, oc, fr, fq); }
            const float gc = GATES[row[s] * 48 + (g * 4 + h) * 3 + 0] * inv;
#pragma unroll
            for (int d = 0; d < 4; ++d)
#pragma unroll
                for (int e = 0; e < 4; ++e) out[s][d][e] = oc[0][d][e] * gc;
        }
    }
    asm volatile("; MARK_TOPK");
    unsigned long long un_lo[2] = {0ull, 0ull}, un_hi[2] = {0ull, 0ull};
    asm volatile("s_waitcnt lgkmcnt(0)" ::: "memory");
#pragma unroll
    for (int pass = 0; pass < 2; ++pass) { const int c = lane & 15, tok = 8 * wave + 4 * pass + (lane >> 4);
        unsigned w0, w1 = 0u, w2 = 0u, w3 = 0u;
        if (qb <= 15) w0 = (2u << qb) - 1u;
        else {
            unsigned key[8];
#pragma unroll
            for (int j = 0; j < 8; ++j) { const int n = c + 16 * j; const float v = IMP[tok * 128 + n]; key[j] = (n >= 1 && n <= qb - 2) ? ((__float_as_uint(v) & ~127u) | (unsigned)(127 - n)) : 0u; }
            unsigned thr = 0xFFFFFFFFu;
#pragma unroll 1
            for (int r = 0; r < 13; ++r) { unsigned m = 0u;
#pragma unroll
                for (int j = 0; j < 8; ++j) m = max(m, key[j] < thr ? key[j] : 0u);
                m = max(m, (unsigned)__builtin_amdgcn_update_dpp(0, (int)m, 0xB1, 0xF, 0xF, true)); m = max(m, (unsigned)__builtin_amdgcn_update_dpp(0, (int)m, 0x4E, 0xF, 0xF, true));
                m = max(m, (unsigned)__builtin_amdgcn_update_dpp(0, (int)m, 0x141, 0xF, 0xF, true)); m = max(m, (unsigned)__builtin_amdgcn_update_dpp(0, (int)m, 0x140, 0xF, 0xF, true));
                thr = m; }
            unsigned b[4] = {0u, 0u, 0u, 0u};
#pragma unroll
            for (int j = 0; j < 8; ++j) b[j >> 1] |= (key[j] >= thr ? 1u : 0u) << (c + 16 * (j & 1));
#pragma unroll
            for (int w = 0; w < 4; ++w) { unsigned x = b[w];
                x |= (unsigned)__builtin_amdgcn_update_dpp(0, (int)x, 0xB1, 0xF, 0xF, true); x |= (unsigned)__builtin_amdgcn_update_dpp(0, (int)x, 0x4E, 0xF, 0xF, true);
                x |= (unsigned)__builtin_amdgcn_update_dpp(0, (int)x, 0x141, 0xF, 0xF, true); x |= (unsigned)__builtin_amdgcn_update_dpp(0, (int)x, 0x140, 0xF, 0xF, true); b[w] = x; }
            const unsigned long long flo = 1ull | (qb - 1 < 64 ? 1ull << (qb - 1) : 0ull) | (qb < 64 ? 1ull << qb : 0ull), fhi = (qb - 1 >= 64 ? 1ull << (qb - 65) : 0ull) | (qb >= 64 ? 1ull << (qb - 64) : 0ull);
            w0 = b[0] | (unsigned)flo; w1 = b[1] | (unsigned)(flo >> 32); w2 = b[2] | (unsigned)fhi; w3 = b[3] | (unsigned)(fhi >> 32);
        }
        if (c == 0) { SELM[tok * 4 + 0] = w0; SELM[tok * 4 + 1] = w1; SELM[tok * 4 + 2] = w2; SELM[tok * 4 + 3] = w3; }
        const unsigned u0 = __builtin_amdgcn_readlane((int)w0, 0) | __builtin_amdgcn_readlane((int)w0, 16) | __builtin_amdgcn_readlane((int)w0, 32) | __builtin_amdgcn_readlane((int)w0, 48);
        const unsigned u1 = __builtin_amdgcn_readlane((int)w1, 0) | __builtin_amdgcn_readlane((int)w1, 16) | __builtin_amdgcn_readlane((int)w1, 32) | __builtin_amdgcn_readlane((int)w1, 48);
        const unsigned u2 = __builtin_amdgcn_readlane((int)w2, 0) | __builtin_amdgcn_readlane((int)w2, 16) | __builtin_amdgcn_readlane((int)w2, 32) | __builtin_amdgcn_readlane((int)w2, 48);
        const unsigned u3 = __builtin_amdgcn_readlane((int)w3, 0) | __builtin_amdgcn_readlane((int)w3, 16) | __builtin_amdgcn_readlane((int)w3, 32) | __builtin_amdgcn_readlane((int)w3, 48);
        un_lo[pass] = (unsigned long long)u0 | ((unsigned long long)u1 << 32); un_hi[pass] = (unsigned long long)u2 | ((unsigned long long)u3 << 32);
    }
    asm volatile("s_waitcnt lgkmcnt(0)" ::: "memory");
    bf16x8 qr[2][2];
#pragma unroll
    for (int s = 0; s < 2; ++s)
#pragma unroll
        for (int ks = 0; ks < 2; ++ks) qr[s][ks] = *(const bf16x8*)(QR + row[s] * D + hc + 32 * ks + 8 * fq);
    float gsel[2], gwin[2];
#pragma unroll
    for (int s = 0; s < 2; ++s) { gsel[s] = GATES[row[s] * 48 + (g * 4 + h) * 3 + 1]; gwin[s] = GATES[row[s] * 48 + (g * 4 + h) * 3 + 2]; }
    asm volatile("; MARK_SEL");
    {
        const bf16* KS = (const bf16*)(ws + WS_KS) + seq0 * KVW + g * 64; const bf16* VS = (const bf16*)(ws + WS_VS) + seq0 * KVW + g * 64;
        const bf16* KW = (const bf16*)(ws + WS_KW) + seq0 * KVW + g * 64; const bf16* VW = (const bf16*)(ws + WS_VW) + seq0 * KVW + g * 64;
        const int nsel = qb + 1, n0w = qb >= 8 ? qb - 8 : 0, nit = nsel + (qb - n0w + 1);
#define AT_ISSUE(it_) do { const int it__ = (it_); const bool w__ = it__ >= nsel; const int n__ = w__ ? n0w + (it__ - nsel) : it__; LAS unsigned char* st__ = lds + (it__ & 7) * 16384; \
            stage_block_dma(st__, (w__ ? KW : KS) + (size_t)n__ * 64 * KVW, KVW * 2, wave, lane); stage_block_dma(st__ + 8192, (w__ ? VW : VS) + (size_t)n__ * 64 * KVW, KVW * 2, wave, lane); } while (0)
#define AT_FOLD(gt_) do { _Pragma("unroll") for (int s = 0; s < 2; ++s) { float ls = la[s]; ls += __shfl_xor(ls, 16); ls += __shfl_xor(ls, 32); const float gs = gt_[s] * (ls > 0.f ? 1.f / ls : 0.f); la[s] = 0.f; \
            _Pragma("unroll") for (int d = 0; d < 4; ++d) { out[s][d] += oa[s][d] * gs; oa[s][d] = (f32x4){0.f, 0.f, 0.f, 0.f}; } } } while (0)
        f32x4 oa[2][4]; float la[2] = {0.f, 0.f};
#pragma unroll
        for (int s = 0; s < 2; ++s)
#pragma unroll
            for (int d = 0; d < 4; ++d) oa[s][d] = (f32x4){0.f, 0.f, 0.f, 0.f};
        asm volatile("" : "+v"(qr[0][0]), "+v"(qr[0][1]), "+v"(qr[1][0]), "+v"(qr[1][1]), "+v"(gsel[0]), "+v"(gsel[1]), "+v"(gwin[0]), "+v"(gwin[1]));
        asm volatile("s_waitcnt vmcnt(0)" ::: "memory"); __builtin_amdgcn_s_barrier(); asm volatile("" ::: "memory");
        AT_ISSUE(0); AT_ISSUE(1); if (nit > 2) AT_ISSUE(2); if (nit > 3) AT_ISSUE(3);
        const int fr0_ = fr, fq0_ = fq;
#define AT_STEP(it_) do { if (((it_) & 3) == 0) { asm volatile("s_waitcnt vmcnt(0)" ::: "memory"); __builtin_amdgcn_s_barrier(); asm volatile("" ::: "memory"); \
            _Pragma("unroll") for (int j = 4; j < 8; ++j) if ((it_) + j < nit) AT_ISSUE((it_) + j); } } while (0)
#pragma unroll 1
        for (int it = 0; it < nsel; ++it) {
            AT_STEP(it);
            int fr = fr0_, fq = fq0_; asm volatile("" : "+v"(fr), "+v"(fq));
            const LAS unsigned char* st = lds + (it & 7) * 16384; const int n = it;
            const bool do0 = ((n < 64 ? un_lo[0] >> n : un_hi[0] >> (n - 64)) & 1ull) != 0ull, do1 = ((n < 64 ? un_lo[1] >> n : un_hi[1] >> (n - 64)) & 1ull) != 0ull;
            if (do0 || do1) { float bias[2]; const int lo[2] = {0, 0}, hi[2] = {itok[0], itok[1]};
#pragma unroll
                for (int s = 0; s < 2; ++s) { const unsigned wd = SELM[itok[s] * 4 + (n >> 5)]; bias[s] = ((wd >> (n & 31)) & 1u) ? 0.f : -INFINITY; }
                if (n == qb) attn_block<true>(st, st + 8192, do0, do1, qr, bias, lo, hi, oa, la, fr, fq);
                else attn_block<false>(st, st + 8192, do0, do1, qr, bias, lo, hi, oa, la, fr, fq); }
        }
        AT_FOLD(gsel);
#pragma unroll 1
        for (int it = nsel; it < nit; ++it) {
            AT_STEP(it);
            int fr = fr0_, fq = fq0_; asm volatile("" : "+v"(fr), "+v"(fq));
            const LAS unsigned char* st = lds + (it & 7) * 16384; const int n = n0w + (it - nsel); const float bias[2] = {0.f, 0.f};
            if (n == qb || n == qb - 8) { int lo[2], hi[2];
#pragma unroll
                for (int s = 0; s < 2; ++s) { lo[s] = (n == qb - 8) ? itok[s] + 1 : 0; hi[s] = (n == qb) ? itok[s] : 63; }
                attn_block<true>(st, st + 8192, true, true, qr, bias, lo, hi, oa, la, fr, fq);
            } else { const int lo[2] = {0, 0}, hi[2] = {63, 63}; attn_block<false>(st, st + 8192, true, true, qr, bias, lo, hi, oa, la, fr, fq); }
        }
#undef AT_STEP
#pragma unroll
        for (int s = 0; s < 2; ++s) { float ls = la[s]; ls += __shfl_xor(ls, 16); ls += __shfl_xor(ls, 32); const float gw = gwin[s] * (ls > 0.f ? 1.f / ls : 0.f);
#pragma unroll
            for (int d = 0; d < 4; ++d) { float y[4];
#pragma unroll
                for (int e = 0; e < 4; ++e) y[e] = out[s][d][e] + oa[s][d][e] * gw;
                v2u w; w.x = pk2(y[0], y[1]); w.y = pk2(y[2], y[3]); *(v2u*)(O + row[s] * D + hc + 16 * d + 4 * fq) = w; } }
#undef AT_ISSUE
#undef AT_FOLD
    }
    asm volatile("s_waitcnt lgkmcnt(0)" ::: "memory"); __builtin_amdgcn_s_barrier(); asm volatile("" ::: "memory");
}

__device__ __forceinline__ void stage_f32_rows(LAS unsigned char* dst, const float* src_row0  , int lane) {
#pragma unroll
    for (int half = 0; half < 2; ++half) { f32x4 v[8];
#pragma unroll
        for (int k = 0; k < 8; ++k) { const int r = 32 * half + 4 * k + (lane >> 4); v[k] = __builtin_nontemporal_load((const f32x4*)(src_row0 + (size_t)r * KVW + 4 * (lane & 15))); }
#pragma unroll
        for (int k = 0; k < 8; ++k) { const int r = 32 * half + 4 * k + (lane >> 4), c16 = (lane & 15) >> 1; v2u w; w.x = pk2(v[k][0], v[k][1]); w.y = pk2(v[k][2], v[k][3]);
            *(LAS v2u*)(dst + r * 128 + ((c16 ^ (r & 7)) * 16) + (lane & 1) * 8) = w; } }
}
__device__ __forceinline__ void stage_bf16_rows(LAS unsigned char* dst, const bf16* src_row0, int pitch, int nvalid, int lane) {
#pragma unroll
    for (int k = 0; k < 8; ++k) { const int r = 8 * k + (lane >> 3), c = lane & 7; v4u w = (v4u){0u, 0u, 0u, 0u};
        if (r < nvalid) w = *(const v4u*)(src_row0 + (size_t)r * pitch + 8 * c);
        *(LAS v4u*)(dst + r * 128 + ((c ^ (r & 7)) * 16)) = w; }
}
__device__ __forceinline__ void attn_sample_unit(const In& I, unsigned char* ws, LAS unsigned char* lds, int bs, int g, int half, int wave, int lane_) {
    int lane = lane_; asm volatile("" : "+v"(lane));
    const int fr = lane & 15, fq = lane >> 4, h = fr & 3, tq = fr >> 2;
    const bf16* QN = (const bf16*)(ws + WS_QN); const bf16* QR = (const bf16*)(ws + WS_QR); const float* GATES = (const float*)(ws + WS_GATES); bf16* O = (bf16*)(ws + WS_AC);
    LAS float* IMP = (LAS float*)(lds + SAT_IMP); LAS unsigned* SELM = (LAS unsigned*)(lds + SAT_SELM);
    LAS unsigned char* my = lds + wave * 16384;
    const size_t row = (size_t)MP + 4 * bs + tq; const int hc = (g * 4 + h) * 64; const bool mine = (tq >> 1) == half; const float rowbias = mine ? 0.f : -INFINITY;
    f32x4 acc[2][4]; float lsum[2] = {0.f, 0.f};
    f32x4 oc[2][4]; float lc = 0.f;
#pragma unroll
    for (int d = 0; d < 4; ++d) { acc[0][d] = (f32x4){0.f, 0.f, 0.f, 0.f}; acc[1][d] = acc[0][d]; oc[0][d] = acc[0][d]; oc[1][d] = acc[0][d]; }
    if (wave == 0) {
        const bf16* KC = (const bf16*)(ws + WS_KC) + ((size_t)(2 + bs) * 4 + g) * 128 * 64; const bf16* VC = (const bf16*)(ws + WS_VC) + ((size_t)(2 + bs) * 4 + g) * 128 * 64;
        bf16x8 q[2];
#pragma unroll
        for (int ks = 0; ks < 2; ++ks) q[ks] = *(const bf16x8*)(QN + row * D + hc + 32 * ks + 8 * fq);
        f32x4 sc[2][4];
#pragma unroll 1
        for (int i = 0; i < 2; ++i) {
            stage_bf16_rows(my, KC + (size_t)i * 64 * 64, 64, 64, lane); stage_bf16_rows(my + 8192, VC + (size_t)i * 64 * 64, 64, 64, lane);
            asm volatile("s_waitcnt lgkmcnt(0)" ::: "memory");
            bf16x8 kf[4][2]; kfrags(kf, my, fr, fq);
            f32x4 t[4];
#pragma unroll
            for (int k = 0; k < 4; ++k) { t[k] = (f32x4){0.f, 0.f, 0.f, 0.f};
#pragma unroll
                for (int ks = 0; ks < 2; ++ks) t[k] = __builtin_amdgcn_mfma_f32_16x16x32_bf16(kf[k][ks], q[ks], t[k], 0, 0, 0);
#pragma unroll
                for (int e = 0; e < 4; ++e) { t[k][e] = fast_exp2(t[k][e]); lc += t[k][e]; } }
            bf16x8 p[2][2]; p[0][0] = pack_p(t[0], t[1]); p[0][1] = pack_p(t[2], t[3]); p[1][0] = p[0][0]; p[1][1] = p[0][1];
            pv_block<true, false>(my + 8192, p, oc, fr, fq);
            asm volatile("s_waitcnt lgkmcnt(0)" ::: "memory");
#pragma unroll
            for (int k = 0; k < 4; ++k) { if (i == 0) sc[0][k] = t[k]; else sc[1][k] = t[k]; }
        }
        lc += __shfl_xor(lc, 16); lc += __shfl_xor(lc, 32);
        const float inv = 1.f / lc;
#pragma unroll
        for (int i = 0; i < 2; ++i)
#pragma unroll
            for (int k = 0; k < 4; ++k) { f32x4 pn = sc[i][k] * inv;
#pragma unroll
                for (int e = 0; e < 4; ++e) { float t = pn[e]; t += __shfl_xor(t, 1); t += __shfl_xor(t, 2); pn[e] = t; }
                if (h == 0) *(LAS f32x4*)(IMP + tq * 132 + 64 * i + 16 * k + 4 * fq) = pn; }
    }
    asm volatile("s_waitcnt lgkmcnt(0)" ::: "memory"); __builtin_amdgcn_s_barrier(); asm volatile("" ::: "memory");
    if (wave < 4) {
        const float v0 = IMP[wave * 132 + lane], v1 = IMP[wave * 132 + 64 + lane];
        unsigned u0 = (lane >= 1) ? __float_as_uint(v0) : 0u, u1 = (lane + 64 <= 126) ? __float_as_uint(v1) : 0u;
        unsigned long long mlo = 1ull, mhi = 1ull << 63;
#pragma unroll 1
        for (int r = 0; r < 13; ++r) { const unsigned m = dpp_max_u32(max(u0, u1));
            const unsigned long long b0 = __ballot(u0 == m);
            if (b0) { const int idx = __builtin_ctzll(b0); mlo |= 1ull << idx; if (lane == idx) u0 = 0u; }
            else { const unsigned long long b1 = __ballot(u1 == m); const int idx = __builtin_ctzll(b1); mhi |= 1ull << idx; if (lane == idx) u1 = 0u; } }
        if (lane == 0) { SELM[wave * 8 + 0] = (unsigned)mlo; SELM[wave * 8 + 1] = (unsigned)(mlo >> 32); SELM[wave * 8 + 2] = (unsigned)mhi; SELM[wave * 8 + 3] = (unsigned)(mhi >> 32); }
    }
    asm volatile("s_waitcnt lgkmcnt(0)" ::: "memory"); __builtin_amdgcn_s_barrier(); asm volatile("" ::: "memory");
    unsigned selw[4];
#pragma unroll
    for (int w = 0; w < 4; ++w) selw[w] = SELM[tq * 8 + w];
    unsigned long long un_lo = 0ull, un_hi = 0ull;
#pragma unroll
    for (int t = 2 * half; t < 2 * half + 2; ++t) { un_lo |= (unsigned long long)SELM[t * 8 + 0] | ((unsigned long long)SELM[t * 8 + 1] << 32); un_hi |= (unsigned long long)SELM[t * 8 + 2] | ((unsigned long long)SELM[t * 8 + 3] << 32); }
    un_lo = ((unsigned long long)__builtin_amdgcn_readfirstlane((unsigned)(un_lo >> 32)) << 32) | (unsigned)__builtin_amdgcn_readfirstlane((unsigned)un_lo);
    un_hi = ((unsigned long long)__builtin_amdgcn_readfirstlane((unsigned)(un_hi >> 32)) << 32) | (unsigned)__builtin_amdgcn_readfirstlane((unsigned)un_hi);
    bf16x8 qr[2][2];
#pragma unroll
    for (int ks = 0; ks < 2; ++ks) { qr[0][ks] = *(const bf16x8*)(QR + row * D + hc + 32 * ks + 8 * fq); qr[1][ks] = qr[0][ks]; }
    int cnt = 0;
    { const int* pt = I.page_table + bs * NPAGE;
#pragma unroll 1
      for (int n = 0; n < 128; ++n) { const bool on = ((n < 64 ? un_lo >> n : un_hi >> (n - 64)) & 1ull) != 0ull; if (!on) continue;
          if ((cnt++ & 7) != wave) continue;
          const int pg = pt[n >> 1]; const size_t ro = ((size_t)pg * 128 + (n & 1) * 64) * KVW + g * 64;
          stage_f32_rows(my, I.ck_sel + ro, lane); stage_f32_rows(my + 8192, I.cv_sel + ro, lane);
          asm volatile("s_waitcnt lgkmcnt(0)" ::: "memory");
          const int wi = n >> 5; const unsigned wd = wi == 0 ? selw[0] : (wi == 1 ? selw[1] : (wi == 2 ? selw[2] : selw[3]));
          const float bias[2] = {((wd >> (n & 31)) & 1u) ? rowbias : -INFINITY, 0.f}; const int lo[2] = {0, 0}, hi[2] = {63, 63};
          attn_block<false>(my, my + 8192, true, false, qr, bias, lo, hi, acc, lsum, fr, fq);
          asm volatile("s_waitcnt lgkmcnt(0)" ::: "memory"); } }
#pragma unroll 1
    for (int wb = 0; wb < 8; ++wb) { if ((cnt++ & 7) != wave) continue;
        const size_t ro = ((size_t)bs * 512 + 64 * wb) * KVW + g * 64;
        stage_f32_rows(my, I.ck_win + ro, lane); stage_f32_rows(my + 8192, I.cv_win + ro, lane);
        asm volatile("s_waitcnt lgkmcnt(0)" ::: "memory");
        const float bias[2] = {0.f, rowbias}; const int lo[2] = {0, wb == 0 ? tq + 1 : 0}, hi[2] = {63, 63};
        attn_block<true>(my, my + 8192, false, true, qr, bias, lo, hi, acc, lsum, fr, fq);
        asm volatile("s_waitcnt lgkmcnt(0)" ::: "memory"); }
    if ((cnt++ & 7) == wave) {
        stage_bf16_rows(my, (const bf16*)(ws + WS_KS) + ((size_t)MP + 4 * bs) * KVW + g * 64, KVW, 4, lane); stage_bf16_rows(my + 8192, (const bf16*)(ws + WS_VS) + ((size_t)MP + 4 * bs) * KVW + g * 64, KVW, 4, lane);
        asm volatile("s_waitcnt lgkmcnt(0)" ::: "memory");
        const float bias[2] = {rowbias, 0.f}; const int lo[2] = {0, 0}, hi[2] = {tq, tq};
        attn_block<true>(my, my + 8192, true, false, qr, bias, lo, hi, acc, lsum, fr, fq);
        asm volatile("s_waitcnt lgkmcnt(0)" ::: "memory"); }
    if ((cnt++ & 7) == wave) {
        stage_bf16_rows(my, (const bf16*)(ws + WS_KW) + ((size_t)MP + 4 * bs) * KVW + g * 64, KVW, 4, lane); stage_bf16_rows(my + 8192, (const bf16*)(ws + WS_VW) + ((size_t)MP + 4 * bs) * KVW + g * 64, KVW, 4, lane);
        asm volatile("s_waitcnt lgkmcnt(0)" ::: "memory");
        const float bias[2] = {0.f, rowbias}; const int lo[2] = {0, 0}, hi[2] = {tq, tq};
        attn_block<true>(my, my + 8192, false, true, qr, bias, lo, hi, acc, lsum, fr, fq);
        asm volatile("s_waitcnt lgkmcnt(0)" ::: "memory"); }
    __builtin_amdgcn_s_barrier(); asm volatile("" ::: "memory");
    { LAS float* red = (LAS float*)lds + wave * (2 * 17 * 64);
#pragma unroll
      for (int br = 0; br < 2; ++br) {
#pragma unroll
          for (int d = 0; d < 4; ++d)
#pragma unroll
              for (int e = 0; e < 4; ++e) red[(br * 17 + 4 * d + e) * 64 + lane] = acc[br][d][e];
          red[(br * 17 + 16) * 64 + lane] = lsum[br]; } }
    asm volatile("s_waitcnt lgkmcnt(0)" ::: "memory"); __builtin_amdgcn_s_barrier(); asm volatile("" ::: "memory");
    if (wave == 0) {
        float outv[16];
        const float gc = GATES[row * 48 + (g * 4 + h) * 3 + 0] / lc;
#pragma unroll
        for (int d = 0; d < 4; ++d)
#pragma unroll
            for (int e = 0; e < 4; ++e) outv[4 * d + e] = oc[0][d][e] * gc;
#pragma unroll
        for (int br = 0; br < 2; ++br) { float ls = 0.f; float ob[16];
#pragma unroll
            for (int k = 0; k < 16; ++k) ob[k] = 0.f;
#pragma unroll 1
            for (int w = 0; w < 8; ++w) { const LAS float* red = (const LAS float*)lds + w * (2 * 17 * 64);
#pragma unroll
                for (int k = 0; k < 16; ++k) ob[k] += red[(br * 17 + k) * 64 + lane];
                ls += red[(br * 17 + 16) * 64 + lane]; }
            ls += __shfl_xor(ls, 16); ls += __shfl_xor(ls, 32);
            const float gb = GATES[row * 48 + (g * 4 + h) * 3 + 1 + br] * (ls > 0.f ? 1.f / ls : 0.f);
#pragma unroll
            for (int k = 0; k < 16; ++k) outv[k] += ob[k] * gb; }
#pragma unroll
        for (int d = 0; d < 4; ++d) { v2u w; w.x = pk2(outv[4 * d], outv[4 * d + 1]); w.y = pk2(outv[4 * d + 2], outv[4 * d + 3]); if (mine) *(v2u*)(O + row * D + hc + 16 * d + 4 * fq) = w; }
    }
    asm volatile("s_waitcnt lgkmcnt(0)" ::: "memory"); __builtin_amdgcn_s_barrier(); asm volatile("" ::: "memory");
}
__device__ __forceinline__ void attention_phase(const In& I, unsigned char* ws, LAS unsigned char* lds, int vcu, int G) {
    int tid_ = threadIdx.x; asm volatile("" : "+v"(tid_));
    const int wave = __builtin_amdgcn_readfirstlane(tid_ >> 6), lane = tid_ & 63;
#pragma unroll 1
    for (int k = vcu; k < 1024; k += G) { int bg = k & 7, qb = 127 - (k >> 3);
        if (G == 256) { const int i = k >> 8, j = vcu & 31; bg = vcu >> 5; qb = i == 0 ? 127 - j : (i == 1 ? 64 + j : (i == 2 ? 63 - j : j)); }
        asm volatile("; MARK_PROMPT_UNIT");
        attn_prompt_unit(ws, lds, bg >> 2, bg & 3, qb, wave, lane); }
#pragma unroll 1
#ifdef PROBE_TWICE_SAMPLE
    for (int rep = 0; rep < 2; ++rep)
#endif
    for (int k = vcu; k < 256; k += G) { asm volatile("; MARK_SAMPLE_UNIT"); attn_sample_unit(I, ws, lds, k >> 3, (k >> 1) & 3, k & 1, wave, lane); }
    asm volatile("; MARK_ATT_END");
}

#ifdef PROBE_TEAM_TICKS
#define PROBE_TB_T0 if (threadIdx.x == 0) ((volatile LAS unsigned*)(lds + MISC_OFF))[14] = (unsigned)__builtin_amdgcn_s_memrealtime();
#define PROBE_TB_T1 if (threadIdx.x == 0) ((volatile LAS unsigned*)(lds + MISC_OFF))[13] += (unsigned)__builtin_amdgcn_s_memrealtime() - ((volatile LAS unsigned*)(lds + MISC_OFF))[14];
#else
#define PROBE_TB_T0
#define PROBE_TB_T1
#endif
#ifdef PROBE_SK_TICKS
#define PROBE_SK_T0 if (threadIdx.x == 0) ((volatile LAS unsigned*)(lds + MISC_OFF))[14] = (unsigned)__builtin_amdgcn_s_memrealtime();
#define PROBE_SK_T1 __syncthreads(); if (threadIdx.x == 0) ((volatile LAS unsigned*)(lds + MISC_OFF))[13] += (unsigned)__builtin_amdgcn_s_memrealtime() - ((volatile LAS unsigned*)(lds + MISC_OFF))[14];
#else
#define PROBE_SK_T0
#define PROBE_SK_T1
#endif
#ifdef PROBE_SK2_TICKS
#define PROBE_SK2_T0 if (threadIdx.x == 0) ((volatile LAS unsigned*)(lds + MISC_OFF))[14] = (unsigned)__builtin_amdgcn_s_memrealtime();
#define PROBE_SK2_T1 __syncthreads(); if (threadIdx.x == 0) ((volatile LAS unsigned*)(lds + MISC_OFF))[13] += (unsigned)__builtin_amdgcn_s_memrealtime() - ((volatile LAS unsigned*)(lds + MISC_OFF))[14];
#else
#define PROBE_SK2_T0
#define PROBE_SK2_T1
#endif
#ifdef PROBE_GW
__device__ float g_w[256];
#define PROBE_BAR_T0 const unsigned pb0_ = (unsigned)__builtin_amdgcn_s_memrealtime();
#define PROBE_BAR_T1 if (pid == PROBE_PID && threadIdx.x == 0) __hip_atomic_store(&g_w[blockIdx.x & 255], (float)((unsigned)__builtin_amdgcn_s_memrealtime() - pb0_) * 0.01f, __ATOMIC_RELAXED, __HIP_MEMORY_SCOPE_AGENT);
#elif defined(PROBE_BAR_TICKS)
#define PROBE_BAR_T0 if (threadIdx.x == 0) ((volatile LAS unsigned*)(lds + MISC_OFF))[14] = (unsigned)__builtin_amdgcn_s_memrealtime();
#define PROBE_BAR_T1 if (threadIdx.x == 0) ((volatile LAS unsigned*)(lds + MISC_OFF))[13] += (unsigned)__builtin_amdgcn_s_memrealtime() - ((volatile LAS unsigned*)(lds + MISC_OFF))[14];
#else
#define PROBE_BAR_T0
#define PROBE_BAR_T1
#endif
#ifdef PROBE_EPI_TICKS
#define PROBE_END_SEAM SEAM();
#else
#define PROBE_END_SEAM
#endif
#ifdef PROBE_TWICE_ATT
#define PROBE_ATT SEAM(); attention_phase(I, ws, lds, vcu, G);
#else
#define PROBE_ATT
#endif
#ifndef NSA_MIXER_BODY
#define NSA_MIXER_BODY { CmpSrc cs{out + O_KCP, out + O_VCP, nullptr, 0, 2, 2}; compress_phase(I, ws, lds, cs, vcu, G); } SEAM(); \
    attention_phase(I, ws, lds, vcu, G); PROBE_ATT SEAM();
#endif

struct Args { const void* in[26]; float* out; unsigned char* ws; int ph_lo, ph_hi; };
__global__ void __launch_bounds__(NWAVES * 64, 2) fwd(Args args) {
    extern __shared__ __attribute__((aligned(16))) unsigned char lds_[];
    LAS unsigned char* lds = (LAS unsigned char*)lds_;
    const int tid = threadIdx.x, lane = tid & 63, wave = __builtin_amdgcn_readfirstlane(tid >> 6);
    const int G = gridDim.x; int vcu; { const int bx = blockIdx.x; vcu = (G % 8 == 0) ? (bx % 8) * (G / 8) + bx / 8 : bx; }
    unsigned char* ws = args.ws; float* out = args.out;
    gu32* ctl = (gu32*)(ws + WS_CTL);
    In I;
    I.x_prompt = (const float*)args.in[0]; I.x_sample = (const float*)args.in[1]; I.state_conv = (const float*)args.in[2]; I.ck_cmp = (const float*)args.in[3]; I.cv_cmp = (const float*)args.in[4];
    I.ck_sel = (const float*)args.in[5]; I.cv_sel = (const float*)args.in[6]; I.ck_win = (const float*)args.in[7]; I.cv_win = (const float*)args.in[8]; I.page_table = (const int*)args.in[9];
    I.p_prompt = (const float*)args.in[10]; I.p_sample = (const float*)args.in[11]; I.norm_g = (const float*)args.in[12]; I.w_gu = (const float*)args.in[13]; I.w_down = (const float*)args.in[14];
    I.w_proj = (const float*)args.in[15]; I.w_gate = (const float*)args.in[16]; I.cw_in = (const float*)args.in[17]; I.cw = (const float*)args.in[18]; I.cw_out = (const float*)args.in[19];
    I.nw_in = (const float*)args.in[20]; I.qk_g = (const float*)args.in[21]; I.cmp_pos = (const float*)args.in[22]; I.cmp_w1 = (const float*)args.in[23]; I.cmp_w2 = (const float*)args.in[24]; I.nw_out = (const float*)args.in[25];
    for (int u = tid; u < (LDS_BYTES - LDSCTL_OFF) / 4; u += NWAVES * 64) ((LAS unsigned*)(lds + LDSCTL_OFF))[u] = 0u;
    __syncthreads();
    (void)xcd_barrier_post((unsigned*)ctl + CW_BAR, (volatile LAS unsigned*)(lds + MISC_OFF) + 8);
    const int hi = args.ph_hi; int pid = 0;
    const bool team_ok = (G == 256);
    unsigned* const ctlw = (unsigned*)(ws + WS_CTL);
    if (team_ok && tid == 0) __hip_atomic_store(ctlw + CW_XCC + blockIdx.x, xb_xcc_id() + 1u, __ATOMIC_RELAXED, __HIP_MEMORY_SCOPE_AGENT);
    unsigned tep = 0u, sk_need = 0u, sk_pend = 0u; bool arrived = false;
#define SEAM() do { asm volatile("; SEAM_MARK %0" :: "i"(__LINE__)); ++pid; if (pid >= hi) return; if (sk_pend) { asm volatile("s_waitcnt vmcnt(0)" ::: "memory"); __syncthreads(); if (threadIdx.x == 0) (void)xb_add((unsigned*)(ws + WS_CTL) + CW_SKCNT, sk_pend); sk_pend = 0u; } XcdBarrier b_; b_.bar = (unsigned*)(ws + WS_CTL) + CW_BAR; b_.x = xb_xcc_id(); b_.st = (volatile LAS unsigned*)(lds + MISC_OFF) + 8; PROBE_BAR_T0 xcd_barrier(b_); PROBE_BAR_T1 } while (0)
#define SEAM_T() do { if (!team_ok) { SEAM(); } else { asm volatile("; SEAM_T_MARK %0" :: "i"(__LINE__)); ++pid; if (pid >= hi) return; \
      if (arrived) { PROBE_TB_T0 team_wait((unsigned*)(ws + WS_CTL), 4u * tep, sk_pend); PROBE_TB_T1 } \
      else { ++tep; PROBE_TB_T0 team_barrier((unsigned*)(ws + WS_CTL), 4u * tep, (volatile LAS unsigned*)(lds + MISC_OFF) + 12, sk_pend); PROBE_TB_T1 } sk_pend = 0u; arrived = false; } } while (0)
#define TEAM_ARRIVE() do { if (team_ok) { ++tep; team_arrive((unsigned*)(ws + WS_CTL), (volatile LAS unsigned*)(lds + MISC_OFF) + 12); arrived = true; } } while (0)


    bf16* const XB_0 = (bf16*)(ws + WS_XB); bf16* const XB_1 = (bf16*)(ws + WS_XB + SZ_XB);
    float* const SS_0 = (float*)(ws + WS_SS); float* const SS_1 = (float*)(ws + WS_SS + SZ_SS);
    bf16* const Hb = (bf16*)(ws + WS_H); bf16* const ACb = (bf16*)(ws + WS_AC);
    bf16* const PBb = (bf16*)(ws + WS_PB); bf16* const Pb = (bf16*)(ws + WS_P);

#ifdef PROBE_EPI_TICKS
    if (blockIdx.x == 0 && tid == 0) g_ticks_store = 0ull;
#endif
#ifdef PH_HI_OVERRIDE
    { const size_t gt = (size_t)(vcu * NWAVES + wave) * 64 + lane, NT = (size_t)G * NWAVES * 64;
      for (size_t i = DBG_FILL_FROM / 4 + gt; i < O_END / 4; i += NT) ((GAS f32x4*)out)[i] = (f32x4){0.f, 0.f, 0.f, 0.f}; }
#endif
    p0_prologue(I, out, ws, lds, vcu, G, wave, lane);
    cmp_bias_partials(I, ws, vcu, G, wave, lane);
#ifdef PROBE_TWICE_PRO
    SEAM(); p0_prologue(I, out, ws, lds, vcu, G, wave, lane);
#endif
    SEAM();
    if (team_ok && tid == 0) { const int t0 = (int)blockIdx.x & 63; unsigned x0 = xb_ld(ctlw + CW_XCC + t0), same = 1u;
        for (int m = 1; m < 4; ++m) same = (xb_ld(ctlw + CW_XCC + t0 + 64 * m) == x0) ? same : 2u;
        ((volatile LAS unsigned*)(lds + MISC_OFF))[12] = same; }
#define SK_REM(units_) ((units_) % G)
#define SK_FIRST(units_) ((SK_REM(units_) == 0 || (int)blockIdx.x >= SK_REM(units_)) ? (G - 1 - (int)blockIdx.x) : 0x3fffffff)
#define SK_STRIDE(units_) (SK_REM(units_) == 0 ? G : G - SK_REM(units_))
#define PH_PROJ(l) { const bf16* Wp = (const bf16*)(ws + WS_WPROJ + (size_t)(l) * SZ_WPROJ); int kk_ = PLE; asm volatile("" : "+s"(kk_)); \
      pg8::Gemm g{PBb + (size_t)(l) * MT * PLE, Wp, MP, D, kk_}; GOrder S; S.init(MP, D, G, (int)blockIdx.x); pg8::EpiRaw<false> E{Pb + (size_t)(l) * MT * D, D, nullptr}; \
      pg8::gemm_phase<pg8::EpiRaw<false>, GOrder, true, true>(lds, g, S, E); \
      SkRaw<false> SE{Pb + (size_t)(l) * MT * D, D, nullptr}; skinny_phase<0, 4>(lds, PBb + ((size_t)(l) * MT + MP) * PLE, Wp, PLE, D / 64, SE, SK_FIRST(256), SK_STRIDE(256), nullptr, 0u, sk_pend); }
    PH_PROJ(0)
    PH_PROJ(1)
    { CmpSrc cs{I.ck_cmp, I.cv_cmp, I.page_table, 2, 32, 16}; compress_phase(I, ws, lds, cs, vcu, G); }
    ++pid;

#define XBP(c) ((bf16*)(ws + WS_XB + (size_t)(c) * SZ_XB))
#define SSP(c) ((float*)(ws + WS_SS + (size_t)(c) * SZ_SS))
#define SSSP(c) ((float*)(ws + WS_SSS + (size_t)(c) * SZ_SSS))
#define PH_GU(l, s, c, ARR) { const bf16* Wgu = (const bf16*)(ws + WS_WGU + (size_t)((l) * 2 + (s)) * SZ_WGU); \
      pg8::Gemm g{XBP(c), Wgu, MP, NGU, D}; GOrder S; S.init(MP, NGU, G, (int)blockIdx.x); pg8::EpiSwiglu E{Hb, SSP(c)}; \
      pg8::gemm_phase<pg8::EpiSwiglu, GOrder, true, true>(lds, g, S, E); if (ARR) TEAM_ARRIVE(); \
      PROBE_SK_T0 SkSwiglu SE{Hb, SSSP(c)}; skinny_phase<1, 4>(lds, XBP(c) + (size_t)MP * D, Wgu, D, FF / 32, SE, SK_FIRST(64 * (NGU / 256)), SK_STRIDE(64 * (NGU / 256)), ctlw, sk_need, sk_pend); sk_need += 4u * (FF / 32); PROBE_SK_T1 }
#define PH_RESID(Asrc, K_, Wt, scale, c, SKS, ARR, LOW) { pg8::Gemm g{(Asrc), (const bf16*)(Wt), MP, D, (K_)}; GOrder S; S.init(MP, D, G, (int)blockIdx.x); \
      pg8::EpiResid<false, false> E{XBP(c), nullptr, XBP((c) ^ 1), SSP((c) ^ 1), (scale), nullptr, nullptr}; \
      pg8::gemm_phase<pg8::EpiResid<false, false>, GOrder, true, true>(lds, g, S, E); if (ARR) TEAM_ARRIVE(); \
      if (SKS) { PROBE_SK2_T0 SkResid<false> SE{XBP(c), nullptr, XBP((c) ^ 1), SSSP((c) ^ 1), (scale), nullptr, nullptr, 0};   \
      skinny_phase<0, 2>(lds, (Asrc) + (size_t)MP * (K_), (const bf16*)(Wt), (K_), D / 32, SE, ((LOW) && team_ok) ? ((int)blockIdx.x < 128 ? (int)blockIdx.x : 0x3fffffff) : SK_FIRST(256), SK_STRIDE(256), ctlw, sk_need, sk_pend); sk_need += 4u * (D / 32); PROBE_SK2_T1 } }
#define PH_RAW(Wt, N_, NCU_, c, Ob, HI) { pg8::Gemm g{XBP(c), (const bf16*)(Wt), MP, (N_), D}; GOrder S; S.init(MP, (N_), G, (int)blockIdx.x); pg8::EpiRaw<true> E{(Ob), (N_), SSP(c)}; \
      pg8::gemm_phase<pg8::EpiRaw<true>, GOrder, true, true>(lds, g, S, E); \
      SkRaw<true> SE{(Ob), (N_), SSSP(c)}; skinny_phase<0, 4>(lds, XBP(c) + (size_t)MP * D, (const bf16*)(Wt), D, (NCU_), SE, ((HI) && team_ok) ? ((int)blockIdx.x >= 128 ? (int)blockIdx.x - 128 : 0x3fffffff) : SK_FIRST(64 * ((N_) / 256)), ((HI) && team_ok) ? 128 : SK_STRIDE(64 * ((N_) / 256)), ctlw, sk_need, sk_pend); sk_need += 4u * (NCU_); }
#define PH_GATE(l, c, FIN, ARR) { const bf16* Wg = (const bf16*)(ws + WS_WGATE + (size_t)(l) * SZ_WSQ); const bf16* Pl = Pb + (size_t)(l) * MT * D; \
      pg8::Gemm g{XBP(c), Wg, MP, D, D}; GOrder S; S.init(MP, D, G, (int)blockIdx.x); pg8::EpiResid<true, FIN> E{XBP(c), out, XBP((c) ^ 1), SSP((c) ^ 1), 1.0f, SSP(c), Pl}; \
      pg8::gemm_phase<pg8::EpiResid<true, FIN>, GOrder, true, true>(lds, g, S, E); if (ARR) TEAM_ARRIVE(); \
      SkResid<true> SE{XBP(c), out, XBP((c) ^ 1), SSSP((c) ^ 1), 1.0f, SSSP(c), Pl, FIN};   \
      skinny_phase<0, 2>(lds, XBP(c) + (size_t)MP * D, Wg, D, D / 32, SE, ((FIN) && team_ok) ? ((int)blockIdx.x < 128 ? (int)blockIdx.x : 0x3fffffff) : SK_FIRST(256), SK_STRIDE(256), ctlw, sk_need, sk_pend); sk_need += 4u * (D / 32); }

    PH_GU(0, 0, 0, 1) SEAM_T();
    PH_RESID(Hb, FF, ws + WS_WDN + 0 * SZ_WDN, 0.5f, 0, 1, 1, 1) SEAM_T();
    PH_RAW(ws + WS_WCIN, NCV, NCV / 64, 1, (bf16*)(ws + WS_CV), 1) SEAM();
    conv_post(I, out, ws, vcu, G, wave, lane); SEAM();
#ifdef PROBE_TWICE_POST
    conv_post(I, out, ws, vcu, G, wave, lane); SEAM();
#endif
    PH_RESID(ACb, D, ws + WS_WCOUT, 1.0f, 1, 1, 1, 0) SEAM_T();
    PH_GU(0, 1, 0, 1) SEAM_T();
    PH_RESID(Hb, FF, ws + WS_WDN + 1 * SZ_WDN, 0.5f, 0, 1, 1, 0) SEAM_T();
    PH_GATE(0, 1, false, 1) SEAM_T();
    PH_GU(1, 0, 0, 1) SEAM_T();
    PH_RESID(Hb, FF, ws + WS_WDN + 2 * SZ_WDN, 0.5f, 0, 1, 1, 0) SEAM_T();
    PH_RAW(ws + WS_WNIN, NNSP, (NNS + 63) / 64, 1, Hb, 0) SEAM();
    nsa_post(I, out, ws, vcu, G, wave, lane); SEAM();
#ifdef PROBE_TWICE_POST
    nsa_post(I, out, ws, vcu, G, wave, lane); SEAM();
#endif
    NSA_MIXER_BODY
    PH_RESID(ACb, D, ws + WS_WNOUT, 1.0f, 1, 1, 1, 0) SEAM_T();
    PH_GU(1, 1, 0, 1) SEAM_T();
    PH_RESID(Hb, FF, ws + WS_WDN + 3 * SZ_WDN, 0.5f, 0, 1, 1, 0) SEAM_T();
    PH_GATE(1, 1, true, 0)
#ifdef PROBE_EPI_TICKS
    if ((PROBE_COND) && tid == 0) atomicAdd(g_probe_ticks, (unsigned long long)((volatile LAS unsigned*)(lds + MISC_OFF))[13]);
#endif
    PROBE_END_SEAM
#ifdef PROBE_EPI_TICKS
#ifdef PROBE_GW
    { float us = 0.f; { PROBE_STAT }
#else
    { const float us = (float)__hip_atomic_load(&g_ticks_store, __ATOMIC_RELAXED, __HIP_MEMORY_SCOPE_AGENT) * 0.01f * PROBE_MUL;
#endif
      const float sc = 1.f + sqrtf(us * 1e-6f);
      const size_t gt = (size_t)(vcu * NWAVES + wave) * 64 + lane, NT = (size_t)G * NWAVES * 64;
      for (size_t i = O_CONVS / 4 + gt; i < O_KCP / 4; i += NT) ((GAS f32x4*)out)[i] *= sc; }
#endif
#ifdef DBG_SCALE_FROM
    { const size_t gt = (size_t)(vcu * NWAVES + wave) * 64 + lane, NT = (size_t)G * NWAVES * 64;
      for (size_t i = (DBG_SCALE_FROM) / 4 + gt; i < (DBG_SCALE_TO) / 4; i += NT) ((GAS f32x4*)out)[i] *= 1.2f; }
#endif
#undef SEAM
}

#ifdef PH_HI_OVERRIDE
#define PH_HI PH_HI_OVERRIDE
#endif
#ifndef PH_HI
#define PH_HI 1000
#endif
extern "C" void kernel_launch(void* const* d_in, const int* in_sizes, int n_in, void* d_out, int out_size, void* d_ws, size_t ws_size, hipStream_t stream) {
    static int grid = 0;
    if (grid == 0) {
        if (n_in != 26 || out_size != (int)O_END || ws_size < WS_END) { fprintf(stderr, "kernel_launch: unexpected sizes n_in %d out %d ws %zu (need %zu)\n", n_in, out_size, ws_size, (size_t)WS_END); grid = -1; return; }
        int dev = 0, cus = 0, per_cu = 0;
        if (hipGetDevice(&dev) != hipSuccess || hipDeviceGetAttribute(&cus, hipDeviceAttributeMultiprocessorCount, dev) != hipSuccess) { grid = -1; return; }
        if (hipFuncSetAttribute((const void*)fwd, hipFuncAttributeMaxDynamicSharedMemorySize, LDS_BYTES) != hipSuccess) { fprintf(stderr, "kernel_launch: hipFuncSetAttribute failed\n"); grid = -1; return; }
        if (hipOccupancyMaxActiveBlocksPerMultiprocessor(&per_cu, (const void*)fwd, NWAVES * 64, LDS_BYTES) != hipSuccess || per_cu < 1) { fprintf(stderr, "kernel_launch: occupancy query says %d\n", per_cu); (void)hipGetLastError(); grid = -1; return; }
        grid = cus;
    }
    if (grid < 0) return;
    (void)hipMemsetAsync((char*)d_ws + WS_CTL, 0, CTL_ZERO_BYTES, stream);
    Args a{};
    for (int i = 0; i < 26; ++i) a.in[i] = d_in[i];
    a.out = (float*)d_out; a.ws = (unsigned char*)d_ws; a.ph_lo = 0; a.ph_hi = PH_HI;
    hipLaunchKernelGGL(fwd, dim3(grid), dim3(NWAVES * 64), LDS_BYTES, stream, a);
}
```
